# Optimizing an MI355X kernel written in HIP

```python
import math
import jax, jax.numpy as jnp
from jax import lax
import numpy as np

D_MODEL = 2048
BATCH = 4
SEQ = 4096
DEPTH = 4

GRID_W = 64
CTX_LEN = 256
EPS = 1e-6
CONV_K = 3
CHUNK = 128
N_BRANCH = 4
BRANCH_WIDTH = D_MODEL // 2
SSD_INNER = BRANCH_WIDTH
SSD_HEAD_DIM = 64
SSD_HEADS = SSD_INNER // SSD_HEAD_DIM
SSD_GROUPS = 4
SSD_STATE = 128
SSD_CONV_CH = SSD_INNER + 2 * SSD_GROUPS * SSD_STATE
POOL_WIDTH = BRANCH_WIDTH
POOL_WINDOWS = (2, 4, 8, 16)
N_POOL = len(POOL_WINDOWS)
POOL_GROUP = POOL_WIDTH // N_POOL
SC_WIDTH = BRANCH_WIDTH
RET_V = BRANCH_WIDTH
RET_HEADS = 8
RET_V_HEAD = RET_V // RET_HEADS
RET_K_HEAD = RET_V_HEAD // 2
RET_QK = RET_HEADS * RET_K_HEAD
ROPE_BASE = 10000.0
D_FF = 256 * ((8 * D_MODEL // 3 + 255) // 256)
SPLIT_SIZES = (SSD_INNER, SSD_CONV_CH, SSD_HEADS, POOL_WIDTH, SC_WIDTH, SC_WIDTH, SC_WIDTH,
               RET_QK, RET_QK, RET_V, RET_V)
IN_COLS = sum(SPLIT_SIZES)
SPLIT_OFFSETS = tuple(int(o) for o in np.cumsum(SPLIT_SIZES)[:-1])

kernel_name = 'hybrid_ssd_pool_shortconv_retention_dit'


def rmsnorm(x, w):
    xf = x.astype(jnp.float32)
    y = xf * lax.rsqrt(jnp.mean(jnp.square(xf), axis=-1, keepdims=True) + EPS)
    return (y * w).astype(x.dtype)


def head_layernorm(y):
    yf = y.astype(jnp.float32)
    mu = jnp.mean(yf, axis=-1, keepdims=True)
    var = jnp.mean(jnp.square(yf - mu), axis=-1, keepdims=True)
    return ((yf - mu) * lax.rsqrt(var + EPS)).astype(y.dtype)


def modulate(h, shift, scale):
    return h * (1.0 + scale) + shift


def dwconv_centered(u, w):
    k_taps = w.shape[0]
    pad = k_taps // 2
    n = u.shape[1]
    up = jnp.pad(u, ((0, 0), (pad, pad), (0, 0)))
    y = up[:, 0:n] * w[0]
    for j in range(1, k_taps):
        y = y + up[:, j:j + n] * w[j]
    return y


def chunked_scan(q, k, v, log_a, h0):
    bsz, n, nh, dn = q.shape
    dp = v.shape[-1]
    nc = n // CHUNK
    f32 = jnp.float32
    qc = q.astype(f32).reshape(bsz, nc, CHUNK, nh, dn)
    kc = k.astype(f32).reshape(bsz, nc, CHUNK, nh, dn)
    vc = v.astype(f32).reshape(bsz, nc, CHUNK, nh, dp)
    cum = jnp.cumsum(log_a.astype(f32).reshape(bsz, nc, CHUNK, nh), axis=2)
    causal = jnp.tril(jnp.ones((CHUNK, CHUNK), dtype=bool))[None, None, :, :, None]
    seg = cum[:, :, :, None, :] - cum[:, :, None, :, :]
    decay = jnp.exp(jnp.where(causal, seg, -jnp.inf))
    scores = jnp.einsum('bcihn,bcjhn->bcijh', qc, kc) * decay
    y_intra = jnp.einsum('bcijh,bcjhp->bcihp', scores, vc)
    last = cum[:, :, -1:, :]
    w_in = jnp.exp(last - cum)
    states = jnp.einsum('bcjhn,bcjhp->bchnp', kc * w_in[..., None], vc)
    chunk_decay = jnp.exp(last[:, :, 0, :])

    def step(h, inp):
        s, d = inp
        return h * d[:, :, None, None] + s, h

    h_final, h_enter = lax.scan(step, h0.astype(f32),
                                (jnp.moveaxis(states, 1, 0), jnp.moveaxis(chunk_decay, 1, 0)))
    h_enter = jnp.moveaxis(h_enter, 0, 1)
    y_inter = jnp.einsum('bcihn,bchnp->bcihp', qc, h_enter) * jnp.exp(cum)[..., None]
    y = (y_intra + y_inter).reshape(bsz, n, nh, dp)
    return y.astype(q.dtype), h_final


def bidir_scan(q, k, v_f, v_b, la_f, la_b, h0_f, h0_b):
    y_f, h_f = chunked_scan(q, k, v_f, la_f, h0_f)
    fl = lambda a: jnp.flip(a, axis=1)
    y_b, h_b = chunked_scan(fl(q), fl(k), fl(v_b), fl(la_b), h0_b)
    return y_f + fl(y_b), h_f, h_b


def axial_rope(t, rows):
    dh = t.shape[-1]
    half = dh // 2
    quarter = half // 2
    f32 = jnp.float32
    row = jnp.repeat(jnp.arange(rows), GRID_W).astype(f32)
    col = jnp.tile(jnp.arange(GRID_W), rows).astype(f32)
    inv = ROPE_BASE ** (-jnp.arange(quarter, dtype=f32) / quarter)

    def rot(xp, pos):
        ang = pos[:, None] * inv[None, :]
        cos = jnp.cos(ang)[None, :, None, :]
        sin = jnp.sin(ang)[None, :, None, :]
        x1 = xp[..., :quarter].astype(f32)
        x2 = xp[..., quarter:].astype(f32)
        return jnp.concatenate([x1 * cos - x2 * sin, x1 * sin + x2 * cos], axis=-1)

    return jnp.concatenate([rot(t[..., :half], row), rot(t[..., half:], col)], axis=-1).astype(t.dtype)


def multiscale_pool(u, pool_w, pool_scale):
    bsz, n, _ = u.shape
    f32 = jnp.float32
    g = u.reshape(bsz, n, N_POOL, POOL_GROUP).astype(f32)
    cs = jnp.pad(jnp.cumsum(g, axis=1), ((0, 0), (1, 0), (0, 0), (0, 0)))
    t = jnp.arange(n)
    means = []
    for gi, win in enumerate(POOL_WINDOWS):
        lo = jnp.clip(t - win // 2, 0, n)
        hi = jnp.clip(t - win // 2 + win, 0, n)
        csg = cs[:, :, gi]
        s = csg[:, hi] - csg[:, lo]
        means.append(s / (hi - lo).astype(f32)[None, :, None])
    pooled = (jnp.stack(means, axis=2) - g).astype(u.dtype)
    y = jnp.einsum('blgc,gcd->blgd', pooled, pool_w)
    return y.reshape(bsz, n, POOL_WIDTH) * pool_scale


def stream_features(h, lp, rows):
    bsz, n, _ = h.shape
    f32 = jnp.float32
    u = h @ lp['w_in']
    z, xbc, dt_raw, pool_in, sc_b, sc_c, sc_x, rq, rk, rv, rg = jnp.split(u, SPLIT_OFFSETS, axis=-1)
    xbc = jax.nn.silu(dwconv_centered(xbc, lp['ssd_conv_w']) + lp['ssd_conv_b'])
    xs, bm, cm = jnp.split(xbc, (SSD_INNER, SSD_INNER + SSD_GROUPS * SSD_STATE), axis=-1)
    xh = xs.reshape(bsz, n, SSD_HEADS, SSD_HEAD_DIM)
    rep = SSD_HEADS // SSD_GROUPS
    bm = jnp.repeat(bm.reshape(bsz, n, SSD_GROUPS, SSD_STATE), rep, axis=2)
    cm = jnp.repeat(cm.reshape(bsz, n, SSD_GROUPS, SSD_STATE), rep, axis=2)
    dt = jax.nn.softplus(dt_raw.astype(f32)[:, :, None, :] + lp['ssd_dt_bias'].astype(f32))
    a = -jnp.exp(lp['ssd_a_log'].astype(f32))
    la = dt * a
    v = xh[:, :, None] * dt[..., None]
    ssd = (cm, bm, v[:, :, 0], v[:, :, 1], la[:, :, 0], la[:, :, 1])
    q = rq.reshape(bsz, n, RET_HEADS, RET_K_HEAD) * (RET_K_HEAD ** -0.5)
    k = rk.reshape(bsz, n, RET_HEADS, RET_K_HEAD)
    if rows is not None:
        q = axial_rope(q, rows)
        k = axial_rope(k, rows)
    vr = rv.reshape(bsz, n, RET_HEADS, RET_V_HEAD)
    la_r = jnp.broadcast_to(jax.nn.log_sigmoid(lp['ret_decay_logit'].astype(f32)), (bsz, n, 2, RET_HEADS))
    ret = (q, k, vr, vr, la_r[:, :, 0], la_r[:, :, 1])
    return dict(ssd=ssd, ret=ret, xh=xh, z=z, pool_in=pool_in, sc=(sc_b, sc_c, sc_x), rg=rg)


def mixer_out(h, f, y_ssd_scan, y_ret_scan, lp):
    bsz, n, _ = h.shape
    y = (y_ssd_scan + f['xh'] * lp['ssd_d'][:, None]).reshape(bsz, n, SSD_INNER)
    y_ssd = rmsnorm(y * jax.nn.silu(f['z']), lp['ssd_norm_w'])
    y_pool = multiscale_pool(f['pool_in'], lp['pool_w'], lp['pool_scale'])
    sc_b, sc_c, sc_x = f['sc']
    y_sc = sc_b * dwconv_centered(sc_c * sc_x, lp['sconv_w'])
    y_ret = jax.nn.silu(f['rg']) * head_layernorm(y_ret_scan).reshape(bsz, n, RET_V)
    merged = None
    for i, yb in enumerate((y_ssd, y_pool, y_sc, y_ret)):
        gate = jax.nn.sigmoid(h @ lp['w_gate'][i] + lp['b_gate'][i])
        term = gate * (yb @ lp['w_branch'][i])
        merged = term if merged is None else merged + term
    return merged @ lp['w_o']


def conv_ffn(h, lp):
    u = dwconv_centered(h @ lp['ffn_up'], lp['ffn_conv_w']) + lp['ffn_conv_b']
    a, b = jnp.split(u, 2, axis=-1)
    return (jax.nn.silu(a) * b) @ lp['ffn_down']


def setup_inputs(seed: int = 0) -> dict:
    key = jax.random.key(seed)
    k = jax.random.split(key, 28)
    f32 = jnp.float32
    L, D = DEPTH, D_MODEL

    def nrm(kk, shape, scale):
        return jax.random.normal(kk, shape, f32) * scale

    def gain(kk, shape):
        return 1.0 + nrm(kk, shape, 0.02)

    dt0 = jnp.exp(jax.random.uniform(k[11], (L, 2, SSD_HEADS), f32, math.log(1e-3), math.log(1e-1)))
    gam = 1.0 - jnp.exp2(-(5.0 + jnp.arange(RET_HEADS, dtype=f32)))
    gam_logit = jnp.log(gam) - jnp.log1p(-gam)
    return {
        'x': nrm(k[0], (BATCH, SEQ, D), 1.0),
        'c': nrm(k[1], (BATCH, D), 1.0),
        'ctx': nrm(k[2], (BATCH, CTX_LEN, D), 1.0),
        'c_ctx': nrm(k[3], (D,), 1.0),
        'w_mod': nrm(k[4], (L, D, 6 * D), 0.5 * D ** -0.5),
        'b_mod': nrm(k[5], (L, 6 * D), 0.01),
        'norm1_w': gain(k[6], (L, D)),
        'w_in': nrm(k[7], (L, D, IN_COLS), D ** -0.5),
        'ssd_conv_w': nrm(k[8], (L, CONV_K, SSD_CONV_CH), CONV_K ** -0.5),
        'ssd_conv_b': nrm(k[9], (L, SSD_CONV_CH), 0.01),
        'ssd_a_log': jnp.log(jax.random.uniform(k[10], (L, 2, SSD_HEADS), f32, 1.0, 16.0)),
        'ssd_dt_bias': dt0 + jnp.log(-jnp.expm1(-dt0)),
        'ssd_d': 1.0 + nrm(k[12], (L, SSD_HEADS), 0.1),
        'ssd_norm_w': gain(k[13], (L, SSD_INNER)),
        'pool_w': nrm(k[14], (L, N_POOL, POOL_GROUP, POOL_GROUP), POOL_GROUP ** -0.5),
        'pool_scale': gain(k[15], (L, POOL_WIDTH)),
        'sconv_w': nrm(k[16], (L, CONV_K, SC_WIDTH), CONV_K ** -0.5),
        'ret_decay_logit': jnp.broadcast_to(gam_logit, (L, 2, RET_HEADS)) + nrm(k[17], (L, 2, RET_HEADS), 0.05),
        'w_branch': nrm(k[18], (L, N_BRANCH, BRANCH_WIDTH, D), BRANCH_WIDTH ** -0.5),
        'w_gate': nrm(k[19], (L, N_BRANCH, D, D), D ** -0.5),
        'b_gate': nrm(k[20], (L, N_BRANCH, D), 0.01),
        'w_o': nrm(k[21], (L, D, D), D ** -0.5),
        'norm2_w': gain(k[22], (L, D)),
        'ffn_up': nrm(k[23], (L, D, 2 * D_FF), D ** -0.5),
        'ffn_conv_w': nrm(k[24], (L, CONV_K, 2 * D_FF), CONV_K ** -0.5),
        'ffn_conv_b': nrm(k[25], (L, 2 * D_FF), 0.01),
        'ffn_down': nrm(k[26], (L, D_FF, D), D_FF ** -0.5),
        'final_norm_w': gain(k[27], (D,)),
    }


def reference(x, c, ctx, c_ctx, w_mod, b_mod, norm1_w, w_in, ssd_conv_w, ssd_conv_b, ssd_a_log,
              ssd_dt_bias, ssd_d, ssd_norm_w, pool_w, pool_scale, sconv_w, ret_decay_logit,
              w_branch, w_gate, b_gate, w_o, norm2_w, ffn_up, ffn_conv_w, ffn_conv_b, ffn_down,
              final_norm_w):
    bsz, n_lat, _ = x.shape
    rows = n_lat // GRID_W
    xl, xc = x, ctx
    ssd0 = jnp.zeros((bsz, SSD_HEADS, SSD_STATE, SSD_HEAD_DIM), jnp.float32)
    ret0 = jnp.zeros((bsz, RET_HEADS, RET_K_HEAD, RET_V_HEAD), jnp.float32)
    for l in range(DEPTH):
        lp = dict(w_in=w_in[l], ssd_conv_w=ssd_conv_w[l], ssd_conv_b=ssd_conv_b[l],
                  ssd_a_log=ssd_a_log[l], ssd_dt_bias=ssd_dt_bias[l], ssd_d=ssd_d[l],
                  ssd_norm_w=ssd_norm_w[l], pool_w=pool_w[l], pool_scale=pool_scale[l],
                  sconv_w=sconv_w[l], ret_decay_logit=ret_decay_logit[l], w_branch=w_branch[l],
                  w_gate=w_gate[l], b_gate=b_gate[l], w_o=w_o[l], ffn_up=ffn_up[l],
                  ffn_conv_w=ffn_conv_w[l], ffn_conv_b=ffn_conv_b[l], ffn_down=ffn_down[l])
        sh1, sc1, g1, sh2, sc2, g2 = jnp.split((jax.nn.silu(c) @ w_mod[l] + b_mod[l])[:, None, :], 6, axis=-1)
        csh1, csc1, cg1, csh2, csc2, cg2 = jnp.split(jax.nn.silu(c_ctx) @ w_mod[l] + b_mod[l], 6, axis=-1)
        hl = modulate(rmsnorm(xl, norm1_w[l]), sh1, sc1)
        hc = modulate(rmsnorm(xc, norm1_w[l]), csh1, csc1)
        fl = stream_features(hl, lp, rows)
        fc = stream_features(hc, lp, None)
        yc_ssd, hf_ssd, hb_ssd = bidir_scan(*fc['ssd'], ssd0, ssd0)
        yc_ret, hf_ret, hb_ret = bidir_scan(*fc['ret'], ret0, ret0)
        yl_ssd, _, _ = bidir_scan(*fl['ssd'], hf_ssd, hb_ssd)
        yl_ret, _, _ = bidir_scan(*fl['ret'], hf_ret, hb_ret)
        xl = xl + g1 * mixer_out(hl, fl, yl_ssd, yl_ret, lp)
        xl = xl + g2 * conv_ffn(modulate(rmsnorm(xl, norm2_w[l]), sh2, sc2), lp)
        if l < DEPTH - 1:
            xc = xc + cg1 * mixer_out(hc, fc, yc_ssd, yc_ret, lp)
            xc = xc + cg2 * conv_ffn(modulate(rmsnorm(xc, norm2_w[l]), csh2, csc2), lp)
    return rmsnorm(xl, final_norm_w)
```

```cpp
#include <hip/hip_runtime.h>
#include <cstdio>
#include <cstdint>

#ifndef MK_PER_PHASE
#define MK_PER_PHASE 0
#endif

namespace pg8 {
#define PG8_LAS __attribute__((address_space(3)))
typedef unsigned short bf16_t;
typedef short bf16x8 __attribute__((ext_vector_type(8)));
typedef float f32x4 __attribute__((ext_vector_type(4)));
typedef unsigned u32x4 __attribute__((ext_vector_type(4)));
constexpr int BM = 256, BK = 64, HALF = 128, HTB = HALF * BK * 2, STAGE_BYTES = 8 * HTB, NXCD = 8, WGM = 8;

__host__ __device__ __forceinline__ int lds_byte(int r, int c) { const int st = (r >> 4) * 2 + (c >> 5), rr = r & 15, cc = c & 31, ob = rr * 64 + cc * 2; return st * 1024 + (ob ^ (((ob >> 9) & 1) << 5)); }
__host__ __device__ __forceinline__ void stage_rc(int b, int& R, int& C) { const int st = b / 1024, sb = b % 1024, swz = sb ^ (((sb >> 9) & 1) << 5); R = (st >> 1) * 16 + swz / 64; C = (st & 1) * 32 + (swz % 64) / 2; }
__host__ __device__ __forceinline__ int perm32(int rho) { const int n = rho >> 4, i = rho & 15; return 8 * (i >> 2) + 4 * n + (i & 3); }

struct Unit { int pm, pn, sub; };
struct Gemm { const char* A; const char* B; size_t a_tile, a_pn, a_sub, b_tile, b_sub; int lda, ldb, K; };

template <int NSUB> struct TileOrder {
    int nM, nN, nwg, G, c, wgm;
    __device__ __forceinline__ void init(int nM_, int nN_, int G_, int c_, int wgm_ = 4) { nM = nM_; nN = nN_; nwg = nM * nN; G = G_; c = c_; wgm = wgm_; }
    __device__ __forceinline__ bool next(int i, Unit& u) const {
        const int sub = i % NSUB; const long L = (long)(i / NSUB) * G + c; if (L >= nwg) return false;
        int wgid = (int)L; { const int q = nwg / NXCD, r = nwg % NXCD, xcd = wgid % NXCD, off = wgid / NXCD; wgid = (xcd < r ? xcd * (q + 1) : r * (q + 1) + (xcd - r) * q) + off; }
        const int nig = wgm * nN, gid = wgid / nig, fm = gid * wgm, gsz = (nM - fm) < wgm ? (nM - fm) : wgm;
        u.pm = fm + ((wgid % nig) % gsz); u.pn = (wgid % nig) / gsz; u.sub = sub; return true;
    }
};

template <int NSUB> struct SplitOrder {
    int nM, nN, pm0, G, c;
    __device__ __forceinline__ void init(int nM_, int nN_, int pm0_, int G_, int c_) { nM = nM_; nN = nN_; pm0 = pm0_; G = G_; c = c_; }
    __device__ __forceinline__ bool next(int i, Unit& u) const {
        const int j = i * G + c; if (j >= nM * nN * NSUB) return false;
        const int tile = j / NSUB; u.sub = j % NSUB; u.pm = pm0 + tile / nN; u.pn = tile % nN; return true;
    }
};
typedef __bf16 bf16x2_t __attribute__((ext_vector_type(2)));
typedef float f32x2_t __attribute__((ext_vector_type(2)));
__device__ __forceinline__ unsigned cvt_pk_bf16(float lo, float hi) { const f32x2_t v = {lo, hi}; return __builtin_bit_cast(unsigned, __builtin_convertvector(v, bf16x2_t)); }

template <class Epi, class Sched>
__device__ __forceinline__ void gemm_phase(PG8_LAS unsigned char* lds, const Gemm g, const Sched& S, const Epi& E) {
    int tid_ = threadIdx.x; asm volatile("" : "+v"(tid_));
    const int tid = tid_, wid = __builtin_amdgcn_readfirstlane(tid >> 6), lane = tid & 63, wr = wid >> 2, wc = wid & 3, fr = lane & 15, fq = lane >> 4;
    const int K = g.K, nt = K / BK;
    unsigned voffA[2], voffB[2];
#pragma unroll
    for (int i = 0; i < 2; ++i) { int R, C; stage_rc(tid * 16 + i * 8192, R, C); const int Rb = Epi::PERM ? ((R & ~31) + perm32(R & 31)) : R;
        voffA[i] = (unsigned)(R * g.lda + C) * 2u; voffB[i] = (unsigned)(Rb * g.ldb + C) * 2u; }
    const size_t kstep = (size_t)(BK * 2);
    const size_t hstepA = (size_t)HALF * g.lda * 2, hstepB = (size_t)HALF * g.ldb * 2;
    const unsigned ldsw = (unsigned)wid * 1024u;
    const int aoff = lds_byte(wr * 64 + fr, fq * 8), boff = lds_byte(wc * 32 + fr, fq * 8);
#define PG8_SA(b, h) (((b) * 2 + (h)) * HTB)
#define PG8_SB(b, h) ((4 + (b) * 2 + (h)) * HTB)
#define PG8_STAGE(bufoff, gbase, voff) do { _Pragma("unroll") for (int _i = 0; _i < 2; ++_i) \
        __builtin_amdgcn_global_load_lds((const unsigned*)((const char*)(gbase) + (voff)[_i]), (PG8_LAS unsigned*)(lds + (bufoff) + ldsw + _i * 8192), 16, 0, 0); } while (0)
#define PG8_LDA(dst, b, h) do { _Pragma("unroll") for (int m = 0; m < 4; ++m) _Pragma("unroll") for (int k = 0; k < 2; ++k) dst[m][k] = *(const PG8_LAS bf16x8*)(lds + PG8_SA(b, h) + aoff + m * 2048 + k * 1024); } while (0)
#define PG8_LDB(dst, b, h) do { _Pragma("unroll") for (int n = 0; n < 2; ++n) _Pragma("unroll") for (int k = 0; k < 2; ++k) dst[n][k] = *(const PG8_LAS bf16x8*)(lds + PG8_SB(b, h) + boff + n * 2048 + k * 1024); } while (0)
#define PG8_MMA(ai, bj, At, Bt) do { __builtin_amdgcn_s_setprio(1); _Pragma("unroll") for (int m = 0; m < 4; ++m) _Pragma("unroll") for (int n = 0; n < 2; ++n) _Pragma("unroll") for (int k = 0; k < 2; ++k) \
        acc[ai][bj][m][n] = __builtin_amdgcn_mfma_f32_16x16x32_bf16(Bt[n][k], At[m][k], acc[ai][bj][m][n], 0, 0, 0); __builtin_amdgcn_s_setprio(0); } while (0)
#define PG8_WAIT_V(n) asm volatile("s_waitcnt vmcnt(" #n ")" ::: "memory")
#define PG8_WAIT_L(n) asm volatile("s_waitcnt lgkmcnt(" #n ")" ::: "memory")
#define PG8_BAR __builtin_amdgcn_s_barrier()
#define PG8_SCHED __builtin_amdgcn_sched_barrier(0)
    Unit cur, nxt; int ui = 0;
    if (!S.next(0, cur)) return;
    if constexpr (Epi::PRE) E.pre(lds, cur, wid, lane, 0);
    f32x4 acc[2][2][4][2];
#pragma unroll
    for (int a = 0; a < 2; ++a)
#pragma unroll
        for (int b = 0; b < 2; ++b)
#pragma unroll
            for (int m = 0; m < 4; ++m)
#pragma unroll
                for (int n = 0; n < 2; ++n) acc[a][b][m][n] = (f32x4){0.f, 0.f, 0.f, 0.f};
    bf16x8 At[4][2], B0[2][2], B1[2][2];
    const char* cA = g.A + (size_t)cur.pm * g.a_tile + (size_t)cur.pn * g.a_pn + (size_t)cur.sub * g.a_sub;
    const char* cB = g.B + (size_t)cur.pn * g.b_tile + (size_t)cur.sub * g.b_sub;
    PG8_STAGE(PG8_SB(0, 0), cB, voffB); PG8_STAGE(PG8_SB(0, 1), cB + hstepB, voffB); PG8_STAGE(PG8_SA(0, 0), cA, voffA); PG8_STAGE(PG8_SA(0, 1), cA + hstepA, voffA);
    if (wr == 1) PG8_BAR;
    PG8_WAIT_V(2); PG8_BAR;
    PG8_STAGE(PG8_SB(1, 0), cB + kstep, voffB); PG8_STAGE(PG8_SA(1, 0), cA + kstep, voffA); PG8_STAGE(PG8_SB(1, 1), cB + hstepB + kstep, voffB);
    PG8_WAIT_V(6); PG8_BAR;
    for (;;) {
        const bool has_next = S.next(ui + 1, nxt);
        const char* nA = has_next ? g.A + (size_t)nxt.pm * g.a_tile + (size_t)nxt.pn * g.a_pn + (size_t)nxt.sub * g.a_sub : cA;
        const char* nB = has_next ? g.B + (size_t)nxt.pn * g.b_tile + (size_t)nxt.sub * g.b_sub : cB;
        for (int t = 0; t < nt; t += 2) {
            const bool last = (t == nt - 2);
            const char* a1 = cA + (size_t)(t + 1) * kstep;
            const char* a2 = last ? nA : cA + (size_t)(t + 2) * kstep; const char* b2 = last ? nB : cB + (size_t)(t + 2) * kstep;
            const char* a3 = a2 + kstep; const char* b3 = b2 + kstep;
            PG8_LDB(B0, 0, 0); PG8_LDB(B1, 0, 1); PG8_SCHED; PG8_LDA(At, 0, 0); PG8_STAGE(PG8_SA(1, 1), a1 + hstepA, voffA);
            PG8_WAIT_V(8); PG8_WAIT_L(0); PG8_BAR; PG8_MMA(0, 0, At, B0); PG8_MMA(0, 1, At, B1); PG8_BAR; PG8_SCHED;
            PG8_LDA(At, 0, 1); PG8_STAGE(PG8_SB(0, 0), b2, voffB); PG8_STAGE(PG8_SB(0, 1), b2 + hstepB, voffB); PG8_STAGE(PG8_SA(0, 0), a2, voffA);
            PG8_WAIT_V(8); PG8_WAIT_L(0); PG8_BAR; PG8_MMA(1, 0, At, B0); PG8_MMA(1, 1, At, B1); PG8_BAR; PG8_SCHED;
            PG8_LDB(B0, 1, 0); PG8_LDB(B1, 1, 1); PG8_SCHED; PG8_LDA(At, 1, 0); PG8_STAGE(PG8_SA(0, 1), a2 + hstepA, voffA);
            PG8_WAIT_V(8); PG8_WAIT_L(0); PG8_BAR; PG8_MMA(0, 0, At, B0); PG8_MMA(0, 1, At, B1); PG8_BAR; PG8_SCHED;
            PG8_LDA(At, 1, 1); PG8_STAGE(PG8_SB(1, 0), b3, voffB); PG8_STAGE(PG8_SB(1, 1), b3 + hstepB, voffB); PG8_STAGE(PG8_SA(1, 0), a3, voffA);
            PG8_WAIT_V(8); PG8_WAIT_L(0); PG8_BAR; PG8_MMA(1, 0, At, B0); PG8_MMA(1, 1, At, B1); PG8_BAR; PG8_SCHED;
        }
        if (wr == 0) PG8_BAR;
        bool zero_acc = true;
        if constexpr (Epi::PRE) E(acc, cur, wr, wc, fr, fq, lds, ui & 1);
        else if constexpr (Epi::CHAIN) zero_acc = E(acc, cur, wr, wc, fr, fq); else E(acc, cur, wr, wc, fr, fq);
        if (!has_next) break;
        if (zero_acc) {
#pragma unroll
        for (int a = 0; a < 2; ++a)
#pragma unroll
            for (int b = 0; b < 2; ++b)
#pragma unroll
                for (int m = 0; m < 4; ++m)
#pragma unroll
                    for (int n = 0; n < 2; ++n) acc[a][b][m][n] = (f32x4){0.f, 0.f, 0.f, 0.f};
        }
        cur = nxt; cA = nA; cB = nB; ++ui;
        if constexpr (Epi::PRE) E.pre(lds, cur, wid, lane, ui & 1);
        if (wr == 1) PG8_BAR;
    }
    PG8_WAIT_V(0);
    PG8_BAR;
#undef PG8_SA
#undef PG8_SB
#undef PG8_STAGE
#undef PG8_LDA
#undef PG8_LDB
#undef PG8_MMA
#undef PG8_WAIT_V
#undef PG8_WAIT_L
#undef PG8_BAR
#undef PG8_SCHED
}
}

constexpr int NWAVES = 8;
constexpr int D = 2048, NB = 4, SEQ = 4096, CTX = 256, DEPTH = 4;
constexpr int ML = NB * SEQ;
constexpr int MC = NB * CTX;
constexpr int M = ML + MC;
constexpr int UC = 10240;
constexpr int NIG = 10496 + 8192;
constexpr int DFF = 5632, UPC = 2 * DFF;
constexpr int IN_COLS = 10256;
constexpr float EPS = 1e-6f;
constexpr int U_Z = 0, U_XBC = 1024, U_POOL = 3072, U_SCB = 4096, U_SCC = 5120, U_SCX = 6144, U_RQ = 7168, U_RK = 7680, U_RV = 8192, U_RG = 9216;

constexpr size_t MiB = 1u << 20;
constexpr size_t WS_CTL = 0, CTL_ZERO_BYTES = 128 * 1024;
constexpr size_t WS_MOD = 1 * MiB;
constexpr size_t WS_ROPE = WS_MOD + (size_t)DEPTH * 5 * 12288 * 4;
constexpr size_t WS_X = 2 * MiB;
constexpr size_t WS_H = WS_X + 136 * MiB;
constexpr size_t WS_WIG = WS_H + 68 * MiB;
constexpr size_t WS_WB = WS_WIG + 73 * MiB;
constexpr size_t WS_WO = WS_WB + 16 * MiB;
constexpr size_t WS_WUP = WS_WO + 8 * MiB;
constexpr size_t WS_WDN = WS_WUP + 44 * MiB;
constexpr size_t WS_WPOOL = WS_WDN + 22 * MiB;
constexpr size_t W_SPAN = WS_WPOOL + 1 * MiB - WS_WIG;
constexpr size_t WS_U = WS_WIG + 2 * W_SPAN;
constexpr size_t WS_DT = WS_U + 340 * MiB;
constexpr size_t WS_G = WS_DT + 2 * MiB;
constexpr size_t WS_UP = WS_U;
constexpr size_t WS_CUMA = WS_G + 140 * MiB;
constexpr size_t WS_DTA = WS_CUMA + 4 * MiB;
constexpr size_t WS_PART = WS_G + 152 * MiB;
constexpr size_t WS_XBCA = WS_G + 272 * MiB;
constexpr size_t WS_RQK = WS_XBCA + 68 * MiB;
constexpr size_t WS_YS = WS_RQK + 34 * MiB;
constexpr size_t WS_YB = WS_YS + 136 * MiB;
constexpr size_t WS_POOLED = WS_YB + 136 * MiB;
constexpr size_t WS_MERGED = WS_POOLED + 34 * MiB;
constexpr size_t WS_MRG32 = WS_XBCA;
constexpr size_t WS_ACT = WS_XBCA;
constexpr size_t WS_END = WS_MERGED + 68 * MiB;
static_assert(WS_UP + (size_t)M * UPC * 2 <= WS_XBCA, "UP overlay");
static_assert(WS_DTA + 4 * MiB <= WS_PART && WS_PART + 32 * MiB <= WS_XBCA, "PART");
static_assert(WS_UP + (size_t)M * UPC * 2 <= WS_CUMA && WS_DTA + 4 * MiB <= WS_XBCA && (size_t)2 * 16 * M * 4 <= 4 * MiB, "cum/dt arrays");
static_assert(WS_ACT + (size_t)M * DFF * 2 <= WS_YB, "ACT overlay");
static_assert(WS_MRG32 + (size_t)M * D * 4 <= WS_YS + 34 * MiB, "MRG32 overlay");
static_assert(WS_ROPE + 8192 <= WS_X, "mod/rope");
constexpr size_t YS_STRIDE = (size_t)M * 1024;

constexpr int CW_TMO = 0, CW_CODE = 1, CW_BAR = 4096, CW_Q = 16384, CW_FIN = 20480;

constexpr int RING_OFF = 0, RING_BYTES = 131072;
constexpr int LDSCTL_OFF = RING_BYTES, MISC_OFF = LDSCTL_OFF + 320;
constexpr int LDS_BYTES = 147456;

#define GAS __attribute__((address_space(1)))
#define LAS __attribute__((address_space(3)))
typedef unsigned short bf16;
typedef unsigned v4u __attribute__((ext_vector_type(4)));
typedef unsigned v2u __attribute__((ext_vector_type(2)));
typedef float f32x4 __attribute__((ext_vector_type(4)));
typedef float f32x16 __attribute__((ext_vector_type(16)));
typedef short bf16x8 __attribute__((ext_vector_type(8)));
typedef GAS unsigned gu32;
#define RLX_AGENT __ATOMIC_RELAXED, __HIP_MEMORY_SCOPE_AGENT
#define LDS_WAIT() asm volatile("s_waitcnt lgkmcnt(0)" ::: "memory")
#define VM_WAIT() asm volatile("s_waitcnt vmcnt(0)" ::: "memory")
__device__ __forceinline__ unsigned f2bf(float f) { return (unsigned)__builtin_bit_cast(unsigned short, (__bf16)f); }
__device__ __forceinline__ unsigned pk2(float lo, float hi) { return pg8::cvt_pk_bf16(lo, hi); }
__device__ __forceinline__ float bflo(unsigned w) { return __builtin_bit_cast(float, w << 16); }
__device__ __forceinline__ float bfhi(unsigned w) { return __builtin_bit_cast(float, w & 0xffff0000u); }
__device__ __forceinline__ float bf1(unsigned short b) { return __builtin_bit_cast(float, (unsigned)b << 16); }
__device__ __forceinline__ void unpack8(const v4u w, float (&f)[8]) { f[0] = bflo(w.x); f[1] = bfhi(w.x); f[2] = bflo(w.y); f[3] = bfhi(w.y); f[4] = bflo(w.z); f[5] = bfhi(w.z); f[6] = bflo(w.w); f[7] = bfhi(w.w); }
__device__ __forceinline__ v4u pack8(const float (&f)[8]) { v4u w; w.x = pk2(f[0], f[1]); w.y = pk2(f[2], f[3]); w.z = pk2(f[4], f[5]); w.w = pk2(f[6], f[7]); return w; }
__device__ __forceinline__ float sigmoidf_(float x) { return __builtin_amdgcn_rcpf(1.0f + __expf(-x)); }
__device__ __forceinline__ float siluf_(float x) { return x * sigmoidf_(x); }
__device__ __forceinline__ float softplusf_(float x) { return fmaxf(x, 0.f) + log1pf(expf(-fabsf(x))); }
__device__ __forceinline__ float wave_sum(float v) {
#pragma unroll
    for (int o = 1; o < 64; o <<= 1) v += __shfl_xor(v, o);
    return v;
}

#define XB_TMO      128
#define XB_XCNT(j)  (256  + 64 * (j))
#define XB_XSUB(j)  (1280 + 64 * (j))
#define XB_XGEN(j)  (2304 + 64 * (j))
#define XB_TOP      3328
#define XB_TOPGEN   3392
#define XCD_BAR_WORDS 3456
#define XB_SPIN_CAP (1u << 18)
__device__ __forceinline__ unsigned xb_ld(unsigned* p)              { return __hip_atomic_load(p, __ATOMIC_RELAXED, __HIP_MEMORY_SCOPE_AGENT); }
__device__ __forceinline__ unsigned xb_add(unsigned* p, unsigned v) { return __hip_atomic_fetch_add(p, v, __ATOMIC_RELAXED, __HIP_MEMORY_SCOPE_AGENT); }
__device__ __forceinline__ unsigned xb_xcc_id() { return (unsigned)__builtin_amdgcn_s_getreg((3 << 11) | 20) & 0xFu; }
#define XB_SPIN(cond, bar) do { unsigned _sp = 0; while (cond) { __builtin_amdgcn_s_sleep(1); \
    if ((++_sp & 255u) == 0u) { if (xb_ld(&(bar)[XB_TMO])) break; if (_sp > XB_SPIN_CAP) { atomicAdd(&(bar)[XB_TMO], 1u); break; } } } } while (0)
struct XcdBarrier { unsigned* bar; unsigned x; volatile LAS unsigned* st; };
__device__ __forceinline__ XcdBarrier xcd_barrier_post(unsigned* bar, volatile LAS unsigned* st) {
    XcdBarrier b; b.bar = bar; b.x = xb_xcc_id(); b.st = st;
    if (threadIdx.x == 0) (void)xb_add(&bar[XB_XCNT(b.x)], 1u);
    return b;
}
__device__ __forceinline__ void xcd_barrier_complete(unsigned* bar, unsigned x, unsigned& nloc, unsigned& nx) {
    const unsigned G = gridDim.x * gridDim.y * gridDim.z;
    unsigned sum, cnt, mine, sp = 0u;
    for (;;) {
        sum = 0u; cnt = 0u; mine = 0u;
#pragma unroll
        for (unsigned j = 0; j < 16; ++j) { const unsigned c = xb_ld(&bar[XB_XCNT(j)]); sum += c; cnt += (c > 0u) ? 1u : 0u; mine = (j == x) ? c : mine; }
        if (sum == G) break;
        __builtin_amdgcn_s_sleep(1);
        if ((++sp & 255u) == 0u) { if (xb_ld(&bar[XB_TMO])) break; if (sp > XB_SPIN_CAP) { atomicAdd(&bar[XB_TMO], 1u); break; } }
    }
    nloc = mine > 0u ? mine : 1u; nx = cnt > 0u ? cnt : 1u;
}
__device__ __forceinline__ void xcd_barrier(const XcdBarrier& b) {
    asm volatile("s_waitcnt vmcnt(0)" ::: "memory");
    __syncthreads();
    if (threadIdx.x == 0) {
        unsigned* bar = b.bar;
        __builtin_amdgcn_s_waitcnt(0);
        unsigned nloc = b.st[0], nx = b.st[1];
        if (nloc == 0u) { xcd_barrier_complete(bar, b.x, nloc, nx); b.st[0] = nloc; b.st[1] = nx; }
        const unsigned old = xb_add(&bar[XB_XSUB(b.x)], 1u);
        const unsigned gen = old / nloc;
        if (old + 1u == (gen + 1u) * nloc) {
            __builtin_amdgcn_fence(__ATOMIC_RELEASE, "agent");
            asm volatile("s_waitcnt vmcnt(0)" ::: "memory");
            const unsigned og = xb_add(&bar[XB_TOP], 1u);
            const unsigned tg = og / nx;
            if (og + 1u == (tg + 1u) * nx) xb_add(&bar[XB_TOPGEN], 1u);
            else XB_SPIN(xb_ld(&bar[XB_TOPGEN]) == tg, bar);
            __builtin_amdgcn_fence(__ATOMIC_ACQUIRE, "agent");
            xb_add(&bar[XB_XGEN(b.x)], 1u);
            asm volatile("s_waitcnt vmcnt(0)" ::: "memory");
        } else {
            XB_SPIN(xb_ld(&bar[XB_XGEN(b.x)]) == gen, bar);
            __builtin_amdgcn_fence(__ATOMIC_ACQUIRE, "agent");
            asm volatile("s_waitcnt vmcnt(0)" ::: "memory");
        }
    }
    __syncthreads();
}

struct Args {
    const float* in[28];
    float* out; unsigned char* ws;
    int ph_lo, ph_hi, variant, pad;
};
struct Frame {
    LAS unsigned char* lds;
    int tid, lane, wave, G, bid, variant;
    unsigned char* ws;
    const float* const* in;
};
__device__ __forceinline__ void frame_refresh(Frame& F) {
    int t = threadIdx.x; asm volatile("" : "+v"(t)); F.tid = t; F.lane = t & 63; F.wave = __builtin_amdgcn_readfirstlane(t >> 6);
    int b = blockIdx.x; asm volatile("" : "+s"(b)); F.bid = b;
}
enum { I_X = 0, I_C, I_CTX, I_CCTX, I_WMOD, I_BMOD, I_NORM1, I_WIN, I_SSDCW, I_SSDCB, I_SSDALOG, I_SSDDTB, I_SSDD, I_SSDNW, I_POOLW, I_POOLS, I_SCONVW, I_RETDL,
       I_WBR, I_WGATE, I_BGATE, I_WO, I_NORM2, I_FFNUP, I_FFNCW, I_FFNCB, I_FFNDN, I_FNW };

__device__ __forceinline__ void seq_bounds(int row, int& s0, int& s1) {
    if (row < ML) { s0 = row & ~(SEQ - 1); s1 = s0 + SEQ; } else { s0 = ML + ((row - ML) & ~(CTX - 1)); s1 = s0 + CTX; }
}
__device__ __forceinline__ int mod_vec(int row) { return row < ML ? (row >> 12) : 4; }

__device__ __forceinline__ void phase_mod(Frame& F) {
    frame_refresh(F);
    LAS float* sv = (LAS float*)(F.lds);
    LAS float* red = (LAS float*)(F.lds + 5 * 2048 * 4);
    const float* c = F.in[I_C]; const float* cc = F.in[I_CCTX];
    for (int i = F.tid; i < 5 * 2048; i += 512) { const int v = i >> 11, k = i & 2047; const float x = v < 4 ? c[v * 2048 + k] : cc[k]; sv[i] = siluf_(x); }
    __syncthreads();
    float* MOD = (float*)(F.ws + WS_MOD);
    for (int it = F.bid; it < DEPTH * 48; it += F.G) {
        const int l = it / 48, jb = it % 48;
        const float* W = F.in[I_WMOD] + (size_t)l * 2048 * 12288 + jb * 256 + 4 * F.lane;
        float a[5][4];
#pragma unroll
        for (int v = 0; v < 5; ++v) { a[v][0] = a[v][1] = a[v][2] = a[v][3] = 0.f; }
        const int k0 = F.wave * 256;
#pragma unroll 4
        for (int k = 0; k < 256; ++k) {
            const f32x4 w = *(const f32x4*)(W + (size_t)(k0 + k) * 12288);
#pragma unroll
            for (int v = 0; v < 5; ++v) { const float s = sv[v * 2048 + k0 + k]; a[v][0] += s * w.x; a[v][1] += s * w.y; a[v][2] += s * w.z; a[v][3] += s * w.w; }
        }
#pragma unroll
        for (int v = 0; v < 5; ++v) *(LAS f32x4*)(red + (F.wave * 5 + v) * 256 + 4 * F.lane) = (f32x4){a[v][0], a[v][1], a[v][2], a[v][3]};
        __syncthreads();
        for (int i = F.tid; i < 5 * 256; i += 512) { const int v = i >> 8, j = i & 255; float s = 0.f;
#pragma unroll
            for (int w = 0; w < 8; ++w) s += red[(w * 5 + v) * 256 + j];
            MOD[((size_t)l * 5 + v) * 12288 + jb * 256 + j] = s + F.in[I_BMOD][l * 12288 + jb * 256 + j]; }
        __syncthreads();
    }
    if (F.bid == F.G - 1) {
        float* R = (float*)(F.ws + WS_ROPE);
        for (int i = F.tid; i < 1024; i += 512) { const int pos = i >> 4, m = i & 15; const float inv = powf(10000.0f, -(float)m / 16.0f); const float ang = (float)pos * inv; R[2 * i] = cosf(ang); R[2 * i + 1] = sinf(ang); }
    }
}

template <class RowMap>
__device__ __forceinline__ void transpose_item(const float* W, int K, int N, bf16* WT, const RowMap& rm, LAS float* scr, int item, int lane) {
    const int nblk = (N + 31) / 32, kb = item / nblk, nb = item % nblk, k0 = 64 * kb, n0 = 32 * nb;
    const bool nok = (n0 + (lane & 31)) < N;
#pragma unroll 8
    for (int i = 0; i < 32; ++i) { const int kk = 2 * i + (lane >> 5); scr[kk * 33 + (lane & 31)] = nok ? W[(size_t)(k0 + kk) * N + n0 + (lane & 31)] : 0.f; }
    LDS_WAIT(); asm volatile("" ::: "memory");
    const int c = lane & 7;
#pragma unroll
    for (int j = 0; j < 4; ++j) { const int n = (lane >> 3) + 8 * j; const LAS float* s = scr + (8 * c) * 33 + n;
        v4u o; o.x = pk2(s[0 * 33], s[1 * 33]); o.y = pk2(s[2 * 33], s[3 * 33]); o.z = pk2(s[4 * 33], s[5 * 33]); o.w = pk2(s[6 * 33], s[7 * 33]);
        if (n0 + n < N) *(GAS v4u*)(WT + (size_t)rm(n0 + n) * K + k0 + 8 * c) = o; }
    LDS_WAIT(); asm volatile("" ::: "memory");
}
struct RowId { int off; __device__ __forceinline__ int operator()(int n) const { return n + off; } };
struct RowUp { __device__ __forceinline__ int operator()(int n) const { const int h = n >= DFF ? 1 : 0, c = n - h * DFF; return (c >> 7) * 256 + h * 128 + (c & 127); } };
struct RowWin { __device__ __forceinline__ int operator()(int n) const { return n < 3072 ? n : (n < 3088 ? 10240 + (n - 3072) : n - 16); } };

constexpr int CI_IN = 32 * 321, CI_G1 = 32 * 64, CI_B1 = 16 * 64, CI_O = 32 * 64, CI_UP = 32 * 352, CI_DN = 88 * 64, CI_P1 = 4 * 8, CI_Z = 30;
constexpr int NITW = CI_IN + 4 * CI_G1 + 4 * CI_B1 + CI_O + CI_UP + CI_DN + 4 * CI_P1 + CI_Z;
__device__ __forceinline__ void convert_item(Frame& F, int l, int it, LAS float* scr, int lane) {
    unsigned char* wb = F.ws + (size_t)(l & 1) * W_SPAN;
    bf16* WIG = (bf16*)(wb + WS_WIG); bf16* WB = (bf16*)(wb + WS_WB); bf16* WO = (bf16*)(wb + WS_WO);
    bf16* WUP = (bf16*)(wb + WS_WUP); bf16* WDN = (bf16*)(wb + WS_WDN); bf16* WPOOL = (bf16*)(wb + WS_WPOOL);
    int r = it;
    if (r < CI_IN) { transpose_item(F.in[I_WIN] + (size_t)l * 2048 * IN_COLS, 2048, IN_COLS, WIG, RowWin{}, scr, r, lane); return; } r -= CI_IN;
    if (r < 4 * CI_G1) { const int i = r / CI_G1; transpose_item(F.in[I_WGATE] + ((size_t)l * 4 + i) * 2048 * 2048, 2048, 2048, WIG, RowId{10496 + i * 2048}, scr, r % CI_G1, lane); return; } r -= 4 * CI_G1;
    if (r < 4 * CI_B1) { const int i = r / CI_B1; transpose_item(F.in[I_WBR] + ((size_t)l * 4 + i) * 1024 * 2048, 1024, 2048, WB + (size_t)i * 2048 * 1024, RowId{0}, scr, r % CI_B1, lane); return; } r -= 4 * CI_B1;
    if (r < CI_O) { transpose_item(F.in[I_WO] + (size_t)l * 2048 * 2048, 2048, 2048, WO, RowId{0}, scr, r, lane); return; } r -= CI_O;
    if (r < CI_UP) { transpose_item(F.in[I_FFNUP] + (size_t)l * 2048 * UPC, 2048, UPC, WUP, RowUp{}, scr, r, lane); return; } r -= CI_UP;
    if (r < CI_DN) { transpose_item(F.in[I_FFNDN] + (size_t)l * DFF * 2048, DFF, 2048, WDN, RowId{0}, scr, r, lane); return; } r -= CI_DN;
    if (r < 4 * CI_P1) { const int g = r / CI_P1; transpose_item(F.in[I_POOLW] + ((size_t)l * 4 + g) * 256 * 256, 256, 256, WPOOL + (size_t)g * 256 * 256, RowId{0}, scr, r % CI_P1, lane); return; } r -= 4 * CI_P1;
    {
        unsigned char* base = (unsigned char*)WIG + (size_t)(10256 + 8 * r) * 2048 * 2;
#pragma unroll 4
        for (int k = 0; k < 32; ++k) *(GAS v4u*)(base + (size_t)(k * 64 + lane) * 16) = (v4u){0u, 0u, 0u, 0u};
    }
}
__device__ __forceinline__ void steal_convert(Frame& F, int l, int finidx, bool drain) {
    frame_refresh(F);
    gu32* q = (gu32*)(F.ws + WS_CTL) + CW_Q + 64 * l;
    gu32* fin = (gu32*)(F.ws + WS_CTL) + CW_FIN + 64 * finidx;
    volatile LAS unsigned* box = (volatile LAS unsigned*)(F.lds + MISC_OFF);
    LAS float* scr = (LAS float*)(F.lds + F.wave * 16384);
    if (F.tid == 0 && !drain) __hip_atomic_fetch_add(fin, 1u, RLX_AGENT);
    for (;;) {
        if (F.tid == 0) { unsigned v = 0xffffffffu; if (drain || __hip_atomic_load(fin, RLX_AGENT) < (unsigned)F.G) v = __hip_atomic_fetch_add(q, 1u, RLX_AGENT); box[0] = v; }
        __syncthreads();
        const unsigned got = box[0];
        __syncthreads();
        if (got == 0xffffffffu) break;
        const int base = (int)got * 8;
        if (base >= NITW) break;
        { const int wi = base + F.wave; if (wi < NITW) convert_item(F, l, wi, scr, F.lane); }
    }
}

template <bool FIRST>
__device__ __forceinline__ void phase_norm(Frame& F, int l, const float* nw, int sh_off, int sc_off, int nrows, bool addpart = false) {
    frame_refresh(F);
    float* X = (float*)(F.ws + WS_X); bf16* H = (bf16*)(F.ws + WS_H); const float* MOD = (const float*)(F.ws + WS_MOD);
    const int gw = F.bid * NWAVES + F.wave, NGW = F.G * NWAVES;
    for (int row = gw; row < nrows; row += NGW) {
        const float* src = FIRST ? (row < ML ? F.in[I_X] + (size_t)row * D : F.in[I_CTX] + (size_t)(row - ML) * D) : X + (size_t)row * D;
        f32x4 v[8]; float ss = 0.f;
#pragma unroll
        for (int j = 0; j < 8; ++j) { v[j] = *(const f32x4*)(src + 256 * j + 4 * F.lane); ss += (v[j].x * v[j].x + v[j].y * v[j].y) + (v[j].z * v[j].z + v[j].w * v[j].w); }
        if (FIRST) {
#pragma unroll
            for (int j = 0; j < 8; ++j) *(f32x4*)(X + (size_t)row * D + 256 * j + 4 * F.lane) = v[j];
        }
        if (!FIRST && addpart && row >= ML) {
            const float* P = (const float*)(F.ws + WS_PART) + (size_t)(row - ML) * D;
            ss = 0.f;
#pragma unroll
            for (int j = 0; j < 8; ++j) {
#pragma unroll
                for (int sp = 0; sp < 4; ++sp) v[j] += *(const f32x4*)(P + (size_t)sp * MC * D + 256 * j + 4 * F.lane);
                *(f32x4*)(X + (size_t)row * D + 256 * j + 4 * F.lane) = v[j];
                ss += (v[j].x * v[j].x + v[j].y * v[j].y) + (v[j].z * v[j].z + v[j].w * v[j].w);
            }
        }
        const float rs = rsqrtf(wave_sum(ss) * (1.0f / D) + EPS);
        const float* mv = MOD + ((size_t)l * 5 + mod_vec(row)) * 12288;
#pragma unroll
        for (int j = 0; j < 8; ++j) { const int c = 256 * j + 4 * F.lane;
            const f32x4 w = *(const f32x4*)(nw + c), sh = *(const f32x4*)(mv + sh_off + c), sc = *(const f32x4*)(mv + sc_off + c);
            const f32x4 y = v[j] * rs * w; const f32x4 h = y * (sc + 1.0f) + sh;
            v2u o; o.x = pk2(h.x, h.y); o.y = pk2(h.z, h.w); *(v2u*)(H + (size_t)row * D + c) = o; }
    }
}
__device__ __forceinline__ void phase_final(Frame& F, float* out) {
    frame_refresh(F);
    const float* X = (const float*)(F.ws + WS_X); const float* nw = F.in[I_FNW];
    const int gw = F.bid * NWAVES + F.wave, NGW = F.G * NWAVES;
    for (int row = gw; row < ML; row += NGW) {
        f32x4 v[8]; float ss = 0.f;
#pragma unroll
        for (int j = 0; j < 8; ++j) { v[j] = *(const f32x4*)(X + (size_t)row * D + 256 * j + 4 * F.lane); ss += (v[j].x * v[j].x + v[j].y * v[j].y) + (v[j].z * v[j].z + v[j].w * v[j].w); }
        const float rs = rsqrtf(wave_sum(ss) * (1.0f / D) + EPS);
#pragma unroll
        for (int j = 0; j < 8; ++j) { const int c = 256 * j + 4 * F.lane; *(f32x4*)(out + (size_t)row * D + c) = v[j] * rs * *(const f32x4*)(nw + c); }
    }
}

__device__ __forceinline__ v4u ldrow(const bf16* base, int row, int ld, int col, bool ok) { return ok ? *(const v4u*)(base + (size_t)row * ld + col) : (v4u){0u, 0u, 0u, 0u}; }
__device__ __forceinline__ void ld8f(const float* p, float (&f)[8]) { const f32x4 a = *(const f32x4*)p, b = *(const f32x4*)(p + 4); f[0] = a.x; f[1] = a.y; f[2] = a.z; f[3] = a.w; f[4] = b.x; f[5] = b.y; f[6] = b.z; f[7] = b.w; }

__device__ __forceinline__ void sc_task(Frame& F, int l, int r, int lane) {
    const bf16* U = (const bf16*)(F.ws + WS_U); bf16* YB2 = (bf16*)(F.ws + WS_YB) + 2 * YS_STRIDE;
            const int rb = r >> 1, cb = r & 1, c = cb * 512 + lane * 8, r0 = rb * 32; int s0, s1; seq_bounds(r0, s0, s1);
            float w0[8], w1[8], w2[8];
            ld8f(F.in[I_SCONVW] + ((size_t)l * 3 + 0) * 1024 + c, w0); ld8f(F.in[I_SCONVW] + ((size_t)l * 3 + 1) * 1024 + c, w1); ld8f(F.in[I_SCONVW] + ((size_t)l * 3 + 2) * 1024 + c, w2);
            for (int r4 = r0; r4 < r0 + 32; r4 += 4) {
                v4u bc[6], bx[6], bg[4];
#pragma unroll
                for (int k = 0; k < 6; ++k) { const int s = r4 - 1 + k; const bool ok = s >= s0 && s < s1; bc[k] = ldrow(U, s, UC, U_SCC + c, ok); bx[k] = ldrow(U, s, UC, U_SCX + c, ok); }
#pragma unroll
                for (int k = 0; k < 4; ++k) bg[k] = ldrow(U, r4 + k, UC, U_SCB + c, true);
                float pr[6][8];
#pragma unroll
                for (int k = 0; k < 6; ++k) { float a[8], b[8]; unpack8(bc[k], a); unpack8(bx[k], b);
#pragma unroll
                    for (int e = 0; e < 8; ++e) pr[k][e] = a[e] * b[e]; }
#pragma unroll
                for (int j = 0; j < 4; ++j) { float g[8], o[8]; unpack8(bg[j], g);
#pragma unroll
                    for (int e = 0; e < 8; ++e) o[e] = g[e] * (w0[e] * pr[j][e] + w1[e] * pr[j + 1][e] + w2[e] * pr[j + 2][e]);
                    *(v4u*)(YB2 + (size_t)(r4 + j) * 1024 + c) = pack8(o); }
            }
}
__device__ __forceinline__ void sc_phase(Frame& F, int l, int c, int Gs) {
    frame_refresh(F);
    const int gw = c * NWAVES + F.wave, NGW = Gs * NWAVES;
    for (int task = gw; task < (M / 32) * 2; task += NGW) sc_task(F, l, task, F.lane);
}
template <int HMAX>
__device__ __forceinline__ void pool_task(const bf16* U, bf16* POOLED, int r0, int s0, int s1, int c, int half) {
    constexpr int NR = 8 + 2 * HMAX - 1, HA = HMAX / 2;
    const bool big = (half == HMAX);
    for (int r8 = r0; r8 < r0 + 32; r8 += 8) {
        v4u buf[NR];
#pragma unroll
        for (int k = 0; k < NR; ++k) { const int s = r8 - HMAX + k; buf[k] = ldrow(U, s, UC, U_POOL + c, s >= s0 && s < s1); }
        float sa[8], sb[8];
#pragma unroll
        for (int e = 0; e < 8; ++e) { sa[e] = 0.f; sb[e] = 0.f; }
#pragma unroll
        for (int k = 0; k < 2 * HMAX; ++k) { float t[8]; unpack8(buf[k], t);
#pragma unroll
            for (int e = 0; e < 8; ++e) { sb[e] += t[e]; if (k >= HA && k < HMAX + HA) sa[e] += t[e]; } }
#pragma unroll
        for (int j = 0; j < 8; ++j) {
            const int rr = r8 + j; int lo = rr - half, hi = rr + half; lo = lo < s0 ? s0 : lo; hi = hi > s1 ? s1 : hi;
            float x[8], o[8]; unpack8(buf[j + HMAX], x); const float inv = 1.0f / (float)(hi - lo);
#pragma unroll
            for (int e = 0; e < 8; ++e) o[e] = (big ? sb[e] : sa[e]) * inv - x[e];
            *(v4u*)(POOLED + (size_t)rr * 1024 + c) = pack8(o);
            if (j < 7) {
                float tin[8], tout[8];
                unpack8(buf[j + 2 * HMAX], tin); unpack8(buf[j], tout);
#pragma unroll
                for (int e = 0; e < 8; ++e) sb[e] += tin[e] - tout[e];
                unpack8(buf[j + HMAX + HA], tin); unpack8(buf[j + HA], tout);
#pragma unroll
                for (int e = 0; e < 8; ++e) sa[e] += tin[e] - tout[e];
            }
        }
    }
}
__device__ __forceinline__ void phase_pre(Frame& F, int l) {
    frame_refresh(F);
    const bf16* U = (const bf16*)(F.ws + WS_U);
    bf16* XBCA = (bf16*)(F.ws + WS_XBCA); bf16* RQK = (bf16*)(F.ws + WS_RQK); bf16* YB2 = (bf16*)(F.ws + WS_YB) + 2 * YS_STRIDE; bf16* POOLED = (bf16*)(F.ws + WS_POOLED);
    const float* ROPE = (const float*)(F.ws + WS_ROPE);
    const int gw = F.bid * NWAVES + F.wave, NGW = F.G * NWAVES, lane = F.lane;
    constexpr int NRB = M / 32;
    constexpr int T_CUM = (M / 64) * 2, T_XBC = NRB * 4, T_POOL = NRB * 2, T_ROPE = NRB;
    float* CUMA = (float*)(F.ws + WS_CUMA); float* DTA = (float*)(F.ws + WS_DTA); const float* DT = (const float*)(F.ws + WS_DT);
    for (int task = gw; task < T_CUM + T_XBC + T_POOL + T_ROPE; task += NGW) {
        int r = task;
        if (r < T_CUM) {
            const int blk = r >> 1, dir = r & 1, row = blk * 64 + (dir ? 63 - lane : lane);
            for (int hh = 0; hh < 16; ++hh) {
                const float dt = softplusf_(DT[(size_t)row * 16 + hh] + F.in[I_SSDDTB][(l * 2 + dir) * 16 + hh]);
                float cum = dt * -expf(F.in[I_SSDALOG][(l * 2 + dir) * 16 + hh]);
#pragma unroll
                for (int o = 1; o < 64; o <<= 1) { const float t = __shfl_up(cum, o); if (lane >= o) cum += t; }
                CUMA[(size_t)(dir * 16 + hh) * M + row] = cum; DTA[(size_t)(dir * 16 + hh) * M + row] = dt;
            }
            continue;
        }
        r -= T_CUM;
        if (r < T_XBC) {
            const int rb = r >> 2, cb = r & 3, c = cb * 512 + lane * 8, r0 = rb * 32; int s0, s1; seq_bounds(r0, s0, s1);
            float w0[8], w1[8], w2[8], bb[8];
            ld8f(F.in[I_SSDCW] + ((size_t)l * 3 + 0) * 2048 + c, w0); ld8f(F.in[I_SSDCW] + ((size_t)l * 3 + 1) * 2048 + c, w1); ld8f(F.in[I_SSDCW] + ((size_t)l * 3 + 2) * 2048 + c, w2); ld8f(F.in[I_SSDCB] + (size_t)l * 2048 + c, bb);
            v4u bufA[10], bufB[10];
#define XBC_LOAD(buf, r8_) do { _Pragma("unroll") for (int k = 0; k < 10; ++k) { const int s = (r8_) - 1 + k; buf[k] = ldrow(U, s, UC, U_XBC + c, s >= s0 && s < s1); } } while (0)
#define XBC_COMP(buf, r8_) do { _Pragma("unroll") for (int j = 0; j < 8; ++j) { \
                    float p[8], q[8], n[8], o[8]; unpack8(buf[j], p); unpack8(buf[j + 1], q); unpack8(buf[j + 2], n); \
                    _Pragma("unroll") for (int e = 0; e < 8; ++e) o[e] = siluf_(w0[e] * p[e] + w1[e] * q[e] + w2[e] * n[e] + bb[e]); \
                    *(v4u*)(XBCA + (size_t)((r8_) + j) * 2048 + c) = pack8(o); } } while (0)
            XBC_LOAD(bufA, r0);
            XBC_LOAD(bufB, r0 + 8);  XBC_COMP(bufA, r0);
            XBC_LOAD(bufA, r0 + 16); XBC_COMP(bufB, r0 + 8);
            XBC_LOAD(bufB, r0 + 24); XBC_COMP(bufA, r0 + 16);
            XBC_COMP(bufB, r0 + 24);
#undef XBC_LOAD
#undef XBC_COMP
            continue;
        }
        r -= T_XBC;
        if (r < T_POOL) {
            const int rb = r >> 1, cb = r & 1, c = cb * 512 + lane * 8, r0 = rb * 32; int s0, s1; seq_bounds(r0, s0, s1);
            const int grp = c >> 8, half = 1 << grp;
            if (cb == 0) pool_task<2>(U, POOLED, r0, s0, s1, c, half); else pool_task<8>(U, POOLED, r0, s0, s1, c, half);
            continue;
        }
        r -= T_POOL;
        {
            const int r0 = r * 32; int s0, s1; seq_bounds(r0, s0, s1);
            const int qk = lane >> 5, rem = lane & 31, head = rem >> 2, part = (rem >> 1) & 1, sub = rem & 1;
            const int c1 = head * 64 + part * 32 + sub * 8, c2 = c1 + 16; const float scl = qk == 0 ? 0.125f : 1.0f;
            const int ucol = (qk == 0 ? U_RQ : U_RK);
            for (int r8 = r0; r8 < r0 + 32; r8 += 8) {
                v4u b1[8], b2[8];
#pragma unroll
                for (int k = 0; k < 8; ++k) { b1[k] = ldrow(U, r8 + k, UC, ucol + c1, true); b2[k] = ldrow(U, r8 + k, UC, ucol + c2, true); }
#pragma unroll
                for (int k = 0; k < 8; ++k) {
                    const int rr = r8 + k; float x1[8], x2[8], o1[8], o2[8]; unpack8(b1[k], x1); unpack8(b2[k], x2);
                    if (rr < ML) {
                        const int t = rr - s0, pos = part == 0 ? (t >> 6) : (t & 63);
                        const float* rp = ROPE + (size_t)(pos * 16 + sub * 8) * 2;
#pragma unroll
                        for (int e = 0; e < 8; ++e) { const float cs = rp[2 * e], sn = rp[2 * e + 1]; o1[e] = (x1[e] * cs - x2[e] * sn) * scl; o2[e] = (x1[e] * sn + x2[e] * cs) * scl; }
                    } else {
#pragma unroll
                        for (int e = 0; e < 8; ++e) { o1[e] = x1[e] * scl; o2[e] = x2[e] * scl; }
                    }
                    *(v4u*)(RQK + (size_t)rr * 1024 + qk * 512 + c1) = pack8(o1); *(v4u*)(RQK + (size_t)rr * 1024 + qk * 512 + c2) = pack8(o2);
                }
            }
        }
    }
}

#define MFMA32(a, b, c) __builtin_amdgcn_mfma_f32_32x32x16_bf16((a), (b), (c), 0, 0, 0)
#define SCAN_BAR() do { asm volatile("s_waitcnt lgkmcnt(0)" ::: "memory"); __builtin_amdgcn_s_barrier(); asm volatile("" ::: "memory"); } while (0)
typedef short s16x4 __attribute__((ext_vector_type(4)));
__device__ __forceinline__ bf16x8 tr_frag(LAS unsigned char* tile, int rs, int c, int ks, int lane) {
    const int h = lane >> 5, blk = (lane >> 4) & 1, q = (lane & 15) >> 2, p = lane & 3;
    LAS unsigned char* a0 = tile + (16 * ks + 8 * h + q) * rs + (32 * c + 16 * blk + 4 * p) * 2;
    const s16x4 lo = __builtin_amdgcn_ds_read_tr16_b64_v4i16((LAS s16x4*)a0);
    const s16x4 hi = __builtin_amdgcn_ds_read_tr16_b64_v4i16((LAS s16x4*)(a0 + 4 * rs));
    return __builtin_shufflevector(lo, hi, 0, 1, 2, 3, 4, 5, 6, 7);
}
template <int DN, int DP, bool SSD>
__device__ __forceinline__ void scan_unit(Frame& F, int l, int b, int h, int dir) {
    frame_refresh(F);
    constexpr int RSQ = (DN + 8) * 2, RSK2 = DN * 2 + 64, RSV = DP * 2 + 64, RSJ = 72 * 2;
    constexpr int O_Q = 0, O_K = O_Q + 64 * RSQ, O_K2 = O_K + 64 * RSQ, O_V = O_K2 + 64 * RSK2, O_VW = O_V + 64 * RSV, O_S = O_VW + 64 * RSV, O_HST = O_S + 64 * RSJ, O_CUM = O_HST + DP * RSQ, O_END = O_CUM + 256;
    static_assert(O_END <= RING_BYTES, "scan LDS");
    LAS unsigned char* lds = F.lds;
    const int tid = F.tid, lane = F.lane, w = F.wave, r = lane & 31, hh = lane >> 5;
    const bf16* XBCA = (const bf16*)(F.ws + WS_XBCA); const bf16* RQK = (const bf16*)(F.ws + WS_RQK); const bf16* U = (const bf16*)(F.ws + WS_U);
    const float* CUMA = (const float*)(F.ws + WS_CUMA) + (size_t)(dir * 16 + h) * M; const float* DTA = (const float*)(F.ws + WS_DTA) + (size_t)(dir * 16 + h) * M;
    bf16* YS = (bf16*)(F.ws + WS_YS) + (size_t)((SSD ? 0 : 2) + dir) * YS_STRIDE;
    const int ycol = SSD ? h * 64 : h * 128;
    float la_const = 0.f;
    if (!SSD) la_const = -softplusf_(-F.in[I_RETDL][(l * 2 + dir) * 8 + h]);
    for (int i = tid; i < DP * RSQ / 16; i += 512) *(LAS v4u*)(lds + O_HST + i * 16) = (v4u){0u, 0u, 0u, 0u};
    f32x16 Hs;
#pragma unroll
    for (int i = 0; i < 16; ++i) Hs[i] = 0.f;
    const int tok8 = tid >> 3, ch8 = tid & 7, tok16 = tid >> 4, ch16 = tid & 15;
    constexpr int NPF = 2;
    v4u preb[NPF][5]; float pcum[NPF], pdt[NPF], pcl[NPF], pcw[NPF];
#pragma unroll
    for (int u = 0; u < NPF; ++u) { pcum[u] = 0.f; pdt[u] = 1.f; pcl[u] = 0.f; pcw[u] = 0.f;
#pragma unroll
        for (int k = 0; k < 5; ++k) preb[u][k] = (v4u){0u, 0u, 0u, 0u}; }
    auto row_of = [&](int st, int i) -> int {
        int base, sub;
        if (st < 4) { base = ML + b * CTX; sub = dir ? 3 - st : st; } else { base = b * SEQ; sub = dir ? 67 - st : st - 4; }
        return base + sub * 64 + (dir ? 63 - i : i);
    };
#define SCAN_PREFETCH(st_, pre, u_) do { \
        const int rn_ = row_of((st_), tok8), rw0_ = row_of((st_), tok16), rw1_ = row_of((st_), 32 + tok16); \
        if (SSD) { const int g = h >> 2; \
            pre[0] = *(const v4u*)(XBCA + (size_t)rn_ * 2048 + h * 64 + 8 * ch8); \
            pre[1] = *(const v4u*)(XBCA + (size_t)rw0_ * 2048 + 1024 + g * 128 + 8 * ch16); pre[2] = *(const v4u*)(XBCA + (size_t)rw1_ * 2048 + 1024 + g * 128 + 8 * ch16); \
            pre[3] = *(const v4u*)(XBCA + (size_t)rw0_ * 2048 + 1536 + g * 128 + 8 * ch16); pre[4] = *(const v4u*)(XBCA + (size_t)rw1_ * 2048 + 1536 + g * 128 + 8 * ch16); \
            pcum[u_] = CUMA[rn_]; pdt[u_] = DTA[rn_]; pcl[u_] = CUMA[row_of((st_), 63)]; pcw[u_] = CUMA[row_of((st_), lane)]; \
        } else { \
            pre[0] = *(const v4u*)(RQK + (size_t)rn_ * 1024 + h * 64 + 8 * ch8); pre[1] = *(const v4u*)(RQK + (size_t)rn_ * 1024 + 512 + h * 64 + 8 * ch8); \
            pre[2] = *(const v4u*)(U + (size_t)rw0_ * UC + U_RV + h * 128 + 8 * ch16); pre[3] = *(const v4u*)(U + (size_t)rw1_ * UC + U_RV + h * 128 + 8 * ch16); \
        } } while (0)
#pragma unroll
    for (int u = 0; u < NPF; ++u) SCAN_PREFETCH(u, preb[u], u);
    for (int st2 = 0; st2 < 68; st2 += NPF) {
#pragma unroll
    for (int u = 0; u < NPF; ++u) {
        const int st = st2 + u;
        v4u (&pre)[5] = preb[u];
        float clast;
        if (SSD) {
            clast = pcl[u];
            const float dtx = pdt[u], wx = __expf(clast - pcum[u]);
            float x[8], v[8], vw[8]; unpack8(pre[0], x);
#pragma unroll
            for (int e = 0; e < 8; ++e) { v[e] = x[e] * dtx; vw[e] = v[e] * wx; }
            *(LAS v4u*)(lds + O_V + tok8 * RSV + 16 * ch8) = pack8(v); *(LAS v4u*)(lds + O_VW + tok8 * RSV + 16 * ch8) = pack8(vw);
            *(LAS v4u*)(lds + O_K + tok16 * RSQ + 16 * ch16) = pre[1]; *(LAS v4u*)(lds + O_K + (32 + tok16) * RSQ + 16 * ch16) = pre[2];
            *(LAS v4u*)(lds + O_K2 + tok16 * RSK2 + 16 * ch16) = pre[1]; *(LAS v4u*)(lds + O_K2 + (32 + tok16) * RSK2 + 16 * ch16) = pre[2];
            *(LAS v4u*)(lds + O_Q + tok16 * RSQ + 16 * ch16) = pre[3]; *(LAS v4u*)(lds + O_Q + (32 + tok16) * RSQ + 16 * ch16) = pre[4];
            if (w == 0) *(LAS float*)(lds + O_CUM + 4 * lane) = pcw[u];
        } else {
            clast = la_const * 64.f;
            *(LAS v4u*)(lds + O_Q + tok8 * RSQ + 16 * ch8) = pre[0];
            *(LAS v4u*)(lds + O_K + tok8 * RSQ + 16 * ch8) = pre[1]; *(LAS v4u*)(lds + O_K2 + tok8 * RSK2 + 16 * ch8) = pre[1];
            const float w0 = __expf(la_const * (float)(63 - tok16)), w1 = __expf(la_const * (float)(31 - tok16));
            float v0[8], v1[8], q0[8], q1[8]; unpack8(pre[2], v0); unpack8(pre[3], v1);
#pragma unroll
            for (int e = 0; e < 8; ++e) { q0[e] = v0[e] * w0; q1[e] = v1[e] * w1; }
            *(LAS v4u*)(lds + O_V + tok16 * RSV + 16 * ch16) = pre[2]; *(LAS v4u*)(lds + O_V + (32 + tok16) * RSV + 16 * ch16) = pre[3];
            *(LAS v4u*)(lds + O_VW + tok16 * RSV + 16 * ch16) = pack8(q0); *(LAS v4u*)(lds + O_VW + (32 + tok16) * RSV + 16 * ch16) = pack8(q1);
            if (w == 0) *(LAS float*)(lds + O_CUM + 4 * lane) = la_const * (float)(lane + 1);
        }
        SCAN_BAR();
        if (st + NPF < 68) SCAN_PREFETCH(st + NPF, pre, u);
        const float dcy = __expf(clast);
        if (w < 4) {
            const int jb = w >> 1, ib = w & 1;
            f32x16 acc;
#pragma unroll
            for (int i = 0; i < 16; ++i) acc[i] = 0.f;
            if (!(jb == 1 && ib == 0)) {
                bf16x8 fa[DN / 16], fq[DN / 16];
#pragma unroll
                for (int kk = 0; kk < DN / 16; ++kk) {
                    fa[kk] = *(const LAS bf16x8*)(lds + O_K + (jb * 32 + r) * RSQ + (kk * 16 + 8 * hh) * 2);
                    fq[kk] = *(const LAS bf16x8*)(lds + O_Q + (ib * 32 + r) * RSQ + (kk * 16 + 8 * hh) * 2);
                }
                __builtin_amdgcn_sched_barrier(0);
#pragma unroll
                for (int kk = 0; kk < DN / 16; ++kk) acc = MFMA32(fa[kk], fq[kk], acc);
            }
            const int i = ib * 32 + r; const float ci = *(const LAS float*)(lds + O_CUM + 4 * i);
#pragma unroll
            for (int g4 = 0; g4 < 4; ++g4) {
                const int j0 = jb * 32 + 8 * g4 + 4 * hh; const f32x4 cj = *(const LAS f32x4*)(lds + O_CUM + 4 * j0);
                float v[4];
#pragma unroll
                for (int e = 0; e < 4; ++e) { const float cje = e == 0 ? cj.x : (e == 1 ? cj.y : (e == 2 ? cj.z : cj.w)); v[e] = (j0 + e <= i) ? acc[4 * g4 + e] * __expf(ci - cje) : 0.f; }
                v2u o; o.x = pk2(v[0], v[1]); o.y = pk2(v[2], v[3]);
                *(LAS v2u*)(lds + O_S + i * RSJ + j0 * 2) = o;
            }
        }
        SCAN_BAR();
        for (int blk = w; blk < (DP / 32) * 2; blk += 8) {
            const int pb = blk >> 1, ib = blk & 1;
            f32x16 a1, a2;
#pragma unroll
            for (int i = 0; i < 16; ++i) { a1[i] = 0.f; a2[i] = 0.f; }
            bf16x8 fv[4], fs[4], fh[DN / 16], fq[DN / 16];
#pragma unroll
            for (int kk = 0; kk < 4; ++kk) {
                fv[kk] = tr_frag(lds + O_V, RSV, pb, kk, lane);
                fs[kk] = *(const LAS bf16x8*)(lds + O_S + (ib * 32 + r) * RSJ + (kk * 16 + 8 * hh) * 2);
            }
#pragma unroll
            for (int kk = 0; kk < DN / 16; ++kk) {
                fh[kk] = *(const LAS bf16x8*)(lds + O_HST + (pb * 32 + r) * RSQ + (kk * 16 + 8 * hh) * 2);
                fq[kk] = *(const LAS bf16x8*)(lds + O_Q + (ib * 32 + r) * RSQ + (kk * 16 + 8 * hh) * 2);
            }
            __builtin_amdgcn_sched_barrier(0);
#pragma unroll
            for (int kk = 0; kk < 4; ++kk) a1 = MFMA32(fv[kk], fs[kk], a1);
#pragma unroll
            for (int kk = 0; kk < DN / 16; ++kk) a2 = MFMA32(fh[kk], fq[kk], a2);
            const int i = ib * 32 + r; const float ei = __expf(*(const LAS float*)(lds + O_CUM + 4 * i));
            const int row = row_of(st, i);
#pragma unroll
            for (int g4 = 0; g4 < 4; ++g4) {
                const int p0 = pb * 32 + 8 * g4 + 4 * hh;
                v2u o; o.x = pk2(a1[4 * g4 + 0] + ei * a2[4 * g4 + 0], a1[4 * g4 + 1] + ei * a2[4 * g4 + 1]); o.y = pk2(a1[4 * g4 + 2] + ei * a2[4 * g4 + 2], a1[4 * g4 + 3] + ei * a2[4 * g4 + 3]);
                *(v2u*)(YS + (size_t)row * 1024 + ycol + p0) = o;
            }
        }
        {
            const int nb = w / (DP / 32), pb = w % (DP / 32);
#pragma unroll
            for (int i = 0; i < 16; ++i) Hs[i] *= dcy;
            bf16x8 fk[4], fw[4];
#pragma unroll
            for (int kk = 0; kk < 4; ++kk) {
                fk[kk] = tr_frag(lds + O_K2, RSK2, nb, kk, lane);
                fw[kk] = tr_frag(lds + O_VW, RSV, pb, kk, lane);
            }
            __builtin_amdgcn_sched_barrier(0);
#pragma unroll
            for (int kk = 0; kk < 4; ++kk) Hs = MFMA32(fk[kk], fw[kk], Hs);
            SCAN_BAR();
#pragma unroll
            for (int g4 = 0; g4 < 4; ++g4) {
                const int n0 = nb * 32 + 8 * g4 + 4 * hh;
                v2u o; o.x = pk2(Hs[4 * g4 + 0], Hs[4 * g4 + 1]); o.y = pk2(Hs[4 * g4 + 2], Hs[4 * g4 + 3]);
                *(LAS v2u*)(lds + O_HST + (pb * 32 + r) * RSQ + n0 * 2) = o;
            }
        }
    }
    }
    __syncthreads();
#undef SCAN_PREFETCH
}

__device__ __forceinline__ void phase_fin(Frame& F, int l, int nrows) {
    frame_refresh(F);
    const bf16* U = (const bf16*)(F.ws + WS_U); const bf16* YS = (const bf16*)(F.ws + WS_YS); bf16* YB = (bf16*)(F.ws + WS_YB);
    const float* nw = F.in[I_SSDNW] + (size_t)l * 1024; const float* dskp = F.in[I_SSDD] + (size_t)l * 16; const bf16* XBCA = (const bf16*)(F.ws + WS_XBCA);
    const int gw = F.bid * NWAVES + F.wave, NGW = F.G * NWAVES, lane = F.lane;
    for (int row = gw; row < nrows; row += NGW) {
        {
            float g[2][8]; float ss = 0.f;
#pragma unroll
            for (int k = 0; k < 2; ++k) { const int c = k * 512 + 8 * lane; float yf[8], yb[8], z[8];
                unpack8(*(const v4u*)(YS + (size_t)row * 1024 + c), yf); unpack8(*(const v4u*)(YS + YS_STRIDE + (size_t)row * 1024 + c), yb); unpack8(*(const v4u*)(U + (size_t)row * UC + U_Z + c), z);
                float xs[8]; unpack8(*(const v4u*)(XBCA + (size_t)row * 2048 + c), xs); const float dsk = dskp[c >> 6];
#pragma unroll
                for (int e = 0; e < 8; ++e) { g[k][e] = (yf[e] + yb[e] + dsk * xs[e]) * siluf_(z[e]); ss += g[k][e] * g[k][e]; } }
            const float rs = rsqrtf(wave_sum(ss) * (1.0f / 1024.0f) + EPS);
#pragma unroll
            for (int k = 0; k < 2; ++k) { const int c = k * 512 + 8 * lane; float wv[8], o[8]; ld8f(nw + c, wv);
#pragma unroll
                for (int e = 0; e < 8; ++e) o[e] = g[k][e] * rs * wv[e];
                *(v4u*)(YB + (size_t)row * 1024 + c) = pack8(o); }
        }
        {
            const int c = 16 * lane; float v[16];
            { float a[8], b2[8]; unpack8(*(const v4u*)(YS + 2 * YS_STRIDE + (size_t)row * 1024 + c), a); unpack8(*(const v4u*)(YS + 3 * YS_STRIDE + (size_t)row * 1024 + c), b2);
#pragma unroll
              for (int e = 0; e < 8; ++e) v[e] = a[e] + b2[e];
              unpack8(*(const v4u*)(YS + 2 * YS_STRIDE + (size_t)row * 1024 + c + 8), a); unpack8(*(const v4u*)(YS + 3 * YS_STRIDE + (size_t)row * 1024 + c + 8), b2);
#pragma unroll
              for (int e = 0; e < 8; ++e) v[8 + e] = a[e] + b2[e]; }
            float s = 0.f;
#pragma unroll
            for (int e = 0; e < 16; ++e) s += v[e];
            s += __shfl_xor(s, 1); s += __shfl_xor(s, 2); s += __shfl_xor(s, 4);
            const float mu = s * (1.0f / 128.0f); float q = 0.f;
#pragma unroll
            for (int e = 0; e < 16; ++e) { v[e] -= mu; q += v[e] * v[e]; }
            q += __shfl_xor(q, 1); q += __shfl_xor(q, 2); q += __shfl_xor(q, 4);
            const float rs = rsqrtf(q * (1.0f / 128.0f) + EPS);
            float g0[8], g1[8], o0[8], o1[8]; unpack8(*(const v4u*)(U + (size_t)row * UC + U_RG + c), g0); unpack8(*(const v4u*)(U + (size_t)row * UC + U_RG + c + 8), g1);
#pragma unroll
            for (int e = 0; e < 8; ++e) { o0[e] = siluf_(g0[e]) * v[e] * rs; o1[e] = siluf_(g1[e]) * v[8 + e] * rs; }
            *(v4u*)(YB + 3 * YS_STRIDE + (size_t)row * 1024 + c) = pack8(o0); *(v4u*)(YB + 3 * YS_STRIDE + (size_t)row * 1024 + c + 8) = pack8(o1);
        }
    }
}

__device__ __forceinline__ v4u ldedge(const bf16* EDGE, int blk, int j, int h, int c, bool ok) { return ok ? *(const v4u*)(EDGE + ((size_t)(blk * 4 + j) * 2 + h) * DFF + c) : (v4u){0u, 0u, 0u, 0u}; }
__device__ __forceinline__ void phase_ffnfix(Frame& F, int l, int nrows) {
    frame_refresh(F);
    const bf16* EDGE = (const bf16*)(F.ws + WS_UP); bf16* ACT = (bf16*)(F.ws + WS_ACT);
    const int gw = F.bid * NWAVES + F.wave, NGW = F.G * NWAVES, lane = F.lane;
    const int ntask = (nrows / 64) * 11;
    for (int task = gw; task < ntask; task += NGW) {
        const int blk = task / 11, cb = task % 11, c = cb * 512 + lane * 8, r0 = blk * 64; int s0, s1; seq_bounds(r0, s0, s1);
        const bool hp = r0 > s0, hn = r0 + 64 < s1;
        float wa0[8], wa1[8], wa2[8], ba[8], wb0[8], wb1[8], wb2[8], bb[8];
        const float* cw = F.in[I_FFNCW] + (size_t)l * 3 * UPC; const float* cbp = F.in[I_FFNCB] + (size_t)l * UPC;
        v4u ra[6], rb[6];
        ra[0] = ldedge(EDGE, blk - 1, 3, 0, c, hp); ra[1] = ldedge(EDGE, blk, 0, 0, c, true); ra[2] = ldedge(EDGE, blk, 1, 0, c, true);
        ra[3] = ldedge(EDGE, blk, 2, 0, c, true); ra[4] = ldedge(EDGE, blk, 3, 0, c, true); ra[5] = ldedge(EDGE, blk + 1, 0, 0, c, hn);
        rb[0] = ldedge(EDGE, blk - 1, 3, 1, c, hp); rb[1] = ldedge(EDGE, blk, 0, 1, c, true); rb[2] = ldedge(EDGE, blk, 1, 1, c, true);
        rb[3] = ldedge(EDGE, blk, 2, 1, c, true); rb[4] = ldedge(EDGE, blk, 3, 1, c, true); rb[5] = ldedge(EDGE, blk + 1, 0, 1, c, hn);
        ld8f(cw + c, wa0); ld8f(cw + UPC + c, wa1); ld8f(cw + 2 * UPC + c, wa2); ld8f(cbp + c, ba);
        ld8f(cw + DFF + c, wb0); ld8f(cw + UPC + DFF + c, wb1); ld8f(cw + 2 * UPC + DFF + c, wb2); ld8f(cbp + DFF + c, bb);
#pragma unroll
        for (int j = 0; j < 2; ++j) {
            float p[8], q[8], n[8], o[8], a[8];
            unpack8(ra[3 * j], p); unpack8(ra[3 * j + 1], q); unpack8(ra[3 * j + 2], n);
#pragma unroll
            for (int e = 0; e < 8; ++e) a[e] = siluf_(wa0[e] * p[e] + wa1[e] * q[e] + wa2[e] * n[e] + ba[e]);
            unpack8(rb[3 * j], p); unpack8(rb[3 * j + 1], q); unpack8(rb[3 * j + 2], n);
#pragma unroll
            for (int e = 0; e < 8; ++e) o[e] = a[e] * (wb0[e] * p[e] + wb1[e] * q[e] + wb2[e] * n[e] + bb[e]);
            *(v4u*)(ACT + (size_t)(r0 + 63 * j) * DFF + c) = pack8(o);
        }
    }
}

using pg8::f32x4; using pg8::Unit; using pg8::HALF; using pg8::BM;
struct EpiInGate {
    static constexpr bool PERM = true, CHAIN = false, PRE = false;
    bf16* U; float* DT; unsigned char* G; const float* bg; int pn0;
    __device__ __forceinline__ void operator()(const f32x4 (&acc)[2][2][4][2], const Unit& u, int wr, int wc, int fr, int fq) const {
        const int row0 = u.pm * BM + wr * 64 + fr, pn = u.pn + pn0;
        if (pn < 40) {
            const int col0 = pn * BM + wc * 32 + 8 * fq;
#pragma unroll
            for (int ai = 0; ai < 2; ++ai)
#pragma unroll
                for (int m = 0; m < 4; ++m) { bf16* rowp = U + (size_t)(row0 + ai * HALF + m * 16) * UC + col0;
#pragma unroll
                    for (int bj = 0; bj < 2; ++bj) { const f32x4 v0 = acc[ai][bj][m][0], v1 = acc[ai][bj][m][1];
                        v4u w; w.x = pg8::cvt_pk_bf16(v0[0], v0[1]); w.y = pg8::cvt_pk_bf16(v0[2], v0[3]); w.z = pg8::cvt_pk_bf16(v1[0], v1[1]); w.w = pg8::cvt_pk_bf16(v1[2], v1[3]);
                        *(v4u*)(rowp + bj * HALF) = w; } }
        } else if (pn == 40) {
            if (wc == 0 && fq < 2) {
#pragma unroll
                for (int ai = 0; ai < 2; ++ai)
#pragma unroll
                    for (int m = 0; m < 4; ++m) { float* rp = DT + (size_t)(row0 + ai * HALF + m * 16) * 16 + 8 * fq; *(f32x4*)rp = acc[ai][0][m][0]; *(f32x4*)(rp + 4) = acc[ai][0][m][1]; }
            }
        } else {
            const int col0 = (pn - 41) * BM + wc * 32 + 8 * fq;
            f32x4 bv[2][2];
#pragma unroll
            for (int bj = 0; bj < 2; ++bj)
#pragma unroll
                for (int n = 0; n < 2; ++n) bv[bj][n] = *(const f32x4*)(bg + col0 + bj * HALF + 4 * n) * -1.44269504f;
            constexpr float QC = 1.0f / 255.99f;
#pragma unroll
            for (int ai = 0; ai < 2; ++ai)
#pragma unroll
                for (int m = 0; m < 4; ++m) { unsigned char* rowp = G + (size_t)(row0 + ai * HALF + m * 16) * 8192 + col0;
#pragma unroll
                    for (int bj = 0; bj < 2; ++bj) {
                        unsigned q[8];
#pragma unroll
                        for (int e = 0; e < 4; ++e) {
                            const float e0 = __builtin_amdgcn_exp2f(__builtin_fmaf(acc[ai][bj][m][0][e], -1.44269504f, bv[bj][0][e])), e1 = __builtin_amdgcn_exp2f(__builtin_fmaf(acc[ai][bj][m][1][e], -1.44269504f, bv[bj][1][e]));
                            q[e] = (unsigned)__builtin_amdgcn_rcpf(__builtin_fmaf(e0, QC, QC)); q[4 + e] = (unsigned)__builtin_amdgcn_rcpf(__builtin_fmaf(e1, QC, QC)); }
                        v2u w; w.x = q[0] | (q[1] << 8) | (q[2] << 16) | (q[3] << 24); w.y = q[4] | (q[5] << 8) | (q[6] << 16) | (q[7] << 24);
                        *(v2u*)(rowp + bj * HALF) = w; } }
        }
    }
};
template <bool SCALE> struct EpiBf16 {
    static constexpr bool PERM = true, CHAIN = false, PRE = false;
    bf16* O; int ldc; const float* scale;
    __device__ __forceinline__ int operator()(const f32x4 (&acc)[2][2][4][2], const Unit& u, int wr, int wc, int fr, int fq) const {
        const int row0 = u.pm * BM + wr * 64 + fr, col0 = u.pn * BM + wc * 32 + 8 * fq;
        f32x4 sv[2][2];
        if (SCALE) {
#pragma unroll
            for (int bj = 0; bj < 2; ++bj)
#pragma unroll
                for (int n = 0; n < 2; ++n) sv[bj][n] = *(const f32x4*)(scale + col0 + bj * HALF + 4 * n);
        }
#pragma unroll
        for (int ai = 0; ai < 2; ++ai)
#pragma unroll
            for (int m = 0; m < 4; ++m) { bf16* rowp = O + (size_t)(row0 + ai * HALF + m * 16) * ldc + col0;
#pragma unroll
                for (int bj = 0; bj < 2; ++bj) { f32x4 v0 = acc[ai][bj][m][0], v1 = acc[ai][bj][m][1];
                    if (SCALE) { v0 = v0 * sv[bj][0]; v1 = v1 * sv[bj][1]; }
                    v4u w; w.x = pg8::cvt_pk_bf16(v0[0], v0[1]); w.y = pg8::cvt_pk_bf16(v0[2], v0[3]); w.z = pg8::cvt_pk_bf16(v1[0], v1[1]); w.w = pg8::cvt_pk_bf16(v1[2], v1[3]);
                    *(v4u*)(rowp + bj * HALF) = w; } }
        return 16;
    }
};
struct EpiFfn {
    static constexpr bool PERM = true, CHAIN = false, PRE = true;
    bf16* ACT; bf16* EDGE; const float* cw; const float* cb;
    static __device__ __forceinline__ float fshr1(float t, float x, float w) { asm("v_fmac_f32_dpp %0, %1, %2 row_shr:1 row_mask:0xf bank_mask:0xf bound_ctrl:0" : "+v"(t) : "v"(x), "v"(w)); return t; }
    static __device__ __forceinline__ float fshl1(float t, float x, float w) { asm("v_fmac_f32_dpp %0, %1, %2 row_shl:1 row_mask:0xf bank_mask:0xf bound_ctrl:0" : "+v"(t) : "v"(x), "v"(w)); return t; }
    static __device__ __forceinline__ float fror1(float t, float x, float w) { asm("v_fmac_f32_dpp %0, %1, %2 row_ror:1 row_mask:0xf bank_mask:0xf" : "+v"(t) : "v"(x), "v"(w)); return t; }
    static __device__ __forceinline__ float fror15(float t, float x, float w) { asm("v_fmac_f32_dpp %0, %1, %2 row_ror:15 row_mask:0xf bank_mask:0xf" : "+v"(t) : "v"(x), "v"(w)); return t; }
    template <int M> static __device__ __forceinline__ f32x4 conv4(const f32x4 (&x)[4][2], int n, const f32x4 (&w)[4], const f32x4 we0, const f32x4 we2) {
        f32x4 r;
#pragma unroll
        for (int e = 0; e < 4; ++e) { const float c = x[M][n][e];
            float t = __builtin_fmaf(w[1][e], c, w[3][e]);
            t = fshr1(t, c, w[0][e]);
            t = fshl1(t, c, w[2][e]);
            if (M > 0) t = fror1(t, x[M > 0 ? M - 1 : 0][n][e], we0[e]);
            if (M < 3) t = fror15(t, x[M < 3 ? M + 1 : 3][n][e], we2[e]);
            r[e] = t; }
        return r;
    }
    template <int M> __device__ __forceinline__ v2u act4(const f32x4 (&xa)[4][2], const f32x4 (&xb)[4][2], int n, const f32x4 (&wa)[4], const f32x4 (&wb)[4], const f32x4 wae0, const f32x4 wae2, const f32x4 wbe0, const f32x4 wbe2) const {
        const f32x4 va = conv4<M>(xa, n, wa, wae0, wae2), vb = conv4<M>(xb, n, wb, wbe0, wbe2);
        float o[4];
#pragma unroll
        for (int e = 0; e < 4; ++e) o[e] = va[e] * __builtin_amdgcn_rcpf(1.0f + __builtin_amdgcn_exp2f(va[e] * -1.44269504f)) * vb[e];
        v2u r; r.x = pk2(o[0], o[1]); r.y = pk2(o[2], o[3]); return r;
    }
    static constexpr int WOFF = 131072 + 320 + 2048;
    __device__ __forceinline__ void pre(PG8_LAS unsigned char* lds, const Unit& u, int wid, int lane, int par) const {
        if (wid < 4) {
            const int a = 2 * wid + (lane >> 5), k = a & 3;
            const float* src = (k < 3 ? cw + k * UPC : cb) + (a >> 2) * DFF + u.pn * 128 + (lane & 31) * 4;
            __builtin_amdgcn_global_load_lds((const unsigned*)src, (PG8_LAS unsigned*)(lds + WOFF + par * 4096 + wid * 1024), 16, 0, 0);
        }
    }
    __device__ __forceinline__ void operator()(const f32x4 (&acc)[2][2][4][2], const Unit& u, int wr, int wc, int fr, int fq, PG8_LAS unsigned char* lds, int par) const {
        const int row0 = u.pm * BM + wr * 64 + fr, c0 = u.pn * 128 + wc * 32 + 8 * fq;
        const float e0 = fr == 0 ? 1.f : 0.f, e15 = fr == 15 ? 1.f : 0.f;
#pragma unroll
        for (int ai = 0; ai < 2; ++ai) {
            const int blk = u.pm * 4 + ai * 2 + wr;
            if (fr < 2 || fr >= 14) {
                const int j = fr < 2 ? fr : fr - 12;
                const f32x4 a0 = fr < 2 ? acc[ai][0][0][0] : acc[ai][0][3][0], a1 = fr < 2 ? acc[ai][0][0][1] : acc[ai][0][3][1];
                const f32x4 b0 = fr < 2 ? acc[ai][1][0][0] : acc[ai][1][3][0], b1 = fr < 2 ? acc[ai][1][0][1] : acc[ai][1][3][1];
                bf16* ep = EDGE + ((size_t)(blk * 4 + j) * 2) * DFF + c0;
                v4u w; w.x = pk2(a0[0], a0[1]); w.y = pk2(a0[2], a0[3]); w.z = pk2(a1[0], a1[1]); w.w = pk2(a1[2], a1[3]); *(v4u*)ep = w;
                w.x = pk2(b0[0], b0[1]); w.y = pk2(b0[2], b0[3]); w.z = pk2(b1[0], b1[1]); w.w = pk2(b1[2], b1[3]); *(v4u*)(ep + DFF) = w;
            }
        }
        __builtin_amdgcn_sched_barrier(0);
        const PG8_LAS float* wl = (const PG8_LAS float*)(lds + WOFF + par * 4096) + wc * 32 + 8 * fq;
#pragma unroll
        for (int ai = 0; ai < 2; ++ai) {
            v2u carry[4];
#pragma unroll
            for (int n = 0; n < 2; ++n) {
                f32x4 wa[4], wb[4];
#pragma unroll
                for (int k = 0; k < 4; ++k) { wa[k] = *(const PG8_LAS f32x4*)(wl + k * 128 + 4 * n); wb[k] = *(const PG8_LAS f32x4*)(wl + (4 + k) * 128 + 4 * n); }
                const f32x4 wae0 = wa[0] * e0, wae2 = wa[2] * e15, wbe0 = wb[0] * e0, wbe2 = wb[2] * e15;
                v2u r[4];
                r[0] = act4<0>(acc[ai][0], acc[ai][1], n, wa, wb, wae0, wae2, wbe0, wbe2); r[1] = act4<1>(acc[ai][0], acc[ai][1], n, wa, wb, wae0, wae2, wbe0, wbe2);
                r[2] = act4<2>(acc[ai][0], acc[ai][1], n, wa, wb, wae0, wae2, wbe0, wbe2); r[3] = act4<3>(acc[ai][0], acc[ai][1], n, wa, wb, wae0, wae2, wbe0, wbe2);
#pragma unroll
                for (int m = 0; m < 4; ++m) {
                    if (n == 0) carry[m] = r[m];
                    else { v4u w; w.x = carry[m].x; w.y = carry[m].y; w.z = r[m].x; w.w = r[m].y; *(v4u*)(ACT + (size_t)(row0 + ai * HALF + m * 16) * DFF + c0) = w; }
                }
                __builtin_amdgcn_sched_barrier(0);
            }
        }
    }
};
struct EpiBranch {
    static constexpr bool PERM = true, CHAIN = true, PRE = false;
    const unsigned char* G; bf16* MERGED; int skip;
    static __device__ __forceinline__ void deq8(const v2u w, float (&g)[8]) {
        g[0] = (float)(w.x & 0xffu); g[1] = (float)((w.x >> 8) & 0xffu); g[2] = (float)((w.x >> 16) & 0xffu); g[3] = (float)(w.x >> 24);
        g[4] = (float)(w.y & 0xffu); g[5] = (float)((w.y >> 8) & 0xffu); g[6] = (float)((w.y >> 16) & 0xffu); g[7] = (float)(w.y >> 24);
#pragma unroll
        for (int e = 0; e < 8; ++e) g[e] = (g[e] + 0.5f) * (1.0f / 256.0f);
    }
    __device__ __forceinline__ bool operator()(f32x4 (&acc)[2][2][4][2], const Unit& u, int wr, int wc, int fr, int fq) const {
        const int row0 = u.pm * BM + wr * 64 + fr, col0 = u.pn * BM + wc * 32 + 8 * fq, sub = u.sub;
        const int subn = sub < 3 ? sub + 1 : sub;
        if (skip) return sub == 3;
        v2u gv[2][4][2], hv[2][4][2];
#pragma unroll
        for (int ai = 0; ai < 2; ++ai)
#pragma unroll
            for (int m = 0; m < 4; ++m)
#pragma unroll
                for (int bj = 0; bj < 2; ++bj) { const unsigned char* gp = G + (size_t)(row0 + ai * HALF + m * 16) * 8192 + col0 + bj * HALF;
                    gv[ai][m][bj] = *(const v2u*)(gp + sub * 2048); hv[ai][m][bj] = *(const v2u*)(gp + subn * 2048); }
#pragma unroll
        for (int ai = 0; ai < 2; ++ai)
#pragma unroll
            for (int m = 0; m < 4; ++m)
#pragma unroll
                for (int bj = 0; bj < 2; ++bj) {
                    float g[8], h[8]; deq8(gv[ai][m][bj], g); deq8(hv[ai][m][bj], h);
                    if (sub < 3) {
#pragma unroll
                        for (int e = 0; e < 8; ++e) g[e] = g[e] * __builtin_amdgcn_rcpf(h[e]);
                    }
                    f32x4& v0 = acc[ai][bj][m][0]; f32x4& v1 = acc[ai][bj][m][1];
                    v0[0] *= g[0]; v0[1] *= g[1]; v0[2] *= g[2]; v0[3] *= g[3]; v1[0] *= g[4]; v1[1] *= g[5]; v1[2] *= g[6]; v1[3] *= g[7];
                    if (sub == 3) { v4u w; w.x = pg8::cvt_pk_bf16(v0[0], v0[1]); w.y = pg8::cvt_pk_bf16(v0[2], v0[3]); w.z = pg8::cvt_pk_bf16(v1[0], v1[1]); w.w = pg8::cvt_pk_bf16(v1[2], v1[3]);
                        *(v4u*)(MERGED + (size_t)(row0 + ai * HALF + m * 16) * 2048 + col0 + bj * HALF) = w; }
                }
        return sub == 3;
    }
};
struct EpiResid {
    static constexpr bool PERM = false, CHAIN = false, PRE = false;
    float* X; const float* modl; int goff, skip;
    __device__ __forceinline__ void operator()(const f32x4 (&acc)[2][2][4][2], const Unit& u, int wr, int wc, int fr, int fq) const {
        if (skip) return;
        const int row0 = u.pm * BM + wr * 64 + fr, col0 = u.pn * BM + wc * 32 + 4 * fq;
        const float* gp = modl + (size_t)(u.pm < 64 ? (u.pm >> 4) : 4) * 12288 + goff + col0;
        f32x4 gv[2][2];
#pragma unroll
        for (int bj = 0; bj < 2; ++bj)
#pragma unroll
            for (int n = 0; n < 2; ++n) gv[bj][n] = *(const f32x4*)(gp + bj * HALF + n * 16);
#pragma unroll
        for (int ai = 0; ai < 2; ++ai) {
            f32x4 xv[4][2][2];
#pragma unroll
            for (int m = 0; m < 4; ++m)
#pragma unroll
                for (int bj = 0; bj < 2; ++bj)
#pragma unroll
                    for (int n = 0; n < 2; ++n) xv[m][bj][n] = *(const f32x4*)(X + (size_t)(row0 + ai * HALF + m * 16) * D + col0 + bj * HALF + n * 16);
#pragma unroll
            for (int m = 0; m < 4; ++m)
#pragma unroll
                for (int bj = 0; bj < 2; ++bj)
#pragma unroll
                    for (int n = 0; n < 2; ++n) *(f32x4*)(X + (size_t)(row0 + ai * HALF + m * 16) * D + col0 + bj * HALF + n * 16) = xv[m][bj][n] + gv[bj][n] * acc[ai][bj][m][n];
        }
    }
};

struct EpiPart {
    static constexpr bool PERM = false, CHAIN = false, PRE = false;
    float* PART; const float* modl; int goff;
    __device__ __forceinline__ int operator()(const f32x4 (&acc)[2][2][4][2], const Unit& u, int wr, int wc, int fr, int fq) const {
        const int row0 = (u.pm - 64) * BM + wr * 64 + fr, col0 = u.pn * BM + wc * 32 + 4 * fq;
        const float* gp = modl + (size_t)4 * 12288 + goff + col0;
        float* P = PART + (size_t)u.sub * MC * D;
        f32x4 gv[2][2];
#pragma unroll
        for (int bj = 0; bj < 2; ++bj)
#pragma unroll
            for (int n = 0; n < 2; ++n) gv[bj][n] = *(const f32x4*)(gp + bj * HALF + n * 16);
#pragma unroll
        for (int ai = 0; ai < 2; ++ai)
#pragma unroll
            for (int m = 0; m < 4; ++m)
#pragma unroll
                for (int bj = 0; bj < 2; ++bj)
#pragma unroll
                    for (int n = 0; n < 2; ++n) *(f32x4*)(P + (size_t)(row0 + ai * HALF + m * 16) * D + col0 + bj * HALF + n * 16) = gv[bj][n] * acc[ai][bj][m][n];
        return 32;
    }
};

constexpr int NPH = 11;
constexpr int N_PHASES = 1 + DEPTH * NPH + 1;

__global__ void __launch_bounds__(NWAVES * 64, 2) fwd_kernel(Args args) {
    extern __shared__ __attribute__((aligned(16))) unsigned char lds_raw[];
    Frame F;
    F.lds = (LAS unsigned char*)lds_raw;
    F.tid = threadIdx.x; F.lane = F.tid & 63; F.wave = __builtin_amdgcn_readfirstlane(F.tid >> 6);
    F.G = gridDim.x; F.bid = blockIdx.x; F.ws = args.ws; F.in = args.in;
#if defined(PROBE_K)
    F.variant = args.variant;
#else
    F.variant = 0;
#endif
    gu32* ctl = (gu32*)(args.ws + WS_CTL);
    for (int u = F.tid; u < (LDS_BYTES - LDSCTL_OFF) / 4; u += NWAVES * 64) ((LAS unsigned*)(F.lds + LDSCTL_OFF))[u] = 0u;
    __syncthreads();
    XcdBarrier bar; bar.bar = (unsigned*)(ctl + CW_BAR); bar.x = 0; bar.st = nullptr;
    if (!MK_PER_PHASE && args.ph_hi - args.ph_lo > 1) bar = xcd_barrier_post((unsigned*)(ctl + CW_BAR), (volatile LAS unsigned*)(F.lds + MISC_OFF) + 8);
    const int lo = args.ph_lo, hi = args.ph_hi;
#ifndef PH_MASK
#define PH_MASK 0xFFFF
#endif
#define EN(b) (((PH_MASK) >> (b)) & 1)
#define IN(k) (lo <= (k) && (k) < hi)
#define SEAM(k) do { if (!MK_PER_PHASE && IN((k) + 1)) xcd_barrier(bar); } while (0)

    if (EN(11) && IN(0)) { phase_mod(F); steal_convert(F, 0, 0, true); SEAM(0); }

    for (int l = 0; l < DEPTH; ++l) {
        const int p0 = 1 + l * NPH;
        const int nrows = (l == DEPTH - 1) ? ML : M;
        const int nMp = nrows / 256;
        const float* modl = (const float*)(F.ws + WS_MOD) + (size_t)l * 5 * 12288;
        const unsigned char* wb = F.ws + (size_t)(l & 1) * W_SPAN;
        const bool cv = l + 1 < DEPTH;
        if (EN(0) && IN(p0 + 0)) {
            if (l == 0) phase_norm<true>(F, l, F.in[I_NORM1] + (size_t)l * D, 0, 2048, M);
            else phase_norm<false>(F, l, F.in[I_NORM1] + (size_t)l * D, 0, 2048, M, true);
            SEAM(p0 + 0);
        }
        if (EN(1) && IN(p0 + 1)) {
            const bool two = (nrows == ML);
            {
                pg8::Gemm g{(const char*)(F.ws + WS_H), (const char*)(wb + WS_WIG), (size_t)256 * D * 2, 0, 0, (size_t)256 * D * 2, 0, D, D, D};
                pg8::TileOrder<1> S; S.init(M / 256, two ? 41 : NIG / 256, F.G, F.bid);
                EpiInGate E{(bf16*)(F.ws + WS_U), (float*)(F.ws + WS_DT), (unsigned char*)(F.ws + WS_G), F.in[I_BGATE] + (size_t)l * 4 * 2048, 0};
                pg8::gemm_phase(F.lds + RING_OFF, g, S, E);
            }
            if (two) {
                pg8::Gemm g{(const char*)(F.ws + WS_H), (const char*)(wb + WS_WIG) + (size_t)41 * 256 * D * 2, (size_t)256 * D * 2, 0, 0, (size_t)256 * D * 2, 0, D, D, D};
                pg8::TileOrder<1> S; S.init(ML / 256, 32, F.G, F.bid);
                EpiInGate E{(bf16*)(F.ws + WS_U), (float*)(F.ws + WS_DT), (unsigned char*)(F.ws + WS_G), F.in[I_BGATE] + (size_t)l * 4 * 2048, 41};
                pg8::gemm_phase(F.lds + RING_OFF, g, S, E);
            }
            if (cv) steal_convert(F, l + 1, 1 + l * 6 + 0, false);
            SEAM(p0 + 1);
        }
        if (EN(2) && IN(p0 + 2)) { phase_pre(F, l); SEAM(p0 + 2); }
        if (EN(3) && IN(p0 + 3)) {
            const int nscan = 192;
            const bool split = F.G > nscan;
            for (int id = F.bid; id < nscan; id += F.G) {
#ifndef NO_SSD
                if (id < 128) scan_unit<128, 64, true>(F, l, id >> 5, (id >> 1) & 15, id & 1);
                else
#endif
#ifndef NO_RET
                { const int j = id - 128; scan_unit<64, 128, false>(F, l, j >> 4, (j >> 1) & 7, j & 1); }
#else
                {}
#endif
            }
#ifndef NO_POOLG
            if (!split || F.bid >= nscan) {
                pg8::Gemm g{(const char*)(F.ws + WS_POOLED), (const char*)(wb + WS_WPOOL), (size_t)256 * 1024 * 2, (size_t)256 * 2, 0, (size_t)256 * 256 * 2, 0, 1024, 256, 256};
                pg8::TileOrder<1> S; S.init(M / 256, 4, split ? F.G - nscan : F.G, split ? F.bid - nscan : F.bid);
                EpiBf16<true> E{(bf16*)(F.ws + WS_YB) + YS_STRIDE, 1024, F.in[I_POOLS] + (size_t)l * 1024};
                pg8::gemm_phase(F.lds + RING_OFF, g, S, E);
                sc_phase(F, l, split ? F.bid - nscan : F.bid, split ? F.G - nscan : F.G);
            }
            if (cv) steal_convert(F, l + 1, 1 + l * 6 + 5, false);
#endif
            SEAM(p0 + 3);
        }
        if (EN(4) && IN(p0 + 4)) { phase_fin(F, l, nrows); SEAM(p0 + 4); }
        if (EN(5) && IN(p0 + 5)) {
            pg8::Gemm g{(const char*)(F.ws + WS_YB), (const char*)(wb + WS_WB), (size_t)256 * 1024 * 2, 0, YS_STRIDE * 2, (size_t)256 * 1024 * 2, (size_t)2048 * 1024 * 2, 1024, 1024, 1024};
            pg8::TileOrder<4> S; S.init(nMp, D / 256, F.G, F.bid, 8);
            EpiBranch E{(const unsigned char*)(F.ws + WS_G), (bf16*)(F.ws + WS_MERGED), F.variant & 128};
            pg8::gemm_phase(F.lds + RING_OFF, g, S, E);
            if (cv) steal_convert(F, l + 1, 1 + l * 6 + 1, false);
            SEAM(p0 + 5);
        }
        if (EN(6) && IN(p0 + 6)) {
            pg8::Gemm g{(const char*)(F.ws + WS_MERGED), (const char*)(wb + WS_WO), (size_t)256 * D * 2, 0, 0, (size_t)256 * D * 2, 0, D, D, D};
            pg8::TileOrder<1> S; S.init(ML / 256, D / 256, F.G, F.bid);
            EpiResid E{(float*)(F.ws + WS_X), modl, 4096, F.variant & 128};
            pg8::gemm_phase(F.lds + RING_OFF, g, S, E);
            if (nMp > ML / 256) {
                pg8::Gemm g2{(const char*)(F.ws + WS_MERGED), (const char*)(wb + WS_WO), (size_t)256 * D * 2, 0, (size_t)(D / 4) * 2, (size_t)256 * D * 2, (size_t)(D / 4) * 2, D, D, D / 4};
                pg8::SplitOrder<4> S2; S2.init(nMp - ML / 256, D / 256, ML / 256, F.G, F.bid);
                EpiPart E2{(float*)(F.ws + WS_PART), modl, 4096};
                pg8::gemm_phase(F.lds + RING_OFF, g2, S2, E2);
            }
            if (cv) steal_convert(F, l + 1, 1 + l * 6 + 2, false);
            SEAM(p0 + 6);
        }
        if (EN(7) && IN(p0 + 7)) { phase_norm<false>(F, l, F.in[I_NORM2] + (size_t)l * D, 6144, 8192, nrows, nrows > ML); SEAM(p0 + 7); }
        if (EN(8) && IN(p0 + 8)) {
            pg8::Gemm g{(const char*)(F.ws + WS_H), (const char*)(wb + WS_WUP), (size_t)256 * D * 2, 0, 0, (size_t)256 * D * 2, 0, D, D, D};
            pg8::TileOrder<1> S; S.init(nMp, UPC / 256, F.G, F.bid);
            EpiFfn E{(bf16*)(F.ws + WS_ACT), (bf16*)(F.ws + WS_UP), F.in[I_FFNCW] + (size_t)l * 3 * UPC, F.in[I_FFNCB] + (size_t)l * UPC};
            pg8::gemm_phase(F.lds + RING_OFF, g, S, E);
            if (cv) steal_convert(F, l + 1, 1 + l * 6 + 3, false);
            SEAM(p0 + 8);
        }
        if (EN(9) && IN(p0 + 9)) { phase_ffnfix(F, l, nrows); SEAM(p0 + 9); }
        if (EN(10) && IN(p0 + 10)) {
            pg8::Gemm g{(const char*)(F.ws + WS_ACT), (const char*)(wb + WS_WDN), (size_t)256 * DFF * 2, 0, 0, (size_t)256 * DFF * 2, 0, DFF, DFF, DFF};
            pg8::TileOrder<1> S; S.init(ML / 256, D / 256, F.G, F.bid, 2);
            EpiResid E{(float*)(F.ws + WS_X), modl, 10240, F.variant & 128};
            pg8::gemm_phase(F.lds + RING_OFF, g, S, E);
            if (nMp > ML / 256) {
                pg8::Gemm g2{(const char*)(F.ws + WS_ACT), (const char*)(wb + WS_WDN), (size_t)256 * DFF * 2, 0, (size_t)(DFF / 4) * 2, (size_t)256 * DFF * 2, (size_t)(DFF / 4) * 2, DFF, DFF, DFF / 4};
                pg8::SplitOrder<4> S2; S2.init(nMp - ML / 256, D / 256, ML / 256, F.G, F.bid);
                EpiPart E2{(float*)(F.ws + WS_PART), modl, 10240};
                pg8::gemm_phase(F.lds + RING_OFF, g2, S2, E2);
            }
            if (cv) steal_convert(F, l + 1, 1 + l * 6 + 4, true);
            SEAM(p0 + 10);
        }
    }
    if (EN(12) && IN(N_PHASES - 1)) {
        phase_final(F, args.out);
    }
#undef IN
#undef SEAM
}

extern "C" void kernel_launch(void* const* d_in, const int* in_sizes, int n_in, void* d_out, int out_size, void* d_ws, size_t ws_size, hipStream_t stream) {
    static int grid = 0;
    if (grid == 0) {
        if (n_in != 28 || in_sizes[0] != ML * D || out_size != ML * D || ws_size < WS_END) { fprintf(stderr, "kernel_launch: unexpected shapes (n_in %d, in0 %d, out %d, ws %zu < %zu); nothing launched\n", n_in, n_in > 0 ? in_sizes[0] : -1, out_size, ws_size, (size_t)WS_END); grid = -1; return; }
        int dev = 0, cus = 0, per_cu = 0;
        if (hipGetDevice(&dev) != hipSuccess || hipDeviceGetAttribute(&cus, hipDeviceAttributeMultiprocessorCount, dev) != hipSuccess) { fprintf(stderr, "kernel_launch: device query failed\n"); grid = -1; return; }
        if (hipFuncSetAttribute((const void*)fwd_kernel, hipFuncAttributeMaxDynamicSharedMemorySize, LDS_BYTES) != hipSuccess) { fprintf(stderr, "kernel_launch: hipFuncSetAttribute failed\n"); grid = -1; return; }
        if (hipOccupancyMaxActiveBlocksPerMultiprocessor(&per_cu, (const void*)fwd_kernel, NWAVES * 64, LDS_BYTES) != hipSuccess || per_cu < 1)
            fprintf(stderr, "kernel_launch: note: occupancy query reports %d workgroups per CU\n", per_cu);
        (void)hipGetLastError();
        grid = cus;
    }
    if (grid < 0) return;
    if (hipMemsetAsync((char*)d_ws + WS_CTL, 0, CTL_ZERO_BYTES, stream) != hipSuccess) { fprintf(stderr, "kernel_launch: memset failed\n"); return; }
    Args a{};
    for (int i = 0; i < 28; ++i) a.in[i] = (const float*)d_in[i];
    a.out = (float*)d_out; a.ws = (unsigned char*)d_ws;
#if defined(PROBE_K)
    a.ph_lo = 0; a.ph_hi = N_PHASES;
    hipLaunchKernelGGL(fwd_kernel, dim3(grid), dim3(NWAVES * 64), LDS_BYTES, stream, a);
    for (int rep = 0; rep < PROBE_REPS; ++rep) for (int l = 0; l < DEPTH; ++l) { a.ph_lo = 1 + l * NPH + PROBE_K; a.ph_hi = a.ph_lo + 1; a.variant = PROBE_VARIANT; hipLaunchKernelGGL(fwd_kernel, dim3(grid), dim3(NWAVES * 64), LDS_BYTES, stream, a); }
#elif MK_PER_PHASE
    for (int p = 0; p < N_PHASES; ++p) { a.ph_lo = p; a.ph_hi = p + 1; hipLaunchKernelGGL(fwd_kernel, dim3(grid), dim3(NWAVES * 64), LDS_BYTES, stream, a); }
#else
    a.ph_lo = 0; a.ph_hi = N_PHASES;
    hipLaunchKernelGGL(fwd_kernel, dim3(grid), dim3(NWAVES * 64), LDS_BYTES, stream, a);
#endif
    const hipError_t le = hipPeekAtLastError();
    if (le != hipSuccess) fprintf(stderr, "kernel_launch: launch failed: %s\n", hipGetErrorName(le));
}
```

```cpp
#include <hip/hip_runtime.h>
#include <cstdio>
#include <cstdint>

#ifndef MK_PER_PHASE
#define MK_PER_PHASE 0
#endif

namespace pg8 {
#define PG8_LAS __attribute__((address_space(3)))
typedef unsigned short bf16_t;
typedef short bf16x8 __attribute__((ext_vector_type(8)));
typedef float f32x4 __attribute__((ext_vector_type(4)));
typedef unsigned u32x4 __attribute__((ext_vector_type(4)));
constexpr int BM = 256, BK = 64, HALF = 128, HTB = HALF * BK * 2, STAGE_BYTES = 8 * HTB, NXCD = 8, WGM = 8;

__host__ __device__ __forceinline__ int lds_byte(int r, int c) { const int st = (r >> 4) * 2 + (c >> 5), rr = r & 15, cc = c & 31, ob = rr * 64 + cc * 2; return st * 1024 + (ob ^ (((ob >> 9) & 1) << 5)); }
__host__ __device__ __forceinline__ void stage_rc(int b, int& R, int& C) { const int st = b / 1024, sb = b % 1024, swz = sb ^ (((sb >> 9) & 1) << 5); R = (st >> 1) * 16 + swz / 64; C = (st & 1) * 32 + (swz % 64) / 2; }
__host__ __device__ __forceinline__ int perm32(int rho) { const int n = rho >> 4, i = rho & 15; return 8 * (i >> 2) + 4 * n + (i & 3); }

struct Unit { int pm, pn, sub; };
struct Gemm { const char* A; const char* B; size_t a_tile, a_pn, a_sub, b_tile, b_sub; int lda, ldb, K; };

template <int NSUB> struct TileOrder {
    int nM, nN, nwg, G, c, wgm;
    __device__ __forceinline__ void init(int nM_, int nN_, int G_, int c_, int wgm_ = 4) { nM = nM_; nN = nN_; nwg = nM * nN; G = G_; c = c_; wgm = wgm_; }
    __device__ __forceinline__ bool next(int i, Unit& u) const {
        const int sub = i % NSUB; const long L = (long)(i / NSUB) * G + c; if (L >= nwg) return false;
        int wgid = (int)L; { const int q = nwg / NXCD, r = nwg % NXCD, xcd = wgid % NXCD, off = wgid / NXCD; wgid = (xcd < r ? xcd * (q + 1) : r * (q + 1) + (xcd - r) * q) + off; }
        const int nig = wgm * nN, gid = wgid / nig, fm = gid * wgm, gsz = (nM - fm) < wgm ? (nM - fm) : wgm;
        u.pm = fm + ((wgid % nig) % gsz); u.pn = (wgid % nig) / gsz; u.sub = sub; return true;
    }
};

template <int NSUB> struct SplitOrder {
    int nM, nN, pm0, G, c;
    __device__ __forceinline__ void init(int nM_, int nN_, int pm0_, int G_, int c_) { nM = nM_; nN = nN_; pm0 = pm0_; G = G_; c = c_; }
    __device__ __forceinline__ bool next(int i, Unit& u) const {
        const int j = i * G + c; if (j >= nM * nN * NSUB) return false;
        const int tile = j / NSUB; u.sub = j % NSUB; u.pm = pm0 + tile / nN; u.pn = tile % nN; return true;
    }
};
typedef __bf16 bf16x2_t __attribute__((ext_vector_type(2)));
typedef float f32x2_t __attribute__((ext_vector_type(2)));
__device__ __forceinline__ unsigned cvt_pk_bf16(float lo, float hi) { const f32x2_t v = {lo, hi}; return __builtin_bit_cast(unsigned, __builtin_convertvector(v, bf16x2_t)); }

template <class Epi, class Sched>
__device__ __forceinline__ void gemm_phase(PG8_LAS unsigned char* lds, const Gemm g, const Sched& S, const Epi& E) {
    int tid_ = threadIdx.x; asm volatile("" : "+v"(tid_));
    const int tid = tid_, wid = __builtin_amdgcn_readfirstlane(tid >> 6), lane = tid & 63, wr = wid >> 2, wc = wid & 3, fr = lane & 15, fq = lane >> 4;
    const int K = g.K, nt = K / BK;
    unsigned voffA[2], voffB[2];
#pragma unroll
    for (int i = 0; i < 2; ++i) { int R, C; stage_rc(tid * 16 + i * 8192, R, C); const int Rb = Epi::PERM ? ((R & ~31) + perm32(R & 31)) : R;
        voffA[i] = (unsigned)(R * g.lda + C) * 2u; voffB[i] = (unsigned)(Rb * g.ldb + C) * 2u; }
    const size_t kstep = (size_t)(BK * 2);
    const size_t hstepA = (size_t)HALF * g.lda * 2, hstepB = (size_t)HALF * g.ldb * 2;
    const unsigned ldsw = (unsigned)wid * 1024u;
    const int aoff = lds_byte(wr * 64 + fr, fq * 8), boff = lds_byte(wc * 32 + fr, fq * 8);
#define PG8_SA(b, h) (((b) * 2 + (h)) * HTB)
#define PG8_SB(b, h) ((4 + (b) * 2 + (h)) * HTB)
#define PG8_STAGE(bufoff, gbase, voff) do { _Pragma("unroll") for (int _i = 0; _i < 2; ++_i) \
        __builtin_amdgcn_global_load_lds((const unsigned*)((const char*)(gbase) + (voff)[_i]), (PG8_LAS unsigned*)(lds + (bufoff) + ldsw + _i * 8192), 16, 0, 0); } while (0)
#define PG8_LDA(dst, b, h) do { _Pragma("unroll") for (int m = 0; m < 4; ++m) _Pragma("unroll") for (int k = 0; k < 2; ++k) dst[m][k] = *(const PG8_LAS bf16x8*)(lds + PG8_SA(b, h) + aoff + m * 2048 + k * 1024); } while (0)
#define PG8_LDB(dst, b, h) do { _Pragma("unroll") for (int n = 0; n < 2; ++n) _Pragma("unroll") for (int k = 0; k < 2; ++k) dst[n][k] = *(const PG8_LAS bf16x8*)(lds + PG8_SB(b, h) + boff + n * 2048 + k * 1024); } while (0)
#define PG8_MMA(ai, bj, At, Bt) do { __builtin_amdgcn_s_setprio(1); _Pragma("unroll") for (int m = 0; m < 4; ++m) _Pragma("unroll") for (int n = 0; n < 2; ++n) _Pragma("unroll") for (int k = 0; k < 2; ++k) \
        acc[ai][bj][m][n] = __builtin_amdgcn_mfma_f32_16x16x32_bf16(Bt[n][k], At[m][k], acc[ai][bj][m][n], 0, 0, 0); __builtin_amdgcn_s_setprio(0); } while (0)
#define PG8_WAIT_V(n) asm volatile("s_waitcnt vmcnt(" #n ")" ::: "memory")
#define PG8_WAIT_L(n) asm volatile("s_waitcnt lgkmcnt(" #n ")" ::: "memory")
#define PG8_BAR __builtin_amdgcn_s_barrier()
#define PG8_SCHED __builtin_amdgcn_sched_barrier(0)
    Unit cur, nxt; int ui = 0;
    if (!S.next(0, cur)) return;
    if constexpr (Epi::PRE) E.pre(lds, cur, wid, lane, 0);
    constexpr int ND = 4, NP = 8 - ND;
    u32x4 pend[NP]; char* pptr = nullptr; int plim = 0; size_t prow = 0;
    if constexpr (Epi::PRE) {
#pragma unroll
        for (int j = 0; j < NP; ++j) pend[j] = (u32x4){0u, 0u, 0u, 0u};
        prow = E.rowbytes();
    }
    f32x4 acc[2][2][4][2];
#pragma unroll
    for (int a = 0; a < 2; ++a)
#pragma unroll
        for (int b = 0; b < 2; ++b)
#pragma unroll
            for (int m = 0; m < 4; ++m)
#pragma unroll
                for (int n = 0; n < 2; ++n) acc[a][b][m][n] = (f32x4){0.f, 0.f, 0.f, 0.f};
    bf16x8 At[4][2], B0[2][2], B1[2][2];
    const char* cA = g.A + (size_t)cur.pm * g.a_tile + (size_t)cur.pn * g.a_pn + (size_t)cur.sub * g.a_sub;
    const char* cB = g.B + (size_t)cur.pn * g.b_tile + (size_t)cur.sub * g.b_sub;
    PG8_STAGE(PG8_SB(0, 0), cB, voffB); PG8_STAGE(PG8_SB(0, 1), cB + hstepB, voffB); PG8_STAGE(PG8_SA(0, 0), cA, voffA); PG8_STAGE(PG8_SA(0, 1), cA + hstepA, voffA);
    if (wr == 1) PG8_BAR;
    PG8_WAIT_V(2); PG8_BAR;
    PG8_STAGE(PG8_SB(1, 0), cB + kstep, voffB); PG8_STAGE(PG8_SA(1, 0), cA + kstep, voffA); PG8_STAGE(PG8_SB(1, 1), cB + hstepB + kstep, voffB);
    PG8_WAIT_V(6); PG8_BAR;
    for (;;) {
        const bool has_next = S.next(ui + 1, nxt);
        const char* nA = has_next ? g.A + (size_t)nxt.pm * g.a_tile + (size_t)nxt.pn * g.a_pn + (size_t)nxt.sub * g.a_sub : cA;
        const char* nB = has_next ? g.B + (size_t)nxt.pn * g.b_tile + (size_t)nxt.sub * g.b_sub : cB;
        for (int t = 0; t < nt; t += 2) {
            const bool last = (t == nt - 2);
            const char* a1 = cA + (size_t)(t + 1) * kstep;
            const char* a2 = last ? nA : cA + (size_t)(t + 2) * kstep; const char* b2 = last ? nB : cB + (size_t)(t + 2) * kstep;
            const char* a3 = a2 + kstep; const char* b3 = b2 + kstep;
            PG8_LDB(B0, 0, 0); PG8_LDB(B1, 0, 1); PG8_SCHED; PG8_LDA(At, 0, 0); PG8_STAGE(PG8_SA(1, 1), a1 + hstepA, voffA);
            if constexpr (Epi::PRE) {
                asm volatile("s_cmp_lt_u32 %2, %3\n\ts_cbranch_scc0 1f\n\tglobal_store_dwordx4 %0, %1, off\n\ts_nop 3\n1:" :: "v"(pptr), "v"(pend[0]), "s"(t), "s"(plim) : "memory", "scc");
#pragma unroll
                for (int j = 0; j < NP - 1; ++j) pend[j] = pend[j + 1];
                pptr += (size_t)(t == 2 * (3 - ND) ? 80 : 16) * prow;
            }
            PG8_WAIT_V(8); PG8_WAIT_L(0); PG8_BAR; PG8_MMA(0, 0, At, B0); PG8_MMA(0, 1, At, B1); PG8_BAR; PG8_SCHED;
            PG8_LDA(At, 0, 1); PG8_STAGE(PG8_SB(0, 0), b2, voffB); PG8_STAGE(PG8_SB(0, 1), b2 + hstepB, voffB); PG8_STAGE(PG8_SA(0, 0), a2, voffA);
            PG8_WAIT_V(8); PG8_WAIT_L(0); PG8_BAR; PG8_MMA(1, 0, At, B0); PG8_MMA(1, 1, At, B1); PG8_BAR; PG8_SCHED;
            PG8_LDB(B0, 1, 0); PG8_LDB(B1, 1, 1); PG8_SCHED; PG8_LDA(At, 1, 0); PG8_STAGE(PG8_SA(0, 1), a2 + hstepA, voffA);
            PG8_WAIT_V(8); PG8_WAIT_L(0); PG8_BAR; PG8_MMA(0, 0, At, B0); PG8_MMA(0, 1, At, B1); PG8_BAR; PG8_SCHED;
            PG8_LDA(At, 1, 1); PG8_STAGE(PG8_SB(1, 0), b3, voffB); PG8_STAGE(PG8_SB(1, 1), b3 + hstepB, voffB); PG8_STAGE(PG8_SA(1, 0), a3, voffA);
            PG8_WAIT_V(8); PG8_WAIT_L(0); PG8_BAR; PG8_MMA(1, 0, At, B0); PG8_MMA(1, 1, At, B1); PG8_BAR; PG8_SCHED;
        }
        if (wr == 0) PG8_BAR;
        bool zero_acc = true;
        if constexpr (Epi::PRE) { int fr2 = fr, fq2 = fq; asm volatile("" : "+v"(fr2), "+v"(fq2));
            E(acc, cur, wr, wc, fr2, fq2, lds, ui & 1, pend, pptr); plim = 2 * NP;
            if (!has_next) {
#pragma unroll
                for (int j = ND; j < 8; ++j) *(u32x4*)(pptr + (size_t)(((j >> 2) * 128 + (j & 3) * 16) - ((ND >> 2) * 128 + (ND & 3) * 16)) * prow) = pend[j - ND];
            } }
        else if constexpr (Epi::CHAIN) zero_acc = E(acc, cur, wr, wc, fr, fq); else E(acc, cur, wr, wc, fr, fq);
        if (!has_next) break;
        if (zero_acc) {
#pragma unroll
        for (int a = 0; a < 2; ++a)
#pragma unroll
            for (int b = 0; b < 2; ++b)
#pragma unroll
                for (int m = 0; m < 4; ++m)
#pragma unroll
                    for (int n = 0; n < 2; ++n) acc[a][b][m][n] = (f32x4){0.f, 0.f, 0.f, 0.f};
        }
        cur = nxt; cA = nA; cB = nB; ++ui;
        if constexpr (Epi::PRE) E.pre(lds, cur, wid, lane, ui & 1);
        if (wr == 1) PG8_BAR;
    }
    PG8_WAIT_V(0);
    PG8_BAR;
#undef PG8_SA
#undef PG8_SB
#undef PG8_STAGE
#undef PG8_LDA
#undef PG8_LDB
#undef PG8_MMA
#undef PG8_WAIT_V
#undef PG8_WAIT_L
#undef PG8_BAR
#undef PG8_SCHED
}
}

constexpr int NWAVES = 8;
constexpr int D = 2048, NB = 4, SEQ = 4096, CTX = 256, DEPTH = 4;
constexpr int ML = NB * SEQ;
constexpr int MC = NB * CTX;
constexpr int M = ML + MC;
constexpr int UC = 10240;
constexpr int NIG = 10496 + 8192;
constexpr int DFF = 5632, UPC = 2 * DFF;
constexpr int IN_COLS = 10256;
constexpr float EPS = 1e-6f;
constexpr int U_Z = 0, U_XBC = 1024, U_POOL = 3072, U_SCB = 4096, U_SCC = 5120, U_SCX = 6144, U_RQ = 7168, U_RK = 7680, U_RV = 8192, U_RG = 9216;

constexpr size_t MiB = 1u << 20;
constexpr size_t WS_CTL = 0, CTL_ZERO_BYTES = 128 * 1024;
constexpr size_t WS_MOD = 1 * MiB;
constexpr size_t WS_ROPE = WS_MOD + (size_t)DEPTH * 5 * 12288 * 4;
constexpr size_t WS_X = 2 * MiB;
constexpr size_t WS_H = WS_X + 136 * MiB;
constexpr size_t WS_WIG = WS_H + 68 * MiB;
constexpr size_t WS_WB = WS_WIG + 73 * MiB;
constexpr size_t WS_WO = WS_WB + 16 * MiB;
constexpr size_t WS_WUP = WS_WO + 8 * MiB;
constexpr size_t WS_WDN = WS_WUP + 44 * MiB;
constexpr size_t WS_WPOOL = WS_WDN + 22 * MiB;
constexpr size_t W_SPAN = WS_WPOOL + 1 * MiB - WS_WIG;
constexpr size_t WS_U = WS_WIG + 2 * W_SPAN;
constexpr size_t WS_DT = WS_U + 340 * MiB;
constexpr size_t WS_G = WS_DT + 2 * MiB;
constexpr size_t WS_UP = WS_U;
constexpr size_t WS_CUMA = WS_G + 140 * MiB;
constexpr size_t WS_DTA = WS_CUMA + 4 * MiB;
constexpr size_t WS_PART = WS_G + 152 * MiB;
constexpr size_t WS_XBCA = WS_G + 272 * MiB;
constexpr size_t WS_RQK = WS_XBCA + 68 * MiB;
constexpr size_t WS_YS = WS_RQK + 34 * MiB;
constexpr size_t WS_YB = WS_YS + 136 * MiB;
constexpr size_t WS_POOLED = WS_YB + 136 * MiB;
constexpr size_t WS_MERGED = WS_POOLED + 34 * MiB;
constexpr size_t WS_MRG32 = WS_XBCA;
constexpr size_t WS_ACT = WS_XBCA;
constexpr size_t WS_END = WS_MERGED + 68 * MiB;
static_assert(WS_UP + (size_t)M * UPC * 2 <= WS_XBCA, "UP overlay");
static_assert(WS_DTA + 4 * MiB <= WS_PART && WS_PART + 32 * MiB <= WS_XBCA, "PART");
static_assert(WS_UP + (size_t)M * UPC * 2 <= WS_CUMA && WS_DTA + 4 * MiB <= WS_XBCA && (size_t)2 * 16 * M * 4 <= 4 * MiB, "cum/dt arrays");
static_assert(WS_ACT + (size_t)M * DFF * 2 <= WS_YB, "ACT overlay");
static_assert(WS_MRG32 + (size_t)M * D * 4 <= WS_YS + 34 * MiB, "MRG32 overlay");
static_assert(WS_ROPE + 8192 <= WS_X, "mod/rope");
constexpr size_t YS_STRIDE = (size_t)M * 1024;

constexpr int CW_TMO = 0, CW_CODE = 1, CW_BAR = 4096, CW_Q = 16384, CW_FIN = 20480;

constexpr int RING_OFF = 0, RING_BYTES = 131072;
constexpr int LDSCTL_OFF = RING_BYTES, MISC_OFF = LDSCTL_OFF + 320;
constexpr int LDS_BYTES = 147456;

#define GAS __attribute__((address_space(1)))
#define LAS __attribute__((address_space(3)))
typedef unsigned short bf16;
typedef unsigned v4u __attribute__((ext_vector_type(4)));
typedef unsigned v2u __attribute__((ext_vector_type(2)));
typedef float f32x4 __attribute__((ext_vector_type(4)));
typedef float f32x16 __attribute__((ext_vector_type(16)));
typedef short bf16x8 __attribute__((ext_vector_type(8)));
typedef GAS unsigned gu32;
#define RLX_AGENT __ATOMIC_RELAXED, __HIP_MEMORY_SCOPE_AGENT
#define LDS_WAIT() asm volatile("s_waitcnt lgkmcnt(0)" ::: "memory")
#define VM_WAIT() asm volatile("s_waitcnt vmcnt(0)" ::: "memory")
__device__ __forceinline__ unsigned f2bf(float f) { return (unsigned)__builtin_bit_cast(unsigned short, (__bf16)f); }
__device__ __forceinline__ unsigned pk2(float lo, float hi) { return pg8::cvt_pk_bf16(lo, hi); }
__device__ __forceinline__ float bflo(unsigned w) { return __builtin_bit_cast(float, w << 16); }
__device__ __forceinline__ float bfhi(unsigned w) { return __builtin_bit_cast(float, w & 0xffff0000u); }
__device__ __forceinline__ float bf1(unsigned short b) { return __builtin_bit_cast(float, (unsigned)b << 16); }
__device__ __forceinline__ void unpack8(const v4u w, float (&f)[8]) { f[0] = bflo(w.x); f[1] = bfhi(w.x); f[2] = bflo(w.y); f[3] = bfhi(w.y); f[4] = bflo(w.z); f[5] = bfhi(w.z); f[6] = bflo(w.w); f[7] = bfhi(w.w); }
__device__ __forceinline__ v4u pack8(const float (&f)[8]) { v4u w; w.x = pk2(f[0], f[1]); w.y = pk2(f[2], f[3]); w.z = pk2(f[4], f[5]); w.w = pk2(f[6], f[7]); return w; }
__device__ __forceinline__ float sigmoidf_(float x) { return __builtin_amdgcn_rcpf(1.0f + __expf(-x)); }
__device__ __forceinline__ float siluf_(float x) { return x * sigmoidf_(x); }
__device__ __forceinline__ float softplusf_(float x) { return fmaxf(x, 0.f) + log1pf(expf(-fabsf(x))); }
template <int CTRL> __device__ __forceinline__ float dppf(float v) { return __builtin_bit_cast(float, __builtin_amdgcn_update_dpp(0, __builtin_bit_cast(int, v), CTRL, 0xf, 0xf, true)); }
__device__ __forceinline__ float red8(float v) { v += dppf<0xB1>(v); v += dppf<0x4E>(v); v += dppf<0x141>(v); return v; }
__device__ __forceinline__ float wave_sum(float v) {
    v = red8(v); v += dppf<0x140>(v);
    v += __builtin_bit_cast(float, __builtin_amdgcn_ds_swizzle(__builtin_bit_cast(int, v), 0x401F));
    return __builtin_bit_cast(float, __builtin_amdgcn_readlane(__builtin_bit_cast(int, v), 0)) + __builtin_bit_cast(float, __builtin_amdgcn_readlane(__builtin_bit_cast(int, v), 32));
}

#define XB_TMO      128
#define XB_XCNT(j)  (256  + 64 * (j))
#define XB_XSUB(j)  (1280 + 64 * (j))
#define XB_XGEN(j)  (2304 + 64 * (j))
#define XB_TOP      3328
#define XB_TOPGEN   3392
#define XCD_BAR_WORDS 3456
#define XB_SPIN_CAP (1u << 18)
__device__ __forceinline__ unsigned xb_ld(unsigned* p)              { return __hip_atomic_load(p, __ATOMIC_RELAXED, __HIP_MEMORY_SCOPE_AGENT); }
__device__ __forceinline__ unsigned xb_add(unsigned* p, unsigned v) { return __hip_atomic_fetch_add(p, v, __ATOMIC_RELAXED, __HIP_MEMORY_SCOPE_AGENT); }
__device__ __forceinline__ unsigned xb_xcc_id() { return (unsigned)__builtin_amdgcn_s_getreg((3 << 11) | 20) & 0xFu; }
#define XB_SPIN(cond, bar) do { unsigned _sp = 0; while (cond) { __builtin_amdgcn_s_sleep(1); \
    if ((++_sp & 255u) == 0u) { if (xb_ld(&(bar)[XB_TMO])) break; if (_sp > XB_SPIN_CAP) { atomicAdd(&(bar)[XB_TMO], 1u); break; } } } } while (0)
struct XcdBarrier { unsigned* bar; unsigned x; volatile LAS unsigned* st; };
__device__ __forceinline__ XcdBarrier xcd_barrier_post(unsigned* bar, volatile LAS unsigned* st) {
    XcdBarrier b; b.bar = bar; b.x = xb_xcc_id(); b.st = st;
    if (threadIdx.x == 0) (void)xb_add(&bar[XB_XCNT(b.x)], 1u);
    return b;
}
__device__ __forceinline__ void xcd_barrier_complete(unsigned* bar, unsigned x, unsigned& nloc, unsigned& nx) {
    const unsigned G = gridDim.x * gridDim.y * gridDim.z;
    unsigned sum, cnt, mine, sp = 0u;
    for (;;) {
        sum = 0u; cnt = 0u; mine = 0u;
#pragma unroll
        for (unsigned j = 0; j < 16; ++j) { const unsigned c = xb_ld(&bar[XB_XCNT(j)]); sum += c; cnt += (c > 0u) ? 1u : 0u; mine = (j == x) ? c : mine; }
        if (sum == G) break;
        __builtin_amdgcn_s_sleep(1);
        if ((++sp & 255u) == 0u) { if (xb_ld(&bar[XB_TMO])) break; if (sp > XB_SPIN_CAP) { atomicAdd(&bar[XB_TMO], 1u); break; } }
    }
    nloc = mine > 0u ? mine : 1u; nx = cnt > 0u ? cnt : 1u;
}
__device__ __forceinline__ void xcd_barrier(const XcdBarrier& b) {
    asm volatile("s_waitcnt vmcnt(0)" ::: "memory");
    __syncthreads();
    if (threadIdx.x == 0) {
        unsigned* bar = b.bar;
        __builtin_amdgcn_s_waitcnt(0);
        unsigned nloc = b.st[0], nx = b.st[1];
        if (nloc == 0u) { xcd_barrier_complete(bar, b.x, nloc, nx); b.st[0] = nloc; b.st[1] = nx; }
        const unsigned old = xb_add(&bar[XB_XSUB(b.x)], 1u);
        const unsigned gen = old / nloc;
        if (old + 1u == (gen + 1u) * nloc) {
            __builtin_amdgcn_fence(__ATOMIC_RELEASE, "agent");
            asm volatile("s_waitcnt vmcnt(0)" ::: "memory");
            const unsigned og = xb_add(&bar[XB_TOP], 1u);
            const unsigned tg = og / nx;
            if (og + 1u == (tg + 1u) * nx) xb_add(&bar[XB_TOPGEN], 1u);
            else XB_SPIN(xb_ld(&bar[XB_TOPGEN]) == tg, bar);
            __builtin_amdgcn_fence(__ATOMIC_ACQUIRE, "agent");
            xb_add(&bar[XB_XGEN(b.x)], 1u);
            asm volatile("s_waitcnt vmcnt(0)" ::: "memory");
        } else {
            XB_SPIN(xb_ld(&bar[XB_XGEN(b.x)]) == gen, bar);
            __builtin_amdgcn_fence(__ATOMIC_ACQUIRE, "agent");
            asm volatile("s_waitcnt vmcnt(0)" ::: "memory");
        }
    }
    __syncthreads();
}

struct Args {
    const float* in[28];
    float* out; unsigned char* ws;
    int ph_lo, ph_hi, variant, pad;
};
struct Frame {
    LAS unsigned char* lds;
    int tid, lane, wave, G, bid, variant;
    unsigned char* ws;
    const float* const* in;
};
__device__ __forceinline__ void frame_refresh(Frame& F) {
    int t = threadIdx.x; asm volatile("" : "+v"(t)); F.tid = t; F.lane = t & 63; F.wave = __builtin_amdgcn_readfirstlane(t >> 6);
    int b = blockIdx.x; asm volatile("" : "+s"(b)); F.bid = b;
}
enum { I_X = 0, I_C, I_CTX, I_CCTX, I_WMOD, I_BMOD, I_NORM1, I_WIN, I_SSDCW, I_SSDCB, I_SSDALOG, I_SSDDTB, I_SSDD, I_SSDNW, I_POOLW, I_POOLS, I_SCONVW, I_RETDL,
       I_WBR, I_WGATE, I_BGATE, I_WO, I_NORM2, I_FFNUP, I_FFNCW, I_FFNCB, I_FFNDN, I_FNW };

__device__ __forceinline__ void seq_bounds(int row, int& s0, int& s1) {
    if (row < ML) { s0 = row & ~(SEQ - 1); s1 = s0 + SEQ; } else { s0 = ML + ((row - ML) & ~(CTX - 1)); s1 = s0 + CTX; }
}
__device__ __forceinline__ int mod_vec(int row) { return row < ML ? (row >> 12) : 4; }

__device__ __forceinline__ void phase_mod(Frame& F) {
    frame_refresh(F);
    LAS float* sv = (LAS float*)(F.lds);
    LAS float* red = (LAS float*)(F.lds + 5 * 2048 * 4);
    const float* c = F.in[I_C]; const float* cc = F.in[I_CCTX];
    for (int i = F.tid; i < 5 * 2048; i += 512) { const int v = i >> 11, k = i & 2047; const float x = v < 4 ? c[v * 2048 + k] : cc[k]; sv[i] = siluf_(x); }
    __syncthreads();
    float* MOD = (float*)(F.ws + WS_MOD);
    for (int it = F.bid; it < DEPTH * 48; it += F.G) {
        const int l = it / 48, jb = it % 48;
        const float* W = F.in[I_WMOD] + (size_t)l * 2048 * 12288 + jb * 256 + 4 * F.lane;
        float a[5][4];
#pragma unroll
        for (int v = 0; v < 5; ++v) { a[v][0] = a[v][1] = a[v][2] = a[v][3] = 0.f; }
        const int k0 = F.wave * 256;
#pragma unroll 4
        for (int k = 0; k < 256; ++k) {
            const f32x4 w = *(const f32x4*)(W + (size_t)(k0 + k) * 12288);
#pragma unroll
            for (int v = 0; v < 5; ++v) { const float s = sv[v * 2048 + k0 + k]; a[v][0] += s * w.x; a[v][1] += s * w.y; a[v][2] += s * w.z; a[v][3] += s * w.w; }
        }
#pragma unroll
        for (int v = 0; v < 5; ++v) *(LAS f32x4*)(red + (F.wave * 5 + v) * 256 + 4 * F.lane) = (f32x4){a[v][0], a[v][1], a[v][2], a[v][3]};
        __syncthreads();
        for (int i = F.tid; i < 5 * 256; i += 512) { const int v = i >> 8, j = i & 255; float s = 0.f;
#pragma unroll
            for (int w = 0; w < 8; ++w) s += red[(w * 5 + v) * 256 + j];
            MOD[((size_t)l * 5 + v) * 12288 + jb * 256 + j] = s + F.in[I_BMOD][l * 12288 + jb * 256 + j]; }
        __syncthreads();
    }
    if (F.bid == F.G - 1) {
        float* R = (float*)(F.ws + WS_ROPE);
        for (int i = F.tid; i < 1024; i += 512) { const int pos = i >> 4, m = i & 15; const float inv = powf(10000.0f, -(float)m / 16.0f); const float ang = (float)pos * inv; R[2 * i] = cosf(ang); R[2 * i + 1] = sinf(ang); }
    }
}

template <class RowMap>
__device__ __forceinline__ void transpose_item(const float* W, int K, int N, bf16* WT, const RowMap& rm, LAS float* scr, int item, int lane) {
    const int nblk = (N + 31) / 32, kb = item / nblk, nb = item % nblk, k0 = 64 * kb, n0 = 32 * nb;
    const bool nok = (n0 + (lane & 31)) < N;
#pragma unroll 8
    for (int i = 0; i < 32; ++i) { const int kk = 2 * i + (lane >> 5); scr[kk * 33 + (lane & 31)] = nok ? W[(size_t)(k0 + kk) * N + n0 + (lane & 31)] : 0.f; }
    LDS_WAIT(); asm volatile("" ::: "memory");
    const int c = lane & 7;
#pragma unroll
    for (int j = 0; j < 4; ++j) { const int n = (lane >> 3) + 8 * j; const LAS float* s = scr + (8 * c) * 33 + n;
        v4u o; o.x = pk2(s[0 * 33], s[1 * 33]); o.y = pk2(s[2 * 33], s[3 * 33]); o.z = pk2(s[4 * 33], s[5 * 33]); o.w = pk2(s[6 * 33], s[7 * 33]);
        if (n0 + n < N) *(GAS v4u*)(WT + (size_t)rm(n0 + n) * K + k0 + 8 * c) = o; }
    LDS_WAIT(); asm volatile("" ::: "memory");
}
struct RowId { int off; __device__ __forceinline__ int operator()(int n) const { return n + off; } };
struct RowUp { __device__ __forceinline__ int operator()(int n) const { const int h = n >= DFF ? 1 : 0, c = n - h * DFF; return (c >> 7) * 256 + h * 128 + (c & 127); } };
struct RowWin { __device__ __forceinline__ int operator()(int n) const { return n < 3072 ? n : (n < 3088 ? 10240 + (n - 3072) : n - 16); } };

constexpr int CI_IN = 32 * 321, CI_G1 = 32 * 64, CI_B1 = 16 * 64, CI_O = 32 * 64, CI_UP = 32 * 352, CI_DN = 88 * 64, CI_P1 = 4 * 8, CI_Z = 30;
constexpr int NITW = CI_IN + 4 * CI_G1 + 4 * CI_B1 + CI_O + CI_UP + CI_DN + 4 * CI_P1 + CI_Z;
__device__ __forceinline__ void convert_item(Frame& F, int l, int it, LAS float* scr, int lane) {
    unsigned char* wb = F.ws + (size_t)(l & 1) * W_SPAN;
    bf16* WIG = (bf16*)(wb + WS_WIG); bf16* WB = (bf16*)(wb + WS_WB); bf16* WO = (bf16*)(wb + WS_WO);
    bf16* WUP = (bf16*)(wb + WS_WUP); bf16* WDN = (bf16*)(wb + WS_WDN); bf16* WPOOL = (bf16*)(wb + WS_WPOOL);
    int r = it;
    if (r < CI_IN) { transpose_item(F.in[I_WIN] + (size_t)l * 2048 * IN_COLS, 2048, IN_COLS, WIG, RowWin{}, scr, r, lane); return; } r -= CI_IN;
    if (r < 4 * CI_G1) { const int i = r / CI_G1; transpose_item(F.in[I_WGATE] + ((size_t)l * 4 + i) * 2048 * 2048, 2048, 2048, WIG, RowId{10496 + i * 2048}, scr, r % CI_G1, lane); return; } r -= 4 * CI_G1;
    if (r < 4 * CI_B1) { const int i = r / CI_B1; transpose_item(F.in[I_WBR] + ((size_t)l * 4 + i) * 1024 * 2048, 1024, 2048, WB + (size_t)i * 2048 * 1024, RowId{0}, scr, r % CI_B1, lane); return; } r -= 4 * CI_B1;
    if (r < CI_O) { transpose_item(F.in[I_WO] + (size_t)l * 2048 * 2048, 2048, 2048, WO, RowId{0}, scr, r, lane); return; } r -= CI_O;
    if (r < CI_UP) { transpose_item(F.in[I_FFNUP] + (size_t)l * 2048 * UPC, 2048, UPC, WUP, RowUp{}, scr, r, lane); return; } r -= CI_UP;
    if (r < CI_DN) { transpose_item(F.in[I_FFNDN] + (size_t)l * DFF * 2048, DFF, 2048, WDN, RowId{0}, scr, r, lane); return; } r -= CI_DN;
    if (r < 4 * CI_P1) { const int g = r / CI_P1; transpose_item(F.in[I_POOLW] + ((size_t)l * 4 + g) * 256 * 256, 256, 256, WPOOL + (size_t)g * 256 * 256, RowId{0}, scr, r % CI_P1, lane); return; } r -= 4 * CI_P1;
    {
        unsigned char* base = (unsigned char*)WIG + (size_t)(10256 + 8 * r) * 2048 * 2;
#pragma unroll 4
        for (int k = 0; k < 32; ++k) *(GAS v4u*)(base + (size_t)(k * 64 + lane) * 16) = (v4u){0u, 0u, 0u, 0u};
    }
}
__device__ __forceinline__ void steal_convert(Frame& F, int l, int finidx, bool drain) {
    frame_refresh(F);
    gu32* q = (gu32*)(F.ws + WS_CTL) + CW_Q + 64 * l;
    gu32* fin = (gu32*)(F.ws + WS_CTL) + CW_FIN + 64 * finidx;
    volatile LAS unsigned* box = (volatile LAS unsigned*)(F.lds + MISC_OFF);
    LAS float* scr = (LAS float*)(F.lds + F.wave * 16384);
    if (F.tid == 0 && !drain) __hip_atomic_fetch_add(fin, 1u, RLX_AGENT);
    for (;;) {
        if (F.tid == 0) { unsigned v = 0xffffffffu; if (drain || __hip_atomic_load(fin, RLX_AGENT) < (unsigned)F.G) v = __hip_atomic_fetch_add(q, 1u, RLX_AGENT); box[0] = v; }
        __syncthreads();
        const unsigned got = box[0];
        __syncthreads();
        if (got == 0xffffffffu) break;
        const int base = (int)got * 8;
        if (base >= NITW) break;
        { const int wi = base + F.wave; if (wi < NITW) convert_item(F, l, wi, scr, F.lane); }
    }
}

template <bool FIRST>
__device__ __forceinline__ void phase_norm(Frame& F, int l, const float* nw, int sh_off, int sc_off, int nrows, bool addpart = false) {
    frame_refresh(F);
    float* X = (float*)(F.ws + WS_X); bf16* H = (bf16*)(F.ws + WS_H); const float* MOD = (const float*)(F.ws + WS_MOD);
    const int gw = F.bid * NWAVES + F.wave, NGW = F.G * NWAVES;
    for (int row = gw; row < nrows; row += NGW) {
        const float* src = FIRST ? (row < ML ? F.in[I_X] + (size_t)row * D : F.in[I_CTX] + (size_t)(row - ML) * D) : X + (size_t)row * D;
        f32x4 v[8]; float ss = 0.f;
#pragma unroll
        for (int j = 0; j < 8; ++j) { v[j] = *(const f32x4*)(src + 256 * j + 4 * F.lane); ss += (v[j].x * v[j].x + v[j].y * v[j].y) + (v[j].z * v[j].z + v[j].w * v[j].w); }
        if (FIRST) {
#pragma unroll
            for (int j = 0; j < 8; ++j) *(f32x4*)(X + (size_t)row * D + 256 * j + 4 * F.lane) = v[j];
        }
        if (!FIRST && addpart && row >= ML) {
            const float* P = (const float*)(F.ws + WS_PART) + (size_t)(row - ML) * D;
            ss = 0.f;
#pragma unroll
            for (int j = 0; j < 8; ++j) {
#pragma unroll
                for (int sp = 0; sp < 4; ++sp) v[j] += *(const f32x4*)(P + (size_t)sp * MC * D + 256 * j + 4 * F.lane);
                *(f32x4*)(X + (size_t)row * D + 256 * j + 4 * F.lane) = v[j];
                ss += (v[j].x * v[j].x + v[j].y * v[j].y) + (v[j].z * v[j].z + v[j].w * v[j].w);
            }
        }
        const float rs = rsqrtf(wave_sum(ss) * (1.0f / D) + EPS);
        const float* mv = MOD + ((size_t)l * 5 + mod_vec(row)) * 12288;
#pragma unroll
        for (int j = 0; j < 8; ++j) { const int c = 256 * j + 4 * F.lane;
            const f32x4 w = *(const f32x4*)(nw + c), sh = *(const f32x4*)(mv + sh_off + c), sc = *(const f32x4*)(mv + sc_off + c);
            const f32x4 y = v[j] * rs * w; const f32x4 h = y * (sc + 1.0f) + sh;
            v2u o; o.x = pk2(h.x, h.y); o.y = pk2(h.z, h.w); *(v2u*)(H + (size_t)row * D + c) = o; }
    }
}
__device__ __forceinline__ void phase_final(Frame& F, float* out) {
    frame_refresh(F);
    const float* X = (const float*)(F.ws + WS_X); const float* nw = F.in[I_FNW];
    const int gw = F.bid * NWAVES + F.wave, NGW = F.G * NWAVES;
    for (int row = gw; row < ML; row += NGW) {
        f32x4 v[8]; float ss = 0.f;
#pragma unroll
        for (int j = 0; j < 8; ++j) { v[j] = *(const f32x4*)(X + (size_t)row * D + 256 * j + 4 * F.lane); ss += (v[j].x * v[j].x + v[j].y * v[j].y) + (v[j].z * v[j].z + v[j].w * v[j].w); }
        const float rs = rsqrtf(wave_sum(ss) * (1.0f / D) + EPS);
#pragma unroll
        for (int j = 0; j < 8; ++j) { const int c = 256 * j + 4 * F.lane; *(f32x4*)(out + (size_t)row * D + c) = v[j] * rs * *(const f32x4*)(nw + c); }
    }
}

__device__ __forceinline__ v4u ldrow(const bf16* base, int row, int ld, int col, bool ok) { return ok ? *(const v4u*)(base + (size_t)row * ld + col) : (v4u){0u, 0u, 0u, 0u}; }
__device__ __forceinline__ void ld8f(const float* p, float (&f)[8]) { const f32x4 a = *(const f32x4*)p, b = *(const f32x4*)(p + 4); f[0] = a.x; f[1] = a.y; f[2] = a.z; f[3] = a.w; f[4] = b.x; f[5] = b.y; f[6] = b.z; f[7] = b.w; }

__device__ __forceinline__ void sc_task(Frame& F, int l, int r, int lane) {
    const bf16* U = (const bf16*)(F.ws + WS_U); bf16* YB2 = (bf16*)(F.ws + WS_YB) + 2 * YS_STRIDE;
            const int rb = r >> 1, cb = r & 1, c = cb * 512 + lane * 8, r0 = rb * 32; int s0, s1; seq_bounds(r0, s0, s1);
            float w0[8], w1[8], w2[8];
            ld8f(F.in[I_SCONVW] + ((size_t)l * 3 + 0) * 1024 + c, w0); ld8f(F.in[I_SCONVW] + ((size_t)l * 3 + 1) * 1024 + c, w1); ld8f(F.in[I_SCONVW] + ((size_t)l * 3 + 2) * 1024 + c, w2);
            for (int r4 = r0; r4 < r0 + 32; r4 += 4) {
                v4u bc[6], bx[6], bg[4];
#pragma unroll
                for (int k = 0; k < 6; ++k) { const int s = r4 - 1 + k; const bool ok = s >= s0 && s < s1; bc[k] = ldrow(U, s, UC, U_SCC + c, ok); bx[k] = ldrow(U, s, UC, U_SCX + c, ok); }
#pragma unroll
                for (int k = 0; k < 4; ++k) bg[k] = ldrow(U, r4 + k, UC, U_SCB + c, true);
                float pr[6][8];
#pragma unroll
                for (int k = 0; k < 6; ++k) { float a[8], b[8]; unpack8(bc[k], a); unpack8(bx[k], b);
#pragma unroll
                    for (int e = 0; e < 8; ++e) pr[k][e] = a[e] * b[e]; }
#pragma unroll
                for (int j = 0; j < 4; ++j) { float g[8], o[8]; unpack8(bg[j], g);
#pragma unroll
                    for (int e = 0; e < 8; ++e) o[e] = g[e] * (w0[e] * pr[j][e] + w1[e] * pr[j + 1][e] + w2[e] * pr[j + 2][e]);
                    *(v4u*)(YB2 + (size_t)(r4 + j) * 1024 + c) = pack8(o); }
            }
}
__device__ __forceinline__ void sc_phase(Frame& F, int l, int c, int Gs) {
    frame_refresh(F);
    const int gw = c * NWAVES + F.wave, NGW = Gs * NWAVES;
    for (int task = gw; task < (M / 32) * 2; task += NGW) sc_task(F, l, task, F.lane);
}
template <int HMAX>
__device__ __forceinline__ void pool_task(const bf16* U, bf16* POOLED, int r0, int s0, int s1, int c, int half) {
    constexpr int NR = 8 + 2 * HMAX - 1, HA = HMAX / 2;
    const bool big = (half == HMAX);
    for (int r8 = r0; r8 < r0 + 32; r8 += 8) {
        v4u buf[NR];
#pragma unroll
        for (int k = 0; k < NR; ++k) { const int s = r8 - HMAX + k; buf[k] = ldrow(U, s, UC, U_POOL + c, s >= s0 && s < s1); }
        float sa[8], sb[8];
#pragma unroll
        for (int e = 0; e < 8; ++e) { sa[e] = 0.f; sb[e] = 0.f; }
#pragma unroll
        for (int k = 0; k < 2 * HMAX; ++k) { float t[8]; unpack8(buf[k], t);
#pragma unroll
            for (int e = 0; e < 8; ++e) { sb[e] += t[e]; if (k >= HA && k < HMAX + HA) sa[e] += t[e]; } }
#pragma unroll
        for (int j = 0; j < 8; ++j) {
            const int rr = r8 + j; int lo = rr - half, hi = rr + half; lo = lo < s0 ? s0 : lo; hi = hi > s1 ? s1 : hi;
            float x[8], o[8]; unpack8(buf[j + HMAX], x); const float inv = 1.0f / (float)(hi - lo);
#pragma unroll
            for (int e = 0; e < 8; ++e) o[e] = (big ? sb[e] : sa[e]) * inv - x[e];
            *(v4u*)(POOLED + (size_t)rr * 1024 + c) = pack8(o);
            if (j < 7) {
                float tin[8], tout[8];
                unpack8(buf[j + 2 * HMAX], tin); unpack8(buf[j], tout);
#pragma unroll
                for (int e = 0; e < 8; ++e) sb[e] += tin[e] - tout[e];
                unpack8(buf[j + HMAX + HA], tin); unpack8(buf[j + HA], tout);
#pragma unroll
                for (int e = 0; e < 8; ++e) sa[e] += tin[e] - tout[e];
            }
        }
    }
}
__device__ __forceinline__ void phase_pre(Frame& F, int l) {
    frame_refresh(F);
    const bf16* U = (const bf16*)(F.ws + WS_U);
    bf16* XBCA = (bf16*)(F.ws + WS_XBCA); bf16* RQK = (bf16*)(F.ws + WS_RQK); bf16* YB2 = (bf16*)(F.ws + WS_YB) + 2 * YS_STRIDE; bf16* POOLED = (bf16*)(F.ws + WS_POOLED);
    const float* ROPE = (const float*)(F.ws + WS_ROPE);
    const int gw = F.bid * NWAVES + F.wave, NGW = F.G * NWAVES, lane = F.lane;
    constexpr int NRB = M / 32;
    constexpr int T_CUM = (M / 64) * 2, T_XBC = NRB * 4, T_POOL = NRB * 2, T_ROPE = NRB;
    float* CUMA = (float*)(F.ws + WS_CUMA); float* DTA = (float*)(F.ws + WS_DTA); const float* DT = (const float*)(F.ws + WS_DT);
    for (int task = gw; task < T_CUM + T_XBC + T_POOL + T_ROPE; task += NGW) {
        int r = task;
        if (r < T_CUM) {
            const int blk = r >> 1, dir = r & 1, row = blk * 64 + (dir ? 63 - lane : lane);
            for (int hh = 0; hh < 16; ++hh) {
                const float dt = softplusf_(DT[(size_t)row * 16 + hh] + F.in[I_SSDDTB][(l * 2 + dir) * 16 + hh]);
                float cum = dt * -expf(F.in[I_SSDALOG][(l * 2 + dir) * 16 + hh]);
#pragma unroll
                for (int o = 1; o < 64; o <<= 1) { const float t = __shfl_up(cum, o); if (lane >= o) cum += t; }
                CUMA[(size_t)(dir * 16 + hh) * M + row] = cum; DTA[(size_t)(dir * 16 + hh) * M + row] = dt;
            }
            continue;
        }
        r -= T_CUM;
        if (r < T_XBC) {
            const int rb = r >> 2, cb = r & 3, c = cb * 512 + lane * 8, r0 = rb * 32; int s0, s1; seq_bounds(r0, s0, s1);
            float w0[8], w1[8], w2[8], bb[8];
            ld8f(F.in[I_SSDCW] + ((size_t)l * 3 + 0) * 2048 + c, w0); ld8f(F.in[I_SSDCW] + ((size_t)l * 3 + 1) * 2048 + c, w1); ld8f(F.in[I_SSDCW] + ((size_t)l * 3 + 2) * 2048 + c, w2); ld8f(F.in[I_SSDCB] + (size_t)l * 2048 + c, bb);
            v4u bufA[10], bufB[10];
#define XBC_LOAD(buf, r8_) do { _Pragma("unroll") for (int k = 0; k < 10; ++k) { const int s = (r8_) - 1 + k; buf[k] = ldrow(U, s, UC, U_XBC + c, s >= s0 && s < s1); } } while (0)
#define XBC_COMP(buf, r8_) do { _Pragma("unroll") for (int j = 0; j < 8; ++j) { \
                    float p[8], q[8], n[8], o[8]; unpack8(buf[j], p); unpack8(buf[j + 1], q); unpack8(buf[j + 2], n); \
                    _Pragma("unroll") for (int e = 0; e < 8; ++e) o[e] = siluf_(w0[e] * p[e] + w1[e] * q[e] + w2[e] * n[e] + bb[e]); \
                    *(v4u*)(XBCA + (size_t)((r8_) + j) * 2048 + c) = pack8(o); } } while (0)
            XBC_LOAD(bufA, r0);
            XBC_LOAD(bufB, r0 + 8);  XBC_COMP(bufA, r0);
            XBC_LOAD(bufA, r0 + 16); XBC_COMP(bufB, r0 + 8);
            XBC_LOAD(bufB, r0 + 24); XBC_COMP(bufA, r0 + 16);
            XBC_COMP(bufB, r0 + 24);
#undef XBC_LOAD
#undef XBC_COMP
            continue;
        }
        r -= T_XBC;
        if (r < T_POOL) {
            const int rb = r >> 1, cb = r & 1, c = cb * 512 + lane * 8, r0 = rb * 32; int s0, s1; seq_bounds(r0, s0, s1);
            const int grp = c >> 8, half = 1 << grp;
            if (cb == 0) pool_task<2>(U, POOLED, r0, s0, s1, c, half); else pool_task<8>(U, POOLED, r0, s0, s1, c, half);
            continue;
        }
        r -= T_POOL;
        {
            const int r0 = r * 32; int s0, s1; seq_bounds(r0, s0, s1);
            const int qk = lane >> 5, rem = lane & 31, head = rem >> 2, part = (rem >> 1) & 1, sub = rem & 1;
            const int c1 = head * 64 + part * 32 + sub * 8, c2 = c1 + 16; const float scl = qk == 0 ? 0.125f : 1.0f;
            const int ucol = (qk == 0 ? U_RQ : U_RK);
            for (int r8 = r0; r8 < r0 + 32; r8 += 8) {
                v4u b1[8], b2[8];
#pragma unroll
                for (int k = 0; k < 8; ++k) { b1[k] = ldrow(U, r8 + k, UC, ucol + c1, true); b2[k] = ldrow(U, r8 + k, UC, ucol + c2, true); }
#pragma unroll
                for (int k = 0; k < 8; ++k) {
                    const int rr = r8 + k; float x1[8], x2[8], o1[8], o2[8]; unpack8(b1[k], x1); unpack8(b2[k], x2);
                    if (rr < ML) {
                        const int t = rr - s0, pos = part == 0 ? (t >> 6) : (t & 63);
                        const float* rp = ROPE + (size_t)(pos * 16 + sub * 8) * 2;
#pragma unroll
                        for (int e = 0; e < 8; ++e) { const float cs = rp[2 * e], sn = rp[2 * e + 1]; o1[e] = (x1[e] * cs - x2[e] * sn) * scl; o2[e] = (x1[e] * sn + x2[e] * cs) * scl; }
                    } else {
#pragma unroll
                        for (int e = 0; e < 8; ++e) { o1[e] = x1[e] * scl; o2[e] = x2[e] * scl; }
                    }
                    *(v4u*)(RQK + (size_t)rr * 1024 + qk * 512 + c1) = pack8(o1); *(v4u*)(RQK + (size_t)rr * 1024 + qk * 512 + c2) = pack8(o2);
                }
            }
        }
    }
}

#define MFMA32(a, b, c) __builtin_amdgcn_mfma_f32_32x32x16_bf16((a), (b), (c), 0, 0, 0)
#define SCAN_BAR() do { asm volatile("s_waitcnt lgkmcnt(0)" ::: "memory"); __builtin_amdgcn_s_barrier(); asm volatile("" ::: "memory"); } while (0)
typedef short s16x4 __attribute__((ext_vector_type(4)));
__device__ __forceinline__ bf16x8 tr_frag(LAS unsigned char* tile, int rs, int c, int ks, int lane) {
    const int h = lane >> 5, blk = (lane >> 4) & 1, q = (lane & 15) >> 2, p = lane & 3;
    LAS unsigned char* a0 = tile + (16 * ks + 8 * h + q) * rs + (32 * c + 16 * blk + 4 * p) * 2;
    const s16x4 lo = __builtin_amdgcn_ds_read_tr16_b64_v4i16((LAS s16x4*)a0);
    const s16x4 hi = __builtin_amdgcn_ds_read_tr16_b64_v4i16((LAS s16x4*)(a0 + 4 * rs));
    return __builtin_shufflevector(lo, hi, 0, 1, 2, 3, 4, 5, 6, 7);
}
template <int DN, int DP, bool SSD>
__device__ __forceinline__ void scan_unit(Frame& F, int l, int b, int h, int dir) {
    frame_refresh(F);
    constexpr int RSQ = (DN + 8) * 2, RSK2 = DN * 2 + 64, RSV = DP * 2 + 64, RSJ = 72 * 2;
    constexpr int O_Q = 0, O_K = O_Q + 64 * RSQ, O_K2 = O_K + 64 * RSQ, O_V = O_K2 + 64 * RSK2, O_VW = O_V + 64 * RSV, O_S = O_VW + 64 * RSV, O_HST = O_S + 64 * RSJ, O_CUM = O_HST + DP * RSQ, O_END = O_CUM + 256;
    static_assert(O_END <= RING_BYTES, "scan LDS");
    LAS unsigned char* lds = F.lds;
    const int tid = F.tid, lane = F.lane, w = F.wave, r = lane & 31, hh = lane >> 5;
    const bf16* XBCA = (const bf16*)(F.ws + WS_XBCA); const bf16* RQK = (const bf16*)(F.ws + WS_RQK); const bf16* U = (const bf16*)(F.ws + WS_U);
    const float* CUMA = (const float*)(F.ws + WS_CUMA) + (size_t)(dir * 16 + h) * M; const float* DTA = (const float*)(F.ws + WS_DTA) + (size_t)(dir * 16 + h) * M;
    bf16* YS = (bf16*)(F.ws + WS_YS) + (size_t)((SSD ? 0 : 2) + dir) * YS_STRIDE;
    const int ycol = SSD ? h * 64 : h * 128;
    float la_const = 0.f;
    if (!SSD) la_const = -softplusf_(-F.in[I_RETDL][(l * 2 + dir) * 8 + h]);
    for (int i = tid; i < DP * RSQ / 16; i += 512) *(LAS v4u*)(lds + O_HST + i * 16) = (v4u){0u, 0u, 0u, 0u};
    f32x16 Hs;
#pragma unroll
    for (int i = 0; i < 16; ++i) Hs[i] = 0.f;
    const int tok8 = tid >> 3, ch8 = tid & 7, tok16 = tid >> 4, ch16 = tid & 15;
    constexpr int NPF = 2;
    v4u preb[NPF][5]; float pcum[NPF], pdt[NPF], pcl[NPF], pcw[NPF];
#pragma unroll
    for (int u = 0; u < NPF; ++u) { pcum[u] = 0.f; pdt[u] = 1.f; pcl[u] = 0.f; pcw[u] = 0.f;
#pragma unroll
        for (int k = 0; k < 5; ++k) preb[u][k] = (v4u){0u, 0u, 0u, 0u}; }
    auto row_of = [&](int st, int i) -> int {
        int base, sub;
        if (st < 4) { base = ML + b * CTX; sub = dir ? 3 - st : st; } else { base = b * SEQ; sub = dir ? 67 - st : st - 4; }
        return base + sub * 64 + (dir ? 63 - i : i);
    };
#define SCAN_PREFETCH(st_, pre, u_) do { \
        const int rn_ = row_of((st_), tok8), rw0_ = row_of((st_), tok16), rw1_ = row_of((st_), 32 + tok16); \
        if (SSD) { const int g = h >> 2; \
            pre[0] = *(const v4u*)(XBCA + (size_t)rn_ * 2048 + h * 64 + 8 * ch8); \
            pre[1] = *(const v4u*)(XBCA + (size_t)rw0_ * 2048 + 1024 + g * 128 + 8 * ch16); pre[2] = *(const v4u*)(XBCA + (size_t)rw1_ * 2048 + 1024 + g * 128 + 8 * ch16); \
            pre[3] = *(const v4u*)(XBCA + (size_t)rw0_ * 2048 + 1536 + g * 128 + 8 * ch16); pre[4] = *(const v4u*)(XBCA + (size_t)rw1_ * 2048 + 1536 + g * 128 + 8 * ch16); \
            pcum[u_] = CUMA[rn_]; pdt[u_] = DTA[rn_]; pcl[u_] = CUMA[row_of((st_), 63)]; pcw[u_] = CUMA[row_of((st_), lane)]; \
        } else { \
            pre[0] = *(const v4u*)(RQK + (size_t)rn_ * 1024 + h * 64 + 8 * ch8); pre[1] = *(const v4u*)(RQK + (size_t)rn_ * 1024 + 512 + h * 64 + 8 * ch8); \
            pre[2] = *(const v4u*)(U + (size_t)rw0_ * UC + U_RV + h * 128 + 8 * ch16); pre[3] = *(const v4u*)(U + (size_t)rw1_ * UC + U_RV + h * 128 + 8 * ch16); \
        } } while (0)
#pragma unroll
    for (int u = 0; u < NPF; ++u) SCAN_PREFETCH(u, preb[u], u);
    for (int st2 = 0; st2 < 68; st2 += NPF) {
#pragma unroll
    for (int u = 0; u < NPF; ++u) {
        const int st = st2 + u;
        v4u (&pre)[5] = preb[u];
        float clast;
        if (SSD) {
            clast = pcl[u];
            const float dtx = pdt[u], wx = __expf(clast - pcum[u]);
            float x[8], v[8], vw[8]; unpack8(pre[0], x);
#pragma unroll
            for (int e = 0; e < 8; ++e) { v[e] = x[e] * dtx; vw[e] = v[e] * wx; }
            *(LAS v4u*)(lds + O_V + tok8 * RSV + 16 * ch8) = pack8(v); *(LAS v4u*)(lds + O_VW + tok8 * RSV + 16 * ch8) = pack8(vw);
            *(LAS v4u*)(lds + O_K + tok16 * RSQ + 16 * ch16) = pre[1]; *(LAS v4u*)(lds + O_K + (32 + tok16) * RSQ + 16 * ch16) = pre[2];
            *(LAS v4u*)(lds + O_K2 + tok16 * RSK2 + 16 * ch16) = pre[1]; *(LAS v4u*)(lds + O_K2 + (32 + tok16) * RSK2 + 16 * ch16) = pre[2];
            *(LAS v4u*)(lds + O_Q + tok16 * RSQ + 16 * ch16) = pre[3]; *(LAS v4u*)(lds + O_Q + (32 + tok16) * RSQ + 16 * ch16) = pre[4];
            if (w == 0) *(LAS float*)(lds + O_CUM + 4 * lane) = pcw[u];
        } else {
            clast = la_const * 64.f;
            *(LAS v4u*)(lds + O_Q + tok8 * RSQ + 16 * ch8) = pre[0];
            *(LAS v4u*)(lds + O_K + tok8 * RSQ + 16 * ch8) = pre[1]; *(LAS v4u*)(lds + O_K2 + tok8 * RSK2 + 16 * ch8) = pre[1];
            const float w0 = __expf(la_const * (float)(63 - tok16)), w1 = __expf(la_const * (float)(31 - tok16));
            float v0[8], v1[8], q0[8], q1[8]; unpack8(pre[2], v0); unpack8(pre[3], v1);
#pragma unroll
            for (int e = 0; e < 8; ++e) { q0[e] = v0[e] * w0; q1[e] = v1[e] * w1; }
            *(LAS v4u*)(lds + O_V + tok16 * RSV + 16 * ch16) = pre[2]; *(LAS v4u*)(lds + O_V + (32 + tok16) * RSV + 16 * ch16) = pre[3];
            *(LAS v4u*)(lds + O_VW + tok16 * RSV + 16 * ch16) = pack8(q0); *(LAS v4u*)(lds + O_VW + (32 + tok16) * RSV + 16 * ch16) = pack8(q1);
            if (w == 0) *(LAS float*)(lds + O_CUM + 4 * lane) = la_const * (float)(lane + 1);
        }
        SCAN_BAR();
        if (st + NPF < 68) SCAN_PREFETCH(st + NPF, pre, u);
        const float dcy = __expf(clast);
        if (w < 4) {
            const int jb = w >> 1, ib = w & 1;
            f32x16 acc;
#pragma unroll
            for (int i = 0; i < 16; ++i) acc[i] = 0.f;
            if (!(jb == 1 && ib == 0)) {
                bf16x8 fa[DN / 16], fq[DN / 16];
#pragma unroll
                for (int kk = 0; kk < DN / 16; ++kk) {
                    fa[kk] = *(const LAS bf16x8*)(lds + O_K + (jb * 32 + r) * RSQ + (kk * 16 + 8 * hh) * 2);
                    fq[kk] = *(const LAS bf16x8*)(lds + O_Q + (ib * 32 + r) * RSQ + (kk * 16 + 8 * hh) * 2);
                }
                __builtin_amdgcn_sched_barrier(0);
#pragma unroll
                for (int kk = 0; kk < DN / 16; ++kk) acc = MFMA32(fa[kk], fq[kk], acc);
            }
            const int i = ib * 32 + r; const float ci = *(const LAS float*)(lds + O_CUM + 4 * i);
#pragma unroll
            for (int g4 = 0; g4 < 4; ++g4) {
                const int j0 = jb * 32 + 8 * g4 + 4 * hh; const f32x4 cj = *(const LAS f32x4*)(lds + O_CUM + 4 * j0);
                float v[4];
#pragma unroll
                for (int e = 0; e < 4; ++e) { const float cje = e == 0 ? cj.x : (e == 1 ? cj.y : (e == 2 ? cj.z : cj.w)); v[e] = (j0 + e <= i) ? acc[4 * g4 + e] * __expf(ci - cje) : 0.f; }
                v2u o; o.x = pk2(v[0], v[1]); o.y = pk2(v[2], v[3]);
                *(LAS v2u*)(lds + O_S + i * RSJ + j0 * 2) = o;
            }
        }
        SCAN_BAR();
        for (int blk = w; blk < (DP / 32) * 2; blk += 8) {
            const int pb = blk >> 1, ib = blk & 1;
            f32x16 a1, a2;
#pragma unroll
            for (int i = 0; i < 16; ++i) { a1[i] = 0.f; a2[i] = 0.f; }
            bf16x8 fv[4], fs[4], fh[DN / 16], fq[DN / 16];
#pragma unroll
            for (int kk = 0; kk < 4; ++kk) {
                fv[kk] = tr_frag(lds + O_V, RSV, pb, kk, lane);
                fs[kk] = *(const LAS bf16x8*)(lds + O_S + (ib * 32 + r) * RSJ + (kk * 16 + 8 * hh) * 2);
            }
#pragma unroll
            for (int kk = 0; kk < DN / 16; ++kk) {
                fh[kk] = *(const LAS bf16x8*)(lds + O_HST + (pb * 32 + r) * RSQ + (kk * 16 + 8 * hh) * 2);
                fq[kk] = *(const LAS bf16x8*)(lds + O_Q + (ib * 32 + r) * RSQ + (kk * 16 + 8 * hh) * 2);
            }
            __builtin_amdgcn_sched_barrier(0);
#pragma unroll
            for (int kk = 0; kk < 4; ++kk) a1 = MFMA32(fv[kk], fs[kk], a1);
#pragma unroll
            for (int kk = 0; kk < DN / 16; ++kk) a2 = MFMA32(fh[kk], fq[kk], a2);
            const int i = ib * 32 + r; const float ei = __expf(*(const LAS float*)(lds + O_CUM + 4 * i));
            const int row = row_of(st, i);
#pragma unroll
            for (int g4 = 0; g4 < 4; ++g4) {
                const int p0 = pb * 32 + 8 * g4 + 4 * hh;
                v2u o; o.x = pk2(a1[4 * g4 + 0] + ei * a2[4 * g4 + 0], a1[4 * g4 + 1] + ei * a2[4 * g4 + 1]); o.y = pk2(a1[4 * g4 + 2] + ei * a2[4 * g4 + 2], a1[4 * g4 + 3] + ei * a2[4 * g4 + 3]);
                *(v2u*)(YS + (size_t)row * 1024 + ycol + p0) = o;
            }
        }
        {
            const int nb = w / (DP / 32), pb = w % (DP / 32);
#pragma unroll
            for (int i = 0; i < 16; ++i) Hs[i] *= dcy;
            bf16x8 fk[4], fw[4];
#pragma unroll
            for (int kk = 0; kk < 4; ++kk) {
                fk[kk] = tr_frag(lds + O_K2, RSK2, nb, kk, lane);
                fw[kk] = tr_frag(lds + O_VW, RSV, pb, kk, lane);
            }
            __builtin_amdgcn_sched_barrier(0);
#pragma unroll
            for (int kk = 0; kk < 4; ++kk) Hs = MFMA32(fk[kk], fw[kk], Hs);
            SCAN_BAR();
#pragma unroll
            for (int g4 = 0; g4 < 4; ++g4) {
                const int n0 = nb * 32 + 8 * g4 + 4 * hh;
                v2u o; o.x = pk2(Hs[4 * g4 + 0], Hs[4 * g4 + 1]); o.y = pk2(Hs[4 * g4 + 2], Hs[4 * g4 + 3]);
                *(LAS v2u*)(lds + O_HST + (pb * 32 + r) * RSQ + n0 * 2) = o;
            }
        }
    }
    }
    __syncthreads();
#undef SCAN_PREFETCH
}

__device__ __forceinline__ void phase_fin(Frame& F, int l, int nrows) {
    frame_refresh(F);
    const bf16* U = (const bf16*)(F.ws + WS_U); const bf16* YS = (const bf16*)(F.ws + WS_YS); bf16* YB = (bf16*)(F.ws + WS_YB);
    const float* nw = F.in[I_SSDNW] + (size_t)l * 1024; const float* dskp = F.in[I_SSDD] + (size_t)l * 16; const bf16* XBCA = (const bf16*)(F.ws + WS_XBCA);
    const int gw = F.bid * NWAVES + F.wave, NGW = F.G * NWAVES, lane = F.lane;
    for (int row = gw; row < nrows; row += NGW) {
        {
            float g[2][8]; float ss = 0.f;
#pragma unroll
            for (int k = 0; k < 2; ++k) { const int c = k * 512 + 8 * lane; float yf[8], yb[8], z[8];
                unpack8(*(const v4u*)(YS + (size_t)row * 1024 + c), yf); unpack8(*(const v4u*)(YS + YS_STRIDE + (size_t)row * 1024 + c), yb); unpack8(*(const v4u*)(U + (size_t)row * UC + U_Z + c), z);
                float xs[8]; unpack8(*(const v4u*)(XBCA + (size_t)row * 2048 + c), xs); const float dsk = dskp[c >> 6];
#pragma unroll
                for (int e = 0; e < 8; ++e) { g[k][e] = (yf[e] + yb[e] + dsk * xs[e]) * siluf_(z[e]); ss += g[k][e] * g[k][e]; } }
            const float rs = rsqrtf(wave_sum(ss) * (1.0f / 1024.0f) + EPS);
#pragma unroll
            for (int k = 0; k < 2; ++k) { const int c = k * 512 + 8 * lane; float wv[8], o[8]; ld8f(nw + c, wv);
#pragma unroll
                for (int e = 0; e < 8; ++e) o[e] = g[k][e] * rs * wv[e];
                *(v4u*)(YB + (size_t)row * 1024 + c) = pack8(o); }
        }
        {
            const int c = 16 * lane; float v[16];
            { float a[8], b2[8]; unpack8(*(const v4u*)(YS + 2 * YS_STRIDE + (size_t)row * 1024 + c), a); unpack8(*(const v4u*)(YS + 3 * YS_STRIDE + (size_t)row * 1024 + c), b2);
#pragma unroll
              for (int e = 0; e < 8; ++e) v[e] = a[e] + b2[e];
              unpack8(*(const v4u*)(YS + 2 * YS_STRIDE + (size_t)row * 1024 + c + 8), a); unpack8(*(const v4u*)(YS + 3 * YS_STRIDE + (size_t)row * 1024 + c + 8), b2);
#pragma unroll
              for (int e = 0; e < 8; ++e) v[8 + e] = a[e] + b2[e]; }
            float s = 0.f;
#pragma unroll
            for (int e = 0; e < 16; ++e) s += v[e];
            s = red8(s);
            const float mu = s * (1.0f / 128.0f); float q = 0.f;
#pragma unroll
            for (int e = 0; e < 16; ++e) { v[e] -= mu; q += v[e] * v[e]; }
            q = red8(q);
            const float rs = rsqrtf(q * (1.0f / 128.0f) + EPS);
            float g0[8], g1[8], o0[8], o1[8]; unpack8(*(const v4u*)(U + (size_t)row * UC + U_RG + c), g0); unpack8(*(const v4u*)(U + (size_t)row * UC + U_RG + c + 8), g1);
#pragma unroll
            for (int e = 0; e < 8; ++e) { o0[e] = siluf_(g0[e]) * v[e] * rs; o1[e] = siluf_(g1[e]) * v[8 + e] * rs; }
            *(v4u*)(YB + 3 * YS_STRIDE + (size_t)row * 1024 + c) = pack8(o0); *(v4u*)(YB + 3 * YS_STRIDE + (size_t)row * 1024 + c + 8) = pack8(o1);
        }
    }
}

__device__ __forceinline__ v4u ldedge(const bf16* EDGE, int blk, int j, int h, int c, bool ok) { return ok ? *(const v4u*)(EDGE + ((size_t)(blk * 4 + j) * 2 + h) * DFF + c) : (v4u){0u, 0u, 0u, 0u}; }
__device__ __forceinline__ void phase_ffnfix(Frame& F, int l, int nrows) {
    frame_refresh(F);
    const bf16* EDGE = (const bf16*)(F.ws + WS_UP); bf16* ACT = (bf16*)(F.ws + WS_ACT);
    const int gw = F.bid * NWAVES + F.wave, NGW = F.G * NWAVES, lane = F.lane;
    const int ntask = (nrows / 64) * 11;
    for (int task = gw; task < ntask; task += NGW) {
        const int blk = task / 11, cb = task % 11, c = cb * 512 + lane * 8, r0 = blk * 64; int s0, s1; seq_bounds(r0, s0, s1);
        const bool hp = r0 > s0, hn = r0 + 64 < s1;
        float wa0[8], wa1[8], wa2[8], ba[8], wb0[8], wb1[8], wb2[8], bb[8];
        const float* cw = F.in[I_FFNCW] + (size_t)l * 3 * UPC; const float* cbp = F.in[I_FFNCB] + (size_t)l * UPC;
        v4u ra[6], rb[6];
        ra[0] = ldedge(EDGE, blk - 1, 3, 0, c, hp); ra[1] = ldedge(EDGE, blk, 0, 0, c, true); ra[2] = ldedge(EDGE, blk, 1, 0, c, true);
        ra[3] = ldedge(EDGE, blk, 2, 0, c, true); ra[4] = ldedge(EDGE, blk, 3, 0, c, true); ra[5] = ldedge(EDGE, blk + 1, 0, 0, c, hn);
        rb[0] = ldedge(EDGE, blk - 1, 3, 1, c, hp); rb[1] = ldedge(EDGE, blk, 0, 1, c, true); rb[2] = ldedge(EDGE, blk, 1, 1, c, true);
        rb[3] = ldedge(EDGE, blk, 2, 1, c, true); rb[4] = ldedge(EDGE, blk, 3, 1, c, true); rb[5] = ldedge(EDGE, blk + 1, 0, 1, c, hn);
        ld8f(cw + c, wa0); ld8f(cw + UPC + c, wa1); ld8f(cw + 2 * UPC + c, wa2); ld8f(cbp + c, ba);
        ld8f(cw + DFF + c, wb0); ld8f(cw + UPC + DFF + c, wb1); ld8f(cw + 2 * UPC + DFF + c, wb2); ld8f(cbp + DFF + c, bb);
#pragma unroll
        for (int j = 0; j < 2; ++j) {
            float p[8], q[8], n[8], o[8], a[8];
            unpack8(ra[3 * j], p); unpack8(ra[3 * j + 1], q); unpack8(ra[3 * j + 2], n);
#pragma unroll
            for (int e = 0; e < 8; ++e) a[e] = siluf_(wa0[e] * p[e] + wa1[e] * q[e] + wa2[e] * n[e] + ba[e]);
            unpack8(rb[3 * j], p); unpack8(rb[3 * j + 1], q); unpack8(rb[3 * j + 2], n);
#pragma unroll
            for (int e = 0; e < 8; ++e) o[e] = a[e] * (wb0[e] * p[e] + wb1[e] * q[e] + wb2[e] * n[e] + bb[e]);
            *(v4u*)(ACT + (size_t)(r0 + 63 * j) * DFF + c) = pack8(o);
        }
    }
}

using pg8::f32x4; using pg8::Unit; using pg8::HALF; using pg8::BM;
struct EpiInGate {
    static constexpr bool PERM = true, CHAIN = false, PRE = false;
    bf16* U; float* DT; unsigned char* G; const float* bg; int pn0;
    __device__ __forceinline__ void operator()(const f32x4 (&acc)[2][2][4][2], const Unit& u, int wr, int wc, int fr, int fq) const {
        const int row0 = u.pm * BM + wr * 64 + fr, pn = u.pn + pn0;
        if (pn < 40) {
            const int col0 = pn * BM + wc * 32 + 8 * fq;
#pragma unroll
            for (int ai = 0; ai < 2; ++ai)
#pragma unroll
                for (int m = 0; m < 4; ++m) { bf16* rowp = U + (size_t)(row0 + ai * HALF + m * 16) * UC + col0;
#pragma unroll
                    for (int bj = 0; bj < 2; ++bj) { const f32x4 v0 = acc[ai][bj][m][0], v1 = acc[ai][bj][m][1];
                        v4u w; w.x = pg8::cvt_pk_bf16(v0[0], v0[1]); w.y = pg8::cvt_pk_bf16(v0[2], v0[3]); w.z = pg8::cvt_pk_bf16(v1[0], v1[1]); w.w = pg8::cvt_pk_bf16(v1[2], v1[3]);
                        *(v4u*)(rowp + bj * HALF) = w; } }
        } else if (pn == 40) {
            if (wc == 0 && fq < 2) {
#pragma unroll
                for (int ai = 0; ai < 2; ++ai)
#pragma unroll
                    for (int m = 0; m < 4; ++m) { float* rp = DT + (size_t)(row0 + ai * HALF + m * 16) * 16 + 8 * fq; *(f32x4*)rp = acc[ai][0][m][0]; *(f32x4*)(rp + 4) = acc[ai][0][m][1]; }
            }
        } else {
            const int col0 = (pn - 41) * BM + wc * 32 + 8 * fq;
            f32x4 bv[2][2];
#pragma unroll
            for (int bj = 0; bj < 2; ++bj)
#pragma unroll
                for (int n = 0; n < 2; ++n) bv[bj][n] = *(const f32x4*)(bg + col0 + bj * HALF + 4 * n) * -1.44269504f;
            constexpr float QC = 1.0f / 255.99f;
#pragma unroll
            for (int ai = 0; ai < 2; ++ai)
#pragma unroll
                for (int m = 0; m < 4; ++m) { unsigned char* rowp = G + (size_t)(row0 + ai * HALF + m * 16) * 8192 + col0;
#pragma unroll
                    for (int bj = 0; bj < 2; ++bj) {
                        unsigned q[8];
#pragma unroll
                        for (int e = 0; e < 4; ++e) {
                            const float e0 = __builtin_amdgcn_exp2f(__builtin_fmaf(acc[ai][bj][m][0][e], -1.44269504f, bv[bj][0][e])), e1 = __builtin_amdgcn_exp2f(__builtin_fmaf(acc[ai][bj][m][1][e], -1.44269504f, bv[bj][1][e]));
                            q[e] = (unsigned)__builtin_amdgcn_rcpf(__builtin_fmaf(e0, QC, QC)); q[4 + e] = (unsigned)__builtin_amdgcn_rcpf(__builtin_fmaf(e1, QC, QC)); }
                        v2u w; w.x = q[0] | (q[1] << 8) | (q[2] << 16) | (q[3] << 24); w.y = q[4] | (q[5] << 8) | (q[6] << 16) | (q[7] << 24);
                        *(v2u*)(rowp + bj * HALF) = w; } }
        }
    }
};
template <bool SCALE> struct EpiBf16 {
    static constexpr bool PERM = true, CHAIN = false, PRE = false;
    bf16* O; int ldc; const float* scale;
    __device__ __forceinline__ int operator()(const f32x4 (&acc)[2][2][4][2], const Unit& u, int wr, int wc, int fr, int fq) const {
        const int row0 = u.pm * BM + wr * 64 + fr, col0 = u.pn * BM + wc * 32 + 8 * fq;
        f32x4 sv[2][2];
        if (SCALE) {
#pragma unroll
            for (int bj = 0; bj < 2; ++bj)
#pragma unroll
                for (int n = 0; n < 2; ++n) sv[bj][n] = *(const f32x4*)(scale + col0 + bj * HALF + 4 * n);
        }
#pragma unroll
        for (int ai = 0; ai < 2; ++ai)
#pragma unroll
            for (int m = 0; m < 4; ++m) { bf16* rowp = O + (size_t)(row0 + ai * HALF + m * 16) * ldc + col0;
#pragma unroll
                for (int bj = 0; bj < 2; ++bj) { f32x4 v0 = acc[ai][bj][m][0], v1 = acc[ai][bj][m][1];
                    if (SCALE) { v0 = v0 * sv[bj][0]; v1 = v1 * sv[bj][1]; }
                    v4u w; w.x = pg8::cvt_pk_bf16(v0[0], v0[1]); w.y = pg8::cvt_pk_bf16(v0[2], v0[3]); w.z = pg8::cvt_pk_bf16(v1[0], v1[1]); w.w = pg8::cvt_pk_bf16(v1[2], v1[3]);
                    *(v4u*)(rowp + bj * HALF) = w; } }
        return 16;
    }
};
struct EpiFfn {
    static constexpr bool PERM = true, CHAIN = false, PRE = true;
    bf16* ACT; bf16* EDGE; const float* cw; const float* cb;
    static __device__ __forceinline__ float fshr1(float t, float x, float w) { asm("v_fmac_f32_dpp %0, %1, %2 row_shr:1 row_mask:0xf bank_mask:0xf bound_ctrl:0" : "+v"(t) : "v"(x), "v"(w)); return t; }
    static __device__ __forceinline__ float fshl1(float t, float x, float w) { asm("v_fmac_f32_dpp %0, %1, %2 row_shl:1 row_mask:0xf bank_mask:0xf bound_ctrl:0" : "+v"(t) : "v"(x), "v"(w)); return t; }
    static __device__ __forceinline__ float fror1(float t, float x, float w) { asm("v_fmac_f32_dpp %0, %1, %2 row_ror:1 row_mask:0xf bank_mask:0xf" : "+v"(t) : "v"(x), "v"(w)); return t; }
    static __device__ __forceinline__ float fror15(float t, float x, float w) { asm("v_fmac_f32_dpp %0, %1, %2 row_ror:15 row_mask:0xf bank_mask:0xf" : "+v"(t) : "v"(x), "v"(w)); return t; }
    template <int M> static __device__ __forceinline__ f32x4 conv4(const f32x4 (&x)[4][2], int n, const f32x4 (&w)[4], const f32x4 we0, const f32x4 we2) {
        f32x4 r;
#pragma unroll
        for (int e = 0; e < 4; ++e) { const float c = x[M][n][e];
            float t = __builtin_fmaf(w[1][e], c, w[3][e]);
            t = fshr1(t, c, w[0][e]);
            t = fshl1(t, c, w[2][e]);
            if (M > 0) t = fror1(t, x[M > 0 ? M - 1 : 0][n][e], we0[e]);
            if (M < 3) t = fror15(t, x[M < 3 ? M + 1 : 3][n][e], we2[e]);
            r[e] = t; }
        return r;
    }
    template <int M> __device__ __forceinline__ v2u act4(const f32x4 (&xa)[4][2], const f32x4 (&xb)[4][2], int n, const f32x4 (&wa)[4], const f32x4 (&wb)[4], const f32x4 wae0, const f32x4 wae2, const f32x4 wbe0, const f32x4 wbe2) const {
        const f32x4 va = conv4<M>(xa, n, wa, wae0, wae2), vb = conv4<M>(xb, n, wb, wbe0, wbe2);
        float o[4];
#pragma unroll
        for (int e = 0; e < 4; ++e) o[e] = va[e] * __builtin_amdgcn_rcpf(1.0f + __builtin_amdgcn_exp2f(va[e] * -1.44269504f)) * vb[e];
        v2u r; r.x = pk2(o[0], o[1]); r.y = pk2(o[2], o[3]); return r;
    }
    static __device__ __forceinline__ size_t rowbytes() { return (size_t)DFF * 2; }
    static constexpr int WOFF = 131072 + 320 + 2048;
    __device__ __forceinline__ void pre(PG8_LAS unsigned char* lds, const Unit& u, int wid, int lane, int par) const {
        if (wid < 4) {
            const int a = 2 * wid + (lane >> 5), k = a & 3;
            const float* src = (k < 3 ? cw + k * UPC : cb) + (a >> 2) * DFF + u.pn * 128 + (lane & 31) * 4;
            __builtin_amdgcn_global_load_lds((const unsigned*)src, (PG8_LAS unsigned*)(lds + WOFF + par * 4096 + wid * 1024), 16, 0, 0);
        }
    }
    __device__ __forceinline__ void operator()(const f32x4 (&acc)[2][2][4][2], const Unit& u, int wr, int wc, int fr, int fq, PG8_LAS unsigned char* lds, int par, pg8::u32x4 (&pend)[4], char*& pptr) const {
        const int row0 = u.pm * BM + wr * 64 + fr, c0 = u.pn * 128 + wc * 32 + 8 * fq;
        const float e0 = fr == 0 ? 1.f : 0.f, e15 = fr == 15 ? 1.f : 0.f;
#pragma unroll
        for (int ai = 0; ai < 2; ++ai) {
            const int blk = u.pm * 4 + ai * 2 + wr;
            if (fr < 2 || fr >= 14) {
                const int j = fr < 2 ? fr : fr - 12;
                const f32x4 a0 = fr < 2 ? acc[ai][0][0][0] : acc[ai][0][3][0], a1 = fr < 2 ? acc[ai][0][0][1] : acc[ai][0][3][1];
                const f32x4 b0 = fr < 2 ? acc[ai][1][0][0] : acc[ai][1][3][0], b1 = fr < 2 ? acc[ai][1][0][1] : acc[ai][1][3][1];
                bf16* ep = EDGE + ((size_t)(blk * 4 + j) * 2) * DFF + c0;
                v4u w; w.x = pk2(a0[0], a0[1]); w.y = pk2(a0[2], a0[3]); w.z = pk2(a1[0], a1[1]); w.w = pk2(a1[2], a1[3]); *(v4u*)ep = w;
                w.x = pk2(b0[0], b0[1]); w.y = pk2(b0[2], b0[3]); w.z = pk2(b1[0], b1[1]); w.w = pk2(b1[2], b1[3]); *(v4u*)(ep + DFF) = w;
            }
        }
        __builtin_amdgcn_sched_barrier(0);
        pptr = (char*)(ACT + (size_t)(row0 + 128) * DFF + c0);
        const PG8_LAS float* wl = (const PG8_LAS float*)(lds + WOFF + par * 4096) + wc * 32 + 8 * fq;
#pragma unroll
        for (int ai = 0; ai < 2; ++ai) {
            v2u carry[4];
#pragma unroll
            for (int n = 0; n < 2; ++n) {
                f32x4 wa[4], wb[4];
#pragma unroll
                for (int k = 0; k < 4; ++k) { wa[k] = *(const PG8_LAS f32x4*)(wl + k * 128 + 4 * n); wb[k] = *(const PG8_LAS f32x4*)(wl + (4 + k) * 128 + 4 * n); }
                const f32x4 wae0 = wa[0] * e0, wae2 = wa[2] * e15, wbe0 = wb[0] * e0, wbe2 = wb[2] * e15;
                v2u r[4];
                r[0] = act4<0>(acc[ai][0], acc[ai][1], n, wa, wb, wae0, wae2, wbe0, wbe2); r[1] = act4<1>(acc[ai][0], acc[ai][1], n, wa, wb, wae0, wae2, wbe0, wbe2);
                r[2] = act4<2>(acc[ai][0], acc[ai][1], n, wa, wb, wae0, wae2, wbe0, wbe2); r[3] = act4<3>(acc[ai][0], acc[ai][1], n, wa, wb, wae0, wae2, wbe0, wbe2);
#pragma unroll
                for (int m = 0; m < 4; ++m) {
                    if (n == 0) carry[m] = r[m];
                    else { v4u w; w.x = carry[m].x; w.y = carry[m].y; w.z = r[m].x; w.w = r[m].y; if (ai == 0) *(v4u*)(ACT + (size_t)(row0 + m * 16) * DFF + c0) = w; else pend[m] = w; }
                }
                __builtin_amdgcn_sched_barrier(0);
            }
        }
    }
};
struct EpiBranch {
    static constexpr bool PERM = true, CHAIN = true, PRE = false;
    const unsigned char* G; bf16* MERGED; int skip;
    static __device__ __forceinline__ void deq8(const v2u w, float (&g)[8]) {
        g[0] = (float)(w.x & 0xffu); g[1] = (float)((w.x >> 8) & 0xffu); g[2] = (float)((w.x >> 16) & 0xffu); g[3] = (float)(w.x >> 24);
        g[4] = (float)(w.y & 0xffu); g[5] = (float)((w.y >> 8) & 0xffu); g[6] = (float)((w.y >> 16) & 0xffu); g[7] = (float)(w.y >> 24);
#pragma unroll
        for (int e = 0; e < 8; ++e) g[e] = (g[e] + 0.5f) * (1.0f / 256.0f);
    }
    __device__ __forceinline__ bool operator()(f32x4 (&acc)[2][2][4][2], const Unit& u, int wr, int wc, int fr, int fq) const {
        const int row0 = u.pm * BM + wr * 64 + fr, col0 = u.pn * BM + wc * 32 + 8 * fq, sub = u.sub;
        const int subn = sub < 3 ? sub + 1 : sub;
        if (skip) return sub == 3;
        v2u gv[2][4][2], hv[2][4][2];
#pragma unroll
        for (int ai = 0; ai < 2; ++ai)
#pragma unroll
            for (int m = 0; m < 4; ++m)
#pragma unroll
                for (int bj = 0; bj < 2; ++bj) { const unsigned char* gp = G + (size_t)(row0 + ai * HALF + m * 16) * 8192 + col0 + bj * HALF;
                    gv[ai][m][bj] = *(const v2u*)(gp + sub * 2048); hv[ai][m][bj] = *(const v2u*)(gp + subn * 2048); }
#pragma unroll
        for (int ai = 0; ai < 2; ++ai)
#pragma unroll
            for (int m = 0; m < 4; ++m)
#pragma unroll
                for (int bj = 0; bj < 2; ++bj) {
                    float g[8], h[8]; deq8(gv[ai][m][bj], g); deq8(hv[ai][m][bj], h);
                    if (sub < 3) {
#pragma unroll
                        for (int e = 0; e < 8; ++e) g[e] = g[e] * __builtin_amdgcn_rcpf(h[e]);
                    }
                    f32x4& v0 = acc[ai][bj][m][0]; f32x4& v1 = acc[ai][bj][m][1];
                    v0[0] *= g[0]; v0[1] *= g[1]; v0[2] *= g[2]; v0[3] *= g[3]; v1[0] *= g[4]; v1[1] *= g[5]; v1[2] *= g[6]; v1[3] *= g[7];
                    if (sub == 3) { v4u w; w.x = pg8::cvt_pk_bf16(v0[0], v0[1]); w.y = pg8::cvt_pk_bf16(v0[2], v0[3]); w.z = pg8::cvt_pk_bf16(v1[0], v1[1]); w.w = pg8::cvt_pk_bf16(v1[2], v1[3]);
                        *(v4u*)(MERGED + (size_t)(row0 + ai * HALF + m * 16) * 2048 + col0 + bj * HALF) = w; }
                }
        return sub == 3;
    }
};
struct EpiResid {
    static constexpr bool PERM = false, CHAIN = false, PRE = false;
    float* X; const float* modl; int goff, skip;
    __device__ __forceinline__ void operator()(const f32x4 (&acc)[2][2][4][2], const Unit& u, int wr, int wc, int fr, int fq) const {
        if (skip) return;
        const int row0 = u.pm * BM + wr * 64 + fr, col0 = u.pn * BM + wc * 32 + 4 * fq;
        const float* gp = modl + (size_t)(u.pm < 64 ? (u.pm >> 4) : 4) * 12288 + goff + col0;
        f32x4 gv[2][2];
#pragma unroll
        for (int bj = 0; bj < 2; ++bj)
#pragma unroll
            for (int n = 0; n < 2; ++n) gv[bj][n] = *(const f32x4*)(gp + bj * HALF + n * 16);
#pragma unroll
        for (int ai = 0; ai < 2; ++ai) {
            f32x4 xv[4][2][2];
#pragma unroll
            for (int m = 0; m < 4; ++m)
#pragma unroll
                for (int bj = 0; bj < 2; ++bj)
#pragma unroll
                    for (int n = 0; n < 2; ++n) xv[m][bj][n] = *(const f32x4*)(X + (size_t)(row0 + ai * HALF + m * 16) * D + col0 + bj * HALF + n * 16);
#pragma unroll
            for (int m = 0; m < 4; ++m)
#pragma unroll
                for (int bj = 0; bj < 2; ++bj)
#pragma unroll
                    for (int n = 0; n < 2; ++n) *(f32x4*)(X + (size_t)(row0 + ai * HALF + m * 16) * D + col0 + bj * HALF + n * 16) = xv[m][bj][n] + gv[bj][n] * acc[ai][bj][m][n];
        }
    }
};

struct EpiPart {
    static constexpr bool PERM = false, CHAIN = false, PRE = false;
    float* PART; const float* modl; int goff;
    __device__ __forceinline__ int operator()(const f32x4 (&acc)[2][2][4][2], const Unit& u, int wr, int wc, int fr, int fq) const {
        const int row0 = (u.pm - 64) * BM + wr * 64 + fr, col0 = u.pn * BM + wc * 32 + 4 * fq;
        const float* gp = modl + (size_t)4 * 12288 + goff + col0;
        float* P = PART + (size_t)u.sub * MC * D;
        f32x4 gv[2][2];
#pragma unroll
        for (int bj = 0; bj < 2; ++bj)
#pragma unroll
            for (int n = 0; n < 2; ++n) gv[bj][n] = *(const f32x4*)(gp + bj * HALF + n * 16);
#pragma unroll
        for (int ai = 0; ai < 2; ++ai)
#pragma unroll
            for (int m = 0; m < 4; ++m)
#pragma unroll
                for (int bj = 0; bj < 2; ++bj)
#pragma unroll
                    for (int n = 0; n < 2; ++n) *(f32x4*)(P + (size_t)(row0 + ai * HALF + m * 16) * D + col0 + bj * HALF + n * 16) = gv[bj][n] * acc[ai][bj][m][n];
        return 32;
    }
};

constexpr int NPH = 11;
constexpr int N_PHASES = 1 + DEPTH * NPH + 1;

__global__ void __launch_bounds__(NWAVES * 64, 2) fwd_kernel(Args args) {
    extern __shared__ __attribute__((aligned(16))) unsigned char lds_raw[];
    Frame F;
    F.lds = (LAS unsigned char*)lds_raw;
    F.tid = threadIdx.x; F.lane = F.tid & 63; F.wave = __builtin_amdgcn_readfirstlane(F.tid >> 6);
    F.G = gridDim.x; F.bid = blockIdx.x; F.ws = args.ws; F.in = args.in;
#if defined(PROBE_K)
    F.variant = args.variant;
#else
    F.variant = 0;
#endif
    gu32* ctl = (gu32*)(args.ws + WS_CTL);
    for (int u = F.tid; u < (LDS_BYTES - LDSCTL_OFF) / 4; u += NWAVES * 64) ((LAS unsigned*)(F.lds + LDSCTL_OFF))[u] = 0u;
    __syncthreads();
    XcdBarrier bar; bar.bar = (unsigned*)(ctl + CW_BAR); bar.x = 0; bar.st = nullptr;
    if (!MK_PER_PHASE && args.ph_hi - args.ph_lo > 1) bar = xcd_barrier_post((unsigned*)(ctl + CW_BAR), (volatile LAS unsigned*)(F.lds + MISC_OFF) + 8);
    const int lo = args.ph_lo, hi = args.ph_hi;
#ifndef PH_MASK
#define PH_MASK 0xFFFF
#endif
#define EN(b) (((PH_MASK) >> (b)) & 1)
#define IN(k) (lo <= (k) && (k) < hi)
#define SEAM(k) do { if (!MK_PER_PHASE && IN((k) + 1)) xcd_barrier(bar); } while (0)

    if (EN(11) && IN(0)) { phase_mod(F); steal_convert(F, 0, 0, true); SEAM(0); }

    for (int l = 0; l < DEPTH; ++l) {
        const int p0 = 1 + l * NPH;
        const int nrows = (l == DEPTH - 1) ? ML : M;
        const int nMp = nrows / 256;
        const float* modl = (const float*)(F.ws + WS_MOD) + (size_t)l * 5 * 12288;
        const unsigned char* wb = F.ws + (size_t)(l & 1) * W_SPAN;
        const bool cv = l + 1 < DEPTH;
        if (EN(0) && IN(p0 + 0)) {
            if (l == 0) phase_norm<true>(F, l, F.in[I_NORM1] + (size_t)l * D, 0, 2048, M);
            else phase_norm<false>(F, l, F.in[I_NORM1] + (size_t)l * D, 0, 2048, M, true);
            SEAM(p0 + 0);
        }
        if (EN(1) && IN(p0 + 1)) {
            const bool two = (nrows == ML);
            {
                pg8::Gemm g{(const char*)(F.ws + WS_H), (const char*)(wb + WS_WIG), (size_t)256 * D * 2, 0, 0, (size_t)256 * D * 2, 0, D, D, D};
                pg8::TileOrder<1> S; S.init(M / 256, two ? 41 : NIG / 256, F.G, F.bid);
                EpiInGate E{(bf16*)(F.ws + WS_U), (float*)(F.ws + WS_DT), (unsigned char*)(F.ws + WS_G), F.in[I_BGATE] + (size_t)l * 4 * 2048, 0};
                pg8::gemm_phase(F.lds + RING_OFF, g, S, E);
            }
            if (two) {
                pg8::Gemm g{(const char*)(F.ws + WS_H), (const char*)(wb + WS_WIG) + (size_t)41 * 256 * D * 2, (size_t)256 * D * 2, 0, 0, (size_t)256 * D * 2, 0, D, D, D};
                pg8::TileOrder<1> S; S.init(ML / 256, 32, F.G, F.bid);
                EpiInGate E{(bf16*)(F.ws + WS_U), (float*)(F.ws + WS_DT), (unsigned char*)(F.ws + WS_G), F.in[I_BGATE] + (size_t)l * 4 * 2048, 41};
                pg8::gemm_phase(F.lds + RING_OFF, g, S, E);
            }
            if (cv) steal_convert(F, l + 1, 1 + l * 6 + 0, false);
            SEAM(p0 + 1);
        }
        if (EN(2) && IN(p0 + 2)) { phase_pre(F, l); SEAM(p0 + 2); }
        if (EN(3) && IN(p0 + 3)) {
            const int nscan = 192;
            const bool split = F.G > nscan;
            for (int id = F.bid; id < nscan; id += F.G) {
#ifndef NO_SSD
                if (id < 128) scan_unit<128, 64, true>(F, l, id >> 5, (id >> 1) & 15, id & 1);
                else
#endif
#ifndef NO_RET
                { const int j = id - 128; scan_unit<64, 128, false>(F, l, j >> 4, (j >> 1) & 7, j & 1); }
#else
                {}
#endif
            }
#ifndef NO_POOLG
            if (!split || F.bid >= nscan) {
                pg8::Gemm g{(const char*)(F.ws + WS_POOLED), (const char*)(wb + WS_WPOOL), (size_t)256 * 1024 * 2, (size_t)256 * 2, 0, (size_t)256 * 256 * 2, 0, 1024, 256, 256};
                pg8::TileOrder<1> S; S.init(M / 256, 4, split ? F.G - nscan : F.G, split ? F.bid - nscan : F.bid);
                EpiBf16<true> E{(bf16*)(F.ws + WS_YB) + YS_STRIDE, 1024, F.in[I_POOLS] + (size_t)l * 1024};
                pg8::gemm_phase(F.lds + RING_OFF, g, S, E);
                sc_phase(F, l, split ? F.bid - nscan : F.bid, split ? F.G - nscan : F.G);
            }
            if (cv) steal_convert(F, l + 1, 1 + l * 6 + 5, false);
#endif
            SEAM(p0 + 3);
        }
        if (EN(4) && IN(p0 + 4)) { phase_fin(F, l, nrows); SEAM(p0 + 4); }
        if (EN(5) && IN(p0 + 5)) {
            pg8::Gemm g{(const char*)(F.ws + WS_YB), (const char*)(wb + WS_WB), (size_t)256 * 1024 * 2, 0, YS_STRIDE * 2, (size_t)256 * 1024 * 2, (size_t)2048 * 1024 * 2, 1024, 1024, 1024};
            pg8::TileOrder<4> S; S.init(nMp, D / 256, F.G, F.bid, 8);
            EpiBranch E{(const unsigned char*)(F.ws + WS_G), (bf16*)(F.ws + WS_MERGED), F.variant & 128};
            pg8::gemm_phase(F.lds + RING_OFF, g, S, E);
            if (cv) steal_convert(F, l + 1, 1 + l * 6 + 1, false);
            SEAM(p0 + 5);
        }
        if (EN(6) && IN(p0 + 6)) {
            pg8::Gemm g{(const char*)(F.ws + WS_MERGED), (const char*)(wb + WS_WO), (size_t)256 * D * 2, 0, 0, (size_t)256 * D * 2, 0, D, D, D};
            pg8::TileOrder<1> S; S.init(ML / 256, D / 256, F.G, F.bid);
            EpiResid E{(float*)(F.ws + WS_X), modl, 4096, F.variant & 128};
            pg8::gemm_phase(F.lds + RING_OFF, g, S, E);
            if (nMp > ML / 256) {
                pg8::Gemm g2{(const char*)(F.ws + WS_MERGED), (const char*)(wb + WS_WO), (size_t)256 * D * 2, 0, (size_t)(D / 4) * 2, (size_t)256 * D * 2, (size_t)(D / 4) * 2, D, D, D / 4};
                pg8::SplitOrder<4> S2; S2.init(nMp - ML / 256, D / 256, ML / 256, F.G, F.bid);
                EpiPart E2{(float*)(F.ws + WS_PART), modl, 4096};
                pg8::gemm_phase(F.lds + RING_OFF, g2, S2, E2);
            }
            if (cv) steal_convert(F, l + 1, 1 + l * 6 + 2, false);
            SEAM(p0 + 6);
        }
        if (EN(7) && IN(p0 + 7)) { phase_norm<false>(F, l, F.in[I_NORM2] + (size_t)l * D, 6144, 8192, nrows, nrows > ML); SEAM(p0 + 7); }
        if (EN(8) && IN(p0 + 8)) {
            pg8::Gemm g{(const char*)(F.ws + WS_H), (const char*)(wb + WS_WUP), (size_t)256 * D * 2, 0, 0, (size_t)256 * D * 2, 0, D, D, D};
            pg8::TileOrder<1> S; S.init(nMp, UPC / 256, F.G, F.bid);
            EpiFfn E{(bf16*)(F.ws + WS_ACT), (bf16*)(F.ws + WS_UP), F.in[I_FFNCW] + (size_t)l * 3 * UPC, F.in[I_FFNCB] + (size_t)l * UPC};
            pg8::gemm_phase(F.lds + RING_OFF, g, S, E);
            if (cv) steal_convert(F, l + 1, 1 + l * 6 + 3, false);
            SEAM(p0 + 8);
        }
        if (EN(9) && IN(p0 + 9)) { phase_ffnfix(F, l, nrows); SEAM(p0 + 9); }
        if (EN(10) && IN(p0 + 10)) {
            pg8::Gemm g{(const char*)(F.ws + WS_ACT), (const char*)(wb + WS_WDN), (size_t)256 * DFF * 2, 0, 0, (size_t)256 * DFF * 2, 0, DFF, DFF, DFF};
            pg8::TileOrder<1> S; S.init(ML / 256, D / 256, F.G, F.bid, 2);
            EpiResid E{(float*)(F.ws + WS_X), modl, 10240, F.variant & 128};
            pg8::gemm_phase(F.lds + RING_OFF, g, S, E);
            if (nMp > ML / 256) {
                pg8::Gemm g2{(const char*)(F.ws + WS_ACT), (const char*)(wb + WS_WDN), (size_t)256 * DFF * 2, 0, (size_t)(DFF / 4) * 2, (size_t)256 * DFF * 2, (size_t)(DFF / 4) * 2, DFF, DFF, DFF / 4};
                pg8::SplitOrder<4> S2; S2.init(nMp - ML / 256, D / 256, ML / 256, F.G, F.bid);
                EpiPart E2{(float*)(F.ws + WS_PART), modl, 10240};
                pg8::gemm_phase(F.lds + RING_OFF, g2, S2, E2);
            }
            if (cv) steal_convert(F, l + 1, 1 + l * 6 + 4, true);
            SEAM(p0 + 10);
        }
    }
    if (EN(12) && IN(N_PHASES - 1)) {
        phase_final(F, args.out);
    }
#undef IN
#undef SEAM
}

extern "C" void kernel_launch(void* const* d_in, const int* in_sizes, int n_in, void* d_out, int out_size, void* d_ws, size_t ws_size, hipStream_t stream) {
    static int grid = 0;
    if (grid == 0) {
        if (n_in != 28 || in_sizes[0] != ML * D || out_size != ML * D || ws_size < WS_END) { fprintf(stderr, "kernel_launch: unexpected shapes (n_in %d, in0 %d, out %d, ws %zu < %zu); nothing launched\n", n_in, n_in > 0 ? in_sizes[0] : -1, out_size, ws_size, (size_t)WS_END); grid = -1; return; }
        int dev = 0, cus = 0, per_cu = 0;
        if (hipGetDevice(&dev) != hipSuccess || hipDeviceGetAttribute(&cus, hipDeviceAttributeMultiprocessorCount, dev) != hipSuccess) { fprintf(stderr, "kernel_launch: device query failed\n"); grid = -1; return; }
        if (hipFuncSetAttribute((const void*)fwd_kernel, hipFuncAttributeMaxDynamicSharedMemorySize, LDS_BYTES) != hipSuccess) { fprintf(stderr, "kernel_launch: hipFuncSetAttribute failed\n"); grid = -1; return; }
        if (hipOccupancyMaxActiveBlocksPerMultiprocessor(&per_cu, (const void*)fwd_kernel, NWAVES * 64, LDS_BYTES) != hipSuccess || per_cu < 1)
            fprintf(stderr, "kernel_launch: note: occupancy query reports %d workgroups per CU\n", per_cu);
        (void)hipGetLastError();
        grid = cus;
    }
    if (grid < 0) return;
    if (hipMemsetAsync((char*)d_ws + WS_CTL, 0, CTL_ZERO_BYTES, stream) != hipSuccess) { fprintf(stderr, "kernel_launch: memset failed\n"); return; }
    Args a{};
    for (int i = 0; i < 28; ++i) a.in[i] = (const float*)d_in[i];
    a.out = (float*)d_out; a.ws = (unsigned char*)d_ws;
#if defined(PROBE_K)
    a.ph_lo = 0; a.ph_hi = N_PHASES;
    hipLaunchKernelGGL(fwd_kernel, dim3(grid), dim3(NWAVES * 64), LDS_BYTES, stream, a);
    for (int rep = 0; rep < PROBE_REPS; ++rep) for (int l = 0; l < DEPTH; ++l) { a.ph_lo = 1 + l * NPH + PROBE_K; a.ph_hi = a.ph_lo + 1; a.variant = PROBE_VARIANT; hipLaunchKernelGGL(fwd_kernel, dim3(grid), dim3(NWAVES * 64), LDS_BYTES, stream, a); }
#elif MK_PER_PHASE
    for (int p = 0; p < N_PHASES; ++p) { a.ph_lo = p; a.ph_hi = p + 1; hipLaunchKernelGGL(fwd_kernel, dim3(grid), dim3(NWAVES * 64), LDS_BYTES, stream, a); }
#else
    a.ph_lo = 0; a.ph_hi = N_PHASES;
    hipLaunchKernelGGL(fwd_kernel, dim3(grid), dim3(NWAVES * 64), LDS_BYTES, stream, a);
#endif
    const hipError_t le = hipPeekAtLastError();
    if (le != hipSuccess) fprintf(stderr, "kernel_launch: launch failed: %s\n", hipGetErrorName(le));
}
```

```cpp
#include <hip/hip_runtime.h>
#include <cstdio>
#include <cstdint>

#ifndef MK_PER_PHASE
#define MK_PER_PHASE 0
#endif

namespace pg8 {
#define PG8_LAS __attribute__((address_space(3)))
typedef unsigned short bf16_t;
typedef short bf16x8 __attribute__((ext_vector_type(8)));
typedef float f32x4 __attribute__((ext_vector_type(4)));
typedef unsigned u32x4 __attribute__((ext_vector_type(4)));
constexpr int BM = 256, BK = 64, HALF = 128, HTB = HALF * BK * 2, STAGE_BYTES = 8 * HTB, NXCD = 8, WGM = 8;

__host__ __device__ __forceinline__ int lds_byte(int r, int c) { const int st = (r >> 4) * 2 + (c >> 5), rr = r & 15, cc = c & 31, ob = rr * 64 + cc * 2; return st * 1024 + (ob ^ (((ob >> 9) & 1) << 5)); }
__host__ __device__ __forceinline__ void stage_rc(int b, int& R, int& C) { const int st = b / 1024, sb = b % 1024, swz = sb ^ (((sb >> 9) & 1) << 5); R = (st >> 1) * 16 + swz / 64; C = (st & 1) * 32 + (swz % 64) / 2; }
__host__ __device__ __forceinline__ int perm32(int rho) { const int n = rho >> 4, i = rho & 15; return 8 * (i >> 2) + 4 * n + (i & 3); }

struct Unit { int pm, pn, sub; };
struct Gemm { const char* A; const char* B; size_t a_tile, a_pn, a_sub, b_tile, b_sub; int lda, ldb, K; };

template <int NSUB> struct TileOrder {
    int nM, nN, nwg, G, c, wgm;
    __device__ __forceinline__ void init(int nM_, int nN_, int G_, int c_, int wgm_ = 4) { nM = nM_; nN = nN_; nwg = nM * nN; G = G_; c = c_; wgm = wgm_; }
    __device__ __forceinline__ bool next(int i, Unit& u) const {
        const int sub = i % NSUB; const long L = (long)(i / NSUB) * G + c; if (L >= nwg) return false;
        int wgid = (int)L; { const int q = nwg / NXCD, r = nwg % NXCD, xcd = wgid % NXCD, off = wgid / NXCD; wgid = (xcd < r ? xcd * (q + 1) : r * (q + 1) + (xcd - r) * q) + off; }
        const int nig = wgm * nN, gid = wgid / nig, fm = gid * wgm, gsz = (nM - fm) < wgm ? (nM - fm) : wgm;
        u.pm = fm + ((wgid % nig) % gsz); u.pn = (wgid % nig) / gsz; u.sub = sub; return true;
    }
};

template <int NSUB> struct SplitOrder {
    int nM, nN, pm0, G, c;
    __device__ __forceinline__ void init(int nM_, int nN_, int pm0_, int G_, int c_) { nM = nM_; nN = nN_; pm0 = pm0_; G = G_; c = c_; }
    __device__ __forceinline__ bool next(int i, Unit& u) const {
        const int j = i * G + c; if (j >= nM * nN * NSUB) return false;
        const int tile = j / NSUB; u.sub = j % NSUB; u.pm = pm0 + tile / nN; u.pn = tile % nN; return true;
    }
};
typedef __bf16 bf16x2_t __attribute__((ext_vector_type(2)));
typedef float f32x2_t __attribute__((ext_vector_type(2)));
__device__ __forceinline__ unsigned cvt_pk_bf16(float lo, float hi) { const f32x2_t v = {lo, hi}; return __builtin_bit_cast(unsigned, __builtin_convertvector(v, bf16x2_t)); }

template <class Epi, class Sched>
__device__ __forceinline__ void gemm_phase(PG8_LAS unsigned char* lds, const Gemm g, const Sched& S, const Epi& E) {
    int tid_ = threadIdx.x; asm volatile("" : "+v"(tid_));
    const int tid = tid_, wid = __builtin_amdgcn_readfirstlane(tid >> 6), lane = tid & 63, wr = wid >> 2, wc = wid & 3, fr = lane & 15, fq = lane >> 4;
    const int K = g.K, nt = K / BK;
    unsigned voffA[2], voffB[2];
#pragma unroll
    for (int i = 0; i < 2; ++i) { int R, C; stage_rc(tid * 16 + i * 8192, R, C); const int Rb = Epi::PERM ? ((R & ~31) + perm32(R & 31)) : R;
        voffA[i] = (unsigned)(R * g.lda + C) * 2u; voffB[i] = (unsigned)(Rb * g.ldb + C) * 2u; }
    const size_t kstep = (size_t)(BK * 2);
    const size_t hstepA = (size_t)HALF * g.lda * 2, hstepB = (size_t)HALF * g.ldb * 2;
    const unsigned ldsw = (unsigned)wid * 1024u;
    const int aoff = lds_byte(wr * 64 + fr, fq * 8), boff = lds_byte(wc * 32 + fr, fq * 8);
#define PG8_SA(b, h) (((b) * 2 + (h)) * HTB)
#define PG8_SB(b, h) ((4 + (b) * 2 + (h)) * HTB)
#define PG8_STAGE(bufoff, gbase, voff) do { _Pragma("unroll") for (int _i = 0; _i < 2; ++_i) \
        __builtin_amdgcn_global_load_lds((const unsigned*)((const char*)(gbase) + (voff)[_i]), (PG8_LAS unsigned*)(lds + (bufoff) + ldsw + _i * 8192), 16, 0, 0); } while (0)
#define PG8_LDA(dst, b, h) do { _Pragma("unroll") for (int m = 0; m < 4; ++m) _Pragma("unroll") for (int k = 0; k < 2; ++k) dst[m][k] = *(const PG8_LAS bf16x8*)(lds + PG8_SA(b, h) + aoff + m * 2048 + k * 1024); } while (0)
#define PG8_LDB(dst, b, h) do { _Pragma("unroll") for (int n = 0; n < 2; ++n) _Pragma("unroll") for (int k = 0; k < 2; ++k) dst[n][k] = *(const PG8_LAS bf16x8*)(lds + PG8_SB(b, h) + boff + n * 2048 + k * 1024); } while (0)
#define PG8_MMA(ai, bj, At, Bt) do { __builtin_amdgcn_s_setprio(1); _Pragma("unroll") for (int m = 0; m < 4; ++m) _Pragma("unroll") for (int n = 0; n < 2; ++n) _Pragma("unroll") for (int k = 0; k < 2; ++k) \
        acc[ai][bj][m][n] = __builtin_amdgcn_mfma_f32_16x16x32_bf16(Bt[n][k], At[m][k], acc[ai][bj][m][n], 0, 0, 0); __builtin_amdgcn_s_setprio(0); } while (0)
#define PG8_WAIT_V(n) asm volatile("s_waitcnt vmcnt(" #n ")" ::: "memory")
#define PG8_WAIT_L(n) asm volatile("s_waitcnt lgkmcnt(" #n ")" ::: "memory")
#define PG8_BAR __builtin_amdgcn_s_barrier()
#define PG8_SCHED __builtin_amdgcn_sched_barrier(0)
    Unit cur, nxt; int ui = 0;
    if (!S.next(0, cur)) return;
    f32x4 acc[2][2][4][2];
#pragma unroll
    for (int a = 0; a < 2; ++a)
#pragma unroll
        for (int b = 0; b < 2; ++b)
#pragma unroll
            for (int m = 0; m < 4; ++m)
#pragma unroll
                for (int n = 0; n < 2; ++n) acc[a][b][m][n] = (f32x4){0.f, 0.f, 0.f, 0.f};
    bf16x8 At[4][2], B0[2][2], B1[2][2];
    const char* cA = g.A + (size_t)cur.pm * g.a_tile + (size_t)cur.pn * g.a_pn + (size_t)cur.sub * g.a_sub;
    const char* cB = g.B + (size_t)cur.pn * g.b_tile + (size_t)cur.sub * g.b_sub;
    PG8_STAGE(PG8_SB(0, 0), cB, voffB); PG8_STAGE(PG8_SB(0, 1), cB + hstepB, voffB); PG8_STAGE(PG8_SA(0, 0), cA, voffA); PG8_STAGE(PG8_SA(0, 1), cA + hstepA, voffA);
    if (wr == 1) PG8_BAR;
    PG8_WAIT_V(2); PG8_BAR;
    PG8_STAGE(PG8_SB(1, 0), cB + kstep, voffB); PG8_STAGE(PG8_SA(1, 0), cA + kstep, voffA); PG8_STAGE(PG8_SB(1, 1), cB + hstepB + kstep, voffB);
    PG8_WAIT_V(6); PG8_BAR;
    for (;;) {
        const bool has_next = S.next(ui + 1, nxt);
        const char* nA = has_next ? g.A + (size_t)nxt.pm * g.a_tile + (size_t)nxt.pn * g.a_pn + (size_t)nxt.sub * g.a_sub : cA;
        const char* nB = has_next ? g.B + (size_t)nxt.pn * g.b_tile + (size_t)nxt.sub * g.b_sub : cB;
        for (int t = 0; t < nt; t += 2) {
            const bool last = (t == nt - 2);
            const char* a1 = cA + (size_t)(t + 1) * kstep;
            const char* a2 = last ? nA : cA + (size_t)(t + 2) * kstep; const char* b2 = last ? nB : cB + (size_t)(t + 2) * kstep;
            const char* a3 = a2 + kstep; const char* b3 = b2 + kstep;
            PG8_LDB(B0, 0, 0); PG8_LDB(B1, 0, 1); PG8_SCHED; PG8_LDA(At, 0, 0); PG8_STAGE(PG8_SA(1, 1), a1 + hstepA, voffA);
            PG8_WAIT_V(8); PG8_WAIT_L(0); PG8_BAR; PG8_MMA(0, 0, At, B0); PG8_MMA(0, 1, At, B1); PG8_BAR; PG8_SCHED;
            PG8_LDA(At, 0, 1); PG8_STAGE(PG8_SB(0, 0), b2, voffB); PG8_STAGE(PG8_SB(0, 1), b2 + hstepB, voffB); PG8_STAGE(PG8_SA(0, 0), a2, voffA);
            PG8_WAIT_V(8); PG8_WAIT_L(0); PG8_BAR; PG8_MMA(1, 0, At, B0); PG8_MMA(1, 1, At, B1); PG8_BAR; PG8_SCHED;
            PG8_LDB(B0, 1, 0); PG8_LDB(B1, 1, 1); PG8_SCHED; PG8_LDA(At, 1, 0); PG8_STAGE(PG8_SA(0, 1), a2 + hstepA, voffA);
            PG8_WAIT_V(8); PG8_WAIT_L(0); PG8_BAR; PG8_MMA(0, 0, At, B0); PG8_MMA(0, 1, At, B1); PG8_BAR; PG8_SCHED;
            PG8_LDA(At, 1, 1); PG8_STAGE(PG8_SB(1, 0), b3, voffB); PG8_STAGE(PG8_SB(1, 1), b3 + hstepB, voffB); PG8_STAGE(PG8_SA(1, 0), a3, voffA);
            PG8_WAIT_V(8); PG8_WAIT_L(0); PG8_BAR; PG8_MMA(1, 0, At, B0); PG8_MMA(1, 1, At, B1); PG8_BAR; PG8_SCHED;
        }
        if (wr == 0) PG8_BAR;
        bool zero_acc = true;
        if constexpr (Epi::CHAIN) zero_acc = E(acc, cur, wr, wc, fr, fq); else E(acc, cur, wr, wc, fr, fq);
        if (!has_next) break;
        if (zero_acc) {
#pragma unroll
        for (int a = 0; a < 2; ++a)
#pragma unroll
            for (int b = 0; b < 2; ++b)
#pragma unroll
                for (int m = 0; m < 4; ++m)
#pragma unroll
                    for (int n = 0; n < 2; ++n) acc[a][b][m][n] = (f32x4){0.f, 0.f, 0.f, 0.f};
        }
        cur = nxt; cA = nA; cB = nB; ++ui;
        if (wr == 1) PG8_BAR;
    }
    PG8_WAIT_V(0);
    PG8_BAR;
#undef PG8_SA
#undef PG8_SB
#undef PG8_STAGE
#undef PG8_LDA
#undef PG8_LDB
#undef PG8_MMA
#undef PG8_WAIT_V
#undef PG8_WAIT_L
#undef PG8_BAR
#undef PG8_SCHED
}
}

constexpr int NWAVES = 8;
constexpr int D = 2048, NB = 4, SEQ = 4096, CTX = 256, DEPTH = 4;
constexpr int ML = NB * SEQ;
constexpr int MC = NB * CTX;
constexpr int M = ML + MC;
constexpr int UC = 10240;
constexpr int NIG = 10496 + 8192;
constexpr int DFF = 5632, UPC = 2 * DFF;
constexpr int IN_COLS = 10256;
constexpr float EPS = 1e-6f;
constexpr int U_Z = 0, U_XBC = 1024, U_POOL = 3072, U_SCB = 4096, U_SCC = 5120, U_SCX = 6144, U_RQ = 7168, U_RK = 7680, U_RV = 8192, U_RG = 9216;

constexpr size_t MiB = 1u << 20;
constexpr size_t WS_CTL = 0, CTL_ZERO_BYTES = 128 * 1024;
constexpr size_t WS_MOD = 1 * MiB;
constexpr size_t WS_ROPE = WS_MOD + (size_t)DEPTH * 5 * 12288 * 4;
constexpr size_t WS_X = 2 * MiB;
constexpr size_t WS_H = WS_X + 136 * MiB;
constexpr size_t WS_WIG = WS_H + 68 * MiB;
constexpr size_t WS_WB = WS_WIG + 73 * MiB;
constexpr size_t WS_WO = WS_WB + 16 * MiB;
constexpr size_t WS_WUP = WS_WO + 8 * MiB;
constexpr size_t WS_WDN = WS_WUP + 44 * MiB;
constexpr size_t WS_WPOOL = WS_WDN + 22 * MiB;
constexpr size_t W_SPAN = WS_WPOOL + 1 * MiB - WS_WIG;
constexpr size_t WS_U = WS_WIG + 2 * W_SPAN;
constexpr size_t WS_DT = WS_U + 340 * MiB;
constexpr size_t WS_G = WS_DT + 2 * MiB;
constexpr size_t WS_UP = WS_U;
constexpr size_t WS_CUMA = WS_G + 140 * MiB;
constexpr size_t WS_DTA = WS_CUMA + 4 * MiB;
constexpr size_t WS_PART = WS_G + 152 * MiB;
constexpr size_t WS_XBCA = WS_G + 272 * MiB;
constexpr size_t WS_RQK = WS_XBCA + 68 * MiB;
constexpr size_t WS_YS = WS_RQK + 34 * MiB;
constexpr size_t WS_YB = WS_YS + 136 * MiB;
constexpr size_t WS_POOLED = WS_YB + 136 * MiB;
constexpr size_t WS_MERGED = WS_POOLED + 34 * MiB;
constexpr size_t WS_MRG32 = WS_XBCA;
constexpr size_t WS_ACT = WS_XBCA;
constexpr size_t WS_END = WS_MERGED + 68 * MiB;
static_assert(WS_UP + (size_t)M * UPC * 2 <= WS_XBCA, "UP overlay");
static_assert(WS_DTA + 4 * MiB <= WS_PART && WS_PART + 32 * MiB <= WS_XBCA, "PART");
static_assert(WS_UP + (size_t)M * UPC * 2 <= WS_CUMA && WS_DTA + 4 * MiB <= WS_XBCA && (size_t)2 * 16 * M * 4 <= 4 * MiB, "cum/dt arrays");
static_assert(WS_ACT + (size_t)M * DFF * 2 <= WS_YB, "ACT overlay");
static_assert(WS_MRG32 + (size_t)M * D * 4 <= WS_YS + 34 * MiB, "MRG32 overlay");
static_assert(WS_ROPE + 8192 <= WS_X, "mod/rope");
constexpr size_t YS_STRIDE = (size_t)M * 1024;

constexpr int CW_TMO = 0, CW_CODE = 1, CW_BAR = 4096, CW_Q = 16384, CW_FIN = 20480;

constexpr int RING_OFF = 0, RING_BYTES = 131072;
constexpr int LDSCTL_OFF = RING_BYTES, MISC_OFF = LDSCTL_OFF + 320;
constexpr int LDS_BYTES = 147456;

#define GAS __attribute__((address_space(1)))
#define LAS __attribute__((address_space(3)))
typedef unsigned short bf16;
typedef unsigned v4u __attribute__((ext_vector_type(4)));
typedef unsigned v2u __attribute__((ext_vector_type(2)));
typedef float f32x4 __attribute__((ext_vector_type(4)));
typedef float f32x16 __attribute__((ext_vector_type(16)));
typedef short bf16x8 __attribute__((ext_vector_type(8)));
typedef GAS unsigned gu32;
#define RLX_AGENT __ATOMIC_RELAXED, __HIP_MEMORY_SCOPE_AGENT
#define LDS_WAIT() asm volatile("s_waitcnt lgkmcnt(0)" ::: "memory")
#define VM_WAIT() asm volatile("s_waitcnt vmcnt(0)" ::: "memory")
__device__ __forceinline__ unsigned f2bf(float f) { return (unsigned)__builtin_bit_cast(unsigned short, (__bf16)f); }
__device__ __forceinline__ unsigned pk2(float lo, float hi) { return pg8::cvt_pk_bf16(lo, hi); }
__device__ __forceinline__ float bflo(unsigned w) { return __builtin_bit_cast(float, w << 16); }
__device__ __forceinline__ float bfhi(unsigned w) { return __builtin_bit_cast(float, w & 0xffff0000u); }
__device__ __forceinline__ float bf1(unsigned short b) { return __builtin_bit_cast(float, (unsigned)b << 16); }
__device__ __forceinline__ void unpack8(const v4u w, float (&f)[8]) { f[0] = bflo(w.x); f[1] = bfhi(w.x); f[2] = bflo(w.y); f[3] = bfhi(w.y); f[4] = bflo(w.z); f[5] = bfhi(w.z); f[6] = bflo(w.w); f[7] = bfhi(w.w); }
__device__ __forceinline__ v4u pack8(const float (&f)[8]) { v4u w; w.x = pk2(f[0], f[1]); w.y = pk2(f[2], f[3]); w.z = pk2(f[4], f[5]); w.w = pk2(f[6], f[7]); return w; }
__device__ __forceinline__ float sigmoidf_(float x) { return __builtin_amdgcn_rcpf(1.0f + __expf(-x)); }
__device__ __forceinline__ float siluf_(float x) { return x * sigmoidf_(x); }
__device__ __forceinline__ float softplusf_(float x) { return fmaxf(x, 0.f) + log1pf(expf(-fabsf(x))); }
__device__ __forceinline__ float wave_sum(float v) {
#pragma unroll
    for (int o = 1; o < 64; o <<= 1) v += __shfl_xor(v, o);
    return v;
}

#define XB_TMO      128
#define XB_XCNT(j)  (256  + 64 * (j))
#define XB_XSUB(j)  (1280 + 64 * (j))
#define XB_XGEN(j)  (2304 + 64 * (j))
#define XB_TOP      3328
#define XB_TOPGEN   3392
#define XCD_BAR_WORDS 3456
#define XB_SPIN_CAP (1u << 18)
__device__ __forceinline__ unsigned xb_ld(unsigned* p)              { return __hip_atomic_load(p, __ATOMIC_RELAXED, __HIP_MEMORY_SCOPE_AGENT); }
__device__ __forceinline__ unsigned xb_add(unsigned* p, unsigned v) { return __hip_atomic_fetch_add(p, v, __ATOMIC_RELAXED, __HIP_MEMORY_SCOPE_AGENT); }
__device__ __forceinline__ unsigned xb_xcc_id() { return (unsigned)__builtin_amdgcn_s_getreg((3 << 11) | 20) & 0xFu; }
#define XB_SPIN(cond, bar) do { unsigned _sp = 0; while (cond) { __builtin_amdgcn_s_sleep(1); \
    if ((++_sp & 255u) == 0u) { if (xb_ld(&(bar)[XB_TMO])) break; if (_sp > XB_SPIN_CAP) { atomicAdd(&(bar)[XB_TMO], 1u); break; } } } } while (0)
struct XcdBarrier { unsigned* bar; unsigned x; volatile LAS unsigned* st; };
__device__ __forceinline__ XcdBarrier xcd_barrier_post(unsigned* bar, volatile LAS unsigned* st) {
    XcdBarrier b; b.bar = bar; b.x = xb_xcc_id(); b.st = st;
    if (threadIdx.x == 0) (void)xb_add(&bar[XB_XCNT(b.x)], 1u);
    return b;
}
__device__ __forceinline__ void xcd_barrier_complete(unsigned* bar, unsigned x, unsigned& nloc, unsigned& nx) {
    const unsigned G = gridDim.x * gridDim.y * gridDim.z;
    unsigned sum, cnt, mine, sp = 0u;
    for (;;) {
        sum = 0u; cnt = 0u; mine = 0u;
#pragma unroll
        for (unsigned j = 0; j < 16; ++j) { const unsigned c = xb_ld(&bar[XB_XCNT(j)]); sum += c; cnt += (c > 0u) ? 1u : 0u; mine = (j == x) ? c : mine; }
        if (sum == G) break;
        __builtin_amdgcn_s_sleep(1);
        if ((++sp & 255u) == 0u) { if (xb_ld(&bar[XB_TMO])) break; if (sp > XB_SPIN_CAP) { atomicAdd(&bar[XB_TMO], 1u); break; } }
    }
    nloc = mine > 0u ? mine : 1u; nx = cnt > 0u ? cnt : 1u;
}
__device__ __forceinline__ void xcd_barrier(const XcdBarrier& b) {
    asm volatile("s_waitcnt vmcnt(0)" ::: "memory");
    __syncthreads();
    if (threadIdx.x == 0) {
        unsigned* bar = b.bar;
        __builtin_amdgcn_s_waitcnt(0);
        unsigned nloc = b.st[0], nx = b.st[1];
        if (nloc == 0u) { xcd_barrier_complete(bar, b.x, nloc, nx); b.st[0] = nloc; b.st[1] = nx; }
        const unsigned old = xb_add(&bar[XB_XSUB(b.x)], 1u);
        const unsigned gen = old / nloc;
        if (old + 1u == (gen + 1u) * nloc) {
            __builtin_amdgcn_fence(__ATOMIC_RELEASE, "agent");
            asm volatile("s_waitcnt vmcnt(0)" ::: "memory");
            const unsigned og = xb_add(&bar[XB_TOP], 1u);
            const unsigned tg = og / nx;
            if (og + 1u == (tg + 1u) * nx) xb_add(&bar[XB_TOPGEN], 1u);
            else XB_SPIN(xb_ld(&bar[XB_TOPGEN]) == tg, bar);
            __builtin_amdgcn_fence(__ATOMIC_ACQUIRE, "agent");
            xb_add(&bar[XB_XGEN(b.x)], 1u);
            asm volatile("s_waitcnt vmcnt(0)" ::: "memory");
        } else {
            XB_SPIN(xb_ld(&bar[XB_XGEN(b.x)]) == gen, bar);
            __builtin_amdgcn_fence(__ATOMIC_ACQUIRE, "agent");
            asm volatile("s_waitcnt vmcnt(0)" ::: "memory");
        }
    }
    __syncthreads();
}

struct Args {
    const float* in[28];
    float* out; unsigned char* ws;
    int ph_lo, ph_hi, variant, pad;
};
struct Frame {
    LAS unsigned char* lds;
    int tid, lane, wave, G, bid, variant;
    unsigned char* ws;
    const float* const* in;
};
__device__ __forceinline__ void frame_refresh(Frame& F) {
    int t = threadIdx.x; asm volatile("" : "+v"(t)); F.tid = t; F.lane = t & 63; F.wave = __builtin_amdgcn_readfirstlane(t >> 6);
    int b = blockIdx.x; asm volatile("" : "+s"(b)); F.bid = b;
}
enum { I_X = 0, I_C, I_CTX, I_CCTX, I_WMOD, I_BMOD, I_NORM1, I_WIN, I_SSDCW, I_SSDCB, I_SSDALOG, I_SSDDTB, I_SSDD, I_SSDNW, I_POOLW, I_POOLS, I_SCONVW, I_RETDL,
       I_WBR, I_WGATE, I_BGATE, I_WO, I_NORM2, I_FFNUP, I_FFNCW, I_FFNCB, I_FFNDN, I_FNW };

__device__ __forceinline__ void seq_bounds(int row, int& s0, int& s1) {
    if (row < ML) { s0 = row & ~(SEQ - 1); s1 = s0 + SEQ; } else { s0 = ML + ((row - ML) & ~(CTX - 1)); s1 = s0 + CTX; }
}
__device__ __forceinline__ int mod_vec(int row) { return row < ML ? (row >> 12) : 4; }

__device__ __forceinline__ void phase_mod(Frame& F) {
    frame_refresh(F);
    LAS float* sv = (LAS float*)(F.lds);
    LAS float* red = (LAS float*)(F.lds + 5 * 2048 * 4);
    const float* c = F.in[I_C]; const float* cc = F.in[I_CCTX];
    for (int i = F.tid; i < 5 * 2048; i += 512) { const int v = i >> 11, k = i & 2047; const float x = v < 4 ? c[v * 2048 + k] : cc[k]; sv[i] = siluf_(x); }
    __syncthreads();
    float* MOD = (float*)(F.ws + WS_MOD);
    for (int it = F.bid; it < DEPTH * 48; it += F.G) {
        const int l = it / 48, jb = it % 48;
        const float* W = F.in[I_WMOD] + (size_t)l * 2048 * 12288 + jb * 256 + 4 * F.lane;
        float a[5][4];
#pragma unroll
        for (int v = 0; v < 5; ++v) { a[v][0] = a[v][1] = a[v][2] = a[v][3] = 0.f; }
        const int k0 = F.wave * 256;
#pragma unroll 4
        for (int k = 0; k < 256; ++k) {
            const f32x4 w = *(const f32x4*)(W + (size_t)(k0 + k) * 12288);
#pragma unroll
            for (int v = 0; v < 5; ++v) { const float s = sv[v * 2048 + k0 + k]; a[v][0] += s * w.x; a[v][1] += s * w.y; a[v][2] += s * w.z; a[v][3] += s * w.w; }
        }
#pragma unroll
        for (int v = 0; v < 5; ++v) *(LAS f32x4*)(red + (F.wave * 5 + v) * 256 + 4 * F.lane) = (f32x4){a[v][0], a[v][1], a[v][2], a[v][3]};
        __syncthreads();
        for (int i = F.tid; i < 5 * 256; i += 512) { const int v = i >> 8, j = i & 255; float s = 0.f;
#pragma unroll
            for (int w = 0; w < 8; ++w) s += red[(w * 5 + v) * 256 + j];
            MOD[((size_t)l * 5 + v) * 12288 + jb * 256 + j] = s + F.in[I_BMOD][l * 12288 + jb * 256 + j]; }
        __syncthreads();
    }
    if (F.bid == F.G - 1) {
        float* R = (float*)(F.ws + WS_ROPE);
        for (int i = F.tid; i < 1024; i += 512) { const int pos = i >> 4, m = i & 15; const float inv = powf(10000.0f, -(float)m / 16.0f); const float ang = (float)pos * inv; R[2 * i] = cosf(ang); R[2 * i + 1] = sinf(ang); }
    }
}

template <class RowMap>
__device__ __forceinline__ void transpose_item(const float* W, int K, int N, bf16* WT, const RowMap& rm, LAS float* scr, int item, int lane) {
    const int nblk = (N + 31) / 32, kb = item / nblk, nb = item % nblk, k0 = 64 * kb, n0 = 32 * nb;
    const bool nok = (n0 + (lane & 31)) < N;
#pragma unroll 8
    for (int i = 0; i < 32; ++i) { const int kk = 2 * i + (lane >> 5); scr[kk * 33 + (lane & 31)] = nok ? W[(size_t)(k0 + kk) * N + n0 + (lane & 31)] : 0.f; }
    LDS_WAIT(); asm volatile("" ::: "memory");
    const int c = lane & 7;
#pragma unroll
    for (int j = 0; j < 4; ++j) { const int n = (lane >> 3) + 8 * j; const LAS float* s = scr + (8 * c) * 33 + n;
        v4u o; o.x = pk2(s[0 * 33], s[1 * 33]); o.y = pk2(s[2 * 33], s[3 * 33]); o.z = pk2(s[4 * 33], s[5 * 33]); o.w = pk2(s[6 * 33], s[7 * 33]);
        if (n0 + n < N) *(GAS v4u*)(WT + (size_t)rm(n0 + n) * K + k0 + 8 * c) = o; }
    LDS_WAIT(); asm volatile("" ::: "memory");
}
struct RowId { int off; __device__ __forceinline__ int operator()(int n) const { return n + off; } };
struct RowUp { __device__ __forceinline__ int operator()(int n) const { const int h = n >= DFF ? 1 : 0, c = n - h * DFF; return (c >> 7) * 256 + h * 128 + (c & 127); } };
struct RowWin { __device__ __forceinline__ int operator()(int n) const { return n < 3072 ? n : (n < 3088 ? 10240 + (n - 3072) : n - 16); } };

constexpr int CI_IN = 32 * 321, CI_G1 = 32 * 64, CI_B1 = 16 * 64, CI_O = 32 * 64, CI_UP = 32 * 352, CI_DN = 88 * 64, CI_P1 = 4 * 8, CI_Z = 30;
constexpr int NITW = CI_IN + 4 * CI_G1 + 4 * CI_B1 + CI_O + CI_UP + CI_DN + 4 * CI_P1 + CI_Z;
__device__ __forceinline__ void convert_item(Frame& F, int l, int it, LAS float* scr, int lane) {
    unsigned char* wb = F.ws + (size_t)(l & 1) * W_SPAN;
    bf16* WIG = (bf16*)(wb + WS_WIG); bf16* WB = (bf16*)(wb + WS_WB); bf16* WO = (bf16*)(wb + WS_WO);
    bf16* WUP = (bf16*)(wb + WS_WUP); bf16* WDN = (bf16*)(wb + WS_WDN); bf16* WPOOL = (bf16*)(wb + WS_WPOOL);
    int r = it;
    if (r < CI_IN) { transpose_item(F.in[I_WIN] + (size_t)l * 2048 * IN_COLS, 2048, IN_COLS, WIG, RowWin{}, scr, r, lane); return; } r -= CI_IN;
    if (r < 4 * CI_G1) { const int i = r / CI_G1; transpose_item(F.in[I_WGATE] + ((size_t)l * 4 + i) * 2048 * 2048, 2048, 2048, WIG, RowId{10496 + i * 2048}, scr, r % CI_G1, lane); return; } r -= 4 * CI_G1;
    if (r < 4 * CI_B1) { const int i = r / CI_B1; transpose_item(F.in[I_WBR] + ((size_t)l * 4 + i) * 1024 * 2048, 1024, 2048, WB + (size_t)i * 2048 * 1024, RowId{0}, scr, r % CI_B1, lane); return; } r -= 4 * CI_B1;
    if (r < CI_O) { transpose_item(F.in[I_WO] + (size_t)l * 2048 * 2048, 2048, 2048, WO, RowId{0}, scr, r, lane); return; } r -= CI_O;
    if (r < CI_UP) { transpose_item(F.in[I_FFNUP] + (size_t)l * 2048 * UPC, 2048, UPC, WUP, RowUp{}, scr, r, lane); return; } r -= CI_UP;
    if (r < CI_DN) { transpose_item(F.in[I_FFNDN] + (size_t)l * DFF * 2048, DFF, 2048, WDN, RowId{0}, scr, r, lane); return; } r -= CI_DN;
    if (r < 4 * CI_P1) { const int g = r / CI_P1; transpose_item(F.in[I_POOLW] + ((size_t)l * 4 + g) * 256 * 256, 256, 256, WPOOL + (size_t)g * 256 * 256, RowId{0}, scr, r % CI_P1, lane); return; } r -= 4 * CI_P1;
    {
        unsigned char* base = (unsigned char*)WIG + (size_t)(10256 + 8 * r) * 2048 * 2;
#pragma unroll 4
        for (int k = 0; k < 32; ++k) *(GAS v4u*)(base + (size_t)(k * 64 + lane) * 16) = (v4u){0u, 0u, 0u, 0u};
    }
}
__device__ __forceinline__ void steal_convert(Frame& F, int l, int finidx, bool drain) {
    frame_refresh(F);
    gu32* q = (gu32*)(F.ws + WS_CTL) + CW_Q + 64 * l;
    gu32* fin = (gu32*)(F.ws + WS_CTL) + CW_FIN + 64 * finidx;
    volatile LAS unsigned* box = (volatile LAS unsigned*)(F.lds + MISC_OFF);
    LAS float* scr = (LAS float*)(F.lds + F.wave * 16384);
    if (F.tid == 0 && !drain) __hip_atomic_fetch_add(fin, 1u, RLX_AGENT);
    for (;;) {
        if (F.tid == 0) { unsigned v = 0xffffffffu; if (drain || __hip_atomic_load(fin, RLX_AGENT) < (unsigned)F.G) v = __hip_atomic_fetch_add(q, 1u, RLX_AGENT); box[0] = v; }
        __syncthreads();
        const unsigned got = box[0];
        __syncthreads();
        if (got == 0xffffffffu) break;
        const int base = (int)got * 8;
        if (base >= NITW) break;
        { const int wi = base + F.wave; if (wi < NITW) convert_item(F, l, wi, scr, F.lane); }
    }
}

template <bool FIRST>
__device__ __forceinline__ void phase_norm(Frame& F, int l, const float* nw, int sh_off, int sc_off, int nrows, bool addpart = false) {
    frame_refresh(F);
    float* X = (float*)(F.ws + WS_X); bf16* H = (bf16*)(F.ws + WS_H); const float* MOD = (const float*)(F.ws + WS_MOD);
    const int gw = F.bid * NWAVES + F.wave, NGW = F.G * NWAVES;
    for (int row = gw; row < nrows; row += NGW) {
        const float* src = FIRST ? (row < ML ? F.in[I_X] + (size_t)row * D : F.in[I_CTX] + (size_t)(row - ML) * D) : X + (size_t)row * D;
        f32x4 v[8]; float ss = 0.f;
#pragma unroll
        for (int j = 0; j < 8; ++j) { v[j] = *(const f32x4*)(src + 256 * j + 4 * F.lane); ss += (v[j].x * v[j].x + v[j].y * v[j].y) + (v[j].z * v[j].z + v[j].w * v[j].w); }
        if (FIRST) {
#pragma unroll
            for (int j = 0; j < 8; ++j) *(f32x4*)(X + (size_t)row * D + 256 * j + 4 * F.lane) = v[j];
        }
        if (!FIRST && addpart && row >= ML) {
            const float* P = (const float*)(F.ws + WS_PART) + (size_t)(row - ML) * D;
            ss = 0.f;
#pragma unroll
            for (int j = 0; j < 8; ++j) {
#pragma unroll
                for (int sp = 0; sp < 4; ++sp) v[j] += *(const f32x4*)(P + (size_t)sp * MC * D + 256 * j + 4 * F.lane);
                *(f32x4*)(X + (size_t)row * D + 256 * j + 4 * F.lane) = v[j];
                ss += (v[j].x * v[j].x + v[j].y * v[j].y) + (v[j].z * v[j].z + v[j].w * v[j].w);
            }
        }
        const float rs = rsqrtf(wave_sum(ss) * (1.0f / D) + EPS);
        const float* mv = MOD + ((size_t)l * 5 + mod_vec(row)) * 12288;
#pragma unroll
        for (int j = 0; j < 8; ++j) { const int c = 256 * j + 4 * F.lane;
            const f32x4 w = *(const f32x4*)(nw + c), sh = *(const f32x4*)(mv + sh_off + c), sc = *(const f32x4*)(mv + sc_off + c);
            const f32x4 y = v[j] * rs * w; const f32x4 h = y * (sc + 1.0f) + sh;
            v2u o; o.x = pk2(h.x, h.y); o.y = pk2(h.z, h.w); *(v2u*)(H + (size_t)row * D + c) = o; }
    }
}
__device__ __forceinline__ void phase_final(Frame& F, float* out) {
    frame_refresh(F);
    const float* X = (const float*)(F.ws + WS_X); const float* nw = F.in[I_FNW];
    const int gw = F.bid * NWAVES + F.wave, NGW = F.G * NWAVES;
    for (int row = gw; row < ML; row += NGW) {
        f32x4 v[8]; float ss = 0.f;
#pragma unroll
        for (int j = 0; j < 8; ++j) { v[j] = *(const f32x4*)(X + (size_t)row * D + 256 * j + 4 * F.lane); ss += (v[j].x * v[j].x + v[j].y * v[j].y) + (v[j].z * v[j].z + v[j].w * v[j].w); }
        const float rs = rsqrtf(wave_sum(ss) * (1.0f / D) + EPS);
#pragma unroll
        for (int j = 0; j < 8; ++j) { const int c = 256 * j + 4 * F.lane; *(f32x4*)(out + (size_t)row * D + c) = v[j] * rs * *(const f32x4*)(nw + c); }
    }
}

__device__ __forceinline__ v4u ldrow(const bf16* base, int row, int ld, int col, bool ok) { return ok ? *(const v4u*)(base + (size_t)row * ld + col) : (v4u){0u, 0u, 0u, 0u}; }
__device__ __forceinline__ void ld8f(const float* p, float (&f)[8]) { const f32x4 a = *(const f32x4*)p, b = *(const f32x4*)(p + 4); f[0] = a.x; f[1] = a.y; f[2] = a.z; f[3] = a.w; f[4] = b.x; f[5] = b.y; f[6] = b.z; f[7] = b.w; }

__device__ __forceinline__ void sc_task(Frame& F, int l, int r, int lane) {
    const bf16* U = (const bf16*)(F.ws + WS_U); bf16* YB2 = (bf16*)(F.ws + WS_YB) + 2 * YS_STRIDE;
            const int rb = r >> 1, cb = r & 1, c = cb * 512 + lane * 8, r0 = rb * 32; int s0, s1; seq_bounds(r0, s0, s1);
            float w0[8], w1[8], w2[8];
            ld8f(F.in[I_SCONVW] + ((size_t)l * 3 + 0) * 1024 + c, w0); ld8f(F.in[I_SCONVW] + ((size_t)l * 3 + 1) * 1024 + c, w1); ld8f(F.in[I_SCONVW] + ((size_t)l * 3 + 2) * 1024 + c, w2);
            for (int r4 = r0; r4 < r0 + 32; r4 += 4) {
                v4u bc[6], bx[6], bg[4];
#pragma unroll
                for (int k = 0; k < 6; ++k) { const int s = r4 - 1 + k; const bool ok = s >= s0 && s < s1; bc[k] = ldrow(U, s, UC, U_SCC + c, ok); bx[k] = ldrow(U, s, UC, U_SCX + c, ok); }
#pragma unroll
                for (int k = 0; k < 4; ++k) bg[k] = ldrow(U, r4 + k, UC, U_SCB + c, true);
                float pr[6][8];
#pragma unroll
                for (int k = 0; k < 6; ++k) { float a[8], b[8]; unpack8(bc[k], a); unpack8(bx[k], b);
#pragma unroll
                    for (int e = 0; e < 8; ++e) pr[k][e] = a[e] * b[e]; }
#pragma unroll
                for (int j = 0; j < 4; ++j) { float g[8], o[8]; unpack8(bg[j], g);
#pragma unroll
                    for (int e = 0; e < 8; ++e) o[e] = g[e] * (w0[e] * pr[j][e] + w1[e] * pr[j + 1][e] + w2[e] * pr[j + 2][e]);
                    *(v4u*)(YB2 + (size_t)(r4 + j) * 1024 + c) = pack8(o); }
            }
}
__device__ __forceinline__ void sc_phase(Frame& F, int l, int c, int Gs) {
    frame_refresh(F);
    const int gw = c * NWAVES + F.wave, NGW = Gs * NWAVES;
    for (int task = gw; task < (M / 32) * 2; task += NGW) sc_task(F, l, task, F.lane);
}
template <int HMAX>
__device__ __forceinline__ void pool_task(const bf16* U, bf16* POOLED, int r0, int s0, int s1, int c, int half) {
    constexpr int NR = 8 + 2 * HMAX - 1, HA = HMAX / 2;
    const bool big = (half == HMAX);
    for (int r8 = r0; r8 < r0 + 32; r8 += 8) {
        v4u buf[NR];
#pragma unroll
        for (int k = 0; k < NR; ++k) { const int s = r8 - HMAX + k; buf[k] = ldrow(U, s, UC, U_POOL + c, s >= s0 && s < s1); }
        float sa[8], sb[8];
#pragma unroll
        for (int e = 0; e < 8; ++e) { sa[e] = 0.f; sb[e] = 0.f; }
#pragma unroll
        for (int k = 0; k < 2 * HMAX; ++k) { float t[8]; unpack8(buf[k], t);
#pragma unroll
            for (int e = 0; e < 8; ++e) { sb[e] += t[e]; if (k >= HA && k < HMAX + HA) sa[e] += t[e]; } }
#pragma unroll
        for (int j = 0; j < 8; ++j) {
            const int rr = r8 + j; int lo = rr - half, hi = rr + half; lo = lo < s0 ? s0 : lo; hi = hi > s1 ? s1 : hi;
            float x[8], o[8]; unpack8(buf[j + HMAX], x); const float inv = 1.0f / (float)(hi - lo);
#pragma unroll
            for (int e = 0; e < 8; ++e) o[e] = (big ? sb[e] : sa[e]) * inv - x[e];
            *(v4u*)(POOLED + (size_t)rr * 1024 + c) = pack8(o);
            if (j < 7) {
                float tin[8], tout[8];
                unpack8(buf[j + 2 * HMAX], tin); unpack8(buf[j], tout);
#pragma unroll
                for (int e = 0; e < 8; ++e) sb[e] += tin[e] - tout[e];
                unpack8(buf[j + HMAX + HA], tin); unpack8(buf[j + HA], tout);
#pragma unroll
                for (int e = 0; e < 8; ++e) sa[e] += tin[e] - tout[e];
            }
        }
    }
}
__device__ __forceinline__ void phase_pre(Frame& F, int l) {
    frame_refresh(F);
    const bf16* U = (const bf16*)(F.ws + WS_U);
    bf16* XBCA = (bf16*)(F.ws + WS_XBCA); bf16* RQK = (bf16*)(F.ws + WS_RQK); bf16* YB2 = (bf16*)(F.ws + WS_YB) + 2 * YS_STRIDE; bf16* POOLED = (bf16*)(F.ws + WS_POOLED);
    const float* ROPE = (const float*)(F.ws + WS_ROPE);
    const int gw = F.bid * NWAVES + F.wave, NGW = F.G * NWAVES, lane = F.lane;
    constexpr int NRB = M / 32;
    constexpr int T_CUM = (M / 64) * 2, T_XBC = NRB * 4, T_POOL = NRB * 2, T_ROPE = NRB;
    float* CUMA = (float*)(F.ws + WS_CUMA); float* DTA = (float*)(F.ws + WS_DTA); const float* DT = (const float*)(F.ws + WS_DT);
    for (int task = gw; task < T_CUM + T_XBC + T_POOL + T_ROPE; task += NGW) {
        int r = task;
        if (r < T_CUM) {
            const int blk = r >> 1, dir = r & 1, row = blk * 64 + (dir ? 63 - lane : lane);
            for (int hh = 0; hh < 16; ++hh) {
                const float dt = softplusf_(DT[(size_t)row * 16 + hh] + F.in[I_SSDDTB][(l * 2 + dir) * 16 + hh]);
                float cum = dt * -expf(F.in[I_SSDALOG][(l * 2 + dir) * 16 + hh]);
#pragma unroll
                for (int o = 1; o < 64; o <<= 1) { const float t = __shfl_up(cum, o); if (lane >= o) cum += t; }
                CUMA[(size_t)(dir * 16 + hh) * M + row] = cum; DTA[(size_t)(dir * 16 + hh) * M + row] = dt;
            }
            continue;
        }
        r -= T_CUM;
        if (r < T_XBC) {
            const int rb = r >> 2, cb = r & 3, c = cb * 512 + lane * 8, r0 = rb * 32; int s0, s1; seq_bounds(r0, s0, s1);
            float w0[8], w1[8], w2[8], bb[8];
            ld8f(F.in[I_SSDCW] + ((size_t)l * 3 + 0) * 2048 + c, w0); ld8f(F.in[I_SSDCW] + ((size_t)l * 3 + 1) * 2048 + c, w1); ld8f(F.in[I_SSDCW] + ((size_t)l * 3 + 2) * 2048 + c, w2); ld8f(F.in[I_SSDCB] + (size_t)l * 2048 + c, bb);
            v4u bufA[10], bufB[10];
#define XBC_LOAD(buf, r8_) do { _Pragma("unroll") for (int k = 0; k < 10; ++k) { const int s = (r8_) - 1 + k; buf[k] = ldrow(U, s, UC, U_XBC + c, s >= s0 && s < s1); } } while (0)
#define XBC_COMP(buf, r8_) do { _Pragma("unroll") for (int j = 0; j < 8; ++j) { \
                    float p[8], q[8], n[8], o[8]; unpack8(buf[j], p); unpack8(buf[j + 1], q); unpack8(buf[j + 2], n); \
                    _Pragma("unroll") for (int e = 0; e < 8; ++e) o[e] = siluf_(w0[e] * p[e] + w1[e] * q[e] + w2[e] * n[e] + bb[e]); \
                    *(v4u*)(XBCA + (size_t)((r8_) + j) * 2048 + c) = pack8(o); } } while (0)
            XBC_LOAD(bufA, r0);
            XBC_LOAD(bufB, r0 + 8);  XBC_COMP(bufA, r0);
            XBC_LOAD(bufA, r0 + 16); XBC_COMP(bufB, r0 + 8);
            XBC_LOAD(bufB, r0 + 24); XBC_COMP(bufA, r0 + 16);
            XBC_COMP(bufB, r0 + 24);
#undef XBC_LOAD
#undef XBC_COMP
            continue;
        }
        r -= T_XBC;
        if (r < T_POOL) {
            const int rb = r >> 1, cb = r & 1, c = cb * 512 + lane * 8, r0 = rb * 32; int s0, s1; seq_bounds(r0, s0, s1);
            const int grp = c >> 8, half = 1 << grp;
            if (cb == 0) pool_task<2>(U, POOLED, r0, s0, s1, c, half); else pool_task<8>(U, POOLED, r0, s0, s1, c, half);
            continue;
        }
        r -= T_POOL;
        {
            const int r0 = r * 32; int s0, s1; seq_bounds(r0, s0, s1);
            const int qk = lane >> 5, rem = lane & 31, head = rem >> 2, part = (rem >> 1) & 1, sub = rem & 1;
            const int c1 = head * 64 + part * 32 + sub * 8, c2 = c1 + 16; const float scl = qk == 0 ? 0.125f : 1.0f;
            const int ucol = (qk == 0 ? U_RQ : U_RK);
            for (int r8 = r0; r8 < r0 + 32; r8 += 8) {
                v4u b1[8], b2[8];
#pragma unroll
                for (int k = 0; k < 8; ++k) { b1[k] = ldrow(U, r8 + k, UC, ucol + c1, true); b2[k] = ldrow(U, r8 + k, UC, ucol + c2, true); }
#pragma unroll
                for (int k = 0; k < 8; ++k) {
                    const int rr = r8 + k; float x1[8], x2[8], o1[8], o2[8]; unpack8(b1[k], x1); unpack8(b2[k], x2);
                    if (rr < ML) {
                        const int t = rr - s0, pos = part == 0 ? (t >> 6) : (t & 63);
                        const float* rp = ROPE + (size_t)(pos * 16 + sub * 8) * 2;
#pragma unroll
                        for (int e = 0; e < 8; ++e) { const float cs = rp[2 * e], sn = rp[2 * e + 1]; o1[e] = (x1[e] * cs - x2[e] * sn) * scl; o2[e] = (x1[e] * sn + x2[e] * cs) * scl; }
                    } else {
#pragma unroll
                        for (int e = 0; e < 8; ++e) { o1[e] = x1[e] * scl; o2[e] = x2[e] * scl; }
                    }
                    *(v4u*)(RQK + (size_t)rr * 1024 + qk * 512 + c1) = pack8(o1); *(v4u*)(RQK + (size_t)rr * 1024 + qk * 512 + c2) = pack8(o2);
                }
            }
        }
    }
}

#define MFMA32(a, b, c) __builtin_amdgcn_mfma_f32_32x32x16_bf16((a), (b), (c), 0, 0, 0)
#define SCAN_BAR() do { asm volatile("s_waitcnt lgkmcnt(0)" ::: "memory"); __builtin_amdgcn_s_barrier(); asm volatile("" ::: "memory"); } while (0)
typedef short s16x4 __attribute__((ext_vector_type(4)));
__device__ __forceinline__ bf16x8 tr_frag(LAS unsigned char* tile, int rs, int c, int ks, int lane) {
    const int h = lane >> 5, blk = (lane >> 4) & 1, q = (lane & 15) >> 2, p = lane & 3;
    LAS unsigned char* a0 = tile + (16 * ks + 8 * h + q) * rs + (32 * c + 16 * blk + 4 * p) * 2;
    const s16x4 lo = __builtin_amdgcn_ds_read_tr16_b64_v4i16((LAS s16x4*)a0);
    const s16x4 hi = __builtin_amdgcn_ds_read_tr16_b64_v4i16((LAS s16x4*)(a0 + 4 * rs));
    return __builtin_shufflevector(lo, hi, 0, 1, 2, 3, 4, 5, 6, 7);
}
template <int DN, int DP, bool SSD>
__device__ __forceinline__ void scan_unit(Frame& F, int l, int b, int h, int dir) {
    frame_refresh(F);
    constexpr int RSQ = (DN + 8) * 2, RSK2 = DN * 2 + 64, RSV = DP * 2 + 64, RSJ = 72 * 2;
    constexpr int O_Q = 0, O_K = O_Q + 64 * RSQ, O_K2 = O_K + 64 * RSQ, O_V = O_K2 + 64 * RSK2, O_VW = O_V + 64 * RSV, O_S = O_VW + 64 * RSV, O_HST = O_S + 64 * RSJ, O_CUM = O_HST + DP * RSQ, O_END = O_CUM + 256;
    static_assert(O_END <= RING_BYTES, "scan LDS");
    LAS unsigned char* lds = F.lds;
    const int tid = F.tid, lane = F.lane, w = F.wave, r = lane & 31, hh = lane >> 5;
    const bf16* XBCA = (const bf16*)(F.ws + WS_XBCA); const bf16* RQK = (const bf16*)(F.ws + WS_RQK); const bf16* U = (const bf16*)(F.ws + WS_U);
    const float* CUMA = (const float*)(F.ws + WS_CUMA) + (size_t)(dir * 16 + h) * M; const float* DTA = (const float*)(F.ws + WS_DTA) + (size_t)(dir * 16 + h) * M;
    bf16* YS = (bf16*)(F.ws + WS_YS) + (size_t)((SSD ? 0 : 2) + dir) * YS_STRIDE;
    const int ycol = SSD ? h * 64 : h * 128;
    float la_const = 0.f;
    if (!SSD) la_const = -softplusf_(-F.in[I_RETDL][(l * 2 + dir) * 8 + h]);
    for (int i = tid; i < DP * RSQ / 16; i += 512) *(LAS v4u*)(lds + O_HST + i * 16) = (v4u){0u, 0u, 0u, 0u};
    f32x16 Hs;
#pragma unroll
    for (int i = 0; i < 16; ++i) Hs[i] = 0.f;
    const int tok8 = tid >> 3, ch8 = tid & 7, tok16 = tid >> 4, ch16 = tid & 15;
    constexpr int NPF = 2;
    v4u preb[NPF][5]; float pcum[NPF], pdt[NPF], pcl[NPF], pcw[NPF];
#pragma unroll
    for (int u = 0; u < NPF; ++u) { pcum[u] = 0.f; pdt[u] = 1.f; pcl[u] = 0.f; pcw[u] = 0.f;
#pragma unroll
        for (int k = 0; k < 5; ++k) preb[u][k] = (v4u){0u, 0u, 0u, 0u}; }
    auto row_of = [&](int st, int i) -> int {
        int base, sub;
        if (st < 4) { base = ML + b * CTX; sub = dir ? 3 - st : st; } else { base = b * SEQ; sub = dir ? 67 - st : st - 4; }
        return base + sub * 64 + (dir ? 63 - i : i);
    };
#define SCAN_PREFETCH(st_, pre, u_) do { \
        const int rn_ = row_of((st_), tok8), rw0_ = row_of((st_), tok16), rw1_ = row_of((st_), 32 + tok16); \
        if (SSD) { const int g = h >> 2; \
            pre[0] = *(const v4u*)(XBCA + (size_t)rn_ * 2048 + h * 64 + 8 * ch8); \
            pre[1] = *(const v4u*)(XBCA + (size_t)rw0_ * 2048 + 1024 + g * 128 + 8 * ch16); pre[2] = *(const v4u*)(XBCA + (size_t)rw1_ * 2048 + 1024 + g * 128 + 8 * ch16); \
            pre[3] = *(const v4u*)(XBCA + (size_t)rw0_ * 2048 + 1536 + g * 128 + 8 * ch16); pre[4] = *(const v4u*)(XBCA + (size_t)rw1_ * 2048 + 1536 + g * 128 + 8 * ch16); \
            pcum[u_] = CUMA[rn_]; pdt[u_] = DTA[rn_]; pcl[u_] = CUMA[row_of((st_), 63)]; pcw[u_] = CUMA[row_of((st_), lane)]; \
        } else { \
            pre[0] = *(const v4u*)(RQK + (size_t)rn_ * 1024 + h * 64 + 8 * ch8); pre[1] = *(const v4u*)(RQK + (size_t)rn_ * 1024 + 512 + h * 64 + 8 * ch8); \
            pre[2] = *(const v4u*)(U + (size_t)rw0_ * UC + U_RV + h * 128 + 8 * ch16); pre[3] = *(const v4u*)(U + (size_t)rw1_ * UC + U_RV + h * 128 + 8 * ch16); \
        } } while (0)
#pragma unroll
    for (int u = 0; u < NPF; ++u) SCAN_PREFETCH(u, preb[u], u);
    for (int st2 = 0; st2 < 68; st2 += NPF) {
#pragma unroll
    for (int u = 0; u < NPF; ++u) {
        const int st = st2 + u;
        v4u (&pre)[5] = preb[u];
        float clast;
        if (SSD) {
            clast = pcl[u];
            const float dtx = pdt[u], wx = __expf(clast - pcum[u]);
            float x[8], v[8], vw[8]; unpack8(pre[0], x);
#pragma unroll
            for (int e = 0; e < 8; ++e) { v[e] = x[e] * dtx; vw[e] = v[e] * wx; }
            *(LAS v4u*)(lds + O_V + tok8 * RSV + 16 * ch8) = pack8(v); *(LAS v4u*)(lds + O_VW + tok8 * RSV + 16 * ch8) = pack8(vw);
            *(LAS v4u*)(lds + O_K + tok16 * RSQ + 16 * ch16) = pre[1]; *(LAS v4u*)(lds + O_K + (32 + tok16) * RSQ + 16 * ch16) = pre[2];
            *(LAS v4u*)(lds + O_K2 + tok16 * RSK2 + 16 * ch16) = pre[1]; *(LAS v4u*)(lds + O_K2 + (32 + tok16) * RSK2 + 16 * ch16) = pre[2];
            *(LAS v4u*)(lds + O_Q + tok16 * RSQ + 16 * ch16) = pre[3]; *(LAS v4u*)(lds + O_Q + (32 + tok16) * RSQ + 16 * ch16) = pre[4];
            if (w == 0) *(LAS float*)(lds + O_CUM + 4 * lane) = pcw[u];
        } else {
            clast = la_const * 64.f;
            *(LAS v4u*)(lds + O_Q + tok8 * RSQ + 16 * ch8) = pre[0];
            *(LAS v4u*)(lds + O_K + tok8 * RSQ + 16 * ch8) = pre[1]; *(LAS v4u*)(lds + O_K2 + tok8 * RSK2 + 16 * ch8) = pre[1];
            const float w0 = __expf(la_const * (float)(63 - tok16)), w1 = __expf(la_const * (float)(31 - tok16));
            float v0[8], v1[8], q0[8], q1[8]; unpack8(pre[2], v0); unpack8(pre[3], v1);
#pragma unroll
            for (int e = 0; e < 8; ++e) { q0[e] = v0[e] * w0; q1[e] = v1[e] * w1; }
            *(LAS v4u*)(lds + O_V + tok16 * RSV + 16 * ch16) = pre[2]; *(LAS v4u*)(lds + O_V + (32 + tok16) * RSV + 16 * ch16) = pre[3];
            *(LAS v4u*)(lds + O_VW + tok16 * RSV + 16 * ch16) = pack8(q0); *(LAS v4u*)(lds + O_VW + (32 + tok16) * RSV + 16 * ch16) = pack8(q1);
            if (w == 0) *(LAS float*)(lds + O_CUM + 4 * lane) = la_const * (float)(lane + 1);
        }
        SCAN_BAR();
        if (st + NPF < 68) SCAN_PREFETCH(st + NPF, pre, u);
        const float dcy = __expf(clast);
        if (w < 4) {
            const int jb = w >> 1, ib = w & 1;
            f32x16 acc;
#pragma unroll
            for (int i = 0; i < 16; ++i) acc[i] = 0.f;
            if (!(jb == 1 && ib == 0)) {
                bf16x8 fa[DN / 16], fq[DN / 16];
#pragma unroll
                for (int kk = 0; kk < DN / 16; ++kk) {
                    fa[kk] = *(const LAS bf16x8*)(lds + O_K + (jb * 32 + r) * RSQ + (kk * 16 + 8 * hh) * 2);
                    fq[kk] = *(const LAS bf16x8*)(lds + O_Q + (ib * 32 + r) * RSQ + (kk * 16 + 8 * hh) * 2);
                }
                __builtin_amdgcn_sched_barrier(0);
#pragma unroll
                for (int kk = 0; kk < DN / 16; ++kk) acc = MFMA32(fa[kk], fq[kk], acc);
            }
            const int i = ib * 32 + r; const float ci = *(const LAS float*)(lds + O_CUM + 4 * i);
#pragma unroll
            for (int g4 = 0; g4 < 4; ++g4) {
                const int j0 = jb * 32 + 8 * g4 + 4 * hh; const f32x4 cj = *(const LAS f32x4*)(lds + O_CUM + 4 * j0);
                float v[4];
#pragma unroll
                for (int e = 0; e < 4; ++e) { const float cje = e == 0 ? cj.x : (e == 1 ? cj.y : (e == 2 ? cj.z : cj.w)); v[e] = (j0 + e <= i) ? acc[4 * g4 + e] * __expf(ci - cje) : 0.f; }
                v2u o; o.x = pk2(v[0], v[1]); o.y = pk2(v[2], v[3]);
                *(LAS v2u*)(lds + O_S + i * RSJ + j0 * 2) = o;
            }
        }
        SCAN_BAR();
        for (int blk = w; blk < (DP / 32) * 2; blk += 8) {
            const int pb = blk >> 1, ib = blk & 1;
            f32x16 a1, a2;
#pragma unroll
            for (int i = 0; i < 16; ++i) { a1[i] = 0.f; a2[i] = 0.f; }
            bf16x8 fv[4], fs[4], fh[DN / 16], fq[DN / 16];
#pragma unroll
            for (int kk = 0; kk < 4; ++kk) {
                fv[kk] = tr_frag(lds + O_V, RSV, pb, kk, lane);
                fs[kk] = *(const LAS bf16x8*)(lds + O_S + (ib * 32 + r) * RSJ + (kk * 16 + 8 * hh) * 2);
            }
#pragma unroll
            for (int kk = 0; kk < DN / 16; ++kk) {
                fh[kk] = *(const LAS bf16x8*)(lds + O_HST + (pb * 32 + r) * RSQ + (kk * 16 + 8 * hh) * 2);
                fq[kk] = *(const LAS bf16x8*)(lds + O_Q + (ib * 32 + r) * RSQ + (kk * 16 + 8 * hh) * 2);
            }
            __builtin_amdgcn_sched_barrier(0);
#pragma unroll
            for (int kk = 0; kk < 4; ++kk) a1 = MFMA32(fv[kk], fs[kk], a1);
#pragma unroll
            for (int kk = 0; kk < DN / 16; ++kk) a2 = MFMA32(fh[kk], fq[kk], a2);
            const int i = ib * 32 + r; const float ei = __expf(*(const LAS float*)(lds + O_CUM + 4 * i));
            const int row = row_of(st, i);
#pragma unroll
            for (int g4 = 0; g4 < 4; ++g4) {
                const int p0 = pb * 32 + 8 * g4 + 4 * hh;
                v2u o; o.x = pk2(a1[4 * g4 + 0] + ei * a2[4 * g4 + 0], a1[4 * g4 + 1] + ei * a2[4 * g4 + 1]); o.y = pk2(a1[4 * g4 + 2] + ei * a2[4 * g4 + 2], a1[4 * g4 + 3] + ei * a2[4 * g4 + 3]);
                *(v2u*)(YS + (size_t)row * 1024 + ycol + p0) = o;
            }
        }
        {
            const int nb = w / (DP / 32), pb = w % (DP / 32);
#pragma unroll
            for (int i = 0; i < 16; ++i) Hs[i] *= dcy;
            bf16x8 fk[4], fw[4];
#pragma unroll
            for (int kk = 0; kk < 4; ++kk) {
                fk[kk] = tr_frag(lds + O_K2, RSK2, nb, kk, lane);
                fw[kk] = tr_frag(lds + O_VW, RSV, pb, kk, lane);
            }
            __builtin_amdgcn_sched_barrier(0);
#pragma unroll
            for (int kk = 0; kk < 4; ++kk) Hs = MFMA32(fk[kk], fw[kk], Hs);
            SCAN_BAR();
#pragma unroll
            for (int g4 = 0; g4 < 4; ++g4) {
                const int n0 = nb * 32 + 8 * g4 + 4 * hh;
                v2u o; o.x = pk2(Hs[4 * g4 + 0], Hs[4 * g4 + 1]); o.y = pk2(Hs[4 * g4 + 2], Hs[4 * g4 + 3]);
                *(LAS v2u*)(lds + O_HST + (pb * 32 + r) * RSQ + n0 * 2) = o;
            }
        }
    }
    }
    __syncthreads();
#undef SCAN_PREFETCH
}

__device__ __forceinline__ void phase_fin(Frame& F, int l, int nrows) {
    frame_refresh(F);
    const bf16* U = (const bf16*)(F.ws + WS_U); const bf16* YS = (const bf16*)(F.ws + WS_YS); bf16* YB = (bf16*)(F.ws + WS_YB);
    const float* nw = F.in[I_SSDNW] + (size_t)l * 1024; const float* dskp = F.in[I_SSDD] + (size_t)l * 16; const bf16* XBCA = (const bf16*)(F.ws + WS_XBCA);
    const int gw = F.bid * NWAVES + F.wave, NGW = F.G * NWAVES, lane = F.lane;
    for (int row = gw; row < nrows; row += NGW) {
        {
            float g[2][8]; float ss = 0.f;
#pragma unroll
            for (int k = 0; k < 2; ++k) { const int c = k * 512 + 8 * lane; float yf[8], yb[8], z[8];
                unpack8(*(const v4u*)(YS + (size_t)row * 1024 + c), yf); unpack8(*(const v4u*)(YS + YS_STRIDE + (size_t)row * 1024 + c), yb); unpack8(*(const v4u*)(U + (size_t)row * UC + U_Z + c), z);
                float xs[8]; unpack8(*(const v4u*)(XBCA + (size_t)row * 2048 + c), xs); const float dsk = dskp[c >> 6];
#pragma unroll
                for (int e = 0; e < 8; ++e) { g[k][e] = (yf[e] + yb[e] + dsk * xs[e]) * siluf_(z[e]); ss += g[k][e] * g[k][e]; } }
            const float rs = rsqrtf(wave_sum(ss) * (1.0f / 1024.0f) + EPS);
#pragma unroll
            for (int k = 0; k < 2; ++k) { const int c = k * 512 + 8 * lane; float wv[8], o[8]; ld8f(nw + c, wv);
#pragma unroll
                for (int e = 0; e < 8; ++e) o[e] = g[k][e] * rs * wv[e];
                *(v4u*)(YB + (size_t)row * 1024 + c) = pack8(o); }
        }
        {
            const int c = 16 * lane; float v[16];
            { float a[8], b2[8]; unpack8(*(const v4u*)(YS + 2 * YS_STRIDE + (size_t)row * 1024 + c), a); unpack8(*(const v4u*)(YS + 3 * YS_STRIDE + (size_t)row * 1024 + c), b2);
#pragma unroll
              for (int e = 0; e < 8; ++e) v[e] = a[e] + b2[e];
              unpack8(*(const v4u*)(YS + 2 * YS_STRIDE + (size_t)row * 1024 + c + 8), a); unpack8(*(const v4u*)(YS + 3 * YS_STRIDE + (size_t)row * 1024 + c + 8), b2);
#pragma unroll
              for (int e = 0; e < 8; ++e) v[8 + e] = a[e] + b2[e]; }
            float s = 0.f;
#pragma unroll
            for (int e = 0; e < 16; ++e) s += v[e];
            s += __shfl_xor(s, 1); s += __shfl_xor(s, 2); s += __shfl_xor(s, 4);
            const float mu = s * (1.0f / 128.0f); float q = 0.f;
#pragma unroll
            for (int e = 0; e < 16; ++e) { v[e] -= mu; q += v[e] * v[e]; }
            q += __shfl_xor(q, 1); q += __shfl_xor(q, 2); q += __shfl_xor(q, 4);
            const float rs = rsqrtf(q * (1.0f / 128.0f) + EPS);
            float g0[8], g1[8], o0[8], o1[8]; unpack8(*(const v4u*)(U + (size_t)row * UC + U_RG + c), g0); unpack8(*(const v4u*)(U + (size_t)row * UC + U_RG + c + 8), g1);
#pragma unroll
            for (int e = 0; e < 8; ++e) { o0[e] = siluf_(g0[e]) * v[e] * rs; o1[e] = siluf_(g1[e]) * v[8 + e] * rs; }
            *(v4u*)(YB + 3 * YS_STRIDE + (size_t)row * 1024 + c) = pack8(o0); *(v4u*)(YB + 3 * YS_STRIDE + (size_t)row * 1024 + c + 8) = pack8(o1);
        }
    }
}

__device__ __forceinline__ v4u ldedge(const bf16* EDGE, int blk, int j, int h, int c, bool ok) { return ok ? *(const v4u*)(EDGE + ((size_t)(blk * 4 + j) * 2 + h) * DFF + c) : (v4u){0u, 0u, 0u, 0u}; }
__device__ __forceinline__ void phase_ffnfix(Frame& F, int l, int nrows) {
    frame_refresh(F);
    const bf16* EDGE = (const bf16*)(F.ws + WS_UP); bf16* ACT = (bf16*)(F.ws + WS_ACT);
    const int gw = F.bid * NWAVES + F.wave, NGW = F.G * NWAVES, lane = F.lane;
    const int ntask = (nrows / 64) * 11;
    for (int task = gw; task < ntask; task += NGW) {
        const int blk = task / 11, cb = task % 11, c = cb * 512 + lane * 8, r0 = blk * 64; int s0, s1; seq_bounds(r0, s0, s1);
        const bool hp = r0 > s0, hn = r0 + 64 < s1;
        float wa0[8], wa1[8], wa2[8], ba[8], wb0[8], wb1[8], wb2[8], bb[8];
        const float* cw = F.in[I_FFNCW] + (size_t)l * 3 * UPC; const float* cbp = F.in[I_FFNCB] + (size_t)l * UPC;
        v4u ra[6], rb[6];
        ra[0] = ldedge(EDGE, blk - 1, 3, 0, c, hp); ra[1] = ldedge(EDGE, blk, 0, 0, c, true); ra[2] = ldedge(EDGE, blk, 1, 0, c, true);
        ra[3] = ldedge(EDGE, blk, 2, 0, c, true); ra[4] = ldedge(EDGE, blk, 3, 0, c, true); ra[5] = ldedge(EDGE, blk + 1, 0, 0, c, hn);
        rb[0] = ldedge(EDGE, blk - 1, 3, 1, c, hp); rb[1] = ldedge(EDGE, blk, 0, 1, c, true); rb[2] = ldedge(EDGE, blk, 1, 1, c, true);
        rb[3] = ldedge(EDGE, blk, 2, 1, c, true); rb[4] = ldedge(EDGE, blk, 3, 1, c, true); rb[5] = ldedge(EDGE, blk + 1, 0, 1, c, hn);
        ld8f(cw + c, wa0); ld8f(cw + UPC + c, wa1); ld8f(cw + 2 * UPC + c, wa2); ld8f(cbp + c, ba);
        ld8f(cw + DFF + c, wb0); ld8f(cw + UPC + DFF + c, wb1); ld8f(cw + 2 * UPC + DFF + c, wb2); ld8f(cbp + DFF + c, bb);
#pragma unroll
        for (int j = 0; j < 2; ++j) {
            float p[8], q[8], n[8], o[8], a[8];
            unpack8(ra[3 * j], p); unpack8(ra[3 * j + 1], q); unpack8(ra[3 * j + 2], n);
#pragma unroll
            for (int e = 0; e < 8; ++e) a[e] = siluf_(wa0[e] * p[e] + wa1[e] * q[e] + wa2[e] * n[e] + ba[e]);
            unpack8(rb[3 * j], p); unpack8(rb[3 * j + 1], q); unpack8(rb[3 * j + 2], n);
#pragma unroll
            for (int e = 0; e < 8; ++e) o[e] = a[e] * (wb0[e] * p[e] + wb1[e] * q[e] + wb2[e] * n[e] + bb[e]);
            *(v4u*)(ACT + (size_t)(r0 + 63 * j) * DFF + c) = pack8(o);
        }
    }
}

using pg8::f32x4; using pg8::Unit; using pg8::HALF; using pg8::BM;
__device__ __forceinline__ size_t gate_off(int pm, int gt, int wave, int frag, int lane) { return ((((size_t)pm * 32 + gt) * 8 + wave) * 16 + frag) * 512 + (size_t)lane * 8; }
struct EpiInGate {
    static constexpr bool PERM = true, CHAIN = false;
    bf16* U; float* DT; unsigned char* G; const float* bg; int pn0;
    __device__ __forceinline__ void operator()(const f32x4 (&acc)[2][2][4][2], const Unit& u, int wr, int wc, int fr, int fq) const {
        const int row0 = u.pm * BM + wr * 64 + fr, pn = u.pn + pn0;
        if (pn < 40) {
            const int col0 = pn * BM + wc * 32 + 8 * fq;
#pragma unroll
            for (int ai = 0; ai < 2; ++ai)
#pragma unroll
                for (int m = 0; m < 4; ++m) { bf16* rowp = U + (size_t)(row0 + ai * HALF + m * 16) * UC + col0;
#pragma unroll
                    for (int bj = 0; bj < 2; ++bj) { const f32x4 v0 = acc[ai][bj][m][0], v1 = acc[ai][bj][m][1];
                        v4u w; w.x = pg8::cvt_pk_bf16(v0[0], v0[1]); w.y = pg8::cvt_pk_bf16(v0[2], v0[3]); w.z = pg8::cvt_pk_bf16(v1[0], v1[1]); w.w = pg8::cvt_pk_bf16(v1[2], v1[3]);
                        *(v4u*)(rowp + bj * HALF) = w; } }
        } else if (pn == 40) {
            if (wc == 0 && fq < 2) {
#pragma unroll
                for (int ai = 0; ai < 2; ++ai)
#pragma unroll
                    for (int m = 0; m < 4; ++m) { float* rp = DT + (size_t)(row0 + ai * HALF + m * 16) * 16 + 8 * fq; *(f32x4*)rp = acc[ai][0][m][0]; *(f32x4*)(rp + 4) = acc[ai][0][m][1]; }
            }
        } else {
            const int col0 = (pn - 41) * BM + wc * 32 + 8 * fq;
            f32x4 bv[2][2];
#pragma unroll
            for (int bj = 0; bj < 2; ++bj)
#pragma unroll
                for (int n = 0; n < 2; ++n) bv[bj][n] = *(const f32x4*)(bg + col0 + bj * HALF + 4 * n) * -1.44269504f;
            constexpr float QC = 1.0f / 255.99f;
#pragma unroll
            for (int ai = 0; ai < 2; ++ai)
#pragma unroll
                for (int m = 0; m < 4; ++m) { unsigned char* rowp = G + gate_off(u.pm, pn - 41, wr * 4 + wc, ai * 8 + m * 2, fq * 16 + fr);
#pragma unroll
                    for (int bj = 0; bj < 2; ++bj) {
                        unsigned q[8];
#pragma unroll
                        for (int e = 0; e < 4; ++e) {
                            const float e0 = __builtin_amdgcn_exp2f(__builtin_fmaf(acc[ai][bj][m][0][e], -1.44269504f, bv[bj][0][e])), e1 = __builtin_amdgcn_exp2f(__builtin_fmaf(acc[ai][bj][m][1][e], -1.44269504f, bv[bj][1][e]));
                            q[e] = (unsigned)__builtin_amdgcn_rcpf(__builtin_fmaf(e0, QC, QC)); q[4 + e] = (unsigned)__builtin_amdgcn_rcpf(__builtin_fmaf(e1, QC, QC)); }
                        v2u w; w.x = q[0] | (q[1] << 8) | (q[2] << 16) | (q[3] << 24); w.y = q[4] | (q[5] << 8) | (q[6] << 16) | (q[7] << 24);
                        *(v2u*)(rowp + bj * 512) = w; } }
        }
    }
};
template <bool SCALE> struct EpiBf16 {
    static constexpr bool PERM = true, CHAIN = false;
    bf16* O; int ldc; const float* scale;
    __device__ __forceinline__ int operator()(const f32x4 (&acc)[2][2][4][2], const Unit& u, int wr, int wc, int fr, int fq) const {
        const int row0 = u.pm * BM + wr * 64 + fr, col0 = u.pn * BM + wc * 32 + 8 * fq;
        f32x4 sv[2][2];
        if (SCALE) {
#pragma unroll
            for (int bj = 0; bj < 2; ++bj)
#pragma unroll
                for (int n = 0; n < 2; ++n) sv[bj][n] = *(const f32x4*)(scale + col0 + bj * HALF + 4 * n);
        }
#pragma unroll
        for (int ai = 0; ai < 2; ++ai)
#pragma unroll
            for (int m = 0; m < 4; ++m) { bf16* rowp = O + (size_t)(row0 + ai * HALF + m * 16) * ldc + col0;
#pragma unroll
                for (int bj = 0; bj < 2; ++bj) { f32x4 v0 = acc[ai][bj][m][0], v1 = acc[ai][bj][m][1];
                    if (SCALE) { v0 = v0 * sv[bj][0]; v1 = v1 * sv[bj][1]; }
                    v4u w; w.x = pg8::cvt_pk_bf16(v0[0], v0[1]); w.y = pg8::cvt_pk_bf16(v0[2], v0[3]); w.z = pg8::cvt_pk_bf16(v1[0], v1[1]); w.w = pg8::cvt_pk_bf16(v1[2], v1[3]);
                    *(v4u*)(rowp + bj * HALF) = w; } }
        return 16;
    }
};
struct EpiFfn {
    static constexpr bool PERM = true, CHAIN = false;
    bf16* ACT; bf16* EDGE; const float* cw; const float* cb;
    template <int CTRL> static __device__ __forceinline__ float dpp(float x) { return __builtin_bit_cast(float, __builtin_amdgcn_update_dpp(0, __builtin_bit_cast(int, x), CTRL, 0xf, 0xf, true)); }
    template <int M> static __device__ __forceinline__ f32x4 conv4(const f32x4 (&x)[4][2], int n, const f32x4 (&w)[4], const f32x4 we0, const f32x4 we2) {
        f32x4 r;
#pragma unroll
        for (int e = 0; e < 4; ++e) { const float c = x[M][n][e];
            float t = __builtin_fmaf(w[1][e], c, w[3][e]);
            t = __builtin_fmaf(w[0][e], dpp<0x111>(c), t);
            t = __builtin_fmaf(w[2][e], dpp<0x101>(c), t);
            if (M > 0) t = __builtin_fmaf(we0[e], dpp<0x121>(x[M > 0 ? M - 1 : 0][n][e]), t);
            if (M < 3) t = __builtin_fmaf(we2[e], dpp<0x12f>(x[M < 3 ? M + 1 : 3][n][e]), t);
            r[e] = t; }
        return r;
    }
    template <int M> __device__ __forceinline__ v2u act4(const f32x4 (&xa)[4][2], const f32x4 (&xb)[4][2], int n, const f32x4 (&wa)[4], const f32x4 (&wb)[4], const f32x4 wae0, const f32x4 wae2, const f32x4 wbe0, const f32x4 wbe2) const {
        const f32x4 va = conv4<M>(xa, n, wa, wae0, wae2), vb = conv4<M>(xb, n, wb, wbe0, wbe2);
        float o[4];
#pragma unroll
        for (int e = 0; e < 4; ++e) o[e] = va[e] * __builtin_amdgcn_rcpf(1.0f + __builtin_amdgcn_exp2f(va[e] * -1.44269504f)) * vb[e];
        v2u r; r.x = pk2(o[0], o[1]); r.y = pk2(o[2], o[3]); return r;
    }
    __device__ __forceinline__ void operator()(const f32x4 (&acc)[2][2][4][2], const Unit& u, int wr, int wc, int fr, int fq) const {
        const int row0 = u.pm * BM + wr * 64 + fr, c0 = u.pn * 128 + wc * 32 + 8 * fq;
        const float e0 = fr == 0 ? 1.f : 0.f, e15 = fr == 15 ? 1.f : 0.f;
#pragma unroll
        for (int ai = 0; ai < 2; ++ai) {
            const int blk = u.pm * 4 + ai * 2 + wr;
            if (fr < 2 || fr >= 14) {
                const int j = fr < 2 ? fr : fr - 12;
                const f32x4 a0 = fr < 2 ? acc[ai][0][0][0] : acc[ai][0][3][0], a1 = fr < 2 ? acc[ai][0][0][1] : acc[ai][0][3][1];
                const f32x4 b0 = fr < 2 ? acc[ai][1][0][0] : acc[ai][1][3][0], b1 = fr < 2 ? acc[ai][1][0][1] : acc[ai][1][3][1];
                bf16* ep = EDGE + ((size_t)(blk * 4 + j) * 2) * DFF + c0;
                v4u w; w.x = pk2(a0[0], a0[1]); w.y = pk2(a0[2], a0[3]); w.z = pk2(a1[0], a1[1]); w.w = pk2(a1[2], a1[3]); *(v4u*)ep = w;
                w.x = pk2(b0[0], b0[1]); w.y = pk2(b0[2], b0[3]); w.z = pk2(b1[0], b1[1]); w.w = pk2(b1[2], b1[3]); *(v4u*)(ep + DFF) = w;
            }
        }
        __builtin_amdgcn_sched_barrier(0);
#pragma unroll
        for (int n = 0; n < 2; ++n) {
            f32x4 wa[4], wb[4];
#pragma unroll
            for (int k = 0; k < 3; ++k) { wa[k] = *(const f32x4*)(cw + k * UPC + c0 + 4 * n); wb[k] = *(const f32x4*)(cw + k * UPC + DFF + c0 + 4 * n); }
            wa[3] = *(const f32x4*)(cb + c0 + 4 * n); wb[3] = *(const f32x4*)(cb + DFF + c0 + 4 * n);
            const f32x4 wae0 = wa[0] * e0, wae2 = wa[2] * e15, wbe0 = wb[0] * e0, wbe2 = wb[2] * e15;
#pragma unroll
            for (int ai = 0; ai < 2; ++ai) {
                v2u r[4];
                r[0] = act4<0>(acc[ai][0], acc[ai][1], n, wa, wb, wae0, wae2, wbe0, wbe2); r[1] = act4<1>(acc[ai][0], acc[ai][1], n, wa, wb, wae0, wae2, wbe0, wbe2);
                r[2] = act4<2>(acc[ai][0], acc[ai][1], n, wa, wb, wae0, wae2, wbe0, wbe2); r[3] = act4<3>(acc[ai][0], acc[ai][1], n, wa, wb, wae0, wae2, wbe0, wbe2);
#pragma unroll
                for (int m = 0; m < 4; ++m) *(v2u*)(ACT + (size_t)(row0 + ai * HALF + m * 16) * DFF + c0 + 4 * n) = r[m];
            }
            __builtin_amdgcn_sched_barrier(0);
        }
    }
};
struct EpiBranch {
    static constexpr bool PERM = true, CHAIN = true;
    const unsigned char* G; bf16* MERGED; int skip;
    static __device__ __forceinline__ void deq8(const v2u w, float (&g)[8]) {
        g[0] = (float)(w.x & 0xffu); g[1] = (float)((w.x >> 8) & 0xffu); g[2] = (float)((w.x >> 16) & 0xffu); g[3] = (float)(w.x >> 24);
        g[4] = (float)(w.y & 0xffu); g[5] = (float)((w.y >> 8) & 0xffu); g[6] = (float)((w.y >> 16) & 0xffu); g[7] = (float)(w.y >> 24);
#pragma unroll
        for (int e = 0; e < 8; ++e) g[e] = (g[e] + 0.5f) * (1.0f / 256.0f);
    }
    __device__ __forceinline__ bool operator()(f32x4 (&acc)[2][2][4][2], const Unit& u, int wr, int wc, int fr, int fq) const {
        const int row0 = u.pm * BM + wr * 64 + fr, col0 = u.pn * BM + wc * 32 + 8 * fq, sub = u.sub;
        const int subn = sub < 3 ? sub + 1 : sub;
        if (skip) return sub == 3;
        v2u gv[2][4][2], hv[2][4][2];
#pragma unroll
        for (int ai = 0; ai < 2; ++ai)
#pragma unroll
            for (int m = 0; m < 4; ++m)
#pragma unroll
                for (int bj = 0; bj < 2; ++bj) { const int frag = ai * 8 + m * 2 + bj, wave = wr * 4 + wc, ln = fq * 16 + fr;
                    gv[ai][m][bj] = *(const v2u*)(G + gate_off(u.pm, sub * 8 + u.pn, wave, frag, ln)); hv[ai][m][bj] = *(const v2u*)(G + gate_off(u.pm, subn * 8 + u.pn, wave, frag, ln)); }
#pragma unroll
        for (int ai = 0; ai < 2; ++ai)
#pragma unroll
            for (int m = 0; m < 4; ++m)
#pragma unroll
                for (int bj = 0; bj < 2; ++bj) {
                    float g[8], h[8]; deq8(gv[ai][m][bj], g); deq8(hv[ai][m][bj], h);
                    if (sub < 3) {
#pragma unroll
                        for (int e = 0; e < 8; ++e) g[e] = g[e] * __builtin_amdgcn_rcpf(h[e]);
                    }
                    f32x4& v0 = acc[ai][bj][m][0]; f32x4& v1 = acc[ai][bj][m][1];
                    v0[0] *= g[0]; v0[1] *= g[1]; v0[2] *= g[2]; v0[3] *= g[3]; v1[0] *= g[4]; v1[1] *= g[5]; v1[2] *= g[6]; v1[3] *= g[7];
                    if (sub == 3) { v4u w; w.x = pg8::cvt_pk_bf16(v0[0], v0[1]); w.y = pg8::cvt_pk_bf16(v0[2], v0[3]); w.z = pg8::cvt_pk_bf16(v1[0], v1[1]); w.w = pg8::cvt_pk_bf16(v1[2], v1[3]);
                        *(v4u*)(MERGED + (size_t)(row0 + ai * HALF + m * 16) * 2048 + col0 + bj * HALF) = w; }
                }
        return sub == 3;
    }
};
struct EpiResid {
    static constexpr bool PERM = false, CHAIN = false;
    float* X; const float* modl; int goff, skip;
    __device__ __forceinline__ void operator()(const f32x4 (&acc)[2][2][4][2], const Unit& u, int wr, int wc, int fr, int fq) const {
        if (skip) return;
        const int row0 = u.pm * BM + wr * 64 + fr, col0 = u.pn * BM + wc * 32 + 4 * fq;
        const float* gp = modl + (size_t)(u.pm < 64 ? (u.pm >> 4) : 4) * 12288 + goff + col0;
        f32x4 gv[2][2];
#pragma unroll
        for (int bj = 0; bj < 2; ++bj)
#pragma unroll
            for (int n = 0; n < 2; ++n) gv[bj][n] = *(const f32x4*)(gp + bj * HALF + n * 16);
#pragma unroll
        for (int ai = 0; ai < 2; ++ai) {
            f32x4 xv[4][2][2];
#pragma unroll
            for (int m = 0; m < 4; ++m)
#pragma unroll
                for (int bj = 0; bj < 2; ++bj)
#pragma unroll
                    for (int n = 0; n < 2; ++n) xv[m][bj][n] = *(const f32x4*)(X + (size_t)(row0 + ai * HALF + m * 16) * D + col0 + bj * HALF + n * 16);
#pragma unroll
            for (int m = 0; m < 4; ++m)
#pragma unroll
                for (int bj = 0; bj < 2; ++bj)
#pragma unroll
                    for (int n = 0; n < 2; ++n) *(f32x4*)(X + (size_t)(row0 + ai * HALF + m * 16) * D + col0 + bj * HALF + n * 16) = xv[m][bj][n] + gv[bj][n] * acc[ai][bj][m][n];
        }
    }
};

struct EpiPart {
    static constexpr bool PERM = false, CHAIN = false;
    float* PART; const float* modl; int goff;
    __device__ __forceinline__ int operator()(const f32x4 (&acc)[2][2][4][2], const Unit& u, int wr, int wc, int fr, int fq) const {
        const int row0 = (u.pm - 64) * BM + wr * 64 + fr, col0 = u.pn * BM + wc * 32 + 4 * fq;
        const float* gp = modl + (size_t)4 * 12288 + goff + col0;
        float* P = PART + (size_t)u.sub * MC * D;
        f32x4 gv[2][2];
#pragma unroll
        for (int bj = 0; bj < 2; ++bj)
#pragma unroll
            for (int n = 0; n < 2; ++n) gv[bj][n] = *(const f32x4*)(gp + bj * HALF + n * 16);
#pragma unroll
        for (int ai = 0; ai < 2; ++ai)
#pragma unroll
            for (int m = 0; m < 4; ++m)
#pragma unroll
                for (int bj = 0; bj < 2; ++bj)
#pragma unroll
                    for (int n = 0; n < 2; ++n) *(f32x4*)(P + (size_t)(row0 + ai * HALF + m * 16) * D + col0 + bj * HALF + n * 16) = gv[bj][n] * acc[ai][bj][m][n];
        return 32;
    }
};

constexpr int NPH = 11;
constexpr int N_PHASES = 1 + DEPTH * NPH + 1;

__global__ void __launch_bounds__(NWAVES * 64, 2) fwd_kernel(Args args) {
    extern __shared__ __attribute__((aligned(16))) unsigned char lds_raw[];
    Frame F;
    F.lds = (LAS unsigned char*)lds_raw;
    F.tid = threadIdx.x; F.lane = F.tid & 63; F.wave = __builtin_amdgcn_readfirstlane(F.tid >> 6);
    F.G = gridDim.x; F.bid = blockIdx.x; F.ws = args.ws; F.in = args.in;
#if defined(PROBE_K)
    F.variant = args.variant;
#else
    F.variant = 0;
#endif
    gu32* ctl = (gu32*)(args.ws + WS_CTL);
    for (int u = F.tid; u < (LDS_BYTES - LDSCTL_OFF) / 4; u += NWAVES * 64) ((LAS unsigned*)(F.lds + LDSCTL_OFF))[u] = 0u;
    __syncthreads();
    XcdBarrier bar; bar.bar = (unsigned*)(ctl + CW_BAR); bar.x = 0; bar.st = nullptr;
    if (!MK_PER_PHASE && args.ph_hi - args.ph_lo > 1) bar = xcd_barrier_post((unsigned*)(ctl + CW_BAR), (volatile LAS unsigned*)(F.lds + MISC_OFF) + 8);
    const int lo = args.ph_lo, hi = args.ph_hi;
#ifndef PH_MASK
#define PH_MASK 0xFFFF
#endif
#define EN(b) (((PH_MASK) >> (b)) & 1)
#define IN(k) (lo <= (k) && (k) < hi)
#define SEAM(k) do { if (!MK_PER_PHASE && IN((k) + 1)) xcd_barrier(bar); } while (0)

    if (EN(11) && IN(0)) { phase_mod(F); steal_convert(F, 0, 0, true); SEAM(0); }

    for (int l = 0; l < DEPTH; ++l) {
        const int p0 = 1 + l * NPH;
        const int nrows = (l == DEPTH - 1) ? ML : M;
        const int nMp = nrows / 256;
        const float* modl = (const float*)(F.ws + WS_MOD) + (size_t)l * 5 * 12288;
        const unsigned char* wb = F.ws + (size_t)(l & 1) * W_SPAN;
        const bool cv = l + 1 < DEPTH;
        if (EN(0) && IN(p0 + 0)) {
            if (l == 0) phase_norm<true>(F, l, F.in[I_NORM1] + (size_t)l * D, 0, 2048, M);
            else phase_norm<false>(F, l, F.in[I_NORM1] + (size_t)l * D, 0, 2048, M, true);
            SEAM(p0 + 0);
        }
        if (EN(1) && IN(p0 + 1)) {
            const bool two = (nrows == ML);
            {
                pg8::Gemm g{(const char*)(F.ws + WS_H), (const char*)(wb + WS_WIG), (size_t)256 * D * 2, 0, 0, (size_t)256 * D * 2, 0, D, D, D};
                pg8::TileOrder<1> S; S.init(M / 256, two ? 41 : NIG / 256, F.G, F.bid);
                EpiInGate E{(bf16*)(F.ws + WS_U), (float*)(F.ws + WS_DT), (unsigned char*)(F.ws + WS_G), F.in[I_BGATE] + (size_t)l * 4 * 2048, 0};
                pg8::gemm_phase(F.lds + RING_OFF, g, S, E);
            }
            if (two) {
                pg8::Gemm g{(const char*)(F.ws + WS_H), (const char*)(wb + WS_WIG) + (size_t)41 * 256 * D * 2, (size_t)256 * D * 2, 0, 0, (size_t)256 * D * 2, 0, D, D, D};
                pg8::TileOrder<1> S; S.init(ML / 256, 32, F.G, F.bid);
                EpiInGate E{(bf16*)(F.ws + WS_U), (float*)(F.ws + WS_DT), (unsigned char*)(F.ws + WS_G), F.in[I_BGATE] + (size_t)l * 4 * 2048, 41};
                pg8::gemm_phase(F.lds + RING_OFF, g, S, E);
            }
            if (cv) steal_convert(F, l + 1, 1 + l * 6 + 0, false);
            SEAM(p0 + 1);
        }
        if (EN(2) && IN(p0 + 2)) { phase_pre(F, l); SEAM(p0 + 2); }
        if (EN(3) && IN(p0 + 3)) {
            const int nscan = 192;
            const bool split = F.G > nscan;
            for (int id = F.bid; id < nscan; id += F.G) {
#ifndef NO_SSD
                if (id < 128) scan_unit<128, 64, true>(F, l, id >> 5, (id >> 1) & 15, id & 1);
                else
#endif
#ifndef NO_RET
                { const int j = id - 128; scan_unit<64, 128, false>(F, l, j >> 4, (j >> 1) & 7, j & 1); }
#else
                {}
#endif
            }
#ifndef NO_POOLG
            if (!split || F.bid >= nscan) {
                pg8::Gemm g{(const char*)(F.ws + WS_POOLED), (const char*)(wb + WS_WPOOL), (size_t)256 * 1024 * 2, (size_t)256 * 2, 0, (size_t)256 * 256 * 2, 0, 1024, 256, 256};
                pg8::TileOrder<1> S; S.init(M / 256, 4, split ? F.G - nscan : F.G, split ? F.bid - nscan : F.bid);
                EpiBf16<true> E{(bf16*)(F.ws + WS_YB) + YS_STRIDE, 1024, F.in[I_POOLS] + (size_t)l * 1024};
                pg8::gemm_phase(F.lds + RING_OFF, g, S, E);
                sc_phase(F, l, split ? F.bid - nscan : F.bid, split ? F.G - nscan : F.G);
            }
            if (cv) steal_convert(F, l + 1, 1 + l * 6 + 5, false);
#endif
            SEAM(p0 + 3);
        }
        if (EN(4) && IN(p0 + 4)) { phase_fin(F, l, nrows); SEAM(p0 + 4); }
        if (EN(5) && IN(p0 + 5)) {
            pg8::Gemm g{(const char*)(F.ws + WS_YB), (const char*)(wb + WS_WB), (size_t)256 * 1024 * 2, 0, YS_STRIDE * 2, (size_t)256 * 1024 * 2, (size_t)2048 * 1024 * 2, 1024, 1024, 1024};
            pg8::TileOrder<4> S; S.init(nMp, D / 256, F.G, F.bid, 8);
            EpiBranch E{(const unsigned char*)(F.ws + WS_G), (bf16*)(F.ws + WS_MERGED), F.variant & 128};
            pg8::gemm_phase(F.lds + RING_OFF, g, S, E);
            if (cv) steal_convert(F, l + 1, 1 + l * 6 + 1, false);
            SEAM(p0 + 5);
        }
        if (EN(6) && IN(p0 + 6)) {
            pg8::Gemm g{(const char*)(F.ws + WS_MERGED), (const char*)(wb + WS_WO), (size_t)256 * D * 2, 0, 0, (size_t)256 * D * 2, 0, D, D, D};
            pg8::TileOrder<1> S; S.init(ML / 256, D / 256, F.G, F.bid);
            EpiResid E{(float*)(F.ws + WS_X), modl, 4096, F.variant & 128};
            pg8::gemm_phase(F.lds + RING_OFF, g, S, E);
            if (nMp > ML / 256) {
                pg8::Gemm g2{(const char*)(F.ws + WS_MERGED), (const char*)(wb + WS_WO), (size_t)256 * D * 2, 0, (size_t)(D / 4) * 2, (size_t)256 * D * 2, (size_t)(D / 4) * 2, D, D, D / 4};
                pg8::SplitOrder<4> S2; S2.init(nMp - ML / 256, D / 256, ML / 256, F.G, F.bid);
                EpiPart E2{(float*)(F.ws + WS_PART), modl, 4096};
                pg8::gemm_phase(F.lds + RING_OFF, g2, S2, E2);
            }
            if (cv) steal_convert(F, l + 1, 1 + l * 6 + 2, false);
            SEAM(p0 + 6);
        }
        if (EN(7) && IN(p0 + 7)) { phase_norm<false>(F, l, F.in[I_NORM2] + (size_t)l * D, 6144, 8192, nrows, nrows > ML); SEAM(p0 + 7); }
        if (EN(8) && IN(p0 + 8)) {
            pg8::Gemm g{(const char*)(F.ws + WS_H), (const char*)(wb + WS_WUP), (size_t)256 * D * 2, 0, 0, (size_t)256 * D * 2, 0, D, D, D};
            pg8::TileOrder<1> S; S.init(nMp, UPC / 256, F.G, F.bid);
            EpiFfn E{(bf16*)(F.ws + WS_ACT), (bf16*)(F.ws + WS_UP), F.in[I_FFNCW] + (size_t)l * 3 * UPC, F.in[I_FFNCB] + (size_t)l * UPC};
            pg8::gemm_phase(F.lds + RING_OFF, g, S, E);
            if (cv) steal_convert(F, l + 1, 1 + l * 6 + 3, false);
            SEAM(p0 + 8);
        }
        if (EN(9) && IN(p0 + 9)) { phase_ffnfix(F, l, nrows); SEAM(p0 + 9); }
        if (EN(10) && IN(p0 + 10)) {
            pg8::Gemm g{(const char*)(F.ws + WS_ACT), (const char*)(wb + WS_WDN), (size_t)256 * DFF * 2, 0, 0, (size_t)256 * DFF * 2, 0, DFF, DFF, DFF};
            pg8::TileOrder<1> S; S.init(ML / 256, D / 256, F.G, F.bid, 2);
            EpiResid E{(float*)(F.ws + WS_X), modl, 10240, F.variant & 128};
            pg8::gemm_phase(F.lds + RING_OFF, g, S, E);
            if (nMp > ML / 256) {
                pg8::Gemm g2{(const char*)(F.ws + WS_ACT), (const char*)(wb + WS_WDN), (size_t)256 * DFF * 2, 0, (size_t)(DFF / 4) * 2, (size_t)256 * DFF * 2, (size_t)(DFF / 4) * 2, DFF, DFF, DFF / 4};
                pg8::SplitOrder<4> S2; S2.init(nMp - ML / 256, D / 256, ML / 256, F.G, F.bid);
                EpiPart E2{(float*)(F.ws + WS_PART), modl, 10240};
                pg8::gemm_phase(F.lds + RING_OFF, g2, S2, E2);
            }
            if (cv) steal_convert(F, l + 1, 1 + l * 6 + 4, true);
            SEAM(p0 + 10);
        }
    }
    if (EN(12) && IN(N_PHASES - 1)) {
        phase_final(F, args.out);
    }
#undef IN
#undef SEAM
}

extern "C" void kernel_launch(void* const* d_in, const int* in_sizes, int n_in, void* d_out, int out_size, void* d_ws, size_t ws_size, hipStream_t stream) {
    static int grid = 0;
    if (grid == 0) {
        if (n_in != 28 || in_sizes[0] != ML * D || out_size != ML * D || ws_size < WS_END) { fprintf(stderr, "kernel_launch: unexpected shapes (n_in %d, in0 %d, out %d, ws %zu < %zu); nothing launched\n", n_in, n_in > 0 ? in_sizes[0] : -1, out_size, ws_size, (size_t)WS_END); grid = -1; return; }
        int dev = 0, cus = 0, per_cu = 0;
        if (hipGetDevice(&dev) != hipSuccess || hipDeviceGetAttribute(&cus, hipDeviceAttributeMultiprocessorCount, dev) != hipSuccess) { fprintf(stderr, "kernel_launch: device query failed\n"); grid = -1; return; }
        if (hipFuncSetAttribute((const void*)fwd_kernel, hipFuncAttributeMaxDynamicSharedMemorySize, LDS_BYTES) != hipSuccess) { fprintf(stderr, "kernel_launch: hipFuncSetAttribute failed\n"); grid = -1; return; }
        if (hipOccupancyMaxActiveBlocksPerMultiprocessor(&per_cu, (const void*)fwd_kernel, NWAVES * 64, LDS_BYTES) != hipSuccess || per_cu < 1)
            fprintf(stderr, "kernel_launch: note: occupancy query reports %d workgroups per CU\n", per_cu);
        (void)hipGetLastError();
        grid = cus;
    }
    if (grid < 0) return;
    if (hipMemsetAsync((char*)d_ws + WS_CTL, 0, CTL_ZERO_BYTES, stream) != hipSuccess) { fprintf(stderr, "kernel_launch: memset failed\n"); return; }
    Args a{};
    for (int i = 0; i < 28; ++i) a.in[i] = (const float*)d_in[i];
    a.out = (float*)d_out; a.ws = (unsigned char*)d_ws;
#if defined(PROBE_K)
    a.ph_lo = 0; a.ph_hi = N_PHASES;
    hipLaunchKernelGGL(fwd_kernel, dim3(grid), dim3(NWAVES * 64), LDS_BYTES, stream, a);
    for (int rep = 0; rep < PROBE_REPS; ++rep) for (int l = 0; l < DEPTH; ++l) { a.ph_lo = 1 + l * NPH + PROBE_K; a.ph_hi = a.ph_lo + 1; a.variant = PROBE_VARIANT; hipLaunchKernelGGL(fwd_kernel, dim3(grid), dim3(NWAVES * 64), LDS_BYTES, stream, a); }
#elif MK_PER_PHASE
    for (int p = 0; p < N_PHASES; ++p) { a.ph_lo = p; a.ph_hi = p + 1; hipLaunchKernelGGL(fwd_kernel, dim3(grid), dim3(NWAVES * 64), LDS_BYTES, stream, a); }
#else
    a.ph_lo = 0; a.ph_hi = N_PHASES;
    hipLaunchKernelGGL(fwd_kernel, dim3(grid), dim3(NWAVES * 64), LDS_BYTES, stream, a);
#endif
    const hipError_t le = hipPeekAtLastError();
    if (le != hipSuccess) fprintf(stderr, "kernel_launch: launch failed: %s\n", hipGetErrorName(le));
}
```

```cpp
#include <hip/hip_runtime.h>
#include <cstdio>
#include <cstdint>

#ifndef MK_PER_PHASE
#define MK_PER_PHASE 0
#endif

namespace pg8 {
#define PG8_LAS __attribute__((address_space(3)))
typedef unsigned short bf16_t;
typedef short bf16x8 __attribute__((ext_vector_type(8)));
typedef float f32x4 __attribute__((ext_vector_type(4)));
typedef unsigned u32x4 __attribute__((ext_vector_type(4)));
constexpr int BM = 256, BK = 64, HALF = 128, HTB = HALF * BK * 2, STAGE_BYTES = 8 * HTB, NXCD = 8, WGM = 8;

__host__ __device__ __forceinline__ int lds_byte(int r, int c) { const int st = (r >> 4) * 2 + (c >> 5), rr = r & 15, cc = c & 31, ob = rr * 64 + cc * 2; return st * 1024 + (ob ^ (((ob >> 9) & 1) << 5)); }
__host__ __device__ __forceinline__ void stage_rc(int b, int& R, int& C) { const int st = b / 1024, sb = b % 1024, swz = sb ^ (((sb >> 9) & 1) << 5); R = (st >> 1) * 16 + swz / 64; C = (st & 1) * 32 + (swz % 64) / 2; }
__host__ __device__ __forceinline__ int perm32(int rho) { const int n = rho >> 4, i = rho & 15; return 8 * (i >> 2) + 4 * n + (i & 3); }

struct Unit { int pm, pn, sub; };
struct Gemm { const char* A; const char* B; size_t a_tile, a_pn, a_sub, b_tile, b_sub; int lda, ldb, K; };

template <int NSUB> struct TileOrder {
    int nM, nN, nwg, G, c, wgm;
    __device__ __forceinline__ void init(int nM_, int nN_, int G_, int c_, int wgm_ = 4) { nM = nM_; nN = nN_; nwg = nM * nN; G = G_; c = c_; wgm = wgm_; }
    __device__ __forceinline__ bool next(int i, Unit& u) const {
        const int sub = i % NSUB; const long L = (long)(i / NSUB) * G + c; if (L >= nwg) return false;
        int wgid = (int)L; { const int q = nwg / NXCD, r = nwg % NXCD, xcd = wgid % NXCD, off = wgid / NXCD; wgid = (xcd < r ? xcd * (q + 1) : r * (q + 1) + (xcd - r) * q) + off; }
        const int nig = wgm * nN, gid = wgid / nig, fm = gid * wgm, gsz = (nM - fm) < wgm ? (nM - fm) : wgm;
        u.pm = fm + ((wgid % nig) % gsz); u.pn = (wgid % nig) / gsz; u.sub = sub; return true;
    }
};

template <int NSUB> struct SplitOrder {
    int nM, nN, pm0, G, c;
    __device__ __forceinline__ void init(int nM_, int nN_, int pm0_, int G_, int c_) { nM = nM_; nN = nN_; pm0 = pm0_; G = G_; c = c_; }
    __device__ __forceinline__ bool next(int i, Unit& u) const {
        const int j = i * G + c; if (j >= nM * nN * NSUB) return false;
        const int tile = j / NSUB; u.sub = j % NSUB; u.pm = pm0 + tile / nN; u.pn = tile % nN; return true;
    }
};
typedef __bf16 bf16x2_t __attribute__((ext_vector_type(2)));
typedef float f32x2_t __attribute__((ext_vector_type(2)));
__device__ __forceinline__ unsigned cvt_pk_bf16(float lo, float hi) { const f32x2_t v = {lo, hi}; return __builtin_bit_cast(unsigned, __builtin_convertvector(v, bf16x2_t)); }

template <class Epi, class Sched>
__device__ __forceinline__ void gemm_phase(PG8_LAS unsigned char* lds, const Gemm g, const Sched& S, const Epi& E) {
    int tid_ = threadIdx.x; asm volatile("" : "+v"(tid_));
    const int tid = tid_, wid = __builtin_amdgcn_readfirstlane(tid >> 6), lane = tid & 63, wr = wid >> 2, wc = wid & 3, fr = lane & 15, fq = lane >> 4;
    const int K = g.K, nt = K / BK;
    unsigned voffA[2], voffB[2];
#pragma unroll
    for (int i = 0; i < 2; ++i) { int R, C; stage_rc(tid * 16 + i * 8192, R, C); const int Rb = Epi::PERM ? ((R & ~31) + perm32(R & 31)) : R;
        voffA[i] = (unsigned)(R * g.lda + C) * 2u; voffB[i] = (unsigned)(Rb * g.ldb + C) * 2u; }
    const size_t kstep = (size_t)(BK * 2);
    const size_t hstepA = (size_t)HALF * g.lda * 2, hstepB = (size_t)HALF * g.ldb * 2;
    const unsigned ldsw = (unsigned)wid * 1024u;
    const int aoff = lds_byte(wr * 64 + fr, fq * 8), boff = lds_byte(wc * 32 + fr, fq * 8);
#define PG8_SA(b, h) (((b) * 2 + (h)) * HTB)
#define PG8_SB(b, h) ((4 + (b) * 2 + (h)) * HTB)
#define PG8_STAGE(bufoff, gbase, voff) do { _Pragma("unroll") for (int _i = 0; _i < 2; ++_i) \
        __builtin_amdgcn_global_load_lds((const unsigned*)((const char*)(gbase) + (voff)[_i]), (PG8_LAS unsigned*)(lds + (bufoff) + ldsw + _i * 8192), 16, 0, 0); } while (0)
#define PG8_LDA(dst, b, h) do { _Pragma("unroll") for (int m = 0; m < 4; ++m) _Pragma("unroll") for (int k = 0; k < 2; ++k) dst[m][k] = *(const PG8_LAS bf16x8*)(lds + PG8_SA(b, h) + aoff + m * 2048 + k * 1024); } while (0)
#define PG8_LDB(dst, b, h) do { _Pragma("unroll") for (int n = 0; n < 2; ++n) _Pragma("unroll") for (int k = 0; k < 2; ++k) dst[n][k] = *(const PG8_LAS bf16x8*)(lds + PG8_SB(b, h) + boff + n * 2048 + k * 1024); } while (0)
#define PG8_MMA(ai, bj, At, Bt) do { __builtin_amdgcn_s_setprio(1); _Pragma("unroll") for (int m = 0; m < 4; ++m) _Pragma("unroll") for (int n = 0; n < 2; ++n) _Pragma("unroll") for (int k = 0; k < 2; ++k) \
        acc[ai][bj][m][n] = __builtin_amdgcn_mfma_f32_16x16x32_bf16(Bt[n][k], At[m][k], acc[ai][bj][m][n], 0, 0, 0); __builtin_amdgcn_s_setprio(0); } while (0)
#define PG8_WAIT_V(n) asm volatile("s_waitcnt vmcnt(" #n ")" ::: "memory")
#define PG8_WAIT_L(n) asm volatile("s_waitcnt lgkmcnt(" #n ")" ::: "memory")
#define PG8_BAR __builtin_amdgcn_s_barrier()
#define PG8_SCHED __builtin_amdgcn_sched_barrier(0)
    Unit cur, nxt; int ui = 0;
    if (!S.next(0, cur)) return;
    f32x4 acc[2][2][4][2];
#pragma unroll
    for (int a = 0; a < 2; ++a)
#pragma unroll
        for (int b = 0; b < 2; ++b)
#pragma unroll
            for (int m = 0; m < 4; ++m)
#pragma unroll
                for (int n = 0; n < 2; ++n) acc[a][b][m][n] = (f32x4){0.f, 0.f, 0.f, 0.f};
    bf16x8 At[4][2], B0[2][2], B1[2][2];
    const char* cA = g.A + (size_t)cur.pm * g.a_tile + (size_t)cur.pn * g.a_pn + (size_t)cur.sub * g.a_sub;
    const char* cB = g.B + (size_t)cur.pn * g.b_tile + (size_t)cur.sub * g.b_sub;
    PG8_STAGE(PG8_SB(0, 0), cB, voffB); PG8_STAGE(PG8_SB(0, 1), cB + hstepB, voffB); PG8_STAGE(PG8_SA(0, 0), cA, voffA); PG8_STAGE(PG8_SA(0, 1), cA + hstepA, voffA);
    if (wr == 1) PG8_BAR;
    PG8_WAIT_V(2); PG8_BAR;
    PG8_STAGE(PG8_SB(1, 0), cB + kstep, voffB); PG8_STAGE(PG8_SA(1, 0), cA + kstep, voffA); PG8_STAGE(PG8_SB(1, 1), cB + hstepB + kstep, voffB);
    PG8_WAIT_V(6); PG8_BAR;
    for (;;) {
        const bool has_next = S.next(ui + 1, nxt);
        const char* nA = has_next ? g.A + (size_t)nxt.pm * g.a_tile + (size_t)nxt.pn * g.a_pn + (size_t)nxt.sub * g.a_sub : cA;
        const char* nB = has_next ? g.B + (size_t)nxt.pn * g.b_tile + (size_t)nxt.sub * g.b_sub : cB;
        for (int t = 0; t < nt; t += 2) {
            const bool last = (t == nt - 2);
            const char* a1 = cA + (size_t)(t + 1) * kstep;
            const char* a2 = last ? nA : cA + (size_t)(t + 2) * kstep; const char* b2 = last ? nB : cB + (size_t)(t + 2) * kstep;
            const char* a3 = a2 + kstep; const char* b3 = b2 + kstep;
            PG8_LDB(B0, 0, 0); PG8_LDB(B1, 0, 1); PG8_SCHED; PG8_LDA(At, 0, 0); PG8_STAGE(PG8_SA(1, 1), a1 + hstepA, voffA);
            PG8_WAIT_V(8); PG8_WAIT_L(0); PG8_BAR; PG8_MMA(0, 0, At, B0); PG8_MMA(0, 1, At, B1); PG8_BAR; PG8_SCHED;
            PG8_LDA(At, 0, 1); PG8_STAGE(PG8_SB(0, 0), b2, voffB); PG8_STAGE(PG8_SB(0, 1), b2 + hstepB, voffB); PG8_STAGE(PG8_SA(0, 0), a2, voffA);
            PG8_WAIT_V(8); PG8_WAIT_L(0); PG8_BAR; PG8_MMA(1, 0, At, B0); PG8_MMA(1, 1, At, B1); PG8_BAR; PG8_SCHED;
            PG8_LDB(B0, 1, 0); PG8_LDB(B1, 1, 1); PG8_SCHED; PG8_LDA(At, 1, 0); PG8_STAGE(PG8_SA(0, 1), a2 + hstepA, voffA);
            PG8_WAIT_V(8); PG8_WAIT_L(0); PG8_BAR; PG8_MMA(0, 0, At, B0); PG8_MMA(0, 1, At, B1); PG8_BAR; PG8_SCHED;
            PG8_LDA(At, 1, 1); PG8_STAGE(PG8_SB(1, 0), b3, voffB); PG8_STAGE(PG8_SB(1, 1), b3 + hstepB, voffB); PG8_STAGE(PG8_SA(1, 0), a3, voffA);
            PG8_WAIT_V(8); PG8_WAIT_L(0); PG8_BAR; PG8_MMA(1, 0, At, B0); PG8_MMA(1, 1, At, B1); PG8_BAR; PG8_SCHED;
        }
        if (wr == 0) PG8_BAR;
        bool zero_acc = true;
        int fr2 = fr, fq2 = fq; asm volatile("" : "+v"(fr2), "+v"(fq2));
        if constexpr (Epi::CHAIN) zero_acc = E(acc, cur, wr, wc, fr2, fq2); else E(acc, cur, wr, wc, fr2, fq2);
        if (!has_next) break;
        if (zero_acc) {
#pragma unroll
        for (int a = 0; a < 2; ++a)
#pragma unroll
            for (int b = 0; b < 2; ++b)
#pragma unroll
                for (int m = 0; m < 4; ++m)
#pragma unroll
                    for (int n = 0; n < 2; ++n) acc[a][b][m][n] = (f32x4){0.f, 0.f, 0.f, 0.f};
        }
        cur = nxt; cA = nA; cB = nB; ++ui;
        if (wr == 1) PG8_BAR;
    }
    PG8_WAIT_V(0);
    PG8_BAR;
#undef PG8_SA
#undef PG8_SB
#undef PG8_STAGE
#undef PG8_LDA
#undef PG8_LDB
#undef PG8_MMA
#undef PG8_WAIT_V
#undef PG8_WAIT_L
#undef PG8_BAR
#undef PG8_SCHED
}
}

constexpr int NWAVES = 8;
constexpr int D = 2048, NB = 4, SEQ = 4096, CTX = 256, DEPTH = 4;
constexpr int ML = NB * SEQ;
constexpr int MC = NB * CTX;
constexpr int M = ML + MC;
constexpr int UC = 10240;
constexpr int NIG = 10496 + 8192;
constexpr int DFF = 5632, UPC = 2 * DFF;
constexpr int IN_COLS = 10256;
constexpr float EPS = 1e-6f;
constexpr int U_Z = 0, U_XBC = 1024, U_POOL = 3072, U_SCB = 4096, U_SCC = 5120, U_SCX = 6144, U_RQ = 7168, U_RK = 7680, U_RV = 8192, U_RG = 9216;

constexpr size_t MiB = 1u << 20;
constexpr size_t WS_CTL = 0, CTL_ZERO_BYTES = 128 * 1024;
constexpr size_t WS_MOD = 1 * MiB;
constexpr size_t WS_ROPE = WS_MOD + (size_t)DEPTH * 5 * 12288 * 4;
constexpr size_t WS_X = 2 * MiB;
constexpr size_t WS_H = WS_X + 136 * MiB;
constexpr size_t WS_WIG = WS_H + 68 * MiB;
constexpr size_t WS_WB = WS_WIG + 73 * MiB;
constexpr size_t WS_WO = WS_WB + 16 * MiB;
constexpr size_t WS_WUP = WS_WO + 8 * MiB;
constexpr size_t WS_WDN = WS_WUP + 44 * MiB;
constexpr size_t WS_WPOOL = WS_WDN + 22 * MiB;
constexpr size_t W_SPAN = WS_WPOOL + 1 * MiB - WS_WIG;
constexpr size_t WS_U = WS_WIG + 2 * W_SPAN;
constexpr size_t WS_DT = WS_U + 340 * MiB;
constexpr size_t WS_G = WS_DT + 2 * MiB;
constexpr size_t WS_UP = WS_U;
constexpr size_t WS_CUMA = WS_G + 140 * MiB;
constexpr size_t WS_DTA = WS_CUMA + 4 * MiB;
constexpr size_t WS_PART = WS_G + 152 * MiB;
constexpr size_t WS_XBCA = WS_G + 272 * MiB;
constexpr size_t WS_RQK = WS_XBCA + 68 * MiB;
constexpr size_t WS_YS = WS_RQK + 34 * MiB;
constexpr size_t WS_YB = WS_YS + 136 * MiB;
constexpr size_t WS_POOLED = WS_YB + 136 * MiB;
constexpr size_t WS_MERGED = WS_POOLED + 34 * MiB;
constexpr size_t WS_MRG32 = WS_XBCA;
constexpr size_t WS_ACT = WS_XBCA;
constexpr size_t WS_END = WS_MERGED + 68 * MiB;
static_assert(WS_UP + (size_t)M * UPC * 2 <= WS_XBCA, "UP overlay");
static_assert(WS_DTA + 4 * MiB <= WS_PART && WS_PART + 32 * MiB <= WS_XBCA, "PART");
static_assert(WS_UP + (size_t)M * UPC * 2 <= WS_CUMA && WS_DTA + 4 * MiB <= WS_XBCA && (size_t)2 * 16 * M * 4 <= 4 * MiB, "cum/dt arrays");
static_assert(WS_ACT + (size_t)M * DFF * 2 <= WS_YB, "ACT overlay");
static_assert(WS_MRG32 + (size_t)M * D * 4 <= WS_YS + 34 * MiB, "MRG32 overlay");
static_assert(WS_ROPE + 8192 <= WS_X, "mod/rope");
constexpr size_t YS_STRIDE = (size_t)M * 1024;

constexpr int CW_TMO = 0, CW_CODE = 1, CW_BAR = 4096, CW_Q = 16384, CW_FIN = 20480;

constexpr int RING_OFF = 0, RING_BYTES = 131072;
constexpr int LDSCTL_OFF = RING_BYTES, MISC_OFF = LDSCTL_OFF + 320;
constexpr int LDS_BYTES = 147456;

#define GAS __attribute__((address_space(1)))
#define LAS __attribute__((address_space(3)))
typedef unsigned short bf16;
typedef unsigned v4u __attribute__((ext_vector_type(4)));
typedef unsigned v2u __attribute__((ext_vector_type(2)));
typedef float f32x4 __attribute__((ext_vector_type(4)));
typedef float f32x16 __attribute__((ext_vector_type(16)));
typedef short bf16x8 __attribute__((ext_vector_type(8)));
typedef GAS unsigned gu32;
#define RLX_AGENT __ATOMIC_RELAXED, __HIP_MEMORY_SCOPE_AGENT
#define LDS_WAIT() asm volatile("s_waitcnt lgkmcnt(0)" ::: "memory")
#define VM_WAIT() asm volatile("s_waitcnt vmcnt(0)" ::: "memory")
__device__ __forceinline__ unsigned f2bf(float f) { return (unsigned)__builtin_bit_cast(unsigned short, (__bf16)f); }
__device__ __forceinline__ unsigned pk2(float lo, float hi) { return pg8::cvt_pk_bf16(lo, hi); }
__device__ __forceinline__ float bflo(unsigned w) { return __builtin_bit_cast(float, w << 16); }
__device__ __forceinline__ float bfhi(unsigned w) { return __builtin_bit_cast(float, w & 0xffff0000u); }
__device__ __forceinline__ float bf1(unsigned short b) { return __builtin_bit_cast(float, (unsigned)b << 16); }
__device__ __forceinline__ void unpack8(const v4u w, float (&f)[8]) { f[0] = bflo(w.x); f[1] = bfhi(w.x); f[2] = bflo(w.y); f[3] = bfhi(w.y); f[4] = bflo(w.z); f[5] = bfhi(w.z); f[6] = bflo(w.w); f[7] = bfhi(w.w); }
__device__ __forceinline__ v4u pack8(const float (&f)[8]) { v4u w; w.x = pk2(f[0], f[1]); w.y = pk2(f[2], f[3]); w.z = pk2(f[4], f[5]); w.w = pk2(f[6], f[7]); return w; }
__device__ __forceinline__ float sigmoidf_(float x) { return __builtin_amdgcn_rcpf(1.0f + __expf(-x)); }
__device__ __forceinline__ float siluf_(float x) { return x * sigmoidf_(x); }
__device__ __forceinline__ float softplusf_(float x) { return fmaxf(x, 0.f) + log1pf(expf(-fabsf(x))); }
__device__ __forceinline__ float wave_sum(float v) {
#pragma unroll
    for (int o = 1; o < 64; o <<= 1) v += __shfl_xor(v, o);
    return v;
}

#define XB_TMO      128
#define XB_XCNT(j)  (256  + 64 * (j))
#define XB_XSUB(j)  (1280 + 64 * (j))
#define XB_XGEN(j)  (2304 + 64 * (j))
#define XB_TOP      3328
#define XB_TOPGEN   3392
#define XCD_BAR_WORDS 3456
#define XB_SPIN_CAP (1u << 18)
__device__ __forceinline__ unsigned xb_ld(unsigned* p)              { return __hip_atomic_load(p, __ATOMIC_RELAXED, __HIP_MEMORY_SCOPE_AGENT); }
__device__ __forceinline__ unsigned xb_add(unsigned* p, unsigned v) { return __hip_atomic_fetch_add(p, v, __ATOMIC_RELAXED, __HIP_MEMORY_SCOPE_AGENT); }
__device__ __forceinline__ unsigned xb_xcc_id() { return (unsigned)__builtin_amdgcn_s_getreg((3 << 11) | 20) & 0xFu; }
#define XB_SPIN(cond, bar) do { unsigned _sp = 0; while (cond) { __builtin_amdgcn_s_sleep(1); \
    if ((++_sp & 255u) == 0u) { if (xb_ld(&(bar)[XB_TMO])) break; if (_sp > XB_SPIN_CAP) { atomicAdd(&(bar)[XB_TMO], 1u); break; } } } } while (0)
struct XcdBarrier { unsigned* bar; unsigned x; volatile LAS unsigned* st; };
__device__ __forceinline__ XcdBarrier xcd_barrier_post(unsigned* bar, volatile LAS unsigned* st) {
    XcdBarrier b; b.bar = bar; b.x = xb_xcc_id(); b.st = st;
    if (threadIdx.x == 0) (void)xb_add(&bar[XB_XCNT(b.x)], 1u);
    return b;
}
__device__ __forceinline__ void xcd_barrier_complete(unsigned* bar, unsigned x, unsigned& nloc, unsigned& nx) {
    const unsigned G = gridDim.x * gridDim.y * gridDim.z;
    unsigned sum, cnt, mine, sp = 0u;
    for (;;) {
        sum = 0u; cnt = 0u; mine = 0u;
#pragma unroll
        for (unsigned j = 0; j < 16; ++j) { const unsigned c = xb_ld(&bar[XB_XCNT(j)]); sum += c; cnt += (c > 0u) ? 1u : 0u; mine = (j == x) ? c : mine; }
        if (sum == G) break;
        __builtin_amdgcn_s_sleep(1);
        if ((++sp & 255u) == 0u) { if (xb_ld(&bar[XB_TMO])) break; if (sp > XB_SPIN_CAP) { atomicAdd(&bar[XB_TMO], 1u); break; } }
    }
    nloc = mine > 0u ? mine : 1u; nx = cnt > 0u ? cnt : 1u;
}
__device__ __forceinline__ void xcd_barrier(const XcdBarrier& b) {
    asm volatile("s_waitcnt vmcnt(0)" ::: "memory");
    __syncthreads();
    if (threadIdx.x == 0) {
        unsigned* bar = b.bar;
        __builtin_amdgcn_s_waitcnt(0);
        unsigned nloc = b.st[0], nx = b.st[1];
        if (nloc == 0u) { xcd_barrier_complete(bar, b.x, nloc, nx); b.st[0] = nloc; b.st[1] = nx; }
        const unsigned old = xb_add(&bar[XB_XSUB(b.x)], 1u);
        const unsigned gen = old / nloc;
        if (old + 1u == (gen + 1u) * nloc) {
            __builtin_amdgcn_fence(__ATOMIC_RELEASE, "agent");
            asm volatile("s_waitcnt vmcnt(0)" ::: "memory");
            const unsigned og = xb_add(&bar[XB_TOP], 1u);
            const unsigned tg = og / nx;
            if (og + 1u == (tg + 1u) * nx) xb_add(&bar[XB_TOPGEN], 1u);
            else XB_SPIN(xb_ld(&bar[XB_TOPGEN]) == tg, bar);
            __builtin_amdgcn_fence(__ATOMIC_ACQUIRE, "agent");
            xb_add(&bar[XB_XGEN(b.x)], 1u);
            asm volatile("s_waitcnt vmcnt(0)" ::: "memory");
        } else {
            XB_SPIN(xb_ld(&bar[XB_XGEN(b.x)]) == gen, bar);
            __builtin_amdgcn_fence(__ATOMIC_ACQUIRE, "agent");
            asm volatile("s_waitcnt vmcnt(0)" ::: "memory");
        }
    }
    __syncthreads();
}

struct Args {
    const float* in[28];
    float* out; unsigned char* ws;
    int ph_lo, ph_hi, variant, pad;
};
struct Frame {
    LAS unsigned char* lds;
    int tid, lane, wave, G, bid, variant;
    unsigned char* ws;
    const float* const* in;
};
__device__ __forceinline__ void frame_refresh(Frame& F) {
    int t = threadIdx.x; asm volatile("" : "+v"(t)); F.tid = t; F.lane = t & 63; F.wave = __builtin_amdgcn_readfirstlane(t >> 6);
    int b = blockIdx.x; asm volatile("" : "+s"(b)); F.bid = b;
}
enum { I_X = 0, I_C, I_CTX, I_CCTX, I_WMOD, I_BMOD, I_NORM1, I_WIN, I_SSDCW, I_SSDCB, I_SSDALOG, I_SSDDTB, I_SSDD, I_SSDNW, I_POOLW, I_POOLS, I_SCONVW, I_RETDL,
       I_WBR, I_WGATE, I_BGATE, I_WO, I_NORM2, I_FFNUP, I_FFNCW, I_FFNCB, I_FFNDN, I_FNW };

__device__ __forceinline__ void seq_bounds(int row, int& s0, int& s1) {
    if (row < ML) { s0 = row & ~(SEQ - 1); s1 = s0 + SEQ; } else { s0 = ML + ((row - ML) & ~(CTX - 1)); s1 = s0 + CTX; }
}
__device__ __forceinline__ int mod_vec(int row) { return row < ML ? (row >> 12) : 4; }

__device__ __forceinline__ void phase_mod(Frame& F) {
    frame_refresh(F);
    LAS float* sv = (LAS float*)(F.lds);
    LAS float* red = (LAS float*)(F.lds + 5 * 2048 * 4);
    const float* c = F.in[I_C]; const float* cc = F.in[I_CCTX];
    for (int i = F.tid; i < 5 * 2048; i += 512) { const int v = i >> 11, k = i & 2047; const float x = v < 4 ? c[v * 2048 + k] : cc[k]; sv[i] = siluf_(x); }
    __syncthreads();
    float* MOD = (float*)(F.ws + WS_MOD);
    for (int it = F.bid; it < DEPTH * 48; it += F.G) {
        const int l = it / 48, jb = it % 48;
        const float* W = F.in[I_WMOD] + (size_t)l * 2048 * 12288 + jb * 256 + 4 * F.lane;
        float a[5][4];
#pragma unroll
        for (int v = 0; v < 5; ++v) { a[v][0] = a[v][1] = a[v][2] = a[v][3] = 0.f; }
        const int k0 = F.wave * 256;
#pragma unroll 4
        for (int k = 0; k < 256; ++k) {
            const f32x4 w = *(const f32x4*)(W + (size_t)(k0 + k) * 12288);
#pragma unroll
            for (int v = 0; v < 5; ++v) { const float s = sv[v * 2048 + k0 + k]; a[v][0] += s * w.x; a[v][1] += s * w.y; a[v][2] += s * w.z; a[v][3] += s * w.w; }
        }
#pragma unroll
        for (int v = 0; v < 5; ++v) *(LAS f32x4*)(red + (F.wave * 5 + v) * 256 + 4 * F.lane) = (f32x4){a[v][0], a[v][1], a[v][2], a[v][3]};
        __syncthreads();
        for (int i = F.tid; i < 5 * 256; i += 512) { const int v = i >> 8, j = i & 255; float s = 0.f;
#pragma unroll
            for (int w = 0; w < 8; ++w) s += red[(w * 5 + v) * 256 + j];
            MOD[((size_t)l * 5 + v) * 12288 + jb * 256 + j] = s + F.in[I_BMOD][l * 12288 + jb * 256 + j]; }
        __syncthreads();
    }
    if (F.bid == F.G - 1) {
        float* R = (float*)(F.ws + WS_ROPE);
        for (int i = F.tid; i < 1024; i += 512) { const int pos = i >> 4, m = i & 15; const float inv = powf(10000.0f, -(float)m / 16.0f); const float ang = (float)pos * inv; R[2 * i] = cosf(ang); R[2 * i + 1] = sinf(ang); }
    }
}

template <class RowMap>
__device__ __forceinline__ void transpose_item(const float* W, int K, int N, bf16* WT, const RowMap& rm, LAS float* scr, int item, int lane) {
    const int nblk = (N + 31) / 32, kb = item / nblk, nb = item % nblk, k0 = 64 * kb, n0 = 32 * nb;
    const bool nok = (n0 + (lane & 31)) < N;
#pragma unroll 8
    for (int i = 0; i < 32; ++i) { const int kk = 2 * i + (lane >> 5); scr[kk * 33 + (lane & 31)] = nok ? W[(size_t)(k0 + kk) * N + n0 + (lane & 31)] : 0.f; }
    LDS_WAIT(); asm volatile("" ::: "memory");
    const int c = lane & 7;
#pragma unroll
    for (int j = 0; j < 4; ++j) { const int n = (lane >> 3) + 8 * j; const LAS float* s = scr + (8 * c) * 33 + n;
        v4u o; o.x = pk2(s[0 * 33], s[1 * 33]); o.y = pk2(s[2 * 33], s[3 * 33]); o.z = pk2(s[4 * 33], s[5 * 33]); o.w = pk2(s[6 * 33], s[7 * 33]);
        if (n0 + n < N) *(GAS v4u*)(WT + (size_t)rm(n0 + n) * K + k0 + 8 * c) = o; }
    LDS_WAIT(); asm volatile("" ::: "memory");
}
struct RowId { int off; __device__ __forceinline__ int operator()(int n) const { return n + off; } };
struct RowUp { __device__ __forceinline__ int operator()(int n) const { const int h = n >= DFF ? 1 : 0, c = n - h * DFF; return (c >> 7) * 256 + h * 128 + (c & 127); } };
struct RowWin { __device__ __forceinline__ int operator()(int n) const { return n < 3072 ? n : (n < 3088 ? 10240 + (n - 3072) : n - 16); } };

constexpr int CI_IN = 32 * 321, CI_G1 = 32 * 64, CI_B1 = 16 * 64, CI_O = 32 * 64, CI_UP = 32 * 352, CI_DN = 88 * 64, CI_P1 = 4 * 8, CI_Z = 30;
constexpr int NITW = CI_IN + 4 * CI_G1 + 4 * CI_B1 + CI_O + CI_UP + CI_DN + 4 * CI_P1 + CI_Z;
__device__ __forceinline__ void convert_item(Frame& F, int l, int it, LAS float* scr, int lane) {
    unsigned char* wb = F.ws + (size_t)(l & 1) * W_SPAN;
    bf16* WIG = (bf16*)(wb + WS_WIG); bf16* WB = (bf16*)(wb + WS_WB); bf16* WO = (bf16*)(wb + WS_WO);
    bf16* WUP = (bf16*)(wb + WS_WUP); bf16* WDN = (bf16*)(wb + WS_WDN); bf16* WPOOL = (bf16*)(wb + WS_WPOOL);
    int r = it;
    if (r < CI_IN) { transpose_item(F.in[I_WIN] + (size_t)l * 2048 * IN_COLS, 2048, IN_COLS, WIG, RowWin{}, scr, r, lane); return; } r -= CI_IN;
    if (r < 4 * CI_G1) { const int i = r / CI_G1; transpose_item(F.in[I_WGATE] + ((size_t)l * 4 + i) * 2048 * 2048, 2048, 2048, WIG, RowId{10496 + i * 2048}, scr, r % CI_G1, lane); return; } r -= 4 * CI_G1;
    if (r < 4 * CI_B1) { const int i = r / CI_B1; transpose_item(F.in[I_WBR] + ((size_t)l * 4 + i) * 1024 * 2048, 1024, 2048, WB + (size_t)i * 2048 * 1024, RowId{0}, scr, r % CI_B1, lane); return; } r -= 4 * CI_B1;
    if (r < CI_O) { transpose_item(F.in[I_WO] + (size_t)l * 2048 * 2048, 2048, 2048, WO, RowId{0}, scr, r, lane); return; } r -= CI_O;
    if (r < CI_UP) { transpose_item(F.in[I_FFNUP] + (size_t)l * 2048 * UPC, 2048, UPC, WUP, RowUp{}, scr, r, lane); return; } r -= CI_UP;
    if (r < CI_DN) { transpose_item(F.in[I_FFNDN] + (size_t)l * DFF * 2048, DFF, 2048, WDN, RowId{0}, scr, r, lane); return; } r -= CI_DN;
    if (r < 4 * CI_P1) { const int g = r / CI_P1; transpose_item(F.in[I_POOLW] + ((size_t)l * 4 + g) * 256 * 256, 256, 256, WPOOL + (size_t)g * 256 * 256, RowId{0}, scr, r % CI_P1, lane); return; } r -= 4 * CI_P1;
    {
        unsigned char* base = (unsigned char*)WIG + (size_t)(10256 + 8 * r) * 2048 * 2;
#pragma unroll 4
        for (int k = 0; k < 32; ++k) *(GAS v4u*)(base + (size_t)(k * 64 + lane) * 16) = (v4u){0u, 0u, 0u, 0u};
    }
}
__device__ __forceinline__ void steal_convert(Frame& F, int l, int finidx, bool drain) {
    frame_refresh(F);
    gu32* q = (gu32*)(F.ws + WS_CTL) + CW_Q + 64 * l;
    gu32* fin = (gu32*)(F.ws + WS_CTL) + CW_FIN + 64 * finidx;
    volatile LAS unsigned* box = (volatile LAS unsigned*)(F.lds + MISC_OFF);
    LAS float* scr = (LAS float*)(F.lds + F.wave * 16384);
    if (F.tid == 0 && !drain) __hip_atomic_fetch_add(fin, 1u, RLX_AGENT);
    for (;;) {
        if (F.tid == 0) { unsigned v = 0xffffffffu; if (drain || __hip_atomic_load(fin, RLX_AGENT) < (unsigned)F.G) v = __hip_atomic_fetch_add(q, 1u, RLX_AGENT); box[0] = v; }
        __syncthreads();
        const unsigned got = box[0];
        __syncthreads();
        if (got == 0xffffffffu) break;
        const int base = (int)got * 8;
        if (base >= NITW) break;
        { const int wi = base + F.wave; if (wi < NITW) convert_item(F, l, wi, scr, F.lane); }
    }
}

template <bool FIRST>
__device__ __forceinline__ void phase_norm(Frame& F, int l, const float* nw, int sh_off, int sc_off, int nrows, bool addpart = false) {
    frame_refresh(F);
    float* X = (float*)(F.ws + WS_X); bf16* H = (bf16*)(F.ws + WS_H); const float* MOD = (const float*)(F.ws + WS_MOD);
    const int gw = F.bid * NWAVES + F.wave, NGW = F.G * NWAVES;
    for (int row = gw; row < nrows; row += NGW) {
        const float* src = FIRST ? (row < ML ? F.in[I_X] + (size_t)row * D : F.in[I_CTX] + (size_t)(row - ML) * D) : X + (size_t)row * D;
        f32x4 v[8]; float ss = 0.f;
#pragma unroll
        for (int j = 0; j < 8; ++j) { v[j] = *(const f32x4*)(src + 256 * j + 4 * F.lane); ss += (v[j].x * v[j].x + v[j].y * v[j].y) + (v[j].z * v[j].z + v[j].w * v[j].w); }
        if (FIRST) {
#pragma unroll
            for (int j = 0; j < 8; ++j) *(f32x4*)(X + (size_t)row * D + 256 * j + 4 * F.lane) = v[j];
        }
        if (!FIRST && addpart && row >= ML) {
            const float* P = (const float*)(F.ws + WS_PART) + (size_t)(row - ML) * D;
            ss = 0.f;
#pragma unroll
            for (int j = 0; j < 8; ++j) {
#pragma unroll
                for (int sp = 0; sp < 4; ++sp) v[j] += *(const f32x4*)(P + (size_t)sp * MC * D + 256 * j + 4 * F.lane);
                *(f32x4*)(X + (size_t)row * D + 256 * j + 4 * F.lane) = v[j];
                ss += (v[j].x * v[j].x + v[j].y * v[j].y) + (v[j].z * v[j].z + v[j].w * v[j].w);
            }
        }
        const float rs = rsqrtf(wave_sum(ss) * (1.0f / D) + EPS);
        const float* mv = MOD + ((size_t)l * 5 + mod_vec(row)) * 12288;
#pragma unroll
        for (int j = 0; j < 8; ++j) { const int c = 256 * j + 4 * F.lane;
            const f32x4 w = *(const f32x4*)(nw + c), sh = *(const f32x4*)(mv + sh_off + c), sc = *(const f32x4*)(mv + sc_off + c);
            const f32x4 y = v[j] * rs * w; const f32x4 h = y * (sc + 1.0f) + sh;
            v2u o; o.x = pk2(h.x, h.y); o.y = pk2(h.z, h.w); *(v2u*)(H + (size_t)row * D + c) = o; }
    }
}
__device__ __forceinline__ void phase_final(Frame& F, float* out) {
    frame_refresh(F);
    const float* X = (const float*)(F.ws + WS_X); const float* nw = F.in[I_FNW];
    const int gw = F.bid * NWAVES + F.wave, NGW = F.G * NWAVES;
    for (int row = gw; row < ML; row += NGW) {
        f32x4 v[8]; float ss = 0.f;
#pragma unroll
        for (int j = 0; j < 8; ++j) { v[j] = *(const f32x4*)(X + (size_t)row * D + 256 * j + 4 * F.lane); ss += (v[j].x * v[j].x + v[j].y * v[j].y) + (v[j].z * v[j].z + v[j].w * v[j].w); }
        const float rs = rsqrtf(wave_sum(ss) * (1.0f / D) + EPS);
#pragma unroll
        for (int j = 0; j < 8; ++j) { const int c = 256 * j + 4 * F.lane; *(f32x4*)(out + (size_t)row * D + c) = v[j] * rs * *(const f32x4*)(nw + c); }
    }
}

__device__ __forceinline__ v4u ldrow(const bf16* base, int row, int ld, int col, bool ok) { return ok ? *(const v4u*)(base + (size_t)row * ld + col) : (v4u){0u, 0u, 0u, 0u}; }
__device__ __forceinline__ void ld8f(const float* p, float (&f)[8]) { const f32x4 a = *(const f32x4*)p, b = *(const f32x4*)(p + 4); f[0] = a.x; f[1] = a.y; f[2] = a.z; f[3] = a.w; f[4] = b.x; f[5] = b.y; f[6] = b.z; f[7] = b.w; }

__device__ __forceinline__ void sc_task(Frame& F, int l, int r, int lane) {
    const bf16* U = (const bf16*)(F.ws + WS_U); bf16* YB2 = (bf16*)(F.ws + WS_YB) + 2 * YS_STRIDE;
            const int rb = r >> 1, cb = r & 1, c = cb * 512 + lane * 8, r0 = rb * 32; int s0, s1; seq_bounds(r0, s0, s1);
            float w0[8], w1[8], w2[8];
            ld8f(F.in[I_SCONVW] + ((size_t)l * 3 + 0) * 1024 + c, w0); ld8f(F.in[I_SCONVW] + ((size_t)l * 3 + 1) * 1024 + c, w1); ld8f(F.in[I_SCONVW] + ((size_t)l * 3 + 2) * 1024 + c, w2);
            for (int r4 = r0; r4 < r0 + 32; r4 += 4) {
                v4u bc[6], bx[6], bg[4];
#pragma unroll
                for (int k = 0; k < 6; ++k) { const int s = r4 - 1 + k; const bool ok = s >= s0 && s < s1; bc[k] = ldrow(U, s, UC, U_SCC + c, ok); bx[k] = ldrow(U, s, UC, U_SCX + c, ok); }
#pragma unroll
                for (int k = 0; k < 4; ++k) bg[k] = ldrow(U, r4 + k, UC, U_SCB + c, true);
                float pr[6][8];
#pragma unroll
                for (int k = 0; k < 6; ++k) { float a[8], b[8]; unpack8(bc[k], a); unpack8(bx[k], b);
#pragma unroll
                    for (int e = 0; e < 8; ++e) pr[k][e] = a[e] * b[e]; }
#pragma unroll
                for (int j = 0; j < 4; ++j) { float g[8], o[8]; unpack8(bg[j], g);
#pragma unroll
                    for (int e = 0; e < 8; ++e) o[e] = g[e] * (w0[e] * pr[j][e] + w1[e] * pr[j + 1][e] + w2[e] * pr[j + 2][e]);
                    *(v4u*)(YB2 + (size_t)(r4 + j) * 1024 + c) = pack8(o); }
            }
}
__device__ __forceinline__ void sc_phase(Frame& F, int l, int c, int Gs) {
    frame_refresh(F);
    const int gw = c * NWAVES + F.wave, NGW = Gs * NWAVES;
    for (int task = gw; task < (M / 32) * 2; task += NGW) sc_task(F, l, task, F.lane);
}
template <int HMAX>
__device__ __forceinline__ void pool_task(const bf16* U, bf16* POOLED, int r0, int s0, int s1, int c, int half) {
    constexpr int NR = 8 + 2 * HMAX - 1, HA = HMAX / 2;
    const bool big = (half == HMAX);
    for (int r8 = r0; r8 < r0 + 32; r8 += 8) {
        v4u buf[NR];
#pragma unroll
        for (int k = 0; k < NR; ++k) { const int s = r8 - HMAX + k; buf[k] = ldrow(U, s, UC, U_POOL + c, s >= s0 && s < s1); }
        float sa[8], sb[8];
#pragma unroll
        for (int e = 0; e < 8; ++e) { sa[e] = 0.f; sb[e] = 0.f; }
#pragma unroll
        for (int k = 0; k < 2 * HMAX; ++k) { float t[8]; unpack8(buf[k], t);
#pragma unroll
            for (int e = 0; e < 8; ++e) { sb[e] += t[e]; if (k >= HA && k < HMAX + HA) sa[e] += t[e]; } }
#pragma unroll
        for (int j = 0; j < 8; ++j) {
            const int rr = r8 + j; int lo = rr - half, hi = rr + half; lo = lo < s0 ? s0 : lo; hi = hi > s1 ? s1 : hi;
            float x[8], o[8]; unpack8(buf[j + HMAX], x); const float inv = 1.0f / (float)(hi - lo);
#pragma unroll
            for (int e = 0; e < 8; ++e) o[e] = (big ? sb[e] : sa[e]) * inv - x[e];
            *(v4u*)(POOLED + (size_t)rr * 1024 + c) = pack8(o);
            if (j < 7) {
                float tin[8], tout[8];
                unpack8(buf[j + 2 * HMAX], tin); unpack8(buf[j], tout);
#pragma unroll
                for (int e = 0; e < 8; ++e) sb[e] += tin[e] - tout[e];
                unpack8(buf[j + HMAX + HA], tin); unpack8(buf[j + HA], tout);
#pragma unroll
                for (int e = 0; e < 8; ++e) sa[e] += tin[e] - tout[e];
            }
        }
    }
}
__device__ __forceinline__ void phase_pre(Frame& F, int l) {
    frame_refresh(F);
    const bf16* U = (const bf16*)(F.ws + WS_U);
    bf16* XBCA = (bf16*)(F.ws + WS_XBCA); bf16* RQK = (bf16*)(F.ws + WS_RQK); bf16* YB2 = (bf16*)(F.ws + WS_YB) + 2 * YS_STRIDE; bf16* POOLED = (bf16*)(F.ws + WS_POOLED);
    const float* ROPE = (const float*)(F.ws + WS_ROPE);
    const int gw = F.bid * NWAVES + F.wave, NGW = F.G * NWAVES, lane = F.lane;
    constexpr int NRB = M / 32;
    constexpr int T_CUM = (M / 64) * 2, T_XBC = NRB * 4, T_POOL = NRB * 2, T_ROPE = NRB;
    float* CUMA = (float*)(F.ws + WS_CUMA); float* DTA = (float*)(F.ws + WS_DTA); const float* DT = (const float*)(F.ws + WS_DT);
    for (int task = gw; task < T_CUM + T_XBC + T_POOL + T_ROPE; task += NGW) {
        int r = task;
        if (r < T_CUM) {
            const int blk = r >> 1, dir = r & 1, row = blk * 64 + (dir ? 63 - lane : lane);
            for (int hh = 0; hh < 16; ++hh) {
                const float dt = softplusf_(DT[(size_t)row * 16 + hh] + F.in[I_SSDDTB][(l * 2 + dir) * 16 + hh]);
                float cum = dt * -expf(F.in[I_SSDALOG][(l * 2 + dir) * 16 + hh]);
#pragma unroll
                for (int o = 1; o < 64; o <<= 1) { const float t = __shfl_up(cum, o); if (lane >= o) cum += t; }
                CUMA[(size_t)(dir * 16 + hh) * M + row] = cum; DTA[(size_t)(dir * 16 + hh) * M + row] = dt;
            }
            continue;
        }
        r -= T_CUM;
        if (r < T_XBC) {
            const int rb = r >> 2, cb = r & 3, c = cb * 512 + lane * 8, r0 = rb * 32; int s0, s1; seq_bounds(r0, s0, s1);
            float w0[8], w1[8], w2[8], bb[8];
            ld8f(F.in[I_SSDCW] + ((size_t)l * 3 + 0) * 2048 + c, w0); ld8f(F.in[I_SSDCW] + ((size_t)l * 3 + 1) * 2048 + c, w1); ld8f(F.in[I_SSDCW] + ((size_t)l * 3 + 2) * 2048 + c, w2); ld8f(F.in[I_SSDCB] + (size_t)l * 2048 + c, bb);
            v4u bufA[10], bufB[10];
#define XBC_LOAD(buf, r8_) do { _Pragma("unroll") for (int k = 0; k < 10; ++k) { const int s = (r8_) - 1 + k; buf[k] = ldrow(U, s, UC, U_XBC + c, s >= s0 && s < s1); } } while (0)
#define XBC_COMP(buf, r8_) do { _Pragma("unroll") for (int j = 0; j < 8; ++j) { \
                    float p[8], q[8], n[8], o[8]; unpack8(buf[j], p); unpack8(buf[j + 1], q); unpack8(buf[j + 2], n); \
                    _Pragma("unroll") for (int e = 0; e < 8; ++e) o[e] = siluf_(w0[e] * p[e] + w1[e] * q[e] + w2[e] * n[e] + bb[e]); \
                    *(v4u*)(XBCA + (size_t)((r8_) + j) * 2048 + c) = pack8(o); } } while (0)
            XBC_LOAD(bufA, r0);
            XBC_LOAD(bufB, r0 + 8);  XBC_COMP(bufA, r0);
            XBC_LOAD(bufA, r0 + 16); XBC_COMP(bufB, r0 + 8);
            XBC_LOAD(bufB, r0 + 24); XBC_COMP(bufA, r0 + 16);
            XBC_COMP(bufB, r0 + 24);
#undef XBC_LOAD
#undef XBC_COMP
            continue;
        }
        r -= T_XBC;
        if (r < T_POOL) {
            const int rb = r >> 1, cb = r & 1, c = cb * 512 + lane * 8, r0 = rb * 32; int s0, s1; seq_bounds(r0, s0, s1);
            const int grp = c >> 8, half = 1 << grp;
            if (cb == 0) pool_task<2>(U, POOLED, r0, s0, s1, c, half); else pool_task<8>(U, POOLED, r0, s0, s1, c, half);
            continue;
        }
        r -= T_POOL;
        {
            const int r0 = r * 32; int s0, s1; seq_bounds(r0, s0, s1);
            const int qk = lane >> 5, rem = lane & 31, head = rem >> 2, part = (rem >> 1) & 1, sub = rem & 1;
            const int c1 = head * 64 + part * 32 + sub * 8, c2 = c1 + 16; const float scl = qk == 0 ? 0.125f : 1.0f;
            const int ucol = (qk == 0 ? U_RQ : U_RK);
            for (int r8 = r0; r8 < r0 + 32; r8 += 8) {
                v4u b1[8], b2[8];
#pragma unroll
                for (int k = 0; k < 8; ++k) { b1[k] = ldrow(U, r8 + k, UC, ucol + c1, true); b2[k] = ldrow(U, r8 + k, UC, ucol + c2, true); }
#pragma unroll
                for (int k = 0; k < 8; ++k) {
                    const int rr = r8 + k; float x1[8], x2[8], o1[8], o2[8]; unpack8(b1[k], x1); unpack8(b2[k], x2);
                    if (rr < ML) {
                        const int t = rr - s0, pos = part == 0 ? (t >> 6) : (t & 63);
                        const float* rp = ROPE + (size_t)(pos * 16 + sub * 8) * 2;
#pragma unroll
                        for (int e = 0; e < 8; ++e) { const float cs = rp[2 * e], sn = rp[2 * e + 1]; o1[e] = (x1[e] * cs - x2[e] * sn) * scl; o2[e] = (x1[e] * sn + x2[e] * cs) * scl; }
                    } else {
#pragma unroll
                        for (int e = 0; e < 8; ++e) { o1[e] = x1[e] * scl; o2[e] = x2[e] * scl; }
                    }
                    *(v4u*)(RQK + (size_t)rr * 1024 + qk * 512 + c1) = pack8(o1); *(v4u*)(RQK + (size_t)rr * 1024 + qk * 512 + c2) = pack8(o2);
                }
            }
        }
    }
}

#define MFMA32(a, b, c) __builtin_amdgcn_mfma_f32_32x32x16_bf16((a), (b), (c), 0, 0, 0)
#define SCAN_BAR() do { asm volatile("s_waitcnt lgkmcnt(0)" ::: "memory"); __builtin_amdgcn_s_barrier(); asm volatile("" ::: "memory"); } while (0)
typedef short s16x4 __attribute__((ext_vector_type(4)));
__device__ __forceinline__ bf16x8 tr_frag(LAS unsigned char* tile, int rs, int c, int ks, int lane) {
    const int h = lane >> 5, blk = (lane >> 4) & 1, q = (lane & 15) >> 2, p = lane & 3;
    LAS unsigned char* a0 = tile + (16 * ks + 8 * h + q) * rs + (32 * c + 16 * blk + 4 * p) * 2;
    const s16x4 lo = __builtin_amdgcn_ds_read_tr16_b64_v4i16((LAS s16x4*)a0);
    const s16x4 hi = __builtin_amdgcn_ds_read_tr16_b64_v4i16((LAS s16x4*)(a0 + 4 * rs));
    return __builtin_shufflevector(lo, hi, 0, 1, 2, 3, 4, 5, 6, 7);
}
template <int DN, int DP, bool SSD>
__device__ __forceinline__ void scan_unit(Frame& F, int l, int b, int h, int dir) {
    frame_refresh(F);
    constexpr int RSQ = (DN + 8) * 2, RSK2 = DN * 2 + 64, RSV = DP * 2 + 64, RSJ = 72 * 2;
    constexpr int O_Q = 0, O_K = O_Q + 64 * RSQ, O_K2 = O_K + 64 * RSQ, O_V = O_K2 + 64 * RSK2, O_VW = O_V + 64 * RSV, O_S = O_VW + 64 * RSV, O_HST = O_S + 64 * RSJ, O_CUM = O_HST + DP * RSQ, O_END = O_CUM + 256;
    static_assert(O_END <= RING_BYTES, "scan LDS");
    LAS unsigned char* lds = F.lds;
    const int tid = F.tid, lane = F.lane, w = F.wave, r = lane & 31, hh = lane >> 5;
    const bf16* XBCA = (const bf16*)(F.ws + WS_XBCA); const bf16* RQK = (const bf16*)(F.ws + WS_RQK); const bf16* U = (const bf16*)(F.ws + WS_U);
    const float* CUMA = (const float*)(F.ws + WS_CUMA) + (size_t)(dir * 16 + h) * M; const float* DTA = (const float*)(F.ws + WS_DTA) + (size_t)(dir * 16 + h) * M;
    bf16* YS = (bf16*)(F.ws + WS_YS) + (size_t)((SSD ? 0 : 2) + dir) * YS_STRIDE;
    const int ycol = SSD ? h * 64 : h * 128;
    float la_const = 0.f;
    if (!SSD) la_const = -softplusf_(-F.in[I_RETDL][(l * 2 + dir) * 8 + h]);
    for (int i = tid; i < DP * RSQ / 16; i += 512) *(LAS v4u*)(lds + O_HST + i * 16) = (v4u){0u, 0u, 0u, 0u};
    f32x16 Hs;
#pragma unroll
    for (int i = 0; i < 16; ++i) Hs[i] = 0.f;
    const int tok8 = tid >> 3, ch8 = tid & 7, tok16 = tid >> 4, ch16 = tid & 15;
    constexpr int NPF = 2;
    v4u preb[NPF][5]; float pcum[NPF], pdt[NPF], pcl[NPF], pcw[NPF];
#pragma unroll
    for (int u = 0; u < NPF; ++u) { pcum[u] = 0.f; pdt[u] = 1.f; pcl[u] = 0.f; pcw[u] = 0.f;
#pragma unroll
        for (int k = 0; k < 5; ++k) preb[u][k] = (v4u){0u, 0u, 0u, 0u}; }
    auto row_of = [&](int st, int i) -> int {
        int base, sub;
        if (st < 4) { base = ML + b * CTX; sub = dir ? 3 - st : st; } else { base = b * SEQ; sub = dir ? 67 - st : st - 4; }
        return base + sub * 64 + (dir ? 63 - i : i);
    };
#define SCAN_PREFETCH(st_, pre, u_) do { \
        const int rn_ = row_of((st_), tok8), rw0_ = row_of((st_), tok16), rw1_ = row_of((st_), 32 + tok16); \
        if (SSD) { const int g = h >> 2; \
            pre[0] = *(const v4u*)(XBCA + (size_t)rn_ * 2048 + h * 64 + 8 * ch8); \
            pre[1] = *(const v4u*)(XBCA + (size_t)rw0_ * 2048 + 1024 + g * 128 + 8 * ch16); pre[2] = *(const v4u*)(XBCA + (size_t)rw1_ * 2048 + 1024 + g * 128 + 8 * ch16); \
            pre[3] = *(const v4u*)(XBCA + (size_t)rw0_ * 2048 + 1536 + g * 128 + 8 * ch16); pre[4] = *(const v4u*)(XBCA + (size_t)rw1_ * 2048 + 1536 + g * 128 + 8 * ch16); \
            pcum[u_] = CUMA[rn_]; pdt[u_] = DTA[rn_]; pcl[u_] = CUMA[row_of((st_), 63)]; pcw[u_] = CUMA[row_of((st_), lane)]; \
        } else { \
            pre[0] = *(const v4u*)(RQK + (size_t)rn_ * 1024 + h * 64 + 8 * ch8); pre[1] = *(const v4u*)(RQK + (size_t)rn_ * 1024 + 512 + h * 64 + 8 * ch8); \
            pre[2] = *(const v4u*)(U + (size_t)rw0_ * UC + U_RV + h * 128 + 8 * ch16); pre[3] = *(const v4u*)(U + (size_t)rw1_ * UC + U_RV + h * 128 + 8 * ch16); \
        } } while (0)
#pragma unroll
    for (int u = 0; u < NPF; ++u) SCAN_PREFETCH(u, preb[u], u);
    for (int st2 = 0; st2 < 68; st2 += NPF) {
#pragma unroll
    for (int u = 0; u < NPF; ++u) {
        const int st = st2 + u;
        v4u (&pre)[5] = preb[u];
        float clast;
        if (SSD) {
            clast = pcl[u];
            const float dtx = pdt[u], wx = __expf(clast - pcum[u]);
            float x[8], v[8], vw[8]; unpack8(pre[0], x);
#pragma unroll
            for (int e = 0; e < 8; ++e) { v[e] = x[e] * dtx; vw[e] = v[e] * wx; }
            *(LAS v4u*)(lds + O_V + tok8 * RSV + 16 * ch8) = pack8(v); *(LAS v4u*)(lds + O_VW + tok8 * RSV + 16 * ch8) = pack8(vw);
            *(LAS v4u*)(lds + O_K + tok16 * RSQ + 16 * ch16) = pre[1]; *(LAS v4u*)(lds + O_K + (32 + tok16) * RSQ + 16 * ch16) = pre[2];
            *(LAS v4u*)(lds + O_K2 + tok16 * RSK2 + 16 * ch16) = pre[1]; *(LAS v4u*)(lds + O_K2 + (32 + tok16) * RSK2 + 16 * ch16) = pre[2];
            *(LAS v4u*)(lds + O_Q + tok16 * RSQ + 16 * ch16) = pre[3]; *(LAS v4u*)(lds + O_Q + (32 + tok16) * RSQ + 16 * ch16) = pre[4];
            if (w == 0) *(LAS float*)(lds + O_CUM + 4 * lane) = pcw[u];
        } else {
            clast = la_const * 64.f;
            *(LAS v4u*)(lds + O_Q + tok8 * RSQ + 16 * ch8) = pre[0];
            *(LAS v4u*)(lds + O_K + tok8 * RSQ + 16 * ch8) = pre[1]; *(LAS v4u*)(lds + O_K2 + tok8 * RSK2 + 16 * ch8) = pre[1];
            const float w0 = __expf(la_const * (float)(63 - tok16)), w1 = __expf(la_const * (float)(31 - tok16));
            float v0[8], v1[8], q0[8], q1[8]; unpack8(pre[2], v0); unpack8(pre[3], v1);
#pragma unroll
            for (int e = 0; e < 8; ++e) { q0[e] = v0[e] * w0; q1[e] = v1[e] * w1; }
            *(LAS v4u*)(lds + O_V + tok16 * RSV + 16 * ch16) = pre[2]; *(LAS v4u*)(lds + O_V + (32 + tok16) * RSV + 16 * ch16) = pre[3];
            *(LAS v4u*)(lds + O_VW + tok16 * RSV + 16 * ch16) = pack8(q0); *(LAS v4u*)(lds + O_VW + (32 + tok16) * RSV + 16 * ch16) = pack8(q1);
            if (w == 0) *(LAS float*)(lds + O_CUM + 4 * lane) = la_const * (float)(lane + 1);
        }
        SCAN_BAR();
        if (st + NPF < 68) SCAN_PREFETCH(st + NPF, pre, u);
        const float dcy = __expf(clast);
        if (w < 4) {
            const int jb = w >> 1, ib = w & 1;
            f32x16 acc;
#pragma unroll
            for (int i = 0; i < 16; ++i) acc[i] = 0.f;
            if (!(jb == 1 && ib == 0)) {
                bf16x8 fa[DN / 16], fq[DN / 16];
#pragma unroll
                for (int kk = 0; kk < DN / 16; ++kk) {
                    fa[kk] = *(const LAS bf16x8*)(lds + O_K + (jb * 32 + r) * RSQ + (kk * 16 + 8 * hh) * 2);
                    fq[kk] = *(const LAS bf16x8*)(lds + O_Q + (ib * 32 + r) * RSQ + (kk * 16 + 8 * hh) * 2);
                }
                __builtin_amdgcn_sched_barrier(0);
#pragma unroll
                for (int kk = 0; kk < DN / 16; ++kk) acc = MFMA32(fa[kk], fq[kk], acc);
            }
            const int i = ib * 32 + r; const float ci = *(const LAS float*)(lds + O_CUM + 4 * i);
#pragma unroll
            for (int g4 = 0; g4 < 4; ++g4) {
                const int j0 = jb * 32 + 8 * g4 + 4 * hh; const f32x4 cj = *(const LAS f32x4*)(lds + O_CUM + 4 * j0);
                float v[4];
#pragma unroll
                for (int e = 0; e < 4; ++e) { const float cje = e == 0 ? cj.x : (e == 1 ? cj.y : (e == 2 ? cj.z : cj.w)); v[e] = (j0 + e <= i) ? acc[4 * g4 + e] * __expf(ci - cje) : 0.f; }
                v2u o; o.x = pk2(v[0], v[1]); o.y = pk2(v[2], v[3]);
                *(LAS v2u*)(lds + O_S + i * RSJ + j0 * 2) = o;
            }
        }
        SCAN_BAR();
        for (int blk = w; blk < (DP / 32) * 2; blk += 8) {
            const int pb = blk >> 1, ib = blk & 1;
            f32x16 a1, a2;
#pragma unroll
            for (int i = 0; i < 16; ++i) { a1[i] = 0.f; a2[i] = 0.f; }
            bf16x8 fv[4], fs[4], fh[DN / 16], fq[DN / 16];
#pragma unroll
            for (int kk = 0; kk < 4; ++kk) {
                fv[kk] = tr_frag(lds + O_V, RSV, pb, kk, lane);
                fs[kk] = *(const LAS bf16x8*)(lds + O_S + (ib * 32 + r) * RSJ + (kk * 16 + 8 * hh) * 2);
            }
#pragma unroll
            for (int kk = 0; kk < DN / 16; ++kk) {
                fh[kk] = *(const LAS bf16x8*)(lds + O_HST + (pb * 32 + r) * RSQ + (kk * 16 + 8 * hh) * 2);
                fq[kk] = *(const LAS bf16x8*)(lds + O_Q + (ib * 32 + r) * RSQ + (kk * 16 + 8 * hh) * 2);
            }
            __builtin_amdgcn_sched_barrier(0);
#pragma unroll
            for (int kk = 0; kk < 4; ++kk) a1 = MFMA32(fv[kk], fs[kk], a1);
#pragma unroll
            for (int kk = 0; kk < DN / 16; ++kk) a2 = MFMA32(fh[kk], fq[kk], a2);
            const int i = ib * 32 + r; const float ei = __expf(*(const LAS float*)(lds + O_CUM + 4 * i));
            const int row = row_of(st, i);
#pragma unroll
            for (int g4 = 0; g4 < 4; ++g4) {
                const int p0 = pb * 32 + 8 * g4 + 4 * hh;
                v2u o; o.x = pk2(a1[4 * g4 + 0] + ei * a2[4 * g4 + 0], a1[4 * g4 + 1] + ei * a2[4 * g4 + 1]); o.y = pk2(a1[4 * g4 + 2] + ei * a2[4 * g4 + 2], a1[4 * g4 + 3] + ei * a2[4 * g4 + 3]);
                *(v2u*)(YS + (size_t)row * 1024 + ycol + p0) = o;
            }
        }
        {
            const int nb = w / (DP / 32), pb = w % (DP / 32);
#pragma unroll
            for (int i = 0; i < 16; ++i) Hs[i] *= dcy;
            bf16x8 fk[4], fw[4];
#pragma unroll
            for (int kk = 0; kk < 4; ++kk) {
                fk[kk] = tr_frag(lds + O_K2, RSK2, nb, kk, lane);
                fw[kk] = tr_frag(lds + O_VW, RSV, pb, kk, lane);
            }
            __builtin_amdgcn_sched_barrier(0);
#pragma unroll
            for (int kk = 0; kk < 4; ++kk) Hs = MFMA32(fk[kk], fw[kk], Hs);
            SCAN_BAR();
#pragma unroll
            for (int g4 = 0; g4 < 4; ++g4) {
                const int n0 = nb * 32 + 8 * g4 + 4 * hh;
                v2u o; o.x = pk2(Hs[4 * g4 + 0], Hs[4 * g4 + 1]); o.y = pk2(Hs[4 * g4 + 2], Hs[4 * g4 + 3]);
                *(LAS v2u*)(lds + O_HST + (pb * 32 + r) * RSQ + n0 * 2) = o;
            }
        }
    }
    }
    __syncthreads();
#undef SCAN_PREFETCH
}

__device__ __forceinline__ void phase_fin(Frame& F, int l, int nrows) {
    frame_refresh(F);
    const bf16* U = (const bf16*)(F.ws + WS_U); const bf16* YS = (const bf16*)(F.ws + WS_YS); bf16* YB = (bf16*)(F.ws + WS_YB);
    const float* nw = F.in[I_SSDNW] + (size_t)l * 1024; const float* dskp = F.in[I_SSDD] + (size_t)l * 16; const bf16* XBCA = (const bf16*)(F.ws + WS_XBCA);
    const int gw = F.bid * NWAVES + F.wave, NGW = F.G * NWAVES, lane = F.lane;
    for (int row = gw; row < nrows; row += NGW) {
        {
            float g[2][8]; float ss = 0.f;
#pragma unroll
            for (int k = 0; k < 2; ++k) { const int c = k * 512 + 8 * lane; float yf[8], yb[8], z[8];
                unpack8(*(const v4u*)(YS + (size_t)row * 1024 + c), yf); unpack8(*(const v4u*)(YS + YS_STRIDE + (size_t)row * 1024 + c), yb); unpack8(*(const v4u*)(U + (size_t)row * UC + U_Z + c), z);
                float xs[8]; unpack8(*(const v4u*)(XBCA + (size_t)row * 2048 + c), xs); const float dsk = dskp[c >> 6];
#pragma unroll
                for (int e = 0; e < 8; ++e) { g[k][e] = (yf[e] + yb[e] + dsk * xs[e]) * siluf_(z[e]); ss += g[k][e] * g[k][e]; } }
            const float rs = rsqrtf(wave_sum(ss) * (1.0f / 1024.0f) + EPS);
#pragma unroll
            for (int k = 0; k < 2; ++k) { const int c = k * 512 + 8 * lane; float wv[8], o[8]; ld8f(nw + c, wv);
#pragma unroll
                for (int e = 0; e < 8; ++e) o[e] = g[k][e] * rs * wv[e];
                *(v4u*)(YB + (size_t)row * 1024 + c) = pack8(o); }
        }
        {
            const int c = 16 * lane; float v[16];
            { float a[8], b2[8]; unpack8(*(const v4u*)(YS + 2 * YS_STRIDE + (size_t)row * 1024 + c), a); unpack8(*(const v4u*)(YS + 3 * YS_STRIDE + (size_t)row * 1024 + c), b2);
#pragma unroll
              for (int e = 0; e < 8; ++e) v[e] = a[e] + b2[e];
              unpack8(*(const v4u*)(YS + 2 * YS_STRIDE + (size_t)row * 1024 + c + 8), a); unpack8(*(const v4u*)(YS + 3 * YS_STRIDE + (size_t)row * 1024 + c + 8), b2);
#pragma unroll
              for (int e = 0; e < 8; ++e) v[8 + e] = a[e] + b2[e]; }
            float s = 0.f;
#pragma unroll
            for (int e = 0; e < 16; ++e) s += v[e];
            s += __shfl_xor(s, 1); s += __shfl_xor(s, 2); s += __shfl_xor(s, 4);
            const float mu = s * (1.0f / 128.0f); float q = 0.f;
#pragma unroll
            for (int e = 0; e < 16; ++e) { v[e] -= mu; q += v[e] * v[e]; }
            q += __shfl_xor(q, 1); q += __shfl_xor(q, 2); q += __shfl_xor(q, 4);
            const float rs = rsqrtf(q * (1.0f / 128.0f) + EPS);
            float g0[8], g1[8], o0[8], o1[8]; unpack8(*(const v4u*)(U + (size_t)row * UC + U_RG + c), g0); unpack8(*(const v4u*)(U + (size_t)row * UC + U_RG + c + 8), g1);
#pragma unroll
            for (int e = 0; e < 8; ++e) { o0[e] = siluf_(g0[e]) * v[e] * rs; o1[e] = siluf_(g1[e]) * v[8 + e] * rs; }
            *(v4u*)(YB + 3 * YS_STRIDE + (size_t)row * 1024 + c) = pack8(o0); *(v4u*)(YB + 3 * YS_STRIDE + (size_t)row * 1024 + c + 8) = pack8(o1);
        }
    }
}

__device__ __forceinline__ v4u ldedge(const bf16* EDGE, int blk, int j, int h, int c, bool ok) { return ok ? *(const v4u*)(EDGE + ((size_t)(blk * 4 + j) * 2 + h) * DFF + c) : (v4u){0u, 0u, 0u, 0u}; }
__device__ __forceinline__ void phase_ffnfix(Frame& F, int l, int nrows) {
    frame_refresh(F);
    const bf16* EDGE = (const bf16*)(F.ws + WS_UP); bf16* ACT = (bf16*)(F.ws + WS_ACT);
    const int gw = F.bid * NWAVES + F.wave, NGW = F.G * NWAVES, lane = F.lane;
    const int ntask = (nrows / 64) * 11;
    for (int task = gw; task < ntask; task += NGW) {
        const int blk = task / 11, cb = task % 11, c = cb * 512 + lane * 8, r0 = blk * 64; int s0, s1; seq_bounds(r0, s0, s1);
        const bool hp = r0 > s0, hn = r0 + 64 < s1;
        float wa0[8], wa1[8], wa2[8], ba[8], wb0[8], wb1[8], wb2[8], bb[8];
        const float* cw = F.in[I_FFNCW] + (size_t)l * 3 * UPC; const float* cbp = F.in[I_FFNCB] + (size_t)l * UPC;
        v4u ra[6], rb[6];
        ra[0] = ldedge(EDGE, blk - 1, 3, 0, c, hp); ra[1] = ldedge(EDGE, blk, 0, 0, c, true); ra[2] = ldedge(EDGE, blk, 1, 0, c, true);
        ra[3] = ldedge(EDGE, blk, 2, 0, c, true); ra[4] = ldedge(EDGE, blk, 3, 0, c, true); ra[5] = ldedge(EDGE, blk + 1, 0, 0, c, hn);
        rb[0] = ldedge(EDGE, blk - 1, 3, 1, c, hp); rb[1] = ldedge(EDGE, blk, 0, 1, c, true); rb[2] = ldedge(EDGE, blk, 1, 1, c, true);
        rb[3] = ldedge(EDGE, blk, 2, 1, c, true); rb[4] = ldedge(EDGE, blk, 3, 1, c, true); rb[5] = ldedge(EDGE, blk + 1, 0, 1, c, hn);
        ld8f(cw + c, wa0); ld8f(cw + UPC + c, wa1); ld8f(cw + 2 * UPC + c, wa2); ld8f(cbp + c, ba);
        ld8f(cw + DFF + c, wb0); ld8f(cw + UPC + DFF + c, wb1); ld8f(cw + 2 * UPC + DFF + c, wb2); ld8f(cbp + DFF + c, bb);
#pragma unroll
        for (int j = 0; j < 2; ++j) {
            float p[8], q[8], n[8], o[8], a[8];
            unpack8(ra[3 * j], p); unpack8(ra[3 * j + 1], q); unpack8(ra[3 * j + 2], n);
#pragma unroll
            for (int e = 0; e < 8; ++e) a[e] = siluf_(wa0[e] * p[e] + wa1[e] * q[e] + wa2[e] * n[e] + ba[e]);
            unpack8(rb[3 * j], p); unpack8(rb[3 * j + 1], q); unpack8(rb[3 * j + 2], n);
#pragma unroll
            for (int e = 0; e < 8; ++e) o[e] = a[e] * (wb0[e] * p[e] + wb1[e] * q[e] + wb2[e] * n[e] + bb[e]);
            *(v4u*)(ACT + (size_t)(r0 + 63 * j) * DFF + c) = pack8(o);
        }
    }
}

using pg8::f32x4; using pg8::Unit; using pg8::HALF; using pg8::BM;
__device__ __forceinline__ size_t gate_off(int pm, int gt, int wave, int frag, int lane) { return ((((size_t)pm * 32 + gt) * 8 + wave) * 16 + frag) * 512 + (size_t)lane * 8; }
struct EpiInGate {
    static constexpr bool PERM = true, CHAIN = false;
    bf16* U; float* DT; unsigned char* G; const float* bg; int pn0;
    __device__ __forceinline__ void operator()(const f32x4 (&acc)[2][2][4][2], const Unit& u, int wr, int wc, int fr, int fq) const {
        const int row0 = u.pm * BM + wr * 64 + fr, pn = u.pn + pn0;
        if (pn < 40) {
            const int col0 = pn * BM + wc * 32 + 8 * fq;
#pragma unroll
            for (int ai = 0; ai < 2; ++ai)
#pragma unroll
                for (int m = 0; m < 4; ++m) { bf16* rowp = U + (size_t)(row0 + ai * HALF + m * 16) * UC + col0;
#pragma unroll
                    for (int bj = 0; bj < 2; ++bj) { const f32x4 v0 = acc[ai][bj][m][0], v1 = acc[ai][bj][m][1];
                        v4u w; w.x = pg8::cvt_pk_bf16(v0[0], v0[1]); w.y = pg8::cvt_pk_bf16(v0[2], v0[3]); w.z = pg8::cvt_pk_bf16(v1[0], v1[1]); w.w = pg8::cvt_pk_bf16(v1[2], v1[3]);
                        *(v4u*)(rowp + bj * HALF) = w; } }
        } else if (pn == 40) {
            if (wc == 0 && fq < 2) {
#pragma unroll
                for (int ai = 0; ai < 2; ++ai)
#pragma unroll
                    for (int m = 0; m < 4; ++m) { float* rp = DT + (size_t)(row0 + ai * HALF + m * 16) * 16 + 8 * fq; *(f32x4*)rp = acc[ai][0][m][0]; *(f32x4*)(rp + 4) = acc[ai][0][m][1]; }
            }
        } else {
            const int col0 = (pn - 41) * BM + wc * 32 + 8 * fq;
            f32x4 bv[2][2];
#pragma unroll
            for (int bj = 0; bj < 2; ++bj)
#pragma unroll
                for (int n = 0; n < 2; ++n) bv[bj][n] = *(const f32x4*)(bg + col0 + bj * HALF + 4 * n) * -1.44269504f;
            constexpr float QC = 1.0f / 255.99f;
#pragma unroll
            for (int ai = 0; ai < 2; ++ai)
#pragma unroll
                for (int m = 0; m < 4; ++m) { unsigned char* rowp = G + gate_off(u.pm, pn - 41, wr * 4 + wc, ai * 8 + m * 2, fq * 16 + fr);
#pragma unroll
                    for (int bj = 0; bj < 2; ++bj) {
                        unsigned q[8];
#pragma unroll
                        for (int e = 0; e < 4; ++e) {
                            const float e0 = __builtin_amdgcn_exp2f(__builtin_fmaf(acc[ai][bj][m][0][e], -1.44269504f, bv[bj][0][e])), e1 = __builtin_amdgcn_exp2f(__builtin_fmaf(acc[ai][bj][m][1][e], -1.44269504f, bv[bj][1][e]));
                            q[e] = (unsigned)__builtin_amdgcn_rcpf(__builtin_fmaf(e0, QC, QC)); q[4 + e] = (unsigned)__builtin_amdgcn_rcpf(__builtin_fmaf(e1, QC, QC)); }
                        v2u w; w.x = q[0] | (q[1] << 8) | (q[2] << 16) | (q[3] << 24); w.y = q[4] | (q[5] << 8) | (q[6] << 16) | (q[7] << 24);
                        *(v2u*)(rowp + bj * 512) = w; } }
        }
    }
};
template <bool SCALE> struct EpiBf16 {
    static constexpr bool PERM = true, CHAIN = false;
    bf16* O; int ldc; const float* scale;
    __device__ __forceinline__ int operator()(const f32x4 (&acc)[2][2][4][2], const Unit& u, int wr, int wc, int fr, int fq) const {
        const int row0 = u.pm * BM + wr * 64 + fr, col0 = u.pn * BM + wc * 32 + 8 * fq;
        f32x4 sv[2][2];
        if (SCALE) {
#pragma unroll
            for (int bj = 0; bj < 2; ++bj)
#pragma unroll
                for (int n = 0; n < 2; ++n) sv[bj][n] = *(const f32x4*)(scale + col0 + bj * HALF + 4 * n);
        }
#pragma unroll
        for (int ai = 0; ai < 2; ++ai)
#pragma unroll
            for (int m = 0; m < 4; ++m) { bf16* rowp = O + (size_t)(row0 + ai * HALF + m * 16) * ldc + col0;
#pragma unroll
                for (int bj = 0; bj < 2; ++bj) { f32x4 v0 = acc[ai][bj][m][0], v1 = acc[ai][bj][m][1];
                    if (SCALE) { v0 = v0 * sv[bj][0]; v1 = v1 * sv[bj][1]; }
                    v4u w; w.x = pg8::cvt_pk_bf16(v0[0], v0[1]); w.y = pg8::cvt_pk_bf16(v0[2], v0[3]); w.z = pg8::cvt_pk_bf16(v1[0], v1[1]); w.w = pg8::cvt_pk_bf16(v1[2], v1[3]);
                    *(v4u*)(rowp + bj * HALF) = w; } }
        return 16;
    }
};
struct EpiFfn {
    static constexpr bool PERM = true, CHAIN = false;
    bf16* ACT; bf16* EDGE; const float* cw; const float* cb;
    template <int CTRL> static __device__ __forceinline__ float dpp(float x) { return __builtin_bit_cast(float, __builtin_amdgcn_update_dpp(0, __builtin_bit_cast(int, x), CTRL, 0xf, 0xf, true)); }
    template <int M> static __device__ __forceinline__ f32x4 conv4(const f32x4 (&x)[4][2], int n, const f32x4 (&w)[4], const f32x4 we0, const f32x4 we2) {
        f32x4 r;
#pragma unroll
        for (int e = 0; e < 4; ++e) { const float c = x[M][n][e];
            float t = __builtin_fmaf(w[1][e], c, w[3][e]);
            t = __builtin_fmaf(w[0][e], dpp<0x111>(c), t);
            t = __builtin_fmaf(w[2][e], dpp<0x101>(c), t);
            if (M > 0) t = __builtin_fmaf(we0[e], dpp<0x121>(x[M > 0 ? M - 1 : 0][n][e]), t);
            if (M < 3) t = __builtin_fmaf(we2[e], dpp<0x12f>(x[M < 3 ? M + 1 : 3][n][e]), t);
            r[e] = t; }
        return r;
    }
    template <int M> __device__ __forceinline__ v2u act4(const f32x4 (&xa)[4][2], const f32x4 (&xb)[4][2], int n, const f32x4 (&wa)[4], const f32x4 (&wb)[4], const f32x4 wae0, const f32x4 wae2, const f32x4 wbe0, const f32x4 wbe2) const {
        const f32x4 va = conv4<M>(xa, n, wa, wae0, wae2), vb = conv4<M>(xb, n, wb, wbe0, wbe2);
        float o[4];
#pragma unroll
        for (int e = 0; e < 4; ++e) o[e] = va[e] * __builtin_amdgcn_rcpf(1.0f + __builtin_amdgcn_exp2f(va[e] * -1.44269504f)) * vb[e];
        v2u r; r.x = pk2(o[0], o[1]); r.y = pk2(o[2], o[3]); return r;
    }
    __device__ __forceinline__ void operator()(const f32x4 (&acc)[2][2][4][2], const Unit& u, int wr, int wc, int fr, int fq) const {
        const int row0 = u.pm * BM + wr * 64 + fr, c0 = u.pn * 128 + wc * 32 + 8 * fq;
        const float e0 = fr == 0 ? 1.f : 0.f, e15 = fr == 15 ? 1.f : 0.f;
#pragma unroll
        for (int ai = 0; ai < 2; ++ai) {
            const int blk = u.pm * 4 + ai * 2 + wr;
            if (fr < 2 || fr >= 14) {
                const int j = fr < 2 ? fr : fr - 12;
                const f32x4 a0 = fr < 2 ? acc[ai][0][0][0] : acc[ai][0][3][0], a1 = fr < 2 ? acc[ai][0][0][1] : acc[ai][0][3][1];
                const f32x4 b0 = fr < 2 ? acc[ai][1][0][0] : acc[ai][1][3][0], b1 = fr < 2 ? acc[ai][1][0][1] : acc[ai][1][3][1];
                bf16* ep = EDGE + ((size_t)(blk * 4 + j) * 2) * DFF + c0;
                v4u w; w.x = pk2(a0[0], a0[1]); w.y = pk2(a0[2], a0[3]); w.z = pk2(a1[0], a1[1]); w.w = pk2(a1[2], a1[3]); *(v4u*)ep = w;
                w.x = pk2(b0[0], b0[1]); w.y = pk2(b0[2], b0[3]); w.z = pk2(b1[0], b1[1]); w.w = pk2(b1[2], b1[3]); *(v4u*)(ep + DFF) = w;
            }
        }
        __builtin_amdgcn_sched_barrier(0);
#pragma unroll
        for (int n = 0; n < 2; ++n) {
            f32x4 wa[4], wb[4];
#pragma unroll
            for (int k = 0; k < 3; ++k) { wa[k] = *(const f32x4*)(cw + k * UPC + c0 + 4 * n); wb[k] = *(const f32x4*)(cw + k * UPC + DFF + c0 + 4 * n); }
            wa[3] = *(const f32x4*)(cb + c0 + 4 * n); wb[3] = *(const f32x4*)(cb + DFF + c0 + 4 * n);
            const f32x4 wae0 = wa[0] * e0, wae2 = wa[2] * e15, wbe0 = wb[0] * e0, wbe2 = wb[2] * e15;
#pragma unroll
            for (int ai = 0; ai < 2; ++ai) {
                v2u r[4];
                r[0] = act4<0>(acc[ai][0], acc[ai][1], n, wa, wb, wae0, wae2, wbe0, wbe2); r[1] = act4<1>(acc[ai][0], acc[ai][1], n, wa, wb, wae0, wae2, wbe0, wbe2);
                r[2] = act4<2>(acc[ai][0], acc[ai][1], n, wa, wb, wae0, wae2, wbe0, wbe2); r[3] = act4<3>(acc[ai][0], acc[ai][1], n, wa, wb, wae0, wae2, wbe0, wbe2);
#pragma unroll
                for (int m = 0; m < 4; ++m) *(v2u*)(ACT + (size_t)(row0 + ai * HALF + m * 16) * DFF + c0 + 4 * n) = r[m];
            }
            __builtin_amdgcn_sched_barrier(0);
        }
    }
};
struct EpiBranch {
    static constexpr bool PERM = true, CHAIN = true;
    const unsigned char* G; bf16* MERGED; int skip;
    static __device__ __forceinline__ void deq8(const v2u w, float (&g)[8]) {
        g[0] = (float)(w.x & 0xffu); g[1] = (float)((w.x >> 8) & 0xffu); g[2] = (float)((w.x >> 16) & 0xffu); g[3] = (float)(w.x >> 24);
        g[4] = (float)(w.y & 0xffu); g[5] = (float)((w.y >> 8) & 0xffu); g[6] = (float)((w.y >> 16) & 0xffu); g[7] = (float)(w.y >> 24);
#pragma unroll
        for (int e = 0; e < 8; ++e) g[e] = (g[e] + 0.5f) * (1.0f / 256.0f);
    }
    static __device__ __forceinline__ void deqs(const v2u w, float (&g)[8], float sc) {
        g[0] = (float)(w.x & 0xffu); g[1] = (float)((w.x >> 8) & 0xffu); g[2] = (float)((w.x >> 16) & 0xffu); g[3] = (float)(w.x >> 24);
        g[4] = (float)(w.y & 0xffu); g[5] = (float)((w.y >> 8) & 0xffu); g[6] = (float)((w.y >> 16) & 0xffu); g[7] = (float)(w.y >> 24);
        const float hb = 0.5f * sc;
#pragma unroll
        for (int e = 0; e < 8; ++e) g[e] = __builtin_fmaf(g[e], sc, hb);
    }
    __device__ __forceinline__ bool operator()(f32x4 (&acc)[2][2][4][2], const Unit& u, int wr, int wc, int fr, int fq) const {
        const int row0 = u.pm * BM + wr * 64 + fr, col0 = u.pn * BM + wc * 32 + 8 * fq, sub = u.sub;
        const int subn = sub < 3 ? sub + 1 : sub;
        if (skip) return sub == 3;
        const int wave = wr * 4 + wc, ln = fq * 16 + fr;
        const bool last = sub == 3;
        const float sg = last ? 127.5f / 65536.0f : 1.0f / 256.0f;
        v2u gv[2][4][2], hv[2][4][2];
#pragma unroll
        for (int ai = 0; ai < 2; ++ai)
#pragma unroll
            for (int m = 0; m < 4; ++m)
#pragma unroll
                for (int bj = 0; bj < 2; ++bj) { gv[ai][m][bj] = *(const v2u*)(G + gate_off(u.pm, sub * 8 + u.pn, wave, ai * 8 + m * 2 + bj, ln)); hv[ai][m][bj] = *(const v2u*)(G + gate_off(u.pm, subn * 8 + u.pn, wave, ai * 8 + m * 2 + bj, ln)); }
        __builtin_amdgcn_sched_barrier(0);
#pragma unroll
        for (int ai = 0; ai < 2; ++ai)
#pragma unroll
            for (int m = 0; m < 4; ++m)
#pragma unroll
                for (int bj = 0; bj < 2; ++bj) {
                    v2u hw = hv[ai][m][bj]; if (last) { hw.x = 0x7f7f7f7fu; hw.y = 0x7f7f7f7fu; }
                    float g[8], h[8]; deqs(gv[ai][m][bj], g, sg); deqs(hw, h, 1.0f / 256.0f);
#pragma unroll
                    for (int e = 0; e < 8; ++e) g[e] = g[e] * __builtin_amdgcn_rcpf(h[e]);
                    f32x4& v0 = acc[ai][bj][m][0]; f32x4& v1 = acc[ai][bj][m][1];
                    v0[0] *= g[0]; v0[1] *= g[1]; v0[2] *= g[2]; v0[3] *= g[3]; v1[0] *= g[4]; v1[1] *= g[5]; v1[2] *= g[6]; v1[3] *= g[7];
                    if (bj == 1) __builtin_amdgcn_sched_barrier(0);
                }
        if (last) {
#pragma unroll
            for (int ai = 0; ai < 2; ++ai)
#pragma unroll
                for (int m = 0; m < 4; ++m)
#pragma unroll
                    for (int bj = 0; bj < 2; ++bj) {
                        const f32x4 v0 = acc[ai][bj][m][0], v1 = acc[ai][bj][m][1];
                        v4u w; w.x = pg8::cvt_pk_bf16(v0[0], v0[1]); w.y = pg8::cvt_pk_bf16(v0[2], v0[3]); w.z = pg8::cvt_pk_bf16(v1[0], v1[1]); w.w = pg8::cvt_pk_bf16(v1[2], v1[3]);
                        *(v4u*)(MERGED + (size_t)(row0 + ai * HALF + m * 16) * 2048 + col0 + bj * HALF) = w;
                    }
        }
        return last;
    }
};
struct EpiResid {
    static constexpr bool PERM = false, CHAIN = false;
    float* X; const float* modl; int goff, skip;
    __device__ __forceinline__ void operator()(const f32x4 (&acc)[2][2][4][2], const Unit& u, int wr, int wc, int fr, int fq) const {
        if (skip) return;
        const int row0 = u.pm * BM + wr * 64 + fr, col0 = u.pn * BM + wc * 32 + 4 * fq;
        const float* gp = modl + (size_t)(u.pm < 64 ? (u.pm >> 4) : 4) * 12288 + goff + col0;
        f32x4 gv[2][2];
#pragma unroll
        for (int bj = 0; bj < 2; ++bj)
#pragma unroll
            for (int n = 0; n < 2; ++n) gv[bj][n] = *(const f32x4*)(gp + bj * HALF + n * 16);
#pragma unroll
        for (int ai = 0; ai < 2; ++ai) {
            f32x4 xv[4][2][2];
#pragma unroll
            for (int m = 0; m < 4; ++m)
#pragma unroll
                for (int bj = 0; bj < 2; ++bj)
#pragma unroll
                    for (int n = 0; n < 2; ++n) xv[m][bj][n] = *(const f32x4*)(X + (size_t)(row0 + ai * HALF + m * 16) * D + col0 + bj * HALF + n * 16);
#pragma unroll
            for (int m = 0; m < 4; ++m)
#pragma unroll
                for (int bj = 0; bj < 2; ++bj)
#pragma unroll
                    for (int n = 0; n < 2; ++n) *(f32x4*)(X + (size_t)(row0 + ai * HALF + m * 16) * D + col0 + bj * HALF + n * 16) = xv[m][bj][n] + gv[bj][n] * acc[ai][bj][m][n];
        }
    }
};

struct EpiPart {
    static constexpr bool PERM = false, CHAIN = false;
    float* PART; const float* modl; int goff;
    __device__ __forceinline__ int operator()(const f32x4 (&acc)[2][2][4][2], const Unit& u, int wr, int wc, int fr, int fq) const {
        const int row0 = (u.pm - 64) * BM + wr * 64 + fr, col0 = u.pn * BM + wc * 32 + 4 * fq;
        const float* gp = modl + (size_t)4 * 12288 + goff + col0;
        float* P = PART + (size_t)u.sub * MC * D;
        f32x4 gv[2][2];
#pragma unroll
        for (int bj = 0; bj < 2; ++bj)
#pragma unroll
            for (int n = 0; n < 2; ++n) gv[bj][n] = *(const f32x4*)(gp + bj * HALF + n * 16);
#pragma unroll
        for (int ai = 0; ai < 2; ++ai)
#pragma unroll
            for (int m = 0; m < 4; ++m)
#pragma unroll
                for (int bj = 0; bj < 2; ++bj)
#pragma unroll
                    for (int n = 0; n < 2; ++n) *(f32x4*)(P + (size_t)(row0 + ai * HALF + m * 16) * D + col0 + bj * HALF + n * 16) = gv[bj][n] * acc[ai][bj][m][n];
        return 32;
    }
};

constexpr int NPH = 11;
constexpr int N_PHASES = 1 + DEPTH * NPH + 1;

__global__ void __launch_bounds__(NWAVES * 64, 2) fwd_kernel(Args args) {
    extern __shared__ __attribute__((aligned(16))) unsigned char lds_raw[];
    Frame F;
    F.lds = (LAS unsigned char*)lds_raw;
    F.tid = threadIdx.x; F.lane = F.tid & 63; F.wave = __builtin_amdgcn_readfirstlane(F.tid >> 6);
    F.G = gridDim.x; F.bid = blockIdx.x; F.ws = args.ws; F.in = args.in;
#if defined(PROBE_K)
    F.variant = args.variant;
#else
    F.variant = 0;
#endif
    gu32* ctl = (gu32*)(args.ws + WS_CTL);
    for (int u = F.tid; u < (LDS_BYTES - LDSCTL_OFF) / 4; u += NWAVES * 64) ((LAS unsigned*)(F.lds + LDSCTL_OFF))[u] = 0u;
    __syncthreads();
    XcdBarrier bar; bar.bar = (unsigned*)(ctl + CW_BAR); bar.x = 0; bar.st = nullptr;
    if (!MK_PER_PHASE && args.ph_hi - args.ph_lo > 1) bar = xcd_barrier_post((unsigned*)(ctl + CW_BAR), (volatile LAS unsigned*)(F.lds + MISC_OFF) + 8);
    const int lo = args.ph_lo, hi = args.ph_hi;
#ifndef PH_MASK
#define PH_MASK 0xFFFF
#endif
#define EN(b) (((PH_MASK) >> (b)) & 1)
#define IN(k) (lo <= (k) && (k) < hi)
#define SEAM(k) do { if (!MK_PER_PHASE && IN((k) + 1)) xcd_barrier(bar); } while (0)

    if (EN(11) && IN(0)) { phase_mod(F); steal_convert(F, 0, 0, true); SEAM(0); }

    for (int l = 0; l < DEPTH; ++l) {
        const int p0 = 1 + l * NPH;
        const int nrows = (l == DEPTH - 1) ? ML : M;
        const int nMp = nrows / 256;
        const float* modl = (const float*)(F.ws + WS_MOD) + (size_t)l * 5 * 12288;
        const unsigned char* wb = F.ws + (size_t)(l & 1) * W_SPAN;
        const bool cv = l + 1 < DEPTH;
        if (EN(0) && IN(p0 + 0)) {
            if (l == 0) phase_norm<true>(F, l, F.in[I_NORM1] + (size_t)l * D, 0, 2048, M);
            else phase_norm<false>(F, l, F.in[I_NORM1] + (size_t)l * D, 0, 2048, M, true);
            SEAM(p0 + 0);
        }
        if (EN(1) && IN(p0 + 1)) {
            const bool two = (nrows == ML);
            {
                pg8::Gemm g{(const char*)(F.ws + WS_H), (const char*)(wb + WS_WIG), (size_t)256 * D * 2, 0, 0, (size_t)256 * D * 2, 0, D, D, D};
                pg8::TileOrder<1> S; S.init(M / 256, two ? 41 : NIG / 256, F.G, F.bid);
                EpiInGate E{(bf16*)(F.ws + WS_U), (float*)(F.ws + WS_DT), (unsigned char*)(F.ws + WS_G), F.in[I_BGATE] + (size_t)l * 4 * 2048, 0};
                pg8::gemm_phase(F.lds + RING_OFF, g, S, E);
            }
            if (two) {
                pg8::Gemm g{(const char*)(F.ws + WS_H), (const char*)(wb + WS_WIG) + (size_t)41 * 256 * D * 2, (size_t)256 * D * 2, 0, 0, (size_t)256 * D * 2, 0, D, D, D};
                pg8::TileOrder<1> S; S.init(ML / 256, 32, F.G, F.bid);
                EpiInGate E{(bf16*)(F.ws + WS_U), (float*)(F.ws + WS_DT), (unsigned char*)(F.ws + WS_G), F.in[I_BGATE] + (size_t)l * 4 * 2048, 41};
                pg8::gemm_phase(F.lds + RING_OFF, g, S, E);
            }
            if (cv) steal_convert(F, l + 1, 1 + l * 6 + 0, false);
            SEAM(p0 + 1);
        }
        if (EN(2) && IN(p0 + 2)) { phase_pre(F, l); SEAM(p0 + 2); }
        if (EN(3) && IN(p0 + 3)) {
            const int nscan = 192;
            const bool split = F.G > nscan;
            for (int id = F.bid; id < nscan; id += F.G) {
#ifndef NO_SSD
                if (id < 128) scan_unit<128, 64, true>(F, l, id >> 5, (id >> 1) & 15, id & 1);
                else
#endif
#ifndef NO_RET
                { const int j = id - 128; scan_unit<64, 128, false>(F, l, j >> 4, (j >> 1) & 7, j & 1); }
#else
                {}
#endif
            }
#ifndef NO_POOLG
            if (!split || F.bid >= nscan) {
                pg8::Gemm g{(const char*)(F.ws + WS_POOLED), (const char*)(wb + WS_WPOOL), (size_t)256 * 1024 * 2, (size_t)256 * 2, 0, (size_t)256 * 256 * 2, 0, 1024, 256, 256};
                pg8::TileOrder<1> S; S.init(M / 256, 4, split ? F.G - nscan : F.G, split ? F.bid - nscan : F.bid);
                EpiBf16<true> E{(bf16*)(F.ws + WS_YB) + YS_STRIDE, 1024, F.in[I_POOLS] + (size_t)l * 1024};
                pg8::gemm_phase(F.lds + RING_OFF, g, S, E);
                sc_phase(F, l, split ? F.bid - nscan : F.bid, split ? F.G - nscan : F.G);
            }
            if (cv) steal_convert(F, l + 1, 1 + l * 6 + 5, false);
#endif
            SEAM(p0 + 3);
        }
        if (EN(4) && IN(p0 + 4)) { phase_fin(F, l, nrows); SEAM(p0 + 4); }
        if (EN(5) && IN(p0 + 5)) {
            pg8::Gemm g{(const char*)(F.ws + WS_YB), (const char*)(wb + WS_WB), (size_t)256 * 1024 * 2, 0, YS_STRIDE * 2, (size_t)256 * 1024 * 2, (size_t)2048 * 1024 * 2, 1024, 1024, 1024};
            pg8::TileOrder<4> S; S.init(nMp, D / 256, F.G, F.bid, 8);
            EpiBranch E{(const unsigned char*)(F.ws + WS_G), (bf16*)(F.ws + WS_MERGED), F.variant & 128};
            pg8::gemm_phase(F.lds + RING_OFF, g, S, E);
            if (cv) steal_convert(F, l + 1, 1 + l * 6 + 1, false);
            SEAM(p0 + 5);
        }
        if (EN(6) && IN(p0 + 6)) {
            pg8::Gemm g{(const char*)(F.ws + WS_MERGED), (const char*)(wb + WS_WO), (size_t)256 * D * 2, 0, 0, (size_t)256 * D * 2, 0, D, D, D};
            pg8::TileOrder<1> S; S.init(ML / 256, D / 256, F.G, F.bid);
            EpiResid E{(float*)(F.ws + WS_X), modl, 4096, F.variant & 128};
            pg8::gemm_phase(F.lds + RING_OFF, g, S, E);
            if (nMp > ML / 256) {
                pg8::Gemm g2{(const char*)(F.ws + WS_MERGED), (const char*)(wb + WS_WO), (size_t)256 * D * 2, 0, (size_t)(D / 4) * 2, (size_t)256 * D * 2, (size_t)(D / 4) * 2, D, D, D / 4};
                pg8::SplitOrder<4> S2; S2.init(nMp - ML / 256, D / 256, ML / 256, F.G, F.bid);
                EpiPart E2{(float*)(F.ws + WS_PART), modl, 4096};
                pg8::gemm_phase(F.lds + RING_OFF, g2, S2, E2);
            }
            if (cv) steal_convert(F, l + 1, 1 + l * 6 + 2, false);
            SEAM(p0 + 6);
        }
        if (EN(7) && IN(p0 + 7)) { phase_norm<false>(F, l, F.in[I_NORM2] + (size_t)l * D, 6144, 8192, nrows, nrows > ML); SEAM(p0 + 7); }
        if (EN(8) && IN(p0 + 8)) {
            pg8::Gemm g{(const char*)(F.ws + WS_H), (const char*)(wb + WS_WUP), (size_t)256 * D * 2, 0, 0, (size_t)256 * D * 2, 0, D, D, D};
            pg8::TileOrder<1> S; S.init(nMp, UPC / 256, F.G, F.bid);
            EpiFfn E{(bf16*)(F.ws + WS_ACT), (bf16*)(F.ws + WS_UP), F.in[I_FFNCW] + (size_t)l * 3 * UPC, F.in[I_FFNCB] + (size_t)l * UPC};
            pg8::gemm_phase(F.lds + RING_OFF, g, S, E);
            if (cv) steal_convert(F, l + 1, 1 + l * 6 + 3, false);
            SEAM(p0 + 8);
        }
        if (EN(9) && IN(p0 + 9)) { phase_ffnfix(F, l, nrows); SEAM(p0 + 9); }
        if (EN(10) && IN(p0 + 10)) {
            pg8::Gemm g{(const char*)(F.ws + WS_ACT), (const char*)(wb + WS_WDN), (size_t)256 * DFF * 2, 0, 0, (size_t)256 * DFF * 2, 0, DFF, DFF, DFF};
            pg8::TileOrder<1> S; S.init(ML / 256, D / 256, F.G, F.bid, 2);
            EpiResid E{(float*)(F.ws + WS_X), modl, 10240, F.variant & 128};
            pg8::gemm_phase(F.lds + RING_OFF, g, S, E);
            if (nMp > ML / 256) {
                pg8::Gemm g2{(const char*)(F.ws + WS_ACT), (const char*)(wb + WS_WDN), (size_t)256 * DFF * 2, 0, (size_t)(DFF / 4) * 2, (size_t)256 * DFF * 2, (size_t)(DFF / 4) * 2, DFF, DFF, DFF / 4};
                pg8::SplitOrder<4> S2; S2.init(nMp - ML / 256, D / 256, ML / 256, F.G, F.bid);
                EpiPart E2{(float*)(F.ws + WS_PART), modl, 10240};
                pg8::gemm_phase(F.lds + RING_OFF, g2, S2, E2);
            }
            if (cv) steal_convert(F, l + 1, 1 + l * 6 + 4, true);
            SEAM(p0 + 10);
        }
    }
    if (EN(12) && IN(N_PHASES - 1)) {
        phase_final(F, args.out);
    }
#undef IN
#undef SEAM
}

extern "C" void kernel_launch(void* const* d_in, const int* in_sizes, int n_in, void* d_out, int out_size, void* d_ws, size_t ws_size, hipStream_t stream) {
    static int grid = 0;
    if (grid == 0) {
        if (n_in != 28 || in_sizes[0] != ML * D || out_size != ML * D || ws_size < WS_END) { fprintf(stderr, "kernel_launch: unexpected shapes (n_in %d, in0 %d, out %d, ws %zu < %zu); nothing launched\n", n_in, n_in > 0 ? in_sizes[0] : -1, out_size, ws_size, (size_t)WS_END); grid = -1; return; }
        int dev = 0, cus = 0, per_cu = 0;
        if (hipGetDevice(&dev) != hipSuccess || hipDeviceGetAttribute(&cus, hipDeviceAttributeMultiprocessorCount, dev) != hipSuccess) { fprintf(stderr, "kernel_launch: device query failed\n"); grid = -1; return; }
        if (hipFuncSetAttribute((const void*)fwd_kernel, hipFuncAttributeMaxDynamicSharedMemorySize, LDS_BYTES) != hipSuccess) { fprintf(stderr, "kernel_launch: hipFuncSetAttribute failed\n"); grid = -1; return; }
        if (hipOccupancyMaxActiveBlocksPerMultiprocessor(&per_cu, (const void*)fwd_kernel, NWAVES * 64, LDS_BYTES) != hipSuccess || per_cu < 1)
            fprintf(stderr, "kernel_launch: note: occupancy query reports %d workgroups per CU\n", per_cu);
        (void)hipGetLastError();
        grid = cus;
    }
    if (grid < 0) return;
    if (hipMemsetAsync((char*)d_ws + WS_CTL, 0, CTL_ZERO_BYTES, stream) != hipSuccess) { fprintf(stderr, "kernel_launch: memset failed\n"); return; }
    Args a{};
    for (int i = 0; i < 28; ++i) a.in[i] = (const float*)d_in[i];
    a.out = (float*)d_out; a.ws = (unsigned char*)d_ws;
#if defined(PROBE_K)
    a.ph_lo = 0; a.ph_hi = N_PHASES;
    hipLaunchKernelGGL(fwd_kernel, dim3(grid), dim3(NWAVES * 64), LDS_BYTES, stream, a);
    for (int rep = 0; rep < PROBE_REPS; ++rep) for (int l = 0; l < DEPTH; ++l) { a.ph_lo = 1 + l * NPH + PROBE_K; a.ph_hi = a.ph_lo + 1; a.variant = PROBE_VARIANT; hipLaunchKernelGGL(fwd_kernel, dim3(grid), dim3(NWAVES * 64), LDS_BYTES, stream, a); }
#elif MK_PER_PHASE
    for (int p = 0; p < N_PHASES; ++p) { a.ph_lo = p; a.ph_hi = p + 1; hipLaunchKernelGGL(fwd_kernel, dim3(grid), dim3(NWAVES * 64), LDS_BYTES, stream, a); }
#else
    a.ph_lo = 0; a.ph_hi = N_PHASES;
    hipLaunchKernelGGL(fwd_kernel, dim3(grid), dim3(NWAVES * 64), LDS_BYTES, stream, a);
#endif
    const hipError_t le = hipPeekAtLastError();
    if (le != hipSuccess) fprintf(stderr, "kernel_launch: launch failed: %s\n", hipGetErrorName(le));
}
```

```cpp
#include <hip/hip_runtime.h>
#include <cstdio>
#include <cstdint>

#ifndef MK_PER_PHASE
#define MK_PER_PHASE 0
#endif

namespace pg8 {
#define PG8_LAS __attribute__((address_space(3)))
typedef unsigned short bf16_t;
typedef short bf16x8 __attribute__((ext_vector_type(8)));
typedef float f32x4 __attribute__((ext_vector_type(4)));
typedef unsigned u32x4 __attribute__((ext_vector_type(4)));
constexpr int BM = 256, BK = 64, HALF = 128, HTB = HALF * BK * 2, STAGE_BYTES = 8 * HTB, NXCD = 8, WGM = 8;

__host__ __device__ __forceinline__ int lds_byte(int r, int c) { const int st = (r >> 4) * 2 + (c >> 5), rr = r & 15, cc = c & 31, ob = rr * 64 + cc * 2; return st * 1024 + (ob ^ (((ob >> 9) & 1) << 5)); }
__host__ __device__ __forceinline__ void stage_rc(int b, int& R, int& C) { const int st = b / 1024, sb = b % 1024, swz = sb ^ (((sb >> 9) & 1) << 5); R = (st >> 1) * 16 + swz / 64; C = (st & 1) * 32 + (swz % 64) / 2; }
__host__ __device__ __forceinline__ int perm32(int rho) { const int n = rho >> 4, i = rho & 15; return 8 * (i >> 2) + 4 * n + (i & 3); }

struct Unit { int pm, pn, sub; };
struct Gemm { const char* A; const char* B; size_t a_tile, a_pn, a_sub, b_tile, b_sub; int lda, ldb, K; size_t kstepA = (size_t)(BK * 2); };

template <int NSUB> struct TileOrder {
    int nM, nN, nwg, G, c, wgm;
    __device__ __forceinline__ void init(int nM_, int nN_, int G_, int c_, int wgm_ = 4) { nM = nM_; nN = nN_; nwg = nM * nN; G = G_; c = c_; wgm = wgm_; }
    __device__ __forceinline__ bool next(int i, Unit& u) const {
        const int sub = i % NSUB; const long L = (long)(i / NSUB) * G + c; if (L >= nwg) return false;
        int wgid = (int)L; { const int q = nwg / NXCD, r = nwg % NXCD, xcd = wgid % NXCD, off = wgid / NXCD; wgid = (xcd < r ? xcd * (q + 1) : r * (q + 1) + (xcd - r) * q) + off; }
        const int nig = wgm * nN, gid = wgid / nig, fm = gid * wgm, gsz = (nM - fm) < wgm ? (nM - fm) : wgm;
        u.pm = fm + ((wgid % nig) % gsz); u.pn = (wgid % nig) / gsz; u.sub = sub; return true;
    }
};

template <int NSUB> struct SplitOrder {
    int nM, nN, pm0, G, c;
    __device__ __forceinline__ void init(int nM_, int nN_, int pm0_, int G_, int c_) { nM = nM_; nN = nN_; pm0 = pm0_; G = G_; c = c_; }
    __device__ __forceinline__ bool next(int i, Unit& u) const {
        const int j = i * G + c; if (j >= nM * nN * NSUB) return false;
        const int tile = j / NSUB; u.sub = j % NSUB; u.pm = pm0 + tile / nN; u.pn = tile % nN; return true;
    }
};
typedef __bf16 bf16x2_t __attribute__((ext_vector_type(2)));
typedef float f32x2_t __attribute__((ext_vector_type(2)));
__device__ __forceinline__ unsigned cvt_pk_bf16(float lo, float hi) { const f32x2_t v = {lo, hi}; return __builtin_bit_cast(unsigned, __builtin_convertvector(v, bf16x2_t)); }

template <class Epi, class Sched>
__device__ __forceinline__ void gemm_phase(PG8_LAS unsigned char* lds, const Gemm g, const Sched& S, const Epi& E) {
    int tid_ = threadIdx.x; asm volatile("" : "+v"(tid_));
    const int tid = tid_, wid = __builtin_amdgcn_readfirstlane(tid >> 6), lane = tid & 63, wr = wid >> 2, wc = wid & 3, fr = lane & 15, fq = lane >> 4;
    const int K = g.K, nt = K / BK;
    unsigned voffA[2], voffB[2];
#pragma unroll
    for (int i = 0; i < 2; ++i) { int R, C; stage_rc(tid * 16 + i * 8192, R, C); const int Rb = Epi::PERM ? ((R & ~31) + perm32(R & 31)) : R;
        voffA[i] = (unsigned)(R * g.lda + C) * 2u; voffB[i] = (unsigned)(Rb * g.ldb + C) * 2u; }
    const size_t kstep = (size_t)(BK * 2), kstepA = g.kstepA;
    const size_t hstepA = (size_t)HALF * g.lda * 2, hstepB = (size_t)HALF * g.ldb * 2;
    const unsigned ldsw = (unsigned)wid * 1024u;
    const int aoff = lds_byte(wr * 64 + fr, fq * 8), boff = lds_byte(wc * 32 + fr, fq * 8);
#define PG8_SA(b, h) (((b) * 2 + (h)) * HTB)
#define PG8_SB(b, h) ((4 + (b) * 2 + (h)) * HTB)
#define PG8_STAGE(bufoff, gbase, voff) do { _Pragma("unroll") for (int _i = 0; _i < 2; ++_i) \
        __builtin_amdgcn_global_load_lds((const unsigned*)((const char*)(gbase) + (voff)[_i]), (PG8_LAS unsigned*)(lds + (bufoff) + ldsw + _i * 8192), 16, 0, 0); } while (0)
#define PG8_LDA(dst, b, h) do { _Pragma("unroll") for (int m = 0; m < 4; ++m) _Pragma("unroll") for (int k = 0; k < 2; ++k) dst[m][k] = *(const PG8_LAS bf16x8*)(lds + PG8_SA(b, h) + aoff + m * 2048 + k * 1024); } while (0)
#define PG8_LDB(dst, b, h) do { _Pragma("unroll") for (int n = 0; n < 2; ++n) _Pragma("unroll") for (int k = 0; k < 2; ++k) dst[n][k] = *(const PG8_LAS bf16x8*)(lds + PG8_SB(b, h) + boff + n * 2048 + k * 1024); } while (0)
#define PG8_MMA(ai, bj, At, Bt) do { __builtin_amdgcn_s_setprio(1); _Pragma("unroll") for (int m = 0; m < 4; ++m) _Pragma("unroll") for (int n = 0; n < 2; ++n) _Pragma("unroll") for (int k = 0; k < 2; ++k) \
        acc[ai][bj][m][n] = __builtin_amdgcn_mfma_f32_16x16x32_bf16(Bt[n][k], At[m][k], acc[ai][bj][m][n], 0, 0, 0); __builtin_amdgcn_s_setprio(0); } while (0)
#define PG8_WAIT_V(n) asm volatile("s_waitcnt vmcnt(" #n ")" ::: "memory")
#define PG8_WAIT_L(n) asm volatile("s_waitcnt lgkmcnt(" #n ")" ::: "memory")
#define PG8_BAR __builtin_amdgcn_s_barrier()
#define PG8_SCHED __builtin_amdgcn_sched_barrier(0)
    Unit cur, nxt; int ui = 0;
    if (!S.next(0, cur)) return;
    f32x4 acc[2][2][4][2];
#pragma unroll
    for (int a = 0; a < 2; ++a)
#pragma unroll
        for (int b = 0; b < 2; ++b)
#pragma unroll
            for (int m = 0; m < 4; ++m)
#pragma unroll
                for (int n = 0; n < 2; ++n) acc[a][b][m][n] = (f32x4){0.f, 0.f, 0.f, 0.f};
    bf16x8 At[4][2], B0[2][2], B1[2][2];
    const char* cA = g.A + (size_t)cur.pm * g.a_tile + (size_t)cur.pn * g.a_pn + (size_t)cur.sub * g.a_sub;
    const char* cB = g.B + (size_t)cur.pn * g.b_tile + (size_t)cur.sub * g.b_sub;
    PG8_STAGE(PG8_SB(0, 0), cB, voffB); PG8_STAGE(PG8_SB(0, 1), cB + hstepB, voffB); PG8_STAGE(PG8_SA(0, 0), cA, voffA); PG8_STAGE(PG8_SA(0, 1), cA + hstepA, voffA);
    if (wr == 1) PG8_BAR;
    PG8_WAIT_V(2); PG8_BAR;
    PG8_STAGE(PG8_SB(1, 0), cB + kstep, voffB); PG8_STAGE(PG8_SA(1, 0), cA + kstepA, voffA); PG8_STAGE(PG8_SB(1, 1), cB + hstepB + kstep, voffB);
    PG8_WAIT_V(6); PG8_BAR;
    for (;;) {
        const bool has_next = S.next(ui + 1, nxt);
        const char* nA = has_next ? g.A + (size_t)nxt.pm * g.a_tile + (size_t)nxt.pn * g.a_pn + (size_t)nxt.sub * g.a_sub : cA;
        const char* nB = has_next ? g.B + (size_t)nxt.pn * g.b_tile + (size_t)nxt.sub * g.b_sub : cB;
        for (int t = 0; t < nt; t += 2) {
            const bool last = (t == nt - 2);
            const char* a1 = cA + (size_t)(t + 1) * kstepA;
            const char* a2 = last ? nA : cA + (size_t)(t + 2) * kstepA; const char* b2 = last ? nB : cB + (size_t)(t + 2) * kstep;
            const char* a3 = a2 + kstepA; const char* b3 = b2 + kstep;
            PG8_LDB(B0, 0, 0); PG8_LDB(B1, 0, 1); PG8_SCHED; PG8_LDA(At, 0, 0); PG8_STAGE(PG8_SA(1, 1), a1 + hstepA, voffA);
            PG8_WAIT_V(8); PG8_WAIT_L(0); PG8_BAR; PG8_MMA(0, 0, At, B0); PG8_MMA(0, 1, At, B1); PG8_BAR; PG8_SCHED;
            PG8_LDA(At, 0, 1); PG8_STAGE(PG8_SB(0, 0), b2, voffB); PG8_STAGE(PG8_SB(0, 1), b2 + hstepB, voffB); PG8_STAGE(PG8_SA(0, 0), a2, voffA);
            PG8_WAIT_V(8); PG8_WAIT_L(0); PG8_BAR; PG8_MMA(1, 0, At, B0); PG8_MMA(1, 1, At, B1); PG8_BAR; PG8_SCHED;
            PG8_LDB(B0, 1, 0); PG8_LDB(B1, 1, 1); PG8_SCHED; PG8_LDA(At, 1, 0); PG8_STAGE(PG8_SA(0, 1), a2 + hstepA, voffA);
            PG8_WAIT_V(8); PG8_WAIT_L(0); PG8_BAR; PG8_MMA(0, 0, At, B0); PG8_MMA(0, 1, At, B1); PG8_BAR; PG8_SCHED;
            PG8_LDA(At, 1, 1); PG8_STAGE(PG8_SB(1, 0), b3, voffB); PG8_STAGE(PG8_SB(1, 1), b3 + hstepB, voffB); PG8_STAGE(PG8_SA(1, 0), a3, voffA);
            PG8_WAIT_V(8); PG8_WAIT_L(0); PG8_BAR; PG8_MMA(1, 0, At, B0); PG8_MMA(1, 1, At, B1); PG8_BAR; PG8_SCHED;
        }
        if (wr == 0) PG8_BAR;
        bool zero_acc = true;
        int fr2 = fr, fq2 = fq; asm volatile("" : "+v"(fr2), "+v"(fq2));
        if constexpr (Epi::CHAIN) zero_acc = E(acc, cur, wr, wc, fr2, fq2); else E(acc, cur, wr, wc, fr2, fq2);
        if (!has_next) break;
        if (zero_acc) {
#pragma unroll
        for (int a = 0; a < 2; ++a)
#pragma unroll
            for (int b = 0; b < 2; ++b)
#pragma unroll
                for (int m = 0; m < 4; ++m)
#pragma unroll
                    for (int n = 0; n < 2; ++n) acc[a][b][m][n] = (f32x4){0.f, 0.f, 0.f, 0.f};
        }
        cur = nxt; cA = nA; cB = nB; ++ui;
        if (wr == 1) PG8_BAR;
    }
    PG8_WAIT_V(0);
    PG8_BAR;
#undef PG8_SA
#undef PG8_SB
#undef PG8_STAGE
#undef PG8_LDA
#undef PG8_LDB
#undef PG8_MMA
#undef PG8_WAIT_V
#undef PG8_WAIT_L
#undef PG8_BAR
#undef PG8_SCHED
}
}

constexpr int NWAVES = 8;
constexpr int D = 2048, NB = 4, SEQ = 4096, CTX = 256, DEPTH = 4;
constexpr int ML = NB * SEQ;
constexpr int MC = NB * CTX;
constexpr int M = ML + MC;
constexpr int UC = 10240;
constexpr int NIG = 10496 + 8192;
constexpr int DFF = 5632, UPC = 2 * DFF;
constexpr int IN_COLS = 10256;
constexpr float EPS = 1e-6f;
constexpr int U_Z = 0, U_XBC = 1024, U_POOL = 3072, U_SCB = 4096, U_SCC = 5120, U_SCX = 6144, U_RQ = 7168, U_RK = 7680, U_RV = 8192, U_RG = 9216;

constexpr size_t MiB = 1u << 20;
constexpr size_t WS_CTL = 0, CTL_ZERO_BYTES = 128 * 1024;
constexpr size_t WS_MOD = 1 * MiB;
constexpr size_t WS_ROPE = WS_MOD + (size_t)DEPTH * 5 * 12288 * 4;
constexpr size_t WS_X = 2 * MiB;
constexpr size_t WS_H = WS_X + 136 * MiB;
constexpr size_t WS_WIG = WS_H + 68 * MiB;
constexpr size_t WS_WB = WS_WIG + 73 * MiB;
constexpr size_t WS_WO = WS_WB + 16 * MiB;
constexpr size_t WS_WUP = WS_WO + 8 * MiB;
constexpr size_t WS_WDN = WS_WUP + 44 * MiB;
constexpr size_t WS_WPOOL = WS_WDN + 22 * MiB;
constexpr size_t W_SPAN = WS_WPOOL + 1 * MiB - WS_WIG;
constexpr size_t WS_U = WS_WIG + 2 * W_SPAN;
constexpr size_t WS_DT = WS_U + 340 * MiB;
constexpr size_t WS_G = WS_DT + 2 * MiB;
constexpr size_t WS_UP = WS_U;
constexpr size_t WS_CUMA = WS_G + 140 * MiB;
constexpr size_t WS_DTA = WS_CUMA + 4 * MiB;
constexpr size_t WS_PART = WS_G + 152 * MiB;
constexpr size_t WS_XBCA = WS_G + 272 * MiB;
constexpr size_t WS_RQK = WS_XBCA + 68 * MiB;
constexpr size_t WS_YS = WS_RQK + 34 * MiB;
constexpr size_t WS_YB = WS_YS + 136 * MiB;
constexpr size_t WS_POOLED = WS_YB + 136 * MiB;
constexpr size_t WS_MERGED = WS_POOLED + 34 * MiB;
constexpr size_t WS_MRG32 = WS_XBCA;
constexpr size_t WS_ACT = WS_XBCA;
constexpr size_t WS_END = WS_MERGED + 68 * MiB;
static_assert(WS_UP + (size_t)M * UPC * 2 <= WS_XBCA, "UP overlay");
static_assert(WS_DTA + 4 * MiB <= WS_PART && WS_PART + 32 * MiB <= WS_XBCA, "PART");
static_assert(WS_UP + (size_t)M * UPC * 2 <= WS_CUMA && WS_DTA + 4 * MiB <= WS_XBCA && (size_t)2 * 16 * M * 4 <= 4 * MiB, "cum/dt arrays");
static_assert(WS_ACT + (size_t)M * DFF * 2 <= WS_YB, "ACT overlay");
static_assert(WS_MRG32 + (size_t)M * D * 4 <= WS_YS + 34 * MiB, "MRG32 overlay");
static_assert(WS_ROPE + 8192 <= WS_X, "mod/rope");
constexpr size_t YS_STRIDE = (size_t)M * 1024;

constexpr int CW_TMO = 0, CW_CODE = 1, CW_BAR = 4096, CW_Q = 16384, CW_FIN = 20480;

constexpr int RING_OFF = 0, RING_BYTES = 131072;
constexpr int LDSCTL_OFF = RING_BYTES, MISC_OFF = LDSCTL_OFF + 320;
constexpr int LDS_BYTES = 147456;

#define GAS __attribute__((address_space(1)))
#define LAS __attribute__((address_space(3)))
typedef unsigned short bf16;
typedef unsigned v4u __attribute__((ext_vector_type(4)));
typedef unsigned v2u __attribute__((ext_vector_type(2)));
typedef float f32x4 __attribute__((ext_vector_type(4)));
typedef float f32x16 __attribute__((ext_vector_type(16)));
typedef short bf16x8 __attribute__((ext_vector_type(8)));
typedef GAS unsigned gu32;
#define RLX_AGENT __ATOMIC_RELAXED, __HIP_MEMORY_SCOPE_AGENT
#define LDS_WAIT() asm volatile("s_waitcnt lgkmcnt(0)" ::: "memory")
#define VM_WAIT() asm volatile("s_waitcnt vmcnt(0)" ::: "memory")
__device__ __forceinline__ unsigned f2bf(float f) { return (unsigned)__builtin_bit_cast(unsigned short, (__bf16)f); }
__device__ __forceinline__ unsigned pk2(float lo, float hi) { return pg8::cvt_pk_bf16(lo, hi); }
__device__ __forceinline__ float bflo(unsigned w) { return __builtin_bit_cast(float, w << 16); }
__device__ __forceinline__ float bfhi(unsigned w) { return __builtin_bit_cast(float, w & 0xffff0000u); }
__device__ __forceinline__ float bf1(unsigned short b) { return __builtin_bit_cast(float, (unsigned)b << 16); }
__device__ __forceinline__ void unpack8(const v4u w, float (&f)[8]) { f[0] = bflo(w.x); f[1] = bfhi(w.x); f[2] = bflo(w.y); f[3] = bfhi(w.y); f[4] = bflo(w.z); f[5] = bfhi(w.z); f[6] = bflo(w.w); f[7] = bfhi(w.w); }
__device__ __forceinline__ v4u pack8(const float (&f)[8]) { v4u w; w.x = pk2(f[0], f[1]); w.y = pk2(f[2], f[3]); w.z = pk2(f[4], f[5]); w.w = pk2(f[6], f[7]); return w; }
__device__ __forceinline__ float sigmoidf_(float x) { return __builtin_amdgcn_rcpf(1.0f + __expf(-x)); }
__device__ __forceinline__ float siluf_(float x) { return x * sigmoidf_(x); }
__device__ __forceinline__ float softplusf_(float x) { return fmaxf(x, 0.f) + log1pf(expf(-fabsf(x))); }
__device__ __forceinline__ float wave_sum(float v) {
#pragma unroll
    for (int o = 1; o < 64; o <<= 1) v += __shfl_xor(v, o);
    return v;
}

#define XB_TMO      128
#define XB_XCNT(j)  (256  + 64 * (j))
#define XB_XSUB(j)  (1280 + 64 * (j))
#define XB_XGEN(j)  (2304 + 64 * (j))
#define XB_TOP      3328
#define XB_TOPGEN   3392
#define XCD_BAR_WORDS 3456
#define XB_SPIN_CAP (1u << 18)
__device__ __forceinline__ unsigned xb_ld(unsigned* p)              { return __hip_atomic_load(p, __ATOMIC_RELAXED, __HIP_MEMORY_SCOPE_AGENT); }
__device__ __forceinline__ unsigned xb_add(unsigned* p, unsigned v) { return __hip_atomic_fetch_add(p, v, __ATOMIC_RELAXED, __HIP_MEMORY_SCOPE_AGENT); }
__device__ __forceinline__ unsigned xb_xcc_id() { return (unsigned)__builtin_amdgcn_s_getreg((3 << 11) | 20) & 0xFu; }
#define XB_SPIN(cond, bar) do { unsigned _sp = 0; while (cond) { __builtin_amdgcn_s_sleep(1); \
    if ((++_sp & 255u) == 0u) { if (xb_ld(&(bar)[XB_TMO])) break; if (_sp > XB_SPIN_CAP) { atomicAdd(&(bar)[XB_TMO], 1u); break; } } } } while (0)
struct XcdBarrier { unsigned* bar; unsigned x; volatile LAS unsigned* st; };
__device__ __forceinline__ XcdBarrier xcd_barrier_post(unsigned* bar, volatile LAS unsigned* st) {
    XcdBarrier b; b.bar = bar; b.x = xb_xcc_id(); b.st = st;
    if (threadIdx.x == 0) (void)xb_add(&bar[XB_XCNT(b.x)], 1u);
    return b;
}
__device__ __forceinline__ void xcd_barrier_complete(unsigned* bar, unsigned x, unsigned& nloc, unsigned& nx) {
    const unsigned G = gridDim.x * gridDim.y * gridDim.z;
    unsigned sum, cnt, mine, sp = 0u;
    for (;;) {
        sum = 0u; cnt = 0u; mine = 0u;
#pragma unroll
        for (unsigned j = 0; j < 16; ++j) { const unsigned c = xb_ld(&bar[XB_XCNT(j)]); sum += c; cnt += (c > 0u) ? 1u : 0u; mine = (j == x) ? c : mine; }
        if (sum == G) break;
        __builtin_amdgcn_s_sleep(1);
        if ((++sp & 255u) == 0u) { if (xb_ld(&bar[XB_TMO])) break; if (sp > XB_SPIN_CAP) { atomicAdd(&bar[XB_TMO], 1u); break; } }
    }
    nloc = mine > 0u ? mine : 1u; nx = cnt > 0u ? cnt : 1u;
}
__device__ __forceinline__ void xcd_barrier(const XcdBarrier& b) {
    asm volatile("s_waitcnt vmcnt(0)" ::: "memory");
    __syncthreads();
    if (threadIdx.x == 0) {
        unsigned* bar = b.bar;
        __builtin_amdgcn_s_waitcnt(0);
        unsigned nloc = b.st[0], nx = b.st[1];
        if (nloc == 0u) { xcd_barrier_complete(bar, b.x, nloc, nx); b.st[0] = nloc; b.st[1] = nx; }
        const unsigned old = xb_add(&bar[XB_XSUB(b.x)], 1u);
        const unsigned gen = old / nloc;
        if (old + 1u == (gen + 1u) * nloc) {
            __builtin_amdgcn_fence(__ATOMIC_RELEASE, "agent");
            asm volatile("s_waitcnt vmcnt(0)" ::: "memory");
            const unsigned og = xb_add(&bar[XB_TOP], 1u);
            const unsigned tg = og / nx;
            if (og + 1u == (tg + 1u) * nx) xb_add(&bar[XB_TOPGEN], 1u);
            else XB_SPIN(xb_ld(&bar[XB_TOPGEN]) == tg, bar);
            __builtin_amdgcn_fence(__ATOMIC_ACQUIRE, "agent");
            xb_add(&bar[XB_XGEN(b.x)], 1u);
            asm volatile("s_waitcnt vmcnt(0)" ::: "memory");
        } else {
            XB_SPIN(xb_ld(&bar[XB_XGEN(b.x)]) == gen, bar);
            __builtin_amdgcn_fence(__ATOMIC_ACQUIRE, "agent");
            asm volatile("s_waitcnt vmcnt(0)" ::: "memory");
        }
    }
    __syncthreads();
}

struct Args {
    const float* in[28];
    float* out; unsigned char* ws;
    int ph_lo, ph_hi, variant, pad;
};
struct Frame {
    LAS unsigned char* lds;
    int tid, lane, wave, G, bid, variant;
    unsigned char* ws;
    const float* const* in;
};
__device__ __forceinline__ void frame_refresh(Frame& F) {
    int t = threadIdx.x; asm volatile("" : "+v"(t)); F.tid = t; F.lane = t & 63; F.wave = __builtin_amdgcn_readfirstlane(t >> 6);
    int b = blockIdx.x; asm volatile("" : "+s"(b)); F.bid = b;
}
enum { I_X = 0, I_C, I_CTX, I_CCTX, I_WMOD, I_BMOD, I_NORM1, I_WIN, I_SSDCW, I_SSDCB, I_SSDALOG, I_SSDDTB, I_SSDD, I_SSDNW, I_POOLW, I_POOLS, I_SCONVW, I_RETDL,
       I_WBR, I_WGATE, I_BGATE, I_WO, I_NORM2, I_FFNUP, I_FFNCW, I_FFNCB, I_FFNDN, I_FNW };

__device__ __forceinline__ void seq_bounds(int row, int& s0, int& s1) {
    if (row < ML) { s0 = row & ~(SEQ - 1); s1 = s0 + SEQ; } else { s0 = ML + ((row - ML) & ~(CTX - 1)); s1 = s0 + CTX; }
}
__device__ __forceinline__ int mod_vec(int row) { return row < ML ? (row >> 12) : 4; }

__device__ __forceinline__ void phase_mod(Frame& F) {
    frame_refresh(F);
    LAS float* sv = (LAS float*)(F.lds);
    LAS float* red = (LAS float*)(F.lds + 5 * 2048 * 4);
    const float* c = F.in[I_C]; const float* cc = F.in[I_CCTX];
    for (int i = F.tid; i < 5 * 2048; i += 512) { const int v = i >> 11, k = i & 2047; const float x = v < 4 ? c[v * 2048 + k] : cc[k]; sv[i] = siluf_(x); }
    __syncthreads();
    float* MOD = (float*)(F.ws + WS_MOD);
    for (int it = F.bid; it < DEPTH * 48; it += F.G) {
        const int l = it / 48, jb = it % 48;
        const float* W = F.in[I_WMOD] + (size_t)l * 2048 * 12288 + jb * 256 + 4 * F.lane;
        float a[5][4];
#pragma unroll
        for (int v = 0; v < 5; ++v) { a[v][0] = a[v][1] = a[v][2] = a[v][3] = 0.f; }
        const int k0 = F.wave * 256;
#pragma unroll 4
        for (int k = 0; k < 256; ++k) {
            const f32x4 w = *(const f32x4*)(W + (size_t)(k0 + k) * 12288);
#pragma unroll
            for (int v = 0; v < 5; ++v) { const float s = sv[v * 2048 + k0 + k]; a[v][0] += s * w.x; a[v][1] += s * w.y; a[v][2] += s * w.z; a[v][3] += s * w.w; }
        }
#pragma unroll
        for (int v = 0; v < 5; ++v) *(LAS f32x4*)(red + (F.wave * 5 + v) * 256 + 4 * F.lane) = (f32x4){a[v][0], a[v][1], a[v][2], a[v][3]};
        __syncthreads();
        for (int i = F.tid; i < 5 * 256; i += 512) { const int v = i >> 8, j = i & 255; float s = 0.f;
#pragma unroll
            for (int w = 0; w < 8; ++w) s += red[(w * 5 + v) * 256 + j];
            MOD[((size_t)l * 5 + v) * 12288 + jb * 256 + j] = s + F.in[I_BMOD][l * 12288 + jb * 256 + j]; }
        __syncthreads();
    }
    if (F.bid == F.G - 1) {
        float* R = (float*)(F.ws + WS_ROPE);
        for (int i = F.tid; i < 1024; i += 512) { const int pos = i >> 4, m = i & 15; const float inv = powf(10000.0f, -(float)m / 16.0f); const float ang = (float)pos * inv; R[2 * i] = cosf(ang); R[2 * i + 1] = sinf(ang); }
    }
}

template <class RowMap>
__device__ __forceinline__ void transpose_item(const float* W, int K, int N, bf16* WT, const RowMap& rm, LAS float* scr, int item, int lane) {
    const int nblk = (N + 31) / 32, kb = item / nblk, nb = item % nblk, k0 = 64 * kb, n0 = 32 * nb;
    const bool nok = (n0 + (lane & 31)) < N;
#pragma unroll 8
    for (int i = 0; i < 32; ++i) { const int kk = 2 * i + (lane >> 5); scr[kk * 33 + (lane & 31)] = nok ? W[(size_t)(k0 + kk) * N + n0 + (lane & 31)] : 0.f; }
    LDS_WAIT(); asm volatile("" ::: "memory");
    const int c = lane & 7;
#pragma unroll
    for (int j = 0; j < 4; ++j) { const int n = (lane >> 3) + 8 * j; const LAS float* s = scr + (8 * c) * 33 + n;
        v4u o; o.x = pk2(s[0 * 33], s[1 * 33]); o.y = pk2(s[2 * 33], s[3 * 33]); o.z = pk2(s[4 * 33], s[5 * 33]); o.w = pk2(s[6 * 33], s[7 * 33]);
        if (n0 + n < N) *(GAS v4u*)(WT + (size_t)rm(n0 + n) * K + k0 + 8 * c) = o; }
    LDS_WAIT(); asm volatile("" ::: "memory");
}
struct RowId { int off; __device__ __forceinline__ int operator()(int n) const { return n + off; } };
struct RowUp { __device__ __forceinline__ int operator()(int n) const { const int h = n >= DFF ? 1 : 0, c = n - h * DFF; return (c >> 7) * 256 + h * 128 + (c & 127); } };
struct RowWin { __device__ __forceinline__ int operator()(int n) const { return n < 3072 ? n : (n < 3088 ? 10240 + (n - 3072) : n - 16); } };

constexpr int CI_IN = 32 * 321, CI_G1 = 32 * 64, CI_B1 = 16 * 64, CI_O = 32 * 64, CI_UP = 32 * 352, CI_DN = 88 * 64, CI_P1 = 4 * 8, CI_Z = 30;
constexpr int NITW = CI_IN + 4 * CI_G1 + 4 * CI_B1 + CI_O + CI_UP + CI_DN + 4 * CI_P1 + CI_Z;
__device__ __forceinline__ void convert_item(Frame& F, int l, int it, LAS float* scr, int lane) {
    unsigned char* wb = F.ws + (size_t)(l & 1) * W_SPAN;
    bf16* WIG = (bf16*)(wb + WS_WIG); bf16* WB = (bf16*)(wb + WS_WB); bf16* WO = (bf16*)(wb + WS_WO);
    bf16* WUP = (bf16*)(wb + WS_WUP); bf16* WDN = (bf16*)(wb + WS_WDN); bf16* WPOOL = (bf16*)(wb + WS_WPOOL);
    int r = it;
    if (r < CI_IN) { transpose_item(F.in[I_WIN] + (size_t)l * 2048 * IN_COLS, 2048, IN_COLS, WIG, RowWin{}, scr, r, lane); return; } r -= CI_IN;
    if (r < 4 * CI_G1) { const int i = r / CI_G1; transpose_item(F.in[I_WGATE] + ((size_t)l * 4 + i) * 2048 * 2048, 2048, 2048, WIG, RowId{10496 + i * 2048}, scr, r % CI_G1, lane); return; } r -= 4 * CI_G1;
    if (r < 4 * CI_B1) { const int i = r / CI_B1; transpose_item(F.in[I_WBR] + ((size_t)l * 4 + i) * 1024 * 2048, 1024, 2048, WB + (size_t)i * 2048 * 1024, RowId{0}, scr, r % CI_B1, lane); return; } r -= 4 * CI_B1;
    if (r < CI_O) { transpose_item(F.in[I_WO] + (size_t)l * 2048 * 2048, 2048, 2048, WO, RowId{0}, scr, r, lane); return; } r -= CI_O;
    if (r < CI_UP) { transpose_item(F.in[I_FFNUP] + (size_t)l * 2048 * UPC, 2048, UPC, WUP, RowUp{}, scr, r, lane); return; } r -= CI_UP;
    if (r < CI_DN) { transpose_item(F.in[I_FFNDN] + (size_t)l * DFF * 2048, DFF, 2048, WDN, RowId{0}, scr, r, lane); return; } r -= CI_DN;
    if (r < 4 * CI_P1) { const int g = r / CI_P1; transpose_item(F.in[I_POOLW] + ((size_t)l * 4 + g) * 256 * 256, 256, 256, WPOOL + (size_t)g * 256 * 256, RowId{0}, scr, r % CI_P1, lane); return; } r -= 4 * CI_P1;
    {
        unsigned char* base = (unsigned char*)WIG + (size_t)(10256 + 8 * r) * 2048 * 2;
#pragma unroll 4
        for (int k = 0; k < 32; ++k) *(GAS v4u*)(base + (size_t)(k * 64 + lane) * 16) = (v4u){0u, 0u, 0u, 0u};
    }
}
__device__ __forceinline__ void steal_convert(Frame& F, int l, int finidx, bool drain) {
    frame_refresh(F);
    gu32* q = (gu32*)(F.ws + WS_CTL) + CW_Q + 64 * l;
    gu32* fin = (gu32*)(F.ws + WS_CTL) + CW_FIN + 64 * finidx;
    volatile LAS unsigned* box = (volatile LAS unsigned*)(F.lds + MISC_OFF);
    LAS float* scr = (LAS float*)(F.lds + F.wave * 16384);
    if (F.tid == 0 && !drain) __hip_atomic_fetch_add(fin, 1u, RLX_AGENT);
    for (;;) {
        if (F.tid == 0) { unsigned v = 0xffffffffu; if (drain || __hip_atomic_load(fin, RLX_AGENT) < (unsigned)F.G) v = __hip_atomic_fetch_add(q, 1u, RLX_AGENT); box[0] = v; }
        __syncthreads();
        const unsigned got = box[0];
        __syncthreads();
        if (got == 0xffffffffu) break;
        const int base = (int)got * 8;
        if (base >= NITW) break;
        { const int wi = base + F.wave; if (wi < NITW) convert_item(F, l, wi, scr, F.lane); }
    }
}

template <bool FIRST>
__device__ __forceinline__ void phase_norm(Frame& F, int l, const float* nw, int sh_off, int sc_off, int nrows, bool addpart = false) {
    frame_refresh(F);
    float* X = (float*)(F.ws + WS_X); bf16* H = (bf16*)(F.ws + WS_H); const float* MOD = (const float*)(F.ws + WS_MOD);
    const int gw = F.bid * NWAVES + F.wave, NGW = F.G * NWAVES;
    for (int row = gw; row < nrows; row += NGW) {
        const float* src = FIRST ? (row < ML ? F.in[I_X] + (size_t)row * D : F.in[I_CTX] + (size_t)(row - ML) * D) : X + (size_t)row * D;
        f32x4 v[8]; float ss = 0.f;
#pragma unroll
        for (int j = 0; j < 8; ++j) { v[j] = *(const f32x4*)(src + 256 * j + 4 * F.lane); ss += (v[j].x * v[j].x + v[j].y * v[j].y) + (v[j].z * v[j].z + v[j].w * v[j].w); }
        if (FIRST) {
#pragma unroll
            for (int j = 0; j < 8; ++j) *(f32x4*)(X + (size_t)row * D + 256 * j + 4 * F.lane) = v[j];
        }
        if (!FIRST && addpart && row >= ML) {
            const float* P = (const float*)(F.ws + WS_PART) + (size_t)(row - ML) * D;
            ss = 0.f;
#pragma unroll
            for (int j = 0; j < 8; ++j) {
#pragma unroll
                for (int sp = 0; sp < 4; ++sp) v[j] += *(const f32x4*)(P + (size_t)sp * MC * D + 256 * j + 4 * F.lane);
                *(f32x4*)(X + (size_t)row * D + 256 * j + 4 * F.lane) = v[j];
                ss += (v[j].x * v[j].x + v[j].y * v[j].y) + (v[j].z * v[j].z + v[j].w * v[j].w);
            }
        }
        const float rs = rsqrtf(wave_sum(ss) * (1.0f / D) + EPS);
        const float* mv = MOD + ((size_t)l * 5 + mod_vec(row)) * 12288;
#pragma unroll
        for (int j = 0; j < 8; ++j) { const int c = 256 * j + 4 * F.lane;
            const f32x4 w = *(const f32x4*)(nw + c), sh = *(const f32x4*)(mv + sh_off + c), sc = *(const f32x4*)(mv + sc_off + c);
            const f32x4 y = v[j] * rs * w; const f32x4 h = y * (sc + 1.0f) + sh;
            v2u o; o.x = pk2(h.x, h.y); o.y = pk2(h.z, h.w); *(v2u*)(H + (size_t)row * D + c) = o; }
    }
}
__device__ __forceinline__ void phase_final(Frame& F, float* out) {
    frame_refresh(F);
    const float* X = (const float*)(F.ws + WS_X); const float* nw = F.in[I_FNW];
    const int gw = F.bid * NWAVES + F.wave, NGW = F.G * NWAVES;
    for (int row = gw; row < ML; row += NGW) {
        f32x4 v[8]; float ss = 0.f;
#pragma unroll
        for (int j = 0; j < 8; ++j) { v[j] = *(const f32x4*)(X + (size_t)row * D + 256 * j + 4 * F.lane); ss += (v[j].x * v[j].x + v[j].y * v[j].y) + (v[j].z * v[j].z + v[j].w * v[j].w); }
        const float rs = rsqrtf(wave_sum(ss) * (1.0f / D) + EPS);
#pragma unroll
        for (int j = 0; j < 8; ++j) { const int c = 256 * j + 4 * F.lane; *(f32x4*)(out + (size_t)row * D + c) = v[j] * rs * *(const f32x4*)(nw + c); }
    }
}

__device__ __forceinline__ v4u ldrow(const bf16* base, int row, int ld, int col, bool ok) { return ok ? *(const v4u*)(base + (size_t)row * ld + col) : (v4u){0u, 0u, 0u, 0u}; }
__device__ __forceinline__ void ld8f(const float* p, float (&f)[8]) { const f32x4 a = *(const f32x4*)p, b = *(const f32x4*)(p + 4); f[0] = a.x; f[1] = a.y; f[2] = a.z; f[3] = a.w; f[4] = b.x; f[5] = b.y; f[6] = b.z; f[7] = b.w; }

__device__ __forceinline__ void sc_task(Frame& F, int l, int r, int lane) {
    const bf16* U = (const bf16*)(F.ws + WS_U); bf16* YB2 = (bf16*)(F.ws + WS_YB) + 2 * YS_STRIDE;
            const int rb = r >> 1, cb = r & 1, c = cb * 512 + lane * 8, r0 = rb * 32; int s0, s1; seq_bounds(r0, s0, s1);
            float w0[8], w1[8], w2[8];
            ld8f(F.in[I_SCONVW] + ((size_t)l * 3 + 0) * 1024 + c, w0); ld8f(F.in[I_SCONVW] + ((size_t)l * 3 + 1) * 1024 + c, w1); ld8f(F.in[I_SCONVW] + ((size_t)l * 3 + 2) * 1024 + c, w2);
            for (int r4 = r0; r4 < r0 + 32; r4 += 4) {
                v4u bc[6], bx[6], bg[4];
#pragma unroll
                for (int k = 0; k < 6; ++k) { const int s = r4 - 1 + k; const bool ok = s >= s0 && s < s1; bc[k] = ldrow(U, s, UC, U_SCC + c, ok); bx[k] = ldrow(U, s, UC, U_SCX + c, ok); }
#pragma unroll
                for (int k = 0; k < 4; ++k) bg[k] = ldrow(U, r4 + k, UC, U_SCB + c, true);
                float pr[6][8];
#pragma unroll
                for (int k = 0; k < 6; ++k) { float a[8], b[8]; unpack8(bc[k], a); unpack8(bx[k], b);
#pragma unroll
                    for (int e = 0; e < 8; ++e) pr[k][e] = a[e] * b[e]; }
#pragma unroll
                for (int j = 0; j < 4; ++j) { float g[8], o[8]; unpack8(bg[j], g);
#pragma unroll
                    for (int e = 0; e < 8; ++e) o[e] = g[e] * (w0[e] * pr[j][e] + w1[e] * pr[j + 1][e] + w2[e] * pr[j + 2][e]);
                    *(v4u*)(YB2 + (size_t)(r4 + j) * 1024 + c) = pack8(o); }
            }
}
__device__ __forceinline__ void sc_phase(Frame& F, int l, int c, int Gs) {
    frame_refresh(F);
    const int gw = c * NWAVES + F.wave, NGW = Gs * NWAVES;
    for (int task = gw; task < (M / 32) * 2; task += NGW) sc_task(F, l, task, F.lane);
}
template <int HMAX>
__device__ __forceinline__ void pool_task(const bf16* U, bf16* POOLED, int r0, int s0, int s1, int c, int half) {
    constexpr int NR = 8 + 2 * HMAX - 1, HA = HMAX / 2;
    const bool big = (half == HMAX);
    for (int r8 = r0; r8 < r0 + 32; r8 += 8) {
        v4u buf[NR];
#pragma unroll
        for (int k = 0; k < NR; ++k) { const int s = r8 - HMAX + k; buf[k] = ldrow(U, s, UC, U_POOL + c, s >= s0 && s < s1); }
        float sa[8], sb[8];
#pragma unroll
        for (int e = 0; e < 8; ++e) { sa[e] = 0.f; sb[e] = 0.f; }
#pragma unroll
        for (int k = 0; k < 2 * HMAX; ++k) { float t[8]; unpack8(buf[k], t);
#pragma unroll
            for (int e = 0; e < 8; ++e) { sb[e] += t[e]; if (k >= HA && k < HMAX + HA) sa[e] += t[e]; } }
#pragma unroll
        for (int j = 0; j < 8; ++j) {
            const int rr = r8 + j; int lo = rr - half, hi = rr + half; lo = lo < s0 ? s0 : lo; hi = hi > s1 ? s1 : hi;
            float x[8], o[8]; unpack8(buf[j + HMAX], x); const float inv = 1.0f / (float)(hi - lo);
#pragma unroll
            for (int e = 0; e < 8; ++e) o[e] = (big ? sb[e] : sa[e]) * inv - x[e];
            *(v4u*)(POOLED + (size_t)rr * 1024 + c) = pack8(o);
            if (j < 7) {
                float tin[8], tout[8];
                unpack8(buf[j + 2 * HMAX], tin); unpack8(buf[j], tout);
#pragma unroll
                for (int e = 0; e < 8; ++e) sb[e] += tin[e] - tout[e];
                unpack8(buf[j + HMAX + HA], tin); unpack8(buf[j + HA], tout);
#pragma unroll
                for (int e = 0; e < 8; ++e) sa[e] += tin[e] - tout[e];
            }
        }
    }
}
__device__ __forceinline__ void phase_pre(Frame& F, int l) {
    frame_refresh(F);
    const bf16* U = (const bf16*)(F.ws + WS_U);
    bf16* XBCA = (bf16*)(F.ws + WS_XBCA); bf16* RQK = (bf16*)(F.ws + WS_RQK); bf16* YB2 = (bf16*)(F.ws + WS_YB) + 2 * YS_STRIDE; bf16* POOLED = (bf16*)(F.ws + WS_POOLED);
    const float* ROPE = (const float*)(F.ws + WS_ROPE);
    const int gw = F.bid * NWAVES + F.wave, NGW = F.G * NWAVES, lane = F.lane;
    constexpr int NRB = M / 32;
    constexpr int T_CUM = (M / 64) * 2, T_XBC = NRB * 4, T_POOL = NRB * 2, T_ROPE = NRB;
    float* CUMA = (float*)(F.ws + WS_CUMA); float* DTA = (float*)(F.ws + WS_DTA); const float* DT = (const float*)(F.ws + WS_DT);
    for (int task = gw; task < T_CUM + T_XBC + T_POOL + T_ROPE; task += NGW) {
        int r = task;
        if (r < T_CUM) {
            const int blk = r >> 1, dir = r & 1, row = blk * 64 + (dir ? 63 - lane : lane);
            for (int hh = 0; hh < 16; ++hh) {
                const float dt = softplusf_(DT[(size_t)row * 16 + hh] + F.in[I_SSDDTB][(l * 2 + dir) * 16 + hh]);
                float cum = dt * -expf(F.in[I_SSDALOG][(l * 2 + dir) * 16 + hh]);
#pragma unroll
                for (int o = 1; o < 64; o <<= 1) { const float t = __shfl_up(cum, o); if (lane >= o) cum += t; }
                CUMA[(size_t)(dir * 16 + hh) * M + row] = cum; DTA[(size_t)(dir * 16 + hh) * M + row] = dt;
            }
            continue;
        }
        r -= T_CUM;
        if (r < T_XBC) {
            const int rb = r >> 2, cb = r & 3, c = cb * 512 + lane * 8, r0 = rb * 32; int s0, s1; seq_bounds(r0, s0, s1);
            float w0[8], w1[8], w2[8], bb[8];
            ld8f(F.in[I_SSDCW] + ((size_t)l * 3 + 0) * 2048 + c, w0); ld8f(F.in[I_SSDCW] + ((size_t)l * 3 + 1) * 2048 + c, w1); ld8f(F.in[I_SSDCW] + ((size_t)l * 3 + 2) * 2048 + c, w2); ld8f(F.in[I_SSDCB] + (size_t)l * 2048 + c, bb);
            v4u bufA[10], bufB[10];
#define XBC_LOAD(buf, r8_) do { _Pragma("unroll") for (int k = 0; k < 10; ++k) { const int s = (r8_) - 1 + k; buf[k] = ldrow(U, s, UC, U_XBC + c, s >= s0 && s < s1); } } while (0)
#define XBC_COMP(buf, r8_) do { _Pragma("unroll") for (int j = 0; j < 8; ++j) { \
                    float p[8], q[8], n[8], o[8]; unpack8(buf[j], p); unpack8(buf[j + 1], q); unpack8(buf[j + 2], n); \
                    _Pragma("unroll") for (int e = 0; e < 8; ++e) o[e] = siluf_(w0[e] * p[e] + w1[e] * q[e] + w2[e] * n[e] + bb[e]); \
                    *(v4u*)(XBCA + (size_t)((r8_) + j) * 2048 + c) = pack8(o); } } while (0)
            XBC_LOAD(bufA, r0);
            XBC_LOAD(bufB, r0 + 8);  XBC_COMP(bufA, r0);
            XBC_LOAD(bufA, r0 + 16); XBC_COMP(bufB, r0 + 8);
            XBC_LOAD(bufB, r0 + 24); XBC_COMP(bufA, r0 + 16);
            XBC_COMP(bufB, r0 + 24);
#undef XBC_LOAD
#undef XBC_COMP
            continue;
        }
        r -= T_XBC;
        if (r < T_POOL) {
            const int rb = r >> 1, cb = r & 1, c = cb * 512 + lane * 8, r0 = rb * 32; int s0, s1; seq_bounds(r0, s0, s1);
            const int grp = c >> 8, half = 1 << grp;
            if (cb == 0) pool_task<2>(U, POOLED, r0, s0, s1, c, half); else pool_task<8>(U, POOLED, r0, s0, s1, c, half);
            continue;
        }
        r -= T_POOL;
        {
            const int r0 = r * 32; int s0, s1; seq_bounds(r0, s0, s1);
            const int qk = lane >> 5, rem = lane & 31, head = rem >> 2, part = (rem >> 1) & 1, sub = rem & 1;
            const int c1 = head * 64 + part * 32 + sub * 8, c2 = c1 + 16; const float scl = qk == 0 ? 0.125f : 1.0f;
            const int ucol = (qk == 0 ? U_RQ : U_RK);
            for (int r8 = r0; r8 < r0 + 32; r8 += 8) {
                v4u b1[8], b2[8];
#pragma unroll
                for (int k = 0; k < 8; ++k) { b1[k] = ldrow(U, r8 + k, UC, ucol + c1, true); b2[k] = ldrow(U, r8 + k, UC, ucol + c2, true); }
#pragma unroll
                for (int k = 0; k < 8; ++k) {
                    const int rr = r8 + k; float x1[8], x2[8], o1[8], o2[8]; unpack8(b1[k], x1); unpack8(b2[k], x2);
                    if (rr < ML) {
                        const int t = rr - s0, pos = part == 0 ? (t >> 6) : (t & 63);
                        const float* rp = ROPE + (size_t)(pos * 16 + sub * 8) * 2;
#pragma unroll
                        for (int e = 0; e < 8; ++e) { const float cs = rp[2 * e], sn = rp[2 * e + 1]; o1[e] = (x1[e] * cs - x2[e] * sn) * scl; o2[e] = (x1[e] * sn + x2[e] * cs) * scl; }
                    } else {
#pragma unroll
                        for (int e = 0; e < 8; ++e) { o1[e] = x1[e] * scl; o2[e] = x2[e] * scl; }
                    }
                    *(v4u*)(RQK + (size_t)rr * 1024 + qk * 512 + c1) = pack8(o1); *(v4u*)(RQK + (size_t)rr * 1024 + qk * 512 + c2) = pack8(o2);
                }
            }
        }
    }
}

#define MFMA32(a, b, c) __builtin_amdgcn_mfma_f32_32x32x16_bf16((a), (b), (c), 0, 0, 0)
#define SCAN_BAR() do { asm volatile("s_waitcnt lgkmcnt(0)" ::: "memory"); __builtin_amdgcn_s_barrier(); asm volatile("" ::: "memory"); } while (0)
typedef short s16x4 __attribute__((ext_vector_type(4)));
__device__ __forceinline__ bf16x8 tr_frag(LAS unsigned char* tile, int rs, int c, int ks, int lane) {
    const int h = lane >> 5, blk = (lane >> 4) & 1, q = (lane & 15) >> 2, p = lane & 3;
    LAS unsigned char* a0 = tile + (16 * ks + 8 * h + q) * rs + (32 * c + 16 * blk + 4 * p) * 2;
    const s16x4 lo = __builtin_amdgcn_ds_read_tr16_b64_v4i16((LAS s16x4*)a0);
    const s16x4 hi = __builtin_amdgcn_ds_read_tr16_b64_v4i16((LAS s16x4*)(a0 + 4 * rs));
    return __builtin_shufflevector(lo, hi, 0, 1, 2, 3, 4, 5, 6, 7);
}
template <int DN, int DP, bool SSD>
__device__ __forceinline__ void scan_unit(Frame& F, int l, int b, int h, int dir) {
    frame_refresh(F);
    constexpr int RSQ = (DN + 8) * 2, RSK2 = DN * 2 + 64, RSV = DP * 2 + 64, RSJ = 72 * 2;
    constexpr int O_Q = 0, O_K = O_Q + 64 * RSQ, O_K2 = O_K + 64 * RSQ, O_V = O_K2 + 64 * RSK2, O_VW = O_V + 64 * RSV, O_S = O_VW + 64 * RSV, O_HST = O_S + 64 * RSJ, O_CUM = O_HST + DP * RSQ, O_END = O_CUM + 256;
    static_assert(O_END <= RING_BYTES, "scan LDS");
    LAS unsigned char* lds = F.lds;
    const int tid = F.tid, lane = F.lane, w = F.wave, r = lane & 31, hh = lane >> 5;
    const bf16* XBCA = (const bf16*)(F.ws + WS_XBCA); const bf16* RQK = (const bf16*)(F.ws + WS_RQK); const bf16* U = (const bf16*)(F.ws + WS_U);
    const float* CUMA = (const float*)(F.ws + WS_CUMA) + (size_t)(dir * 16 + h) * M; const float* DTA = (const float*)(F.ws + WS_DTA) + (size_t)(dir * 16 + h) * M;
    bf16* YS = (bf16*)(F.ws + WS_YS) + (size_t)((SSD ? 0 : 2) + dir) * YS_STRIDE;
    const int ycol = SSD ? h * 64 : h * 128;
    float la_const = 0.f;
    if (!SSD) la_const = -softplusf_(-F.in[I_RETDL][(l * 2 + dir) * 8 + h]);
    for (int i = tid; i < DP * RSQ / 16; i += 512) *(LAS v4u*)(lds + O_HST + i * 16) = (v4u){0u, 0u, 0u, 0u};
    f32x16 Hs;
#pragma unroll
    for (int i = 0; i < 16; ++i) Hs[i] = 0.f;
    const int tok8 = tid >> 3, ch8 = tid & 7, tok16 = tid >> 4, ch16 = tid & 15;
    constexpr int NPF = 2;
    v4u preb[NPF][5]; float pcum[NPF], pdt[NPF], pcl[NPF], pcw[NPF];
#pragma unroll
    for (int u = 0; u < NPF; ++u) { pcum[u] = 0.f; pdt[u] = 1.f; pcl[u] = 0.f; pcw[u] = 0.f;
#pragma unroll
        for (int k = 0; k < 5; ++k) preb[u][k] = (v4u){0u, 0u, 0u, 0u}; }
    auto row_of = [&](int st, int i) -> int {
        int base, sub;
        if (st < 4) { base = ML + b * CTX; sub = dir ? 3 - st : st; } else { base = b * SEQ; sub = dir ? 67 - st : st - 4; }
        return base + sub * 64 + (dir ? 63 - i : i);
    };
#define SCAN_PREFETCH(st_, pre, u_) do { \
        const int rn_ = row_of((st_), tok8), rw0_ = row_of((st_), tok16), rw1_ = row_of((st_), 32 + tok16); \
        if (SSD) { const int g = h >> 2; \
            pre[0] = *(const v4u*)(XBCA + (size_t)rn_ * 2048 + h * 64 + 8 * ch8); \
            pre[1] = *(const v4u*)(XBCA + (size_t)rw0_ * 2048 + 1024 + g * 128 + 8 * ch16); pre[2] = *(const v4u*)(XBCA + (size_t)rw1_ * 2048 + 1024 + g * 128 + 8 * ch16); \
            pre[3] = *(const v4u*)(XBCA + (size_t)rw0_ * 2048 + 1536 + g * 128 + 8 * ch16); pre[4] = *(const v4u*)(XBCA + (size_t)rw1_ * 2048 + 1536 + g * 128 + 8 * ch16); \
            pcum[u_] = CUMA[rn_]; pdt[u_] = DTA[rn_]; pcl[u_] = CUMA[row_of((st_), 63)]; pcw[u_] = CUMA[row_of((st_), lane)]; \
        } else { \
            pre[0] = *(const v4u*)(RQK + (size_t)rn_ * 1024 + h * 64 + 8 * ch8); pre[1] = *(const v4u*)(RQK + (size_t)rn_ * 1024 + 512 + h * 64 + 8 * ch8); \
            pre[2] = *(const v4u*)(U + (size_t)rw0_ * UC + U_RV + h * 128 + 8 * ch16); pre[3] = *(const v4u*)(U + (size_t)rw1_ * UC + U_RV + h * 128 + 8 * ch16); \
        } } while (0)
#pragma unroll
    for (int u = 0; u < NPF; ++u) SCAN_PREFETCH(u, preb[u], u);
    for (int st2 = 0; st2 < 68; st2 += NPF) {
#pragma unroll
    for (int u = 0; u < NPF; ++u) {
        const int st = st2 + u;
        v4u (&pre)[5] = preb[u];
        float clast;
        if (SSD) {
            clast = pcl[u];
            const float dtx = pdt[u], wx = __expf(clast - pcum[u]);
            float x[8], v[8], vw[8]; unpack8(pre[0], x);
#pragma unroll
            for (int e = 0; e < 8; ++e) { v[e] = x[e] * dtx; vw[e] = v[e] * wx; }
            *(LAS v4u*)(lds + O_V + tok8 * RSV + 16 * ch8) = pack8(v); *(LAS v4u*)(lds + O_VW + tok8 * RSV + 16 * ch8) = pack8(vw);
            *(LAS v4u*)(lds + O_K + tok16 * RSQ + 16 * ch16) = pre[1]; *(LAS v4u*)(lds + O_K + (32 + tok16) * RSQ + 16 * ch16) = pre[2];
            *(LAS v4u*)(lds + O_K2 + tok16 * RSK2 + 16 * ch16) = pre[1]; *(LAS v4u*)(lds + O_K2 + (32 + tok16) * RSK2 + 16 * ch16) = pre[2];
            *(LAS v4u*)(lds + O_Q + tok16 * RSQ + 16 * ch16) = pre[3]; *(LAS v4u*)(lds + O_Q + (32 + tok16) * RSQ + 16 * ch16) = pre[4];
            if (w == 0) *(LAS float*)(lds + O_CUM + 4 * lane) = pcw[u];
        } else {
            clast = la_const * 64.f;
            *(LAS v4u*)(lds + O_Q + tok8 * RSQ + 16 * ch8) = pre[0];
            *(LAS v4u*)(lds + O_K + tok8 * RSQ + 16 * ch8) = pre[1]; *(LAS v4u*)(lds + O_K2 + tok8 * RSK2 + 16 * ch8) = pre[1];
            const float w0 = __expf(la_const * (float)(63 - tok16)), w1 = __expf(la_const * (float)(31 - tok16));
            float v0[8], v1[8], q0[8], q1[8]; unpack8(pre[2], v0); unpack8(pre[3], v1);
#pragma unroll
            for (int e = 0; e < 8; ++e) { q0[e] = v0[e] * w0; q1[e] = v1[e] * w1; }
            *(LAS v4u*)(lds + O_V + tok16 * RSV + 16 * ch16) = pre[2]; *(LAS v4u*)(lds + O_V + (32 + tok16) * RSV + 16 * ch16) = pre[3];
            *(LAS v4u*)(lds + O_VW + tok16 * RSV + 16 * ch16) = pack8(q0); *(LAS v4u*)(lds + O_VW + (32 + tok16) * RSV + 16 * ch16) = pack8(q1);
            if (w == 0) *(LAS float*)(lds + O_CUM + 4 * lane) = la_const * (float)(lane + 1);
        }
        SCAN_BAR();
        if (st + NPF < 68) SCAN_PREFETCH(st + NPF, pre, u);
        const float dcy = __expf(clast);
        if (w < 4) {
            const int jb = w >> 1, ib = w & 1;
            f32x16 acc;
#pragma unroll
            for (int i = 0; i < 16; ++i) acc[i] = 0.f;
            if (!(jb == 1 && ib == 0)) {
                bf16x8 fa[DN / 16], fq[DN / 16];
#pragma unroll
                for (int kk = 0; kk < DN / 16; ++kk) {
                    fa[kk] = *(const LAS bf16x8*)(lds + O_K + (jb * 32 + r) * RSQ + (kk * 16 + 8 * hh) * 2);
                    fq[kk] = *(const LAS bf16x8*)(lds + O_Q + (ib * 32 + r) * RSQ + (kk * 16 + 8 * hh) * 2);
                }
                __builtin_amdgcn_sched_barrier(0);
#pragma unroll
                for (int kk = 0; kk < DN / 16; ++kk) acc = MFMA32(fa[kk], fq[kk], acc);
            }
            const int i = ib * 32 + r; const float ci = *(const LAS float*)(lds + O_CUM + 4 * i);
#pragma unroll
            for (int g4 = 0; g4 < 4; ++g4) {
                const int j0 = jb * 32 + 8 * g4 + 4 * hh; const f32x4 cj = *(const LAS f32x4*)(lds + O_CUM + 4 * j0);
                float v[4];
#pragma unroll
                for (int e = 0; e < 4; ++e) { const float cje = e == 0 ? cj.x : (e == 1 ? cj.y : (e == 2 ? cj.z : cj.w)); v[e] = (j0 + e <= i) ? acc[4 * g4 + e] * __expf(ci - cje) : 0.f; }
                v2u o; o.x = pk2(v[0], v[1]); o.y = pk2(v[2], v[3]);
                *(LAS v2u*)(lds + O_S + i * RSJ + j0 * 2) = o;
            }
        }
        SCAN_BAR();
        for (int blk = w; blk < (DP / 32) * 2; blk += 8) {
            const int pb = blk >> 1, ib = blk & 1;
            f32x16 a1, a2;
#pragma unroll
            for (int i = 0; i < 16; ++i) { a1[i] = 0.f; a2[i] = 0.f; }
            bf16x8 fv[4], fs[4], fh[DN / 16], fq[DN / 16];
#pragma unroll
            for (int kk = 0; kk < 4; ++kk) {
                fv[kk] = tr_frag(lds + O_V, RSV, pb, kk, lane);
                fs[kk] = *(const LAS bf16x8*)(lds + O_S + (ib * 32 + r) * RSJ + (kk * 16 + 8 * hh) * 2);
            }
#pragma unroll
            for (int kk = 0; kk < DN / 16; ++kk) {
                fh[kk] = *(const LAS bf16x8*)(lds + O_HST + (pb * 32 + r) * RSQ + (kk * 16 + 8 * hh) * 2);
                fq[kk] = *(const LAS bf16x8*)(lds + O_Q + (ib * 32 + r) * RSQ + (kk * 16 + 8 * hh) * 2);
            }
            __builtin_amdgcn_sched_barrier(0);
#pragma unroll
            for (int kk = 0; kk < 4; ++kk) a1 = MFMA32(fv[kk], fs[kk], a1);
#pragma unroll
            for (int kk = 0; kk < DN / 16; ++kk) a2 = MFMA32(fh[kk], fq[kk], a2);
            const int i = ib * 32 + r; const float ei = __expf(*(const LAS float*)(lds + O_CUM + 4 * i));
            const int row = row_of(st, i);
#pragma unroll
            for (int g4 = 0; g4 < 4; ++g4) {
                const int p0 = pb * 32 + 8 * g4 + 4 * hh;
                v2u o; o.x = pk2(a1[4 * g4 + 0] + ei * a2[4 * g4 + 0], a1[4 * g4 + 1] + ei * a2[4 * g4 + 1]); o.y = pk2(a1[4 * g4 + 2] + ei * a2[4 * g4 + 2], a1[4 * g4 + 3] + ei * a2[4 * g4 + 3]);
                *(v2u*)(YS + (size_t)row * 1024 + ycol + p0) = o;
            }
        }
        {
            const int nb = w / (DP / 32), pb = w % (DP / 32);
#pragma unroll
            for (int i = 0; i < 16; ++i) Hs[i] *= dcy;
            bf16x8 fk[4], fw[4];
#pragma unroll
            for (int kk = 0; kk < 4; ++kk) {
                fk[kk] = tr_frag(lds + O_K2, RSK2, nb, kk, lane);
                fw[kk] = tr_frag(lds + O_VW, RSV, pb, kk, lane);
            }
            __builtin_amdgcn_sched_barrier(0);
#pragma unroll
            for (int kk = 0; kk < 4; ++kk) Hs = MFMA32(fk[kk], fw[kk], Hs);
            SCAN_BAR();
#pragma unroll
            for (int g4 = 0; g4 < 4; ++g4) {
                const int n0 = nb * 32 + 8 * g4 + 4 * hh;
                v2u o; o.x = pk2(Hs[4 * g4 + 0], Hs[4 * g4 + 1]); o.y = pk2(Hs[4 * g4 + 2], Hs[4 * g4 + 3]);
                *(LAS v2u*)(lds + O_HST + (pb * 32 + r) * RSQ + n0 * 2) = o;
            }
        }
    }
    }
    __syncthreads();
#undef SCAN_PREFETCH
}

__device__ __forceinline__ void phase_fin(Frame& F, int l, int nrows) {
    frame_refresh(F);
    const bf16* U = (const bf16*)(F.ws + WS_U); const bf16* YS = (const bf16*)(F.ws + WS_YS); bf16* YB = (bf16*)(F.ws + WS_YB);
    const float* nw = F.in[I_SSDNW] + (size_t)l * 1024; const float* dskp = F.in[I_SSDD] + (size_t)l * 16; const bf16* XBCA = (const bf16*)(F.ws + WS_XBCA);
    const int gw = F.bid * NWAVES + F.wave, NGW = F.G * NWAVES, lane = F.lane;
    for (int row = gw; row < nrows; row += NGW) {
        {
            float g[2][8]; float ss = 0.f;
#pragma unroll
            for (int k = 0; k < 2; ++k) { const int c = k * 512 + 8 * lane; float yf[8], yb[8], z[8];
                unpack8(*(const v4u*)(YS + (size_t)row * 1024 + c), yf); unpack8(*(const v4u*)(YS + YS_STRIDE + (size_t)row * 1024 + c), yb); unpack8(*(const v4u*)(U + (size_t)row * UC + U_Z + c), z);
                float xs[8]; unpack8(*(const v4u*)(XBCA + (size_t)row * 2048 + c), xs); const float dsk = dskp[c >> 6];
#pragma unroll
                for (int e = 0; e < 8; ++e) { g[k][e] = (yf[e] + yb[e] + dsk * xs[e]) * siluf_(z[e]); ss += g[k][e] * g[k][e]; } }
            const float rs = rsqrtf(wave_sum(ss) * (1.0f / 1024.0f) + EPS);
#pragma unroll
            for (int k = 0; k < 2; ++k) { const int c = k * 512 + 8 * lane; float wv[8], o[8]; ld8f(nw + c, wv);
#pragma unroll
                for (int e = 0; e < 8; ++e) o[e] = g[k][e] * rs * wv[e];
                *(v4u*)(YB + (size_t)row * 1024 + c) = pack8(o); }
        }
        {
            const int c = 16 * lane; float v[16];
            { float a[8], b2[8]; unpack8(*(const v4u*)(YS + 2 * YS_STRIDE + (size_t)row * 1024 + c), a); unpack8(*(const v4u*)(YS + 3 * YS_STRIDE + (size_t)row * 1024 + c), b2);
#pragma unroll
              for (int e = 0; e < 8; ++e) v[e] = a[e] + b2[e];
              unpack8(*(const v4u*)(YS + 2 * YS_STRIDE + (size_t)row * 1024 + c + 8), a); unpack8(*(const v4u*)(YS + 3 * YS_STRIDE + (size_t)row * 1024 + c + 8), b2);
#pragma unroll
              for (int e = 0; e < 8; ++e) v[8 + e] = a[e] + b2[e]; }
            float s = 0.f;
#pragma unroll
            for (int e = 0; e < 16; ++e) s += v[e];
            s += __shfl_xor(s, 1); s += __shfl_xor(s, 2); s += __shfl_xor(s, 4);
            const float mu = s * (1.0f / 128.0f); float q = 0.f;
#pragma unroll
            for (int e = 0; e < 16; ++e) { v[e] -= mu; q += v[e] * v[e]; }
            q += __shfl_xor(q, 1); q += __shfl_xor(q, 2); q += __shfl_xor(q, 4);
            const float rs = rsqrtf(q * (1.0f / 128.0f) + EPS);
            float g0[8], g1[8], o0[8], o1[8]; unpack8(*(const v4u*)(U + (size_t)row * UC + U_RG + c), g0); unpack8(*(const v4u*)(U + (size_t)row * UC + U_RG + c + 8), g1);
#pragma unroll
            for (int e = 0; e < 8; ++e) { o0[e] = siluf_(g0[e]) * v[e] * rs; o1[e] = siluf_(g1[e]) * v[8 + e] * rs; }
            *(v4u*)(YB + 3 * YS_STRIDE + (size_t)row * 1024 + c) = pack8(o0); *(v4u*)(YB + 3 * YS_STRIDE + (size_t)row * 1024 + c + 8) = pack8(o1);
        }
    }
}

__device__ __forceinline__ size_t act_off(int row, int col) { return (size_t)(row >> 8) * (256 * DFF) + (size_t)(col >> 6) * (256 * 64) + (size_t)((row & 255) * 64 + (col & 63)); }
__device__ __forceinline__ v4u ldedge(const bf16* EDGE, int blk, int j, int h, int c, bool ok) { return ok ? *(const v4u*)(EDGE + ((size_t)(blk * 4 + j) * 2 + h) * DFF + c) : (v4u){0u, 0u, 0u, 0u}; }
__device__ __forceinline__ void phase_ffnfix(Frame& F, int l, int nrows) {
    frame_refresh(F);
    const bf16* EDGE = (const bf16*)(F.ws + WS_UP); bf16* ACT = (bf16*)(F.ws + WS_ACT);
    const int gw = F.bid * NWAVES + F.wave, NGW = F.G * NWAVES, lane = F.lane;
    const int ntask = (nrows / 64) * 11;
    for (int task = gw; task < ntask; task += NGW) {
        const int blk = task / 11, cb = task % 11, c = cb * 512 + lane * 8, r0 = blk * 64; int s0, s1; seq_bounds(r0, s0, s1);
        const bool hp = r0 > s0, hn = r0 + 64 < s1;
        float wa0[8], wa1[8], wa2[8], ba[8], wb0[8], wb1[8], wb2[8], bb[8];
        const float* cw = F.in[I_FFNCW] + (size_t)l * 3 * UPC; const float* cbp = F.in[I_FFNCB] + (size_t)l * UPC;
        v4u ra[6], rb[6];
        ra[0] = ldedge(EDGE, blk - 1, 3, 0, c, hp); ra[1] = ldedge(EDGE, blk, 0, 0, c, true); ra[2] = ldedge(EDGE, blk, 1, 0, c, true);
        ra[3] = ldedge(EDGE, blk, 2, 0, c, true); ra[4] = ldedge(EDGE, blk, 3, 0, c, true); ra[5] = ldedge(EDGE, blk + 1, 0, 0, c, hn);
        rb[0] = ldedge(EDGE, blk - 1, 3, 1, c, hp); rb[1] = ldedge(EDGE, blk, 0, 1, c, true); rb[2] = ldedge(EDGE, blk, 1, 1, c, true);
        rb[3] = ldedge(EDGE, blk, 2, 1, c, true); rb[4] = ldedge(EDGE, blk, 3, 1, c, true); rb[5] = ldedge(EDGE, blk + 1, 0, 1, c, hn);
        ld8f(cw + c, wa0); ld8f(cw + UPC + c, wa1); ld8f(cw + 2 * UPC + c, wa2); ld8f(cbp + c, ba);
        ld8f(cw + DFF + c, wb0); ld8f(cw + UPC + DFF + c, wb1); ld8f(cw + 2 * UPC + DFF + c, wb2); ld8f(cbp + DFF + c, bb);
#pragma unroll
        for (int j = 0; j < 2; ++j) {
            float p[8], q[8], n[8], o[8], a[8];
            unpack8(ra[3 * j], p); unpack8(ra[3 * j + 1], q); unpack8(ra[3 * j + 2], n);
#pragma unroll
            for (int e = 0; e < 8; ++e) a[e] = siluf_(wa0[e] * p[e] + wa1[e] * q[e] + wa2[e] * n[e] + ba[e]);
            unpack8(rb[3 * j], p); unpack8(rb[3 * j + 1], q); unpack8(rb[3 * j + 2], n);
#pragma unroll
            for (int e = 0; e < 8; ++e) o[e] = a[e] * (wb0[e] * p[e] + wb1[e] * q[e] + wb2[e] * n[e] + bb[e]);
            *(v4u*)(ACT + act_off(r0 + 63 * j, c)) = pack8(o);
        }
    }
}

using pg8::f32x4; using pg8::Unit; using pg8::HALF; using pg8::BM;
__device__ __forceinline__ size_t gate_off(int pm, int gt, int wave, int frag, int lane) { return ((((size_t)pm * 32 + gt) * 8 + wave) * 16 + frag) * 512 + (size_t)lane * 8; }
struct EpiInGate {
    static constexpr bool PERM = true, CHAIN = false;
    bf16* U; float* DT; unsigned char* G; const float* bg; int pn0;
    __device__ __forceinline__ void operator()(const f32x4 (&acc)[2][2][4][2], const Unit& u, int wr, int wc, int fr, int fq) const {
        const int row0 = u.pm * BM + wr * 64 + fr, pn = u.pn + pn0;
        if (pn < 40) {
            const int col0 = pn * BM + wc * 32 + 8 * fq;
#pragma unroll
            for (int ai = 0; ai < 2; ++ai)
#pragma unroll
                for (int m = 0; m < 4; ++m) { bf16* rowp = U + (size_t)(row0 + ai * HALF + m * 16) * UC + col0;
#pragma unroll
                    for (int bj = 0; bj < 2; ++bj) { const f32x4 v0 = acc[ai][bj][m][0], v1 = acc[ai][bj][m][1];
                        v4u w; w.x = pg8::cvt_pk_bf16(v0[0], v0[1]); w.y = pg8::cvt_pk_bf16(v0[2], v0[3]); w.z = pg8::cvt_pk_bf16(v1[0], v1[1]); w.w = pg8::cvt_pk_bf16(v1[2], v1[3]);
                        *(v4u*)(rowp + bj * HALF) = w; } }
        } else if (pn == 40) {
            if (wc == 0 && fq < 2) {
#pragma unroll
                for (int ai = 0; ai < 2; ++ai)
#pragma unroll
                    for (int m = 0; m < 4; ++m) { float* rp = DT + (size_t)(row0 + ai * HALF + m * 16) * 16 + 8 * fq; *(f32x4*)rp = acc[ai][0][m][0]; *(f32x4*)(rp + 4) = acc[ai][0][m][1]; }
            }
        } else {
            const int col0 = (pn - 41) * BM + wc * 32 + 8 * fq;
            f32x4 bv[2][2];
#pragma unroll
            for (int bj = 0; bj < 2; ++bj)
#pragma unroll
                for (int n = 0; n < 2; ++n) bv[bj][n] = *(const f32x4*)(bg + col0 + bj * HALF + 4 * n) * -1.44269504f;
            constexpr float QC = 1.0f / 255.99f;
#pragma unroll
            for (int ai = 0; ai < 2; ++ai)
#pragma unroll
                for (int m = 0; m < 4; ++m) { unsigned char* rowp = G + gate_off(u.pm, pn - 41, wr * 4 + wc, ai * 8 + m * 2, fq * 16 + fr);
#pragma unroll
                    for (int bj = 0; bj < 2; ++bj) {
                        unsigned q[8];
#pragma unroll
                        for (int e = 0; e < 4; ++e) {
                            const float e0 = __builtin_amdgcn_exp2f(__builtin_fmaf(acc[ai][bj][m][0][e], -1.44269504f, bv[bj][0][e])), e1 = __builtin_amdgcn_exp2f(__builtin_fmaf(acc[ai][bj][m][1][e], -1.44269504f, bv[bj][1][e]));
                            q[e] = (unsigned)__builtin_amdgcn_rcpf(__builtin_fmaf(e0, QC, QC)); q[4 + e] = (unsigned)__builtin_amdgcn_rcpf(__builtin_fmaf(e1, QC, QC)); }
                        v2u w; w.x = q[0] | (q[1] << 8) | (q[2] << 16) | (q[3] << 24); w.y = q[4] | (q[5] << 8) | (q[6] << 16) | (q[7] << 24);
                        *(v2u*)(rowp + bj * 512) = w; } }
        }
    }
};
template <bool SCALE> struct EpiBf16 {
    static constexpr bool PERM = true, CHAIN = false;
    bf16* O; int ldc; const float* scale;
    __device__ __forceinline__ int operator()(const f32x4 (&acc)[2][2][4][2], const Unit& u, int wr, int wc, int fr, int fq) const {
        const int row0 = u.pm * BM + wr * 64 + fr, col0 = u.pn * BM + wc * 32 + 8 * fq;
        f32x4 sv[2][2];
        if (SCALE) {
#pragma unroll
            for (int bj = 0; bj < 2; ++bj)
#pragma unroll
                for (int n = 0; n < 2; ++n) sv[bj][n] = *(const f32x4*)(scale + col0 + bj * HALF + 4 * n);
        }
#pragma unroll
        for (int ai = 0; ai < 2; ++ai)
#pragma unroll
            for (int m = 0; m < 4; ++m) { bf16* rowp = O + (size_t)(row0 + ai * HALF + m * 16) * ldc + col0;
#pragma unroll
                for (int bj = 0; bj < 2; ++bj) { f32x4 v0 = acc[ai][bj][m][0], v1 = acc[ai][bj][m][1];
                    if (SCALE) { v0 = v0 * sv[bj][0]; v1 = v1 * sv[bj][1]; }
                    v4u w; w.x = pg8::cvt_pk_bf16(v0[0], v0[1]); w.y = pg8::cvt_pk_bf16(v0[2], v0[3]); w.z = pg8::cvt_pk_bf16(v1[0], v1[1]); w.w = pg8::cvt_pk_bf16(v1[2], v1[3]);
                    *(v4u*)(rowp + bj * HALF) = w; } }
        return 16;
    }
};
struct EpiFfn {
    static constexpr bool PERM = true, CHAIN = false;
    bf16* ACT; bf16* EDGE; const float* cw; const float* cb;
    template <int CTRL> static __device__ __forceinline__ float dpp(float x) { return __builtin_bit_cast(float, __builtin_amdgcn_update_dpp(0, __builtin_bit_cast(int, x), CTRL, 0xf, 0xf, true)); }
    template <int M> static __device__ __forceinline__ f32x4 conv4(const f32x4 (&x)[4][2], int n, const f32x4 (&w)[4], const f32x4 we0, const f32x4 we2) {
        f32x4 r;
#pragma unroll
        for (int e = 0; e < 4; ++e) { const float c = x[M][n][e];
            float t = __builtin_fmaf(w[1][e], c, w[3][e]);
            t = __builtin_fmaf(w[0][e], dpp<0x111>(c), t);
            t = __builtin_fmaf(w[2][e], dpp<0x101>(c), t);
            if (M > 0) t = __builtin_fmaf(we0[e], dpp<0x121>(x[M > 0 ? M - 1 : 0][n][e]), t);
            if (M < 3) t = __builtin_fmaf(we2[e], dpp<0x12f>(x[M < 3 ? M + 1 : 3][n][e]), t);
            r[e] = t; }
        return r;
    }
    template <int M> __device__ __forceinline__ v2u act4(const f32x4 (&xa)[4][2], const f32x4 (&xb)[4][2], int n, const f32x4 (&wa)[4], const f32x4 (&wb)[4], const f32x4 wae0, const f32x4 wae2, const f32x4 wbe0, const f32x4 wbe2) const {
        const f32x4 va = conv4<M>(xa, n, wa, wae0, wae2), vb = conv4<M>(xb, n, wb, wbe0, wbe2);
        float o[4];
#pragma unroll
        for (int e = 0; e < 4; ++e) o[e] = va[e] * __builtin_amdgcn_rcpf(1.0f + __builtin_amdgcn_exp2f(va[e] * -1.44269504f)) * vb[e];
        v2u r; r.x = pk2(o[0], o[1]); r.y = pk2(o[2], o[3]); return r;
    }
    __device__ __forceinline__ void operator()(const f32x4 (&acc)[2][2][4][2], const Unit& u, int wr, int wc, int fr, int fq) const {
        const int row0 = u.pm * BM + wr * 64 + fr, c0 = u.pn * 128 + wc * 32 + 8 * fq;
        const float e0 = fr == 0 ? 1.f : 0.f, e15 = fr == 15 ? 1.f : 0.f;
#pragma unroll
        for (int ai = 0; ai < 2; ++ai) {
            const int blk = u.pm * 4 + ai * 2 + wr;
            if (fr < 2 || fr >= 14) {
                const int j = fr < 2 ? fr : fr - 12;
                const f32x4 a0 = fr < 2 ? acc[ai][0][0][0] : acc[ai][0][3][0], a1 = fr < 2 ? acc[ai][0][0][1] : acc[ai][0][3][1];
                const f32x4 b0 = fr < 2 ? acc[ai][1][0][0] : acc[ai][1][3][0], b1 = fr < 2 ? acc[ai][1][0][1] : acc[ai][1][3][1];
                bf16* ep = EDGE + ((size_t)(blk * 4 + j) * 2) * DFF + c0;
                v4u w; w.x = pk2(a0[0], a0[1]); w.y = pk2(a0[2], a0[3]); w.z = pk2(a1[0], a1[1]); w.w = pk2(a1[2], a1[3]); *(v4u*)ep = w;
                w.x = pk2(b0[0], b0[1]); w.y = pk2(b0[2], b0[3]); w.z = pk2(b1[0], b1[1]); w.w = pk2(b1[2], b1[3]); *(v4u*)(ep + DFF) = w;
            }
        }
        __builtin_amdgcn_sched_barrier(0);
#pragma unroll
        for (int n = 0; n < 2; ++n) {
            f32x4 wa[4], wb[4];
#pragma unroll
            for (int k = 0; k < 3; ++k) { wa[k] = *(const f32x4*)(cw + k * UPC + c0 + 4 * n); wb[k] = *(const f32x4*)(cw + k * UPC + DFF + c0 + 4 * n); }
            wa[3] = *(const f32x4*)(cb + c0 + 4 * n); wb[3] = *(const f32x4*)(cb + DFF + c0 + 4 * n);
            const f32x4 wae0 = wa[0] * e0, wae2 = wa[2] * e15, wbe0 = wb[0] * e0, wbe2 = wb[2] * e15;
#pragma unroll
            for (int ai = 0; ai < 2; ++ai) {
                v2u r[4];
                r[0] = act4<0>(acc[ai][0], acc[ai][1], n, wa, wb, wae0, wae2, wbe0, wbe2); r[1] = act4<1>(acc[ai][0], acc[ai][1], n, wa, wb, wae0, wae2, wbe0, wbe2);
                r[2] = act4<2>(acc[ai][0], acc[ai][1], n, wa, wb, wae0, wae2, wbe0, wbe2); r[3] = act4<3>(acc[ai][0], acc[ai][1], n, wa, wb, wae0, wae2, wbe0, wbe2);
#pragma unroll
                for (int m = 0; m < 4; ++m) *(v2u*)(ACT + act_off(row0 + ai * HALF + m * 16, c0 + 4 * n)) = r[m];
            }
            __builtin_amdgcn_sched_barrier(0);
        }
    }
};
struct EpiBranch {
    static constexpr bool PERM = true, CHAIN = true;
    const unsigned char* G; bf16* MERGED; int skip;
    static __device__ __forceinline__ void deq8(const v2u w, float (&g)[8]) {
        g[0] = (float)(w.x & 0xffu); g[1] = (float)((w.x >> 8) & 0xffu); g[2] = (float)((w.x >> 16) & 0xffu); g[3] = (float)(w.x >> 24);
        g[4] = (float)(w.y & 0xffu); g[5] = (float)((w.y >> 8) & 0xffu); g[6] = (float)((w.y >> 16) & 0xffu); g[7] = (float)(w.y >> 24);
#pragma unroll
        for (int e = 0; e < 8; ++e) g[e] = (g[e] + 0.5f) * (1.0f / 256.0f);
    }
    static __device__ __forceinline__ void deqs(const v2u w, float (&g)[8], float sc) {
        g[0] = (float)(w.x & 0xffu); g[1] = (float)((w.x >> 8) & 0xffu); g[2] = (float)((w.x >> 16) & 0xffu); g[3] = (float)(w.x >> 24);
        g[4] = (float)(w.y & 0xffu); g[5] = (float)((w.y >> 8) & 0xffu); g[6] = (float)((w.y >> 16) & 0xffu); g[7] = (float)(w.y >> 24);
        const float hb = 0.5f * sc;
#pragma unroll
        for (int e = 0; e < 8; ++e) g[e] = __builtin_fmaf(g[e], sc, hb);
    }
    __device__ __forceinline__ bool operator()(f32x4 (&acc)[2][2][4][2], const Unit& u, int wr, int wc, int fr, int fq) const {
        const int row0 = u.pm * BM + wr * 64 + fr, col0 = u.pn * BM + wc * 32 + 8 * fq, sub = u.sub;
        const int subn = sub < 3 ? sub + 1 : sub;
        if (skip) return sub == 3;
        const int wave = wr * 4 + wc, ln = fq * 16 + fr;
        const bool last = sub == 3;
        const float sg = last ? 127.5f / 65536.0f : 1.0f / 256.0f;
        v2u gv[2][4][2], hv[2][4][2];
#pragma unroll
        for (int ai = 0; ai < 2; ++ai)
#pragma unroll
            for (int m = 0; m < 4; ++m)
#pragma unroll
                for (int bj = 0; bj < 2; ++bj) { gv[ai][m][bj] = *(const v2u*)(G + gate_off(u.pm, sub * 8 + u.pn, wave, ai * 8 + m * 2 + bj, ln)); hv[ai][m][bj] = *(const v2u*)(G + gate_off(u.pm, subn * 8 + u.pn, wave, ai * 8 + m * 2 + bj, ln)); }
        __builtin_amdgcn_sched_barrier(0);
#pragma unroll
        for (int ai = 0; ai < 2; ++ai)
#pragma unroll
            for (int m = 0; m < 4; ++m)
#pragma unroll
                for (int bj = 0; bj < 2; ++bj) {
                    v2u hw = hv[ai][m][bj]; if (last) { hw.x = 0x7f7f7f7fu; hw.y = 0x7f7f7f7fu; }
                    float g[8], h[8]; deqs(gv[ai][m][bj], g, sg); deqs(hw, h, 1.0f / 256.0f);
#pragma unroll
                    for (int e = 0; e < 8; ++e) g[e] = g[e] * __builtin_amdgcn_rcpf(h[e]);
                    f32x4& v0 = acc[ai][bj][m][0]; f32x4& v1 = acc[ai][bj][m][1];
                    v0[0] *= g[0]; v0[1] *= g[1]; v0[2] *= g[2]; v0[3] *= g[3]; v1[0] *= g[4]; v1[1] *= g[5]; v1[2] *= g[6]; v1[3] *= g[7];
                    if (bj == 1) __builtin_amdgcn_sched_barrier(0);
                }
        if (last) {
#pragma unroll
            for (int ai = 0; ai < 2; ++ai)
#pragma unroll
                for (int m = 0; m < 4; ++m)
#pragma unroll
                    for (int bj = 0; bj < 2; ++bj) {
                        const f32x4 v0 = acc[ai][bj][m][0], v1 = acc[ai][bj][m][1];
                        v4u w; w.x = pg8::cvt_pk_bf16(v0[0], v0[1]); w.y = pg8::cvt_pk_bf16(v0[2], v0[3]); w.z = pg8::cvt_pk_bf16(v1[0], v1[1]); w.w = pg8::cvt_pk_bf16(v1[2], v1[3]);
                        *(v4u*)(MERGED + (size_t)(row0 + ai * HALF + m * 16) * 2048 + col0 + bj * HALF) = w;
                    }
        }
        return last;
    }
};
struct EpiResid {
    static constexpr bool PERM = false, CHAIN = false;
    float* X; const float* modl; int goff, skip;
    __device__ __forceinline__ void operator()(const f32x4 (&acc)[2][2][4][2], const Unit& u, int wr, int wc, int fr, int fq) const {
        if (skip) return;
        const int row0 = u.pm * BM + wr * 64 + fr, col0 = u.pn * BM + wc * 32 + 4 * fq;
        const float* gp = modl + (size_t)(u.pm < 64 ? (u.pm >> 4) : 4) * 12288 + goff + col0;
        f32x4 gv[2][2];
#pragma unroll
        for (int bj = 0; bj < 2; ++bj)
#pragma unroll
            for (int n = 0; n < 2; ++n) gv[bj][n] = *(const f32x4*)(gp + bj * HALF + n * 16);
#pragma unroll
        for (int ai = 0; ai < 2; ++ai) {
            f32x4 xv[4][2][2];
#pragma unroll
            for (int m = 0; m < 4; ++m)
#pragma unroll
                for (int bj = 0; bj < 2; ++bj)
#pragma unroll
                    for (int n = 0; n < 2; ++n) xv[m][bj][n] = *(const f32x4*)(X + (size_t)(row0 + ai * HALF + m * 16) * D + col0 + bj * HALF + n * 16);
#pragma unroll
            for (int m = 0; m < 4; ++m)
#pragma unroll
                for (int bj = 0; bj < 2; ++bj)
#pragma unroll
                    for (int n = 0; n < 2; ++n) *(f32x4*)(X + (size_t)(row0 + ai * HALF + m * 16) * D + col0 + bj * HALF + n * 16) = xv[m][bj][n] + gv[bj][n] * acc[ai][bj][m][n];
        }
    }
};

struct EpiPart {
    static constexpr bool PERM = false, CHAIN = false;
    float* PART; const float* modl; int goff;
    __device__ __forceinline__ int operator()(const f32x4 (&acc)[2][2][4][2], const Unit& u, int wr, int wc, int fr, int fq) const {
        const int row0 = (u.pm - 64) * BM + wr * 64 + fr, col0 = u.pn * BM + wc * 32 + 4 * fq;
        const float* gp = modl + (size_t)4 * 12288 + goff + col0;
        float* P = PART + (size_t)u.sub * MC * D;
        f32x4 gv[2][2];
#pragma unroll
        for (int bj = 0; bj < 2; ++bj)
#pragma unroll
            for (int n = 0; n < 2; ++n) gv[bj][n] = *(const f32x4*)(gp + bj * HALF + n * 16);
#pragma unroll
        for (int ai = 0; ai < 2; ++ai)
#pragma unroll
            for (int m = 0; m < 4; ++m)
#pragma unroll
                for (int bj = 0; bj < 2; ++bj)
#pragma unroll
                    for (int n = 0; n < 2; ++n) *(f32x4*)(P + (size_t)(row0 + ai * HALF + m * 16) * D + col0 + bj * HALF + n * 16) = gv[bj][n] * acc[ai][bj][m][n];
        return 32;
    }
};

constexpr int NPH = 11;
constexpr int N_PHASES = 1 + DEPTH * NPH + 1;

__global__ void __launch_bounds__(NWAVES * 64, 2) fwd_kernel(Args args) {
    extern __shared__ __attribute__((aligned(16))) unsigned char lds_raw[];
    Frame F;
    F.lds = (LAS unsigned char*)lds_raw;
    F.tid = threadIdx.x; F.lane = F.tid & 63; F.wave = __builtin_amdgcn_readfirstlane(F.tid >> 6);
    F.G = gridDim.x; F.bid = blockIdx.x; F.ws = args.ws; F.in = args.in;
#if defined(PROBE_K)
    F.variant = args.variant;
#else
    F.variant = 0;
#endif
    gu32* ctl = (gu32*)(args.ws + WS_CTL);
    for (int u = F.tid; u < (LDS_BYTES - LDSCTL_OFF) / 4; u += NWAVES * 64) ((LAS unsigned*)(F.lds + LDSCTL_OFF))[u] = 0u;
    __syncthreads();
    XcdBarrier bar; bar.bar = (unsigned*)(ctl + CW_BAR); bar.x = 0; bar.st = nullptr;
    if (!MK_PER_PHASE && args.ph_hi - args.ph_lo > 1) bar = xcd_barrier_post((unsigned*)(ctl + CW_BAR), (volatile LAS unsigned*)(F.lds + MISC_OFF) + 8);
    const int lo = args.ph_lo, hi = args.ph_hi;
#ifndef PH_MASK
#define PH_MASK 0xFFFF
#endif
#define EN(b) (((PH_MASK) >> (b)) & 1)
#define IN(k) (lo <= (k) && (k) < hi)
#define SEAM(k) do { if (!MK_PER_PHASE && IN((k) + 1)) xcd_barrier(bar); } while (0)

    if (EN(11) && IN(0)) { phase_mod(F); steal_convert(F, 0, 0, true); SEAM(0); }

    for (int l = 0; l < DEPTH; ++l) {
        const int p0 = 1 + l * NPH;
        const int nrows = (l == DEPTH - 1) ? ML : M;
        const int nMp = nrows / 256;
        const float* modl = (const float*)(F.ws + WS_MOD) + (size_t)l * 5 * 12288;
        const unsigned char* wb = F.ws + (size_t)(l & 1) * W_SPAN;
        const bool cv = l + 1 < DEPTH;
        if (EN(0) && IN(p0 + 0)) {
            if (l == 0) phase_norm<true>(F, l, F.in[I_NORM1] + (size_t)l * D, 0, 2048, M);
            else phase_norm<false>(F, l, F.in[I_NORM1] + (size_t)l * D, 0, 2048, M, true);
            SEAM(p0 + 0);
        }
        if (EN(1) && IN(p0 + 1)) {
            const bool two = (nrows == ML);
            {
                pg8::Gemm g{(const char*)(F.ws + WS_H), (const char*)(wb + WS_WIG), (size_t)256 * D * 2, 0, 0, (size_t)256 * D * 2, 0, D, D, D};
                pg8::TileOrder<1> S; S.init(M / 256, two ? 41 : NIG / 256, F.G, F.bid);
                EpiInGate E{(bf16*)(F.ws + WS_U), (float*)(F.ws + WS_DT), (unsigned char*)(F.ws + WS_G), F.in[I_BGATE] + (size_t)l * 4 * 2048, 0};
                pg8::gemm_phase(F.lds + RING_OFF, g, S, E);
            }
            if (two) {
                pg8::Gemm g{(const char*)(F.ws + WS_H), (const char*)(wb + WS_WIG) + (size_t)41 * 256 * D * 2, (size_t)256 * D * 2, 0, 0, (size_t)256 * D * 2, 0, D, D, D};
                pg8::TileOrder<1> S; S.init(ML / 256, 32, F.G, F.bid);
                EpiInGate E{(bf16*)(F.ws + WS_U), (float*)(F.ws + WS_DT), (unsigned char*)(F.ws + WS_G), F.in[I_BGATE] + (size_t)l * 4 * 2048, 41};
                pg8::gemm_phase(F.lds + RING_OFF, g, S, E);
            }
            if (cv) steal_convert(F, l + 1, 1 + l * 6 + 0, false);
            SEAM(p0 + 1);
        }
        if (EN(2) && IN(p0 + 2)) { phase_pre(F, l); SEAM(p0 + 2); }
        if (EN(3) && IN(p0 + 3)) {
            const int nscan = 192;
            const bool split = F.G > nscan;
            for (int id = F.bid; id < nscan; id += F.G) {
#ifndef NO_SSD
                if (id < 128) scan_unit<128, 64, true>(F, l, id >> 5, (id >> 1) & 15, id & 1);
                else
#endif
#ifndef NO_RET
                { const int j = id - 128; scan_unit<64, 128, false>(F, l, j >> 4, (j >> 1) & 7, j & 1); }
#else
                {}
#endif
            }
#ifndef NO_POOLG
            if (!split || F.bid >= nscan) {
                pg8::Gemm g{(const char*)(F.ws + WS_POOLED), (const char*)(wb + WS_WPOOL), (size_t)256 * 1024 * 2, (size_t)256 * 2, 0, (size_t)256 * 256 * 2, 0, 1024, 256, 256};
                pg8::TileOrder<1> S; S.init(M / 256, 4, split ? F.G - nscan : F.G, split ? F.bid - nscan : F.bid);
                EpiBf16<true> E{(bf16*)(F.ws + WS_YB) + YS_STRIDE, 1024, F.in[I_POOLS] + (size_t)l * 1024};
                pg8::gemm_phase(F.lds + RING_OFF, g, S, E);
                sc_phase(F, l, split ? F.bid - nscan : F.bid, split ? F.G - nscan : F.G);
            }
            if (cv) steal_convert(F, l + 1, 1 + l * 6 + 5, false);
#endif
            SEAM(p0 + 3);
        }
        if (EN(4) && IN(p0 + 4)) { phase_fin(F, l, nrows); SEAM(p0 + 4); }
        if (EN(5) && IN(p0 + 5)) {
            pg8::Gemm g{(const char*)(F.ws + WS_YB), (const char*)(wb + WS_WB), (size_t)256 * 1024 * 2, 0, YS_STRIDE * 2, (size_t)256 * 1024 * 2, (size_t)2048 * 1024 * 2, 1024, 1024, 1024};
            pg8::TileOrder<4> S; S.init(nMp, D / 256, F.G, F.bid, 8);
            EpiBranch E{(const unsigned char*)(F.ws + WS_G), (bf16*)(F.ws + WS_MERGED), F.variant & 128};
            pg8::gemm_phase(F.lds + RING_OFF, g, S, E);
            if (cv) steal_convert(F, l + 1, 1 + l * 6 + 1, false);
            SEAM(p0 + 5);
        }
        if (EN(6) && IN(p0 + 6)) {
            pg8::Gemm g{(const char*)(F.ws + WS_MERGED), (const char*)(wb + WS_WO), (size_t)256 * D * 2, 0, 0, (size_t)256 * D * 2, 0, D, D, D};
            pg8::TileOrder<1> S; S.init(ML / 256, D / 256, F.G, F.bid);
            EpiResid E{(float*)(F.ws + WS_X), modl, 4096, F.variant & 128};
            pg8::gemm_phase(F.lds + RING_OFF, g, S, E);
            if (nMp > ML / 256) {
                pg8::Gemm g2{(const char*)(F.ws + WS_MERGED), (const char*)(wb + WS_WO), (size_t)256 * D * 2, 0, (size_t)(D / 4) * 2, (size_t)256 * D * 2, (size_t)(D / 4) * 2, D, D, D / 4};
                pg8::SplitOrder<4> S2; S2.init(nMp - ML / 256, D / 256, ML / 256, F.G, F.bid);
                EpiPart E2{(float*)(F.ws + WS_PART), modl, 4096};
                pg8::gemm_phase(F.lds + RING_OFF, g2, S2, E2);
            }
            if (cv) steal_convert(F, l + 1, 1 + l * 6 + 2, false);
            SEAM(p0 + 6);
        }
        if (EN(7) && IN(p0 + 7)) { phase_norm<false>(F, l, F.in[I_NORM2] + (size_t)l * D, 6144, 8192, nrows, nrows > ML); SEAM(p0 + 7); }
        if (EN(8) && IN(p0 + 8)) {
            pg8::Gemm g{(const char*)(F.ws + WS_H), (const char*)(wb + WS_WUP), (size_t)256 * D * 2, 0, 0, (size_t)256 * D * 2, 0, D, D, D};
            pg8::TileOrder<1> S; S.init(nMp, UPC / 256, F.G, F.bid);
            EpiFfn E{(bf16*)(F.ws + WS_ACT), (bf16*)(F.ws + WS_UP), F.in[I_FFNCW] + (size_t)l * 3 * UPC, F.in[I_FFNCB] + (size_t)l * UPC};
            pg8::gemm_phase(F.lds + RING_OFF, g, S, E);
            if (cv) steal_convert(F, l + 1, 1 + l * 6 + 3, false);
            SEAM(p0 + 8);
        }
        if (EN(9) && IN(p0 + 9)) { phase_ffnfix(F, l, nrows); SEAM(p0 + 9); }
        if (EN(10) && IN(p0 + 10)) {
            pg8::Gemm g{(const char*)(F.ws + WS_ACT), (const char*)(wb + WS_WDN), (size_t)256 * DFF * 2, 0, 0, (size_t)256 * DFF * 2, 0, 64, DFF, DFF, (size_t)256 * 64 * 2};
            pg8::TileOrder<1> S; S.init(ML / 256, D / 256, F.G, F.bid, 2);
            EpiResid E{(float*)(F.ws + WS_X), modl, 10240, F.variant & 128};
            pg8::gemm_phase(F.lds + RING_OFF, g, S, E);
            if (nMp > ML / 256) {
                pg8::Gemm g2{(const char*)(F.ws + WS_ACT), (const char*)(wb + WS_WDN), (size_t)256 * DFF * 2, 0, (size_t)(DFF / 4 / 64) * 256 * 64 * 2, (size_t)256 * DFF * 2, (size_t)(DFF / 4) * 2, 64, DFF, DFF / 4, (size_t)256 * 64 * 2};
                pg8::SplitOrder<4> S2; S2.init(nMp - ML / 256, D / 256, ML / 256, F.G, F.bid);
                EpiPart E2{(float*)(F.ws + WS_PART), modl, 10240};
                pg8::gemm_phase(F.lds + RING_OFF, g2, S2, E2);
            }
            if (cv) steal_convert(F, l + 1, 1 + l * 6 + 4, true);
            SEAM(p0 + 10);
        }
    }
    if (EN(12) && IN(N_PHASES - 1)) {
        phase_final(F, args.out);
    }
#undef IN
#undef SEAM
}

extern "C" void kernel_launch(void* const* d_in, const int* in_sizes, int n_in, void* d_out, int out_size, void* d_ws, size_t ws_size, hipStream_t stream) {
    static int grid = 0;
    if (grid == 0) {
        if (n_in != 28 || in_sizes[0] != ML * D || out_size != ML * D || ws_size < WS_END) { fprintf(stderr, "kernel_launch: unexpected shapes (n_in %d, in0 %d, out %d, ws %zu < %zu); nothing launched\n", n_in, n_in > 0 ? in_sizes[0] : -1, out_size, ws_size, (size_t)WS_END); grid = -1; return; }
        int dev = 0, cus = 0, per_cu = 0;
        if (hipGetDevice(&dev) != hipSuccess || hipDeviceGetAttribute(&cus, hipDeviceAttributeMultiprocessorCount, dev) != hipSuccess) { fprintf(stderr, "kernel_launch: device query failed\n"); grid = -1; return; }
        if (hipFuncSetAttribute((const void*)fwd_kernel, hipFuncAttributeMaxDynamicSharedMemorySize, LDS_BYTES) != hipSuccess) { fprintf(stderr, "kernel_launch: hipFuncSetAttribute failed\n"); grid = -1; return; }
        if (hipOccupancyMaxActiveBlocksPerMultiprocessor(&per_cu, (const void*)fwd_kernel, NWAVES * 64, LDS_BYTES) != hipSuccess || per_cu < 1)
            fprintf(stderr, "kernel_launch: note: occupancy query reports %d workgroups per CU\n", per_cu);
        (void)hipGetLastError();
        grid = cus;
    }
    if (grid < 0) return;
    if (hipMemsetAsync((char*)d_ws + WS_CTL, 0, CTL_ZERO_BYTES, stream) != hipSuccess) { fprintf(stderr, "kernel_launch: memset failed\n"); return; }
    Args a{};
    for (int i = 0; i < 28; ++i) a.in[i] = (const float*)d_in[i];
    a.out = (float*)d_out; a.ws = (unsigned char*)d_ws;
#if defined(PROBE_K)
    a.ph_lo = 0; a.ph_hi = N_PHASES;
    hipLaunchKernelGGL(fwd_kernel, dim3(grid), dim3(NWAVES * 64), LDS_BYTES, stream, a);
    for (int rep = 0; rep < PROBE_REPS; ++rep) for (int l = 0; l < DEPTH; ++l) { a.ph_lo = 1 + l * NPH + PROBE_K; a.ph_hi = a.ph_lo + 1; a.variant = PROBE_VARIANT; hipLaunchKernelGGL(fwd_kernel, dim3(grid), dim3(NWAVES * 64), LDS_BYTES, stream, a); }
#elif MK_PER_PHASE
    for (int p = 0; p < N_PHASES; ++p) { a.ph_lo = p; a.ph_hi = p + 1; hipLaunchKernelGGL(fwd_kernel, dim3(grid), dim3(NWAVES * 64), LDS_BYTES, stream, a); }
#else
    a.ph_lo = 0; a.ph_hi = N_PHASES;
    hipLaunchKernelGGL(fwd_kernel, dim3(grid), dim3(NWAVES * 64), LDS_BYTES, stream, a);
#endif
    const hipError_t le = hipPeekAtLastError();
    if (le != hipSuccess) fprintf(stderr, "kernel_launch: launch failed: %s\n", hipGetErrorName(le));
}
```

```cpp
#include <hip/hip_runtime.h>
#include <cstdio>
#include <cstdint>

#ifndef MK_PER_PHASE
#define MK_PER_PHASE 0
#endif

namespace pg8 {
#define PG8_LAS __attribute__((address_space(3)))
typedef unsigned short bf16_t;
typedef short bf16x8 __attribute__((ext_vector_type(8)));
typedef float f32x4 __attribute__((ext_vector_type(4)));
typedef unsigned u32x4 __attribute__((ext_vector_type(4)));
constexpr int BM = 256, BK = 64, HALF = 128, HTB = HALF * BK * 2, STAGE_BYTES = 8 * HTB, NXCD = 8, WGM = 8;

__host__ __device__ __forceinline__ int lds_byte(int r, int c) { const int st = (r >> 4) * 2 + (c >> 5), rr = r & 15, cc = c & 31, ob = rr * 64 + cc * 2; return st * 1024 + (ob ^ (((ob >> 9) & 1) << 5)); }
__host__ __device__ __forceinline__ void stage_rc(int b, int& R, int& C) { const int st = b / 1024, sb = b % 1024, swz = sb ^ (((sb >> 9) & 1) << 5); R = (st >> 1) * 16 + swz / 64; C = (st & 1) * 32 + (swz % 64) / 2; }
__host__ __device__ __forceinline__ int perm32(int rho) { const int n = rho >> 4, i = rho & 15; return 8 * (i >> 2) + 4 * n + (i & 3); }

struct Unit { int pm, pn, sub; };
struct Gemm { const char* A; const char* B; size_t a_tile, a_pn, a_sub, b_tile, b_sub; int lda, ldb, K; size_t kstepA = (size_t)(BK * 2); };

template <int NSUB> struct TileOrder {
    int nM, nN, nwg, G, c, wgm;
    __device__ __forceinline__ void init(int nM_, int nN_, int G_, int c_, int wgm_ = 4) { nM = nM_; nN = nN_; nwg = nM * nN; G = G_; c = c_; wgm = wgm_; }
    __device__ __forceinline__ bool next(int i, Unit& u) const {
        const int sub = i % NSUB; const long L = (long)(i / NSUB) * G + c; if (L >= nwg) return false;
        int wgid = (int)L; { const int q = nwg / NXCD, r = nwg % NXCD, xcd = wgid % NXCD, off = wgid / NXCD; wgid = (xcd < r ? xcd * (q + 1) : r * (q + 1) + (xcd - r) * q) + off; }
        const int nig = wgm * nN, gid = wgid / nig, fm = gid * wgm, gsz = (nM - fm) < wgm ? (nM - fm) : wgm;
        u.pm = fm + ((wgid % nig) % gsz); u.pn = (wgid % nig) / gsz; u.sub = sub; return true;
    }
};

template <int NSUB> struct SplitOrder {
    int nM, nN, pm0, G, c;
    __device__ __forceinline__ void init(int nM_, int nN_, int pm0_, int G_, int c_) { nM = nM_; nN = nN_; pm0 = pm0_; G = G_; c = c_; }
    __device__ __forceinline__ bool next(int i, Unit& u) const {
        const int j = i * G + c; if (j >= nM * nN * NSUB) return false;
        const int tile = j / NSUB; u.sub = j % NSUB; u.pm = pm0 + tile / nN; u.pn = tile % nN; return true;
    }
};
typedef __bf16 bf16x2_t __attribute__((ext_vector_type(2)));
typedef float f32x2_t __attribute__((ext_vector_type(2)));
__device__ __forceinline__ unsigned cvt_pk_bf16(float lo, float hi) { const f32x2_t v = {lo, hi}; return __builtin_bit_cast(unsigned, __builtin_convertvector(v, bf16x2_t)); }

template <class Epi, class Sched>
__device__ __forceinline__ void gemm_phase(PG8_LAS unsigned char* lds, const Gemm g, const Sched& S, const Epi& E) {
    int tid_ = threadIdx.x; asm volatile("" : "+v"(tid_));
    const int tid = tid_, wid = __builtin_amdgcn_readfirstlane(tid >> 6), lane = tid & 63, wr = wid >> 2, wc = wid & 3, fr = lane & 15, fq = lane >> 4;
    const int K = g.K, nt = K / BK;
    unsigned voffA[2], voffB[2];
#pragma unroll
    for (int i = 0; i < 2; ++i) { int R, C; stage_rc(tid * 16 + i * 8192, R, C); const int Rb = Epi::PERM ? ((R & ~31) + perm32(R & 31)) : R;
        voffA[i] = (unsigned)(R * g.lda + C) * 2u; voffB[i] = (unsigned)(Rb * g.ldb + C) * 2u; }
    const size_t kstep = (size_t)(BK * 2), kstepA = g.kstepA;
    const size_t hstepA = (size_t)HALF * g.lda * 2, hstepB = (size_t)HALF * g.ldb * 2;
    const unsigned ldsw = (unsigned)wid * 1024u;
    const int aoff = lds_byte(wr * 64 + fr, fq * 8), boff = lds_byte(wc * 32 + fr, fq * 8);
#define PG8_SA(b, h) (((b) * 2 + (h)) * HTB)
#define PG8_SB(b, h) ((4 + (b) * 2 + (h)) * HTB)
#define PG8_STAGE(bufoff, gbase, voff) do { _Pragma("unroll") for (int _i = 0; _i < 2; ++_i) \
        __builtin_amdgcn_global_load_lds((const unsigned*)((const char*)(gbase) + (voff)[_i]), (PG8_LAS unsigned*)(lds + (bufoff) + ldsw + _i * 8192), 16, 0, 0); } while (0)
#define PG8_LDA(dst, b, h) do { _Pragma("unroll") for (int m = 0; m < 4; ++m) _Pragma("unroll") for (int k = 0; k < 2; ++k) dst[m][k] = *(const PG8_LAS bf16x8*)(lds + PG8_SA(b, h) + aoff + m * 2048 + k * 1024); } while (0)
#define PG8_LDB(dst, b, h) do { _Pragma("unroll") for (int n = 0; n < 2; ++n) _Pragma("unroll") for (int k = 0; k < 2; ++k) dst[n][k] = *(const PG8_LAS bf16x8*)(lds + PG8_SB(b, h) + boff + n * 2048 + k * 1024); } while (0)
#define PG8_MMA(ai, bj, At, Bt) do { __builtin_amdgcn_s_setprio(1); _Pragma("unroll") for (int m = 0; m < 4; ++m) _Pragma("unroll") for (int n = 0; n < 2; ++n) _Pragma("unroll") for (int k = 0; k < 2; ++k) \
        acc[ai][bj][m][n] = __builtin_amdgcn_mfma_f32_16x16x32_bf16(Bt[n][k], At[m][k], acc[ai][bj][m][n], 0, 0, 0); __builtin_amdgcn_s_setprio(0); } while (0)
#define PG8_WAIT_V(n) asm volatile("s_waitcnt vmcnt(" #n ")" ::: "memory")
#define PG8_WAIT_L(n) asm volatile("s_waitcnt lgkmcnt(" #n ")" ::: "memory")
#define PG8_BAR __builtin_amdgcn_s_barrier()
#define PG8_SCHED __builtin_amdgcn_sched_barrier(0)
    Unit cur, nxt; int ui = 0;
    if (!S.next(0, cur)) return;
    f32x4 acc[2][2][4][2];
#pragma unroll
    for (int a = 0; a < 2; ++a)
#pragma unroll
        for (int b = 0; b < 2; ++b)
#pragma unroll
            for (int m = 0; m < 4; ++m)
#pragma unroll
                for (int n = 0; n < 2; ++n) acc[a][b][m][n] = (f32x4){0.f, 0.f, 0.f, 0.f};
    bf16x8 At[4][2], B0[2][2], B1[2][2];
    const char* cA = g.A + (size_t)cur.pm * g.a_tile + (size_t)cur.pn * g.a_pn + (size_t)cur.sub * g.a_sub;
    const char* cB = g.B + (size_t)cur.pn * g.b_tile + (size_t)cur.sub * g.b_sub;
    PG8_STAGE(PG8_SB(0, 0), cB, voffB); PG8_STAGE(PG8_SB(0, 1), cB + hstepB, voffB); PG8_STAGE(PG8_SA(0, 0), cA, voffA); PG8_STAGE(PG8_SA(0, 1), cA + hstepA, voffA);
    if (wr == 1) PG8_BAR;
    PG8_WAIT_V(2); PG8_BAR;
    PG8_STAGE(PG8_SB(1, 0), cB + kstep, voffB); PG8_STAGE(PG8_SA(1, 0), cA + kstepA, voffA); PG8_STAGE(PG8_SB(1, 1), cB + hstepB + kstep, voffB);
    PG8_WAIT_V(6); PG8_BAR;
    for (;;) {
        const bool has_next = S.next(ui + 1, nxt);
        const char* nA = has_next ? g.A + (size_t)nxt.pm * g.a_tile + (size_t)nxt.pn * g.a_pn + (size_t)nxt.sub * g.a_sub : cA;
        const char* nB = has_next ? g.B + (size_t)nxt.pn * g.b_tile + (size_t)nxt.sub * g.b_sub : cB;
        for (int t = 0; t < nt; t += 2) {
            const bool last = (t == nt - 2);
            const char* a1 = cA + (size_t)(t + 1) * kstepA;
            const char* a2 = last ? nA : cA + (size_t)(t + 2) * kstepA; const char* b2 = last ? nB : cB + (size_t)(t + 2) * kstep;
            const char* a3 = a2 + kstepA; const char* b3 = b2 + kstep;
            PG8_LDB(B0, 0, 0); PG8_LDB(B1, 0, 1); PG8_SCHED; PG8_LDA(At, 0, 0); PG8_STAGE(PG8_SA(1, 1), a1 + hstepA, voffA);
            PG8_WAIT_V(8); PG8_WAIT_L(0); PG8_BAR; PG8_MMA(0, 0, At, B0); PG8_MMA(0, 1, At, B1); PG8_BAR; PG8_SCHED;
            PG8_LDA(At, 0, 1); PG8_STAGE(PG8_SB(0, 0), b2, voffB); PG8_STAGE(PG8_SB(0, 1), b2 + hstepB, voffB); PG8_STAGE(PG8_SA(0, 0), a2, voffA);
            PG8_WAIT_V(8); PG8_WAIT_L(0); PG8_BAR; PG8_MMA(1, 0, At, B0); PG8_MMA(1, 1, At, B1); PG8_BAR; PG8_SCHED;
            PG8_LDB(B0, 1, 0); PG8_LDB(B1, 1, 1); PG8_SCHED; PG8_LDA(At, 1, 0); PG8_STAGE(PG8_SA(0, 1), a2 + hstepA, voffA);
            PG8_WAIT_V(8); PG8_WAIT_L(0); PG8_BAR; PG8_MMA(0, 0, At, B0); PG8_MMA(0, 1, At, B1); PG8_BAR; PG8_SCHED;
            PG8_LDA(At, 1, 1); PG8_STAGE(PG8_SB(1, 0), b3, voffB); PG8_STAGE(PG8_SB(1, 1), b3 + hstepB, voffB); PG8_STAGE(PG8_SA(1, 0), a3, voffA);
            PG8_WAIT_V(8); PG8_WAIT_L(0); PG8_BAR; PG8_MMA(1, 0, At, B0); PG8_MMA(1, 1, At, B1); PG8_BAR; PG8_SCHED;
        }
        if (wr == 0) PG8_BAR;
        bool zero_acc = true;
        int fr2 = fr, fq2 = fq; asm volatile("" : "+v"(fr2), "+v"(fq2));
        if constexpr (Epi::CHAIN) zero_acc = E(acc, cur, wr, wc, fr2, fq2); else E(acc, cur, wr, wc, fr2, fq2);
        if (!has_next) break;
        if (zero_acc) {
#pragma unroll
        for (int a = 0; a < 2; ++a)
#pragma unroll
            for (int b = 0; b < 2; ++b)
#pragma unroll
                for (int m = 0; m < 4; ++m)
#pragma unroll
                    for (int n = 0; n < 2; ++n) acc[a][b][m][n] = (f32x4){0.f, 0.f, 0.f, 0.f};
        }
        cur = nxt; cA = nA; cB = nB; ++ui;
        if (wr == 1) PG8_BAR;
    }
    PG8_WAIT_V(0);
    PG8_BAR;
#undef PG8_SA
#undef PG8_SB
#undef PG8_STAGE
#undef PG8_LDA
#undef PG8_LDB
#undef PG8_MMA
#undef PG8_WAIT_V
#undef PG8_WAIT_L
#undef PG8_BAR
#undef PG8_SCHED
}
}

constexpr int NWAVES = 8;
constexpr int D = 2048, NB = 4, SEQ = 4096, CTX = 256, DEPTH = 4;
constexpr int ML = NB * SEQ;
constexpr int MC = NB * CTX;
constexpr int M = ML + MC;
constexpr int UC = 10240;
constexpr int NIG = 10496 + 8192;
constexpr int DFF = 5632, UPC = 2 * DFF;
constexpr int IN_COLS = 10256;
constexpr float EPS = 1e-6f;
constexpr int U_Z = 0, U_XBC = 1024, U_POOL = 3072, U_SCB = 4096, U_SCC = 5120, U_SCX = 6144, U_RQ = 7168, U_RK = 7680, U_RV = 8192, U_RG = 9216;

constexpr size_t MiB = 1u << 20;
constexpr size_t WS_CTL = 0, CTL_ZERO_BYTES = 128 * 1024;
constexpr size_t WS_MOD = 1 * MiB;
constexpr size_t WS_ROPE = WS_MOD + (size_t)DEPTH * 5 * 12288 * 4;
constexpr size_t WS_X = 2 * MiB;
constexpr size_t WS_H = WS_X + 136 * MiB;
constexpr size_t WS_WIG = WS_H + 68 * MiB;
constexpr size_t WS_WB = WS_WIG + 73 * MiB;
constexpr size_t WS_WO = WS_WB + 16 * MiB;
constexpr size_t WS_WUP = WS_WO + 8 * MiB;
constexpr size_t WS_WDN = WS_WUP + 44 * MiB;
constexpr size_t WS_WPOOL = WS_WDN + 22 * MiB;
constexpr size_t W_SPAN = WS_WPOOL + 1 * MiB - WS_WIG;
constexpr size_t WS_U = WS_WIG + 2 * W_SPAN;
constexpr size_t WS_DT = WS_U + 340 * MiB;
constexpr size_t WS_G = WS_DT + 2 * MiB;
constexpr size_t WS_UP = WS_U;
constexpr size_t WS_CUMA = WS_G + 140 * MiB;
constexpr size_t WS_DTA = WS_CUMA + 4 * MiB;
constexpr size_t WS_PART = WS_G + 152 * MiB;
constexpr size_t WS_XBCA = WS_G + 272 * MiB;
constexpr size_t WS_RQK = WS_XBCA + 68 * MiB;
constexpr size_t WS_YS = WS_RQK + 34 * MiB;
constexpr size_t WS_YB = WS_YS + 136 * MiB;
constexpr size_t WS_POOLED = WS_YB + 136 * MiB;
constexpr size_t WS_MERGED = WS_POOLED + 34 * MiB;
constexpr size_t WS_MRG32 = WS_XBCA;
constexpr size_t WS_ACT = WS_XBCA;
constexpr size_t WS_END = WS_MERGED + 68 * MiB;
static_assert(WS_UP + (size_t)M * UPC * 2 <= WS_XBCA, "UP overlay");
static_assert(WS_DTA + 4 * MiB <= WS_PART && WS_PART + 32 * MiB <= WS_XBCA, "PART");
static_assert(WS_UP + (size_t)M * UPC * 2 <= WS_CUMA && WS_DTA + 4 * MiB <= WS_XBCA && (size_t)2 * 16 * M * 4 <= 4 * MiB, "cum/dt arrays");
static_assert(WS_ACT + (size_t)M * DFF * 2 <= WS_YB, "ACT overlay");
static_assert(WS_MRG32 + (size_t)M * D * 4 <= WS_YS + 34 * MiB, "MRG32 overlay");
static_assert(WS_ROPE + 8192 <= WS_X, "mod/rope");
__host__ __device__ __forceinline__ size_t yb_off(int row, int col) { return (size_t)(row >> 8) * (256 * 1024) + (size_t)(col >> 6) * (256 * 64) + (size_t)((row & 255) * 64 + (col & 63)); }
constexpr size_t YS_STRIDE = (size_t)M * 1024;

constexpr int CW_TMO = 0, CW_CODE = 1, CW_BAR = 4096, CW_Q = 16384, CW_FIN = 20480;

constexpr int RING_OFF = 0, RING_BYTES = 131072;
constexpr int LDSCTL_OFF = RING_BYTES, MISC_OFF = LDSCTL_OFF + 320;
constexpr int LDS_BYTES = 147456;

#define GAS __attribute__((address_space(1)))
#define LAS __attribute__((address_space(3)))
typedef unsigned short bf16;
typedef unsigned v4u __attribute__((ext_vector_type(4)));
typedef unsigned v2u __attribute__((ext_vector_type(2)));
typedef float f32x4 __attribute__((ext_vector_type(4)));
typedef float f32x16 __attribute__((ext_vector_type(16)));
typedef short bf16x8 __attribute__((ext_vector_type(8)));
typedef GAS unsigned gu32;
#define RLX_AGENT __ATOMIC_RELAXED, __HIP_MEMORY_SCOPE_AGENT
#define LDS_WAIT() asm volatile("s_waitcnt lgkmcnt(0)" ::: "memory")
#define VM_WAIT() asm volatile("s_waitcnt vmcnt(0)" ::: "memory")
__device__ __forceinline__ unsigned f2bf(float f) { return (unsigned)__builtin_bit_cast(unsigned short, (__bf16)f); }
__device__ __forceinline__ unsigned pk2(float lo, float hi) { return pg8::cvt_pk_bf16(lo, hi); }
__device__ __forceinline__ float bflo(unsigned w) { return __builtin_bit_cast(float, w << 16); }
__device__ __forceinline__ float bfhi(unsigned w) { return __builtin_bit_cast(float, w & 0xffff0000u); }
__device__ __forceinline__ float bf1(unsigned short b) { return __builtin_bit_cast(float, (unsigned)b << 16); }
__device__ __forceinline__ void unpack8(const v4u w, float (&f)[8]) { f[0] = bflo(w.x); f[1] = bfhi(w.x); f[2] = bflo(w.y); f[3] = bfhi(w.y); f[4] = bflo(w.z); f[5] = bfhi(w.z); f[6] = bflo(w.w); f[7] = bfhi(w.w); }
__device__ __forceinline__ v4u pack8(const float (&f)[8]) { v4u w; w.x = pk2(f[0], f[1]); w.y = pk2(f[2], f[3]); w.z = pk2(f[4], f[5]); w.w = pk2(f[6], f[7]); return w; }
__device__ __forceinline__ float sigmoidf_(float x) { return __builtin_amdgcn_rcpf(1.0f + __expf(-x)); }
__device__ __forceinline__ float siluf_(float x) { return x * sigmoidf_(x); }
__device__ __forceinline__ float softplusf_(float x) { return fmaxf(x, 0.f) + log1pf(expf(-fabsf(x))); }
template <int CTRL> __device__ __forceinline__ float dppf(float v) { return __builtin_bit_cast(float, __builtin_amdgcn_update_dpp(0, __builtin_bit_cast(int, v), CTRL, 0xf, 0xf, true)); }
__device__ __forceinline__ float red8(float v) { v += dppf<0xB1>(v); v += dppf<0x4E>(v); v += dppf<0x141>(v); return v; }
__device__ __forceinline__ float wave_sum(float v) {
    v = red8(v); v += dppf<0x140>(v);
    v += __builtin_bit_cast(float, __builtin_amdgcn_ds_swizzle(__builtin_bit_cast(int, v), 0x401F));
    return __builtin_bit_cast(float, __builtin_amdgcn_readlane(__builtin_bit_cast(int, v), 0)) + __builtin_bit_cast(float, __builtin_amdgcn_readlane(__builtin_bit_cast(int, v), 32));
}

#define XB_TMO      128
#define XB_XCNT(j)  (256  + 64 * (j))
#define XB_XSUB(j)  (1280 + 64 * (j))
#define XB_XGEN(j)  (2304 + 64 * (j))
#define XB_TOP      3328
#define XB_TOPGEN   3392
#define XCD_BAR_WORDS 3456
#define XB_SPIN_CAP (1u << 18)
__device__ __forceinline__ unsigned xb_ld(unsigned* p)              { return __hip_atomic_load(p, __ATOMIC_RELAXED, __HIP_MEMORY_SCOPE_AGENT); }
__device__ __forceinline__ unsigned xb_add(unsigned* p, unsigned v) { return __hip_atomic_fetch_add(p, v, __ATOMIC_RELAXED, __HIP_MEMORY_SCOPE_AGENT); }
__device__ __forceinline__ unsigned xb_xcc_id() { return (unsigned)__builtin_amdgcn_s_getreg((3 << 11) | 20) & 0xFu; }
#define XB_SPIN(cond, bar) do { unsigned _sp = 0; while (cond) { __builtin_amdgcn_s_sleep(1); \
    if ((++_sp & 255u) == 0u) { if (xb_ld(&(bar)[XB_TMO])) break; if (_sp > XB_SPIN_CAP) { atomicAdd(&(bar)[XB_TMO], 1u); break; } } } } while (0)
struct XcdBarrier { unsigned* bar; unsigned x; volatile LAS unsigned* st; };
__device__ __forceinline__ XcdBarrier xcd_barrier_post(unsigned* bar, volatile LAS unsigned* st) {
    XcdBarrier b; b.bar = bar; b.x = xb_xcc_id(); b.st = st;
    if (threadIdx.x == 0) (void)xb_add(&bar[XB_XCNT(b.x)], 1u);
    return b;
}
__device__ __forceinline__ void xcd_barrier_complete(unsigned* bar, unsigned x, unsigned& nloc, unsigned& nx) {
    const unsigned G = gridDim.x * gridDim.y * gridDim.z;
    unsigned sum, cnt, mine, sp = 0u;
    for (;;) {
        sum = 0u; cnt = 0u; mine = 0u;
#pragma unroll
        for (unsigned j = 0; j < 16; ++j) { const unsigned c = xb_ld(&bar[XB_XCNT(j)]); sum += c; cnt += (c > 0u) ? 1u : 0u; mine = (j == x) ? c : mine; }
        if (sum == G) break;
        __builtin_amdgcn_s_sleep(1);
        if ((++sp & 255u) == 0u) { if (xb_ld(&bar[XB_TMO])) break; if (sp > XB_SPIN_CAP) { atomicAdd(&bar[XB_TMO], 1u); break; } }
    }
    nloc = mine > 0u ? mine : 1u; nx = cnt > 0u ? cnt : 1u;
}
__device__ __forceinline__ void xcd_barrier(const XcdBarrier& b) {
    asm volatile("s_waitcnt vmcnt(0)" ::: "memory");
    __syncthreads();
    if (threadIdx.x == 0) {
        unsigned* bar = b.bar;
        __builtin_amdgcn_s_waitcnt(0);
        unsigned nloc = b.st[0], nx = b.st[1];
        if (nloc == 0u) { xcd_barrier_complete(bar, b.x, nloc, nx); b.st[0] = nloc; b.st[1] = nx; }
        const unsigned old = xb_add(&bar[XB_XSUB(b.x)], 1u);
        const unsigned gen = old / nloc;
        if (old + 1u == (gen + 1u) * nloc) {
            __builtin_amdgcn_fence(__ATOMIC_RELEASE, "agent");
            asm volatile("s_waitcnt vmcnt(0)" ::: "memory");
            const unsigned og = xb_add(&bar[XB_TOP], 1u);
            const unsigned tg = og / nx;
            if (og + 1u == (tg + 1u) * nx) xb_add(&bar[XB_TOPGEN], 1u);
            else XB_SPIN(xb_ld(&bar[XB_TOPGEN]) == tg, bar);
            __builtin_amdgcn_fence(__ATOMIC_ACQUIRE, "agent");
            xb_add(&bar[XB_XGEN(b.x)], 1u);
            asm volatile("s_waitcnt vmcnt(0)" ::: "memory");
        } else {
            XB_SPIN(xb_ld(&bar[XB_XGEN(b.x)]) == gen, bar);
            __builtin_amdgcn_fence(__ATOMIC_ACQUIRE, "agent");
            asm volatile("s_waitcnt vmcnt(0)" ::: "memory");
        }
    }
    __syncthreads();
}

struct Args {
    const float* in[28];
    float* out; unsigned char* ws;
    int ph_lo, ph_hi, variant, pad;
};
struct Frame {
    LAS unsigned char* lds;
    int tid, lane, wave, G, bid, variant;
    unsigned char* ws;
    const float* const* in;
};
__device__ __forceinline__ void frame_refresh(Frame& F) {
    int t = threadIdx.x; asm volatile("" : "+v"(t)); F.tid = t; F.lane = t & 63; F.wave = __builtin_amdgcn_readfirstlane(t >> 6);
    int b = blockIdx.x; asm volatile("" : "+s"(b)); F.bid = b;
}
enum { I_X = 0, I_C, I_CTX, I_CCTX, I_WMOD, I_BMOD, I_NORM1, I_WIN, I_SSDCW, I_SSDCB, I_SSDALOG, I_SSDDTB, I_SSDD, I_SSDNW, I_POOLW, I_POOLS, I_SCONVW, I_RETDL,
       I_WBR, I_WGATE, I_BGATE, I_WO, I_NORM2, I_FFNUP, I_FFNCW, I_FFNCB, I_FFNDN, I_FNW };

__device__ __forceinline__ void seq_bounds(int row, int& s0, int& s1) {
    if (row < ML) { s0 = row & ~(SEQ - 1); s1 = s0 + SEQ; } else { s0 = ML + ((row - ML) & ~(CTX - 1)); s1 = s0 + CTX; }
}
__device__ __forceinline__ int mod_vec(int row) { return row < ML ? (row >> 12) : 4; }

__device__ __forceinline__ void phase_mod(Frame& F) {
    frame_refresh(F);
    LAS float* sv = (LAS float*)(F.lds);
    LAS float* red = (LAS float*)(F.lds + 5 * 2048 * 4);
    const float* c = F.in[I_C]; const float* cc = F.in[I_CCTX];
    for (int i = F.tid; i < 5 * 2048; i += 512) { const int v = i >> 11, k = i & 2047; const float x = v < 4 ? c[v * 2048 + k] : cc[k]; sv[i] = siluf_(x); }
    __syncthreads();
    float* MOD = (float*)(F.ws + WS_MOD);
    for (int it = F.bid; it < DEPTH * 48; it += F.G) {
        const int l = it / 48, jb = it % 48;
        const float* W = F.in[I_WMOD] + (size_t)l * 2048 * 12288 + jb * 256 + 4 * F.lane;
        float a[5][4];
#pragma unroll
        for (int v = 0; v < 5; ++v) { a[v][0] = a[v][1] = a[v][2] = a[v][3] = 0.f; }
        const int k0 = F.wave * 256;
#pragma unroll 4
        for (int k = 0; k < 256; ++k) {
            const f32x4 w = *(const f32x4*)(W + (size_t)(k0 + k) * 12288);
#pragma unroll
            for (int v = 0; v < 5; ++v) { const float s = sv[v * 2048 + k0 + k]; a[v][0] += s * w.x; a[v][1] += s * w.y; a[v][2] += s * w.z; a[v][3] += s * w.w; }
        }
#pragma unroll
        for (int v = 0; v < 5; ++v) *(LAS f32x4*)(red + (F.wave * 5 + v) * 256 + 4 * F.lane) = (f32x4){a[v][0], a[v][1], a[v][2], a[v][3]};
        __syncthreads();
        for (int i = F.tid; i < 5 * 256; i += 512) { const int v = i >> 8, j = i & 255; float s = 0.f;
#pragma unroll
            for (int w = 0; w < 8; ++w) s += red[(w * 5 + v) * 256 + j];
            MOD[((size_t)l * 5 + v) * 12288 + jb * 256 + j] = s + F.in[I_BMOD][l * 12288 + jb * 256 + j]; }
        __syncthreads();
    }
    if (F.bid == F.G - 1) {
        float* R = (float*)(F.ws + WS_ROPE);
        for (int i = F.tid; i < 1024; i += 512) { const int pos = i >> 4, m = i & 15; const float inv = powf(10000.0f, -(float)m / 16.0f); const float ang = (float)pos * inv; R[2 * i] = cosf(ang); R[2 * i + 1] = sinf(ang); }
    }
}

template <class RowMap>
__device__ __forceinline__ void transpose_item(const float* W, int K, int N, bf16* WT, const RowMap& rm, LAS float* scr, int item, int lane) {
    const int nblk = (N + 31) / 32, kb = item / nblk, nb = item % nblk, k0 = 64 * kb, n0 = 32 * nb;
    const bool nok = (n0 + (lane & 31)) < N;
#pragma unroll 8
    for (int i = 0; i < 32; ++i) { const int kk = 2 * i + (lane >> 5); scr[kk * 33 + (lane & 31)] = nok ? W[(size_t)(k0 + kk) * N + n0 + (lane & 31)] : 0.f; }
    LDS_WAIT(); asm volatile("" ::: "memory");
    const int c = lane & 7;
#pragma unroll
    for (int j = 0; j < 4; ++j) { const int n = (lane >> 3) + 8 * j; const LAS float* s = scr + (8 * c) * 33 + n;
        v4u o; o.x = pk2(s[0 * 33], s[1 * 33]); o.y = pk2(s[2 * 33], s[3 * 33]); o.z = pk2(s[4 * 33], s[5 * 33]); o.w = pk2(s[6 * 33], s[7 * 33]);
        if (n0 + n < N) *(GAS v4u*)(WT + (size_t)rm(n0 + n) * K + k0 + 8 * c) = o; }
    LDS_WAIT(); asm volatile("" ::: "memory");
}
struct RowId { int off; __device__ __forceinline__ int operator()(int n) const { return n + off; } };
struct RowUp { __device__ __forceinline__ int operator()(int n) const { const int h = n >= DFF ? 1 : 0, c = n - h * DFF; return (c >> 7) * 256 + h * 128 + (c & 127); } };
struct RowWin { __device__ __forceinline__ int operator()(int n) const { return n < 3072 ? n : (n < 3088 ? 10240 + (n - 3072) : n - 16); } };

constexpr int CI_IN = 32 * 321, CI_G1 = 32 * 64, CI_B1 = 16 * 64, CI_O = 32 * 64, CI_UP = 32 * 352, CI_DN = 88 * 64, CI_P1 = 4 * 8, CI_Z = 30;
constexpr int NITW = CI_IN + 4 * CI_G1 + 4 * CI_B1 + CI_O + CI_UP + CI_DN + 4 * CI_P1 + CI_Z;
__device__ __forceinline__ void convert_item(Frame& F, int l, int it, LAS float* scr, int lane) {
    unsigned char* wb = F.ws + (size_t)(l & 1) * W_SPAN;
    bf16* WIG = (bf16*)(wb + WS_WIG); bf16* WB = (bf16*)(wb + WS_WB); bf16* WO = (bf16*)(wb + WS_WO);
    bf16* WUP = (bf16*)(wb + WS_WUP); bf16* WDN = (bf16*)(wb + WS_WDN); bf16* WPOOL = (bf16*)(wb + WS_WPOOL);
    int r = it;
    if (r < CI_IN) { transpose_item(F.in[I_WIN] + (size_t)l * 2048 * IN_COLS, 2048, IN_COLS, WIG, RowWin{}, scr, r, lane); return; } r -= CI_IN;
    if (r < 4 * CI_G1) { const int i = r / CI_G1; transpose_item(F.in[I_WGATE] + ((size_t)l * 4 + i) * 2048 * 2048, 2048, 2048, WIG, RowId{10496 + i * 2048}, scr, r % CI_G1, lane); return; } r -= 4 * CI_G1;
    if (r < 4 * CI_B1) { const int i = r / CI_B1; transpose_item(F.in[I_WBR] + ((size_t)l * 4 + i) * 1024 * 2048, 1024, 2048, WB + (size_t)i * 2048 * 1024, RowId{0}, scr, r % CI_B1, lane); return; } r -= 4 * CI_B1;
    if (r < CI_O) { transpose_item(F.in[I_WO] + (size_t)l * 2048 * 2048, 2048, 2048, WO, RowId{0}, scr, r, lane); return; } r -= CI_O;
    if (r < CI_UP) { transpose_item(F.in[I_FFNUP] + (size_t)l * 2048 * UPC, 2048, UPC, WUP, RowUp{}, scr, r, lane); return; } r -= CI_UP;
    if (r < CI_DN) { transpose_item(F.in[I_FFNDN] + (size_t)l * DFF * 2048, DFF, 2048, WDN, RowId{0}, scr, r, lane); return; } r -= CI_DN;
    if (r < 4 * CI_P1) { const int g = r / CI_P1; transpose_item(F.in[I_POOLW] + ((size_t)l * 4 + g) * 256 * 256, 256, 256, WPOOL + (size_t)g * 256 * 256, RowId{0}, scr, r % CI_P1, lane); return; } r -= 4 * CI_P1;
    {
        unsigned char* base = (unsigned char*)WIG + (size_t)(10256 + 8 * r) * 2048 * 2;
#pragma unroll 4
        for (int k = 0; k < 32; ++k) *(GAS v4u*)(base + (size_t)(k * 64 + lane) * 16) = (v4u){0u, 0u, 0u, 0u};
    }
}
__device__ __forceinline__ void steal_convert(Frame& F, int l, int finidx, bool drain) {
    frame_refresh(F);
    gu32* q = (gu32*)(F.ws + WS_CTL) + CW_Q + 64 * l;
    gu32* fin = (gu32*)(F.ws + WS_CTL) + CW_FIN + 64 * finidx;
    volatile LAS unsigned* box = (volatile LAS unsigned*)(F.lds + MISC_OFF);
    LAS float* scr = (LAS float*)(F.lds + F.wave * 16384);
    if (F.tid == 0 && !drain) __hip_atomic_fetch_add(fin, 1u, RLX_AGENT);
    for (;;) {
        if (F.tid == 0) { unsigned v = 0xffffffffu; if (drain || __hip_atomic_load(fin, RLX_AGENT) < (unsigned)F.G) v = __hip_atomic_fetch_add(q, 1u, RLX_AGENT); box[0] = v; }
        __syncthreads();
        const unsigned got = box[0];
        __syncthreads();
        if (got == 0xffffffffu) break;
        const int base = (int)got * 8;
        if (base >= NITW) break;
        { const int wi = base + F.wave; if (wi < NITW) convert_item(F, l, wi, scr, F.lane); }
    }
}

template <bool FIRST>
__device__ __forceinline__ void phase_norm(Frame& F, int l, const float* nw, int sh_off, int sc_off, int nrows, bool addpart = false) {
    frame_refresh(F);
    float* X = (float*)(F.ws + WS_X); bf16* H = (bf16*)(F.ws + WS_H); const float* MOD = (const float*)(F.ws + WS_MOD);
    const int gw = F.bid * NWAVES + F.wave, NGW = F.G * NWAVES;
    for (int row = gw; row < nrows; row += NGW) {
        const float* src = FIRST ? (row < ML ? F.in[I_X] + (size_t)row * D : F.in[I_CTX] + (size_t)(row - ML) * D) : X + (size_t)row * D;
        f32x4 v[8]; float ss = 0.f;
#pragma unroll
        for (int j = 0; j < 8; ++j) { v[j] = *(const f32x4*)(src + 256 * j + 4 * F.lane); ss += (v[j].x * v[j].x + v[j].y * v[j].y) + (v[j].z * v[j].z + v[j].w * v[j].w); }
        if (FIRST) {
#pragma unroll
            for (int j = 0; j < 8; ++j) *(f32x4*)(X + (size_t)row * D + 256 * j + 4 * F.lane) = v[j];
        }
        if (!FIRST && addpart && row >= ML) {
            const float* P = (const float*)(F.ws + WS_PART) + (size_t)(row - ML) * D;
            ss = 0.f;
#pragma unroll
            for (int j = 0; j < 8; ++j) {
#pragma unroll
                for (int sp = 0; sp < 4; ++sp) v[j] += *(const f32x4*)(P + (size_t)sp * MC * D + 256 * j + 4 * F.lane);
                *(f32x4*)(X + (size_t)row * D + 256 * j + 4 * F.lane) = v[j];
                ss += (v[j].x * v[j].x + v[j].y * v[j].y) + (v[j].z * v[j].z + v[j].w * v[j].w);
            }
        }
        const float rs = rsqrtf(wave_sum(ss) * (1.0f / D) + EPS);
        const float* mv = MOD + ((size_t)l * 5 + mod_vec(row)) * 12288;
#pragma unroll
        for (int j = 0; j < 8; ++j) { const int c = 256 * j + 4 * F.lane;
            const f32x4 w = *(const f32x4*)(nw + c), sh = *(const f32x4*)(mv + sh_off + c), sc = *(const f32x4*)(mv + sc_off + c);
            const f32x4 y = v[j] * rs * w; const f32x4 h = y * (sc + 1.0f) + sh;
            v2u o; o.x = pk2(h.x, h.y); o.y = pk2(h.z, h.w); *(v2u*)(H + (size_t)row * D + c) = o; }
    }
}
__device__ __forceinline__ void phase_final(Frame& F, float* out) {
    frame_refresh(F);
    const float* X = (const float*)(F.ws + WS_X); const float* nw = F.in[I_FNW];
    const int gw = F.bid * NWAVES + F.wave, NGW = F.G * NWAVES;
    for (int row = gw; row < ML; row += NGW) {
        f32x4 v[8]; float ss = 0.f;
#pragma unroll
        for (int j = 0; j < 8; ++j) { v[j] = *(const f32x4*)(X + (size_t)row * D + 256 * j + 4 * F.lane); ss += (v[j].x * v[j].x + v[j].y * v[j].y) + (v[j].z * v[j].z + v[j].w * v[j].w); }
        const float rs = rsqrtf(wave_sum(ss) * (1.0f / D) + EPS);
#pragma unroll
        for (int j = 0; j < 8; ++j) { const int c = 256 * j + 4 * F.lane; *(f32x4*)(out + (size_t)row * D + c) = v[j] * rs * *(const f32x4*)(nw + c); }
    }
}

__device__ __forceinline__ v4u ldrow(const bf16* base, int row, int ld, int col, bool ok) { return ok ? *(const v4u*)(base + (size_t)row * ld + col) : (v4u){0u, 0u, 0u, 0u}; }
__device__ __forceinline__ void ld8f(const float* p, float (&f)[8]) { const f32x4 a = *(const f32x4*)p, b = *(const f32x4*)(p + 4); f[0] = a.x; f[1] = a.y; f[2] = a.z; f[3] = a.w; f[4] = b.x; f[5] = b.y; f[6] = b.z; f[7] = b.w; }

__device__ __forceinline__ void sc_task(Frame& F, int l, int r, int lane) {
    const bf16* U = (const bf16*)(F.ws + WS_U); bf16* YB2 = (bf16*)(F.ws + WS_YB) + 2 * YS_STRIDE;
            const int rb = r >> 1, cb = r & 1, c = cb * 512 + lane * 8, r0 = rb * 32; int s0, s1; seq_bounds(r0, s0, s1);
            float w0[8], w1[8], w2[8];
            ld8f(F.in[I_SCONVW] + ((size_t)l * 3 + 0) * 1024 + c, w0); ld8f(F.in[I_SCONVW] + ((size_t)l * 3 + 1) * 1024 + c, w1); ld8f(F.in[I_SCONVW] + ((size_t)l * 3 + 2) * 1024 + c, w2);
            for (int r4 = r0; r4 < r0 + 32; r4 += 4) {
                v4u bc[6], bx[6], bg[4];
#pragma unroll
                for (int k = 0; k < 6; ++k) { const int s = r4 - 1 + k; const bool ok = s >= s0 && s < s1; bc[k] = ldrow(U, s, UC, U_SCC + c, ok); bx[k] = ldrow(U, s, UC, U_SCX + c, ok); }
#pragma unroll
                for (int k = 0; k < 4; ++k) bg[k] = ldrow(U, r4 + k, UC, U_SCB + c, true);
                float pr[6][8];
#pragma unroll
                for (int k = 0; k < 6; ++k) { float a[8], b[8]; unpack8(bc[k], a); unpack8(bx[k], b);
#pragma unroll
                    for (int e = 0; e < 8; ++e) pr[k][e] = a[e] * b[e]; }
#pragma unroll
                for (int j = 0; j < 4; ++j) { float g[8], o[8]; unpack8(bg[j], g);
#pragma unroll
                    for (int e = 0; e < 8; ++e) o[e] = g[e] * (w0[e] * pr[j][e] + w1[e] * pr[j + 1][e] + w2[e] * pr[j + 2][e]);
                    *(v4u*)(YB2 + yb_off(r4 + j, c)) = pack8(o); }
            }
}
__device__ __forceinline__ void sc_phase(Frame& F, int l, int c, int Gs) {
    frame_refresh(F);
    const int gw = c * NWAVES + F.wave, NGW = Gs * NWAVES;
    for (int task = gw; task < (M / 32) * 2; task += NGW) sc_task(F, l, task, F.lane);
}
template <int HMAX>
__device__ __forceinline__ void pool_task(const bf16* U, bf16* POOLED, int r0, int s0, int s1, int c, int half) {
    constexpr int NR = 8 + 2 * HMAX - 1, HA = HMAX / 2;
    const bool big = (half == HMAX);
    for (int r8 = r0; r8 < r0 + 32; r8 += 8) {
        v4u buf[NR];
#pragma unroll
        for (int k = 0; k < NR; ++k) { const int s = r8 - HMAX + k; buf[k] = ldrow(U, s, UC, U_POOL + c, s >= s0 && s < s1); }
        float sa[8], sb[8];
#pragma unroll
        for (int e = 0; e < 8; ++e) { sa[e] = 0.f; sb[e] = 0.f; }
#pragma unroll
        for (int k = 0; k < 2 * HMAX; ++k) { float t[8]; unpack8(buf[k], t);
#pragma unroll
            for (int e = 0; e < 8; ++e) { sb[e] += t[e]; if (k >= HA && k < HMAX + HA) sa[e] += t[e]; } }
#pragma unroll
        for (int j = 0; j < 8; ++j) {
            const int rr = r8 + j; int lo = rr - half, hi = rr + half; lo = lo < s0 ? s0 : lo; hi = hi > s1 ? s1 : hi;
            float x[8], o[8]; unpack8(buf[j + HMAX], x); const float inv = 1.0f / (float)(hi - lo);
#pragma unroll
            for (int e = 0; e < 8; ++e) o[e] = (big ? sb[e] : sa[e]) * inv - x[e];
            *(v4u*)(POOLED + (size_t)rr * 1024 + c) = pack8(o);
            if (j < 7) {
                float tin[8], tout[8];
                unpack8(buf[j + 2 * HMAX], tin); unpack8(buf[j], tout);
#pragma unroll
                for (int e = 0; e < 8; ++e) sb[e] += tin[e] - tout[e];
                unpack8(buf[j + HMAX + HA], tin); unpack8(buf[j + HA], tout);
#pragma unroll
                for (int e = 0; e < 8; ++e) sa[e] += tin[e] - tout[e];
            }
        }
    }
}
__device__ __forceinline__ void phase_pre(Frame& F, int l) {
    frame_refresh(F);
    const bf16* U = (const bf16*)(F.ws + WS_U);
    bf16* XBCA = (bf16*)(F.ws + WS_XBCA); bf16* RQK = (bf16*)(F.ws + WS_RQK); bf16* YB2 = (bf16*)(F.ws + WS_YB) + 2 * YS_STRIDE; bf16* POOLED = (bf16*)(F.ws + WS_POOLED);
    const float* ROPE = (const float*)(F.ws + WS_ROPE);
    const int gw = F.bid * NWAVES + F.wave, NGW = F.G * NWAVES, lane = F.lane;
    constexpr int NRB = M / 32;
    constexpr int T_CUM = (M / 64) * 2, T_XBC = NRB * 4, T_POOL = NRB * 2, T_ROPE = NRB;
    float* CUMA = (float*)(F.ws + WS_CUMA); float* DTA = (float*)(F.ws + WS_DTA); const float* DT = (const float*)(F.ws + WS_DT);
    for (int task = gw; task < T_CUM + T_XBC + T_POOL + T_ROPE; task += NGW) {
        int r = task;
        if (r < T_CUM) {
            const int blk = r >> 1, dir = r & 1, row = blk * 64 + (dir ? 63 - lane : lane);
            for (int hh = 0; hh < 16; ++hh) {
                const float dt = softplusf_(DT[(size_t)row * 16 + hh] + F.in[I_SSDDTB][(l * 2 + dir) * 16 + hh]);
                float cum = dt * -expf(F.in[I_SSDALOG][(l * 2 + dir) * 16 + hh]);
#pragma unroll
                for (int o = 1; o < 64; o <<= 1) { const float t = __shfl_up(cum, o); if (lane >= o) cum += t; }
                CUMA[(size_t)(dir * 16 + hh) * M + row] = cum; DTA[(size_t)(dir * 16 + hh) * M + row] = dt;
            }
            continue;
        }
        r -= T_CUM;
        if (r < T_XBC) {
            const int rb = r >> 2, cb = r & 3, c = cb * 512 + lane * 8, r0 = rb * 32; int s0, s1; seq_bounds(r0, s0, s1);
            float w0[8], w1[8], w2[8], bb[8];
            ld8f(F.in[I_SSDCW] + ((size_t)l * 3 + 0) * 2048 + c, w0); ld8f(F.in[I_SSDCW] + ((size_t)l * 3 + 1) * 2048 + c, w1); ld8f(F.in[I_SSDCW] + ((size_t)l * 3 + 2) * 2048 + c, w2); ld8f(F.in[I_SSDCB] + (size_t)l * 2048 + c, bb);
            v4u bufA[10], bufB[10];
#define XBC_LOAD(buf, r8_) do { _Pragma("unroll") for (int k = 0; k < 10; ++k) { const int s = (r8_) - 1 + k; buf[k] = ldrow(U, s, UC, U_XBC + c, s >= s0 && s < s1); } } while (0)
#define XBC_COMP(buf, r8_) do { _Pragma("unroll") for (int j = 0; j < 8; ++j) { \
                    float p[8], q[8], n[8], o[8]; unpack8(buf[j], p); unpack8(buf[j + 1], q); unpack8(buf[j + 2], n); \
                    _Pragma("unroll") for (int e = 0; e < 8; ++e) o[e] = siluf_(w0[e] * p[e] + w1[e] * q[e] + w2[e] * n[e] + bb[e]); \
                    *(v4u*)(XBCA + (size_t)((r8_) + j) * 2048 + c) = pack8(o); } } while (0)
            XBC_LOAD(bufA, r0);
            XBC_LOAD(bufB, r0 + 8);  XBC_COMP(bufA, r0);
            XBC_LOAD(bufA, r0 + 16); XBC_COMP(bufB, r0 + 8);
            XBC_LOAD(bufB, r0 + 24); XBC_COMP(bufA, r0 + 16);
            XBC_COMP(bufB, r0 + 24);
#undef XBC_LOAD
#undef XBC_COMP
            continue;
        }
        r -= T_XBC;
        if (r < T_POOL) {
            const int rb = r >> 1, cb = r & 1, c = cb * 512 + lane * 8, r0 = rb * 32; int s0, s1; seq_bounds(r0, s0, s1);
            const int grp = c >> 8, half = 1 << grp;
            if (cb == 0) pool_task<2>(U, POOLED, r0, s0, s1, c, half); else pool_task<8>(U, POOLED, r0, s0, s1, c, half);
            continue;
        }
        r -= T_POOL;
        {
            const int r0 = r * 32; int s0, s1; seq_bounds(r0, s0, s1);
            const int qk = lane >> 5, rem = lane & 31, head = rem >> 2, part = (rem >> 1) & 1, sub = rem & 1;
            const int c1 = head * 64 + part * 32 + sub * 8, c2 = c1 + 16; const float scl = qk == 0 ? 0.125f : 1.0f;
            const int ucol = (qk == 0 ? U_RQ : U_RK);
            for (int r8 = r0; r8 < r0 + 32; r8 += 8) {
                v4u b1[8], b2[8];
#pragma unroll
                for (int k = 0; k < 8; ++k) { b1[k] = ldrow(U, r8 + k, UC, ucol + c1, true); b2[k] = ldrow(U, r8 + k, UC, ucol + c2, true); }
#pragma unroll
                for (int k = 0; k < 8; ++k) {
                    const int rr = r8 + k; float x1[8], x2[8], o1[8], o2[8]; unpack8(b1[k], x1); unpack8(b2[k], x2);
                    if (rr < ML) {
                        const int t = rr - s0, pos = part == 0 ? (t >> 6) : (t & 63);
                        const float* rp = ROPE + (size_t)(pos * 16 + sub * 8) * 2;
#pragma unroll
                        for (int e = 0; e < 8; ++e) { const float cs = rp[2 * e], sn = rp[2 * e + 1]; o1[e] = (x1[e] * cs - x2[e] * sn) * scl; o2[e] = (x1[e] * sn + x2[e] * cs) * scl; }
                    } else {
#pragma unroll
                        for (int e = 0; e < 8; ++e) { o1[e] = x1[e] * scl; o2[e] = x2[e] * scl; }
                    }
                    *(v4u*)(RQK + (size_t)rr * 1024 + qk * 512 + c1) = pack8(o1); *(v4u*)(RQK + (size_t)rr * 1024 + qk * 512 + c2) = pack8(o2);
                }
            }
        }
    }
}

#define MFMA32(a, b, c) __builtin_amdgcn_mfma_f32_32x32x16_bf16((a), (b), (c), 0, 0, 0)
#define SCAN_BAR() do { asm volatile("s_waitcnt lgkmcnt(0)" ::: "memory"); __builtin_amdgcn_s_barrier(); asm volatile("" ::: "memory"); } while (0)
typedef short s16x4 __attribute__((ext_vector_type(4)));
__device__ __forceinline__ bf16x8 tr_frag(LAS unsigned char* tile, int rs, int c, int ks, int lane) {
    const int h = lane >> 5, blk = (lane >> 4) & 1, q = (lane & 15) >> 2, p = lane & 3;
    LAS unsigned char* a0 = tile + (16 * ks + 8 * h + q) * rs + (32 * c + 16 * blk + 4 * p) * 2;
    const s16x4 lo = __builtin_amdgcn_ds_read_tr16_b64_v4i16((LAS s16x4*)a0);
    const s16x4 hi = __builtin_amdgcn_ds_read_tr16_b64_v4i16((LAS s16x4*)(a0 + 4 * rs));
    return __builtin_shufflevector(lo, hi, 0, 1, 2, 3, 4, 5, 6, 7);
}
template <int DN, int DP, bool SSD>
__device__ __forceinline__ void scan_unit(Frame& F, int l, int b, int h, int dir) {
    frame_refresh(F);
    constexpr int RSQ = (DN + 8) * 2, RSK2 = DN * 2 + 64, RSV = DP * 2 + 64, RSJ = 72 * 2;
    constexpr int O_Q = 0, O_K = O_Q + 64 * RSQ, O_K2 = O_K + 64 * RSQ, O_V = O_K2 + 64 * RSK2, O_VW = O_V + 64 * RSV, O_S = O_VW + 64 * RSV, O_HST = O_S + 64 * RSJ, O_CUM = O_HST + DP * RSQ, O_END = O_CUM + 256;
    static_assert(O_END <= RING_BYTES, "scan LDS");
    LAS unsigned char* lds = F.lds;
    const int tid = F.tid, lane = F.lane, w = F.wave, r = lane & 31, hh = lane >> 5;
    const bf16* XBCA = (const bf16*)(F.ws + WS_XBCA); const bf16* RQK = (const bf16*)(F.ws + WS_RQK); const bf16* U = (const bf16*)(F.ws + WS_U);
    const float* CUMA = (const float*)(F.ws + WS_CUMA) + (size_t)(dir * 16 + h) * M; const float* DTA = (const float*)(F.ws + WS_DTA) + (size_t)(dir * 16 + h) * M;
    bf16* YS = (bf16*)(F.ws + WS_YS) + (size_t)((SSD ? 0 : 2) + dir) * YS_STRIDE;
    const int ycol = SSD ? h * 64 : h * 128;
    float la_const = 0.f;
    if (!SSD) la_const = -softplusf_(-F.in[I_RETDL][(l * 2 + dir) * 8 + h]);
    for (int i = tid; i < DP * RSQ / 16; i += 512) *(LAS v4u*)(lds + O_HST + i * 16) = (v4u){0u, 0u, 0u, 0u};
    f32x16 Hs;
#pragma unroll
    for (int i = 0; i < 16; ++i) Hs[i] = 0.f;
    const int tok8 = tid >> 3, ch8 = tid & 7, tok16 = tid >> 4, ch16 = tid & 15;
    constexpr int NPF = 2;
    v4u preb[NPF][5]; float pcum[NPF], pdt[NPF], pcl[NPF], pcw[NPF];
#pragma unroll
    for (int u = 0; u < NPF; ++u) { pcum[u] = 0.f; pdt[u] = 1.f; pcl[u] = 0.f; pcw[u] = 0.f;
#pragma unroll
        for (int k = 0; k < 5; ++k) preb[u][k] = (v4u){0u, 0u, 0u, 0u}; }
    auto row_of = [&](int st, int i) -> int {
        int base, sub;
        if (st < 4) { base = ML + b * CTX; sub = dir ? 3 - st : st; } else { base = b * SEQ; sub = dir ? 67 - st : st - 4; }
        return base + sub * 64 + (dir ? 63 - i : i);
    };
#define SCAN_PREFETCH(st_, pre, u_) do { \
        const int rn_ = row_of((st_), tok8), rw0_ = row_of((st_), tok16), rw1_ = row_of((st_), 32 + tok16); \
        if (SSD) { const int g = h >> 2; \
            pre[0] = *(const v4u*)(XBCA + (size_t)rn_ * 2048 + h * 64 + 8 * ch8); \
            pre[1] = *(const v4u*)(XBCA + (size_t)rw0_ * 2048 + 1024 + g * 128 + 8 * ch16); pre[2] = *(const v4u*)(XBCA + (size_t)rw1_ * 2048 + 1024 + g * 128 + 8 * ch16); \
            pre[3] = *(const v4u*)(XBCA + (size_t)rw0_ * 2048 + 1536 + g * 128 + 8 * ch16); pre[4] = *(const v4u*)(XBCA + (size_t)rw1_ * 2048 + 1536 + g * 128 + 8 * ch16); \
            pcum[u_] = CUMA[rn_]; pdt[u_] = DTA[rn_]; pcl[u_] = CUMA[row_of((st_), 63)]; pcw[u_] = CUMA[row_of((st_), lane)]; \
        } else { \
            pre[0] = *(const v4u*)(RQK + (size_t)rn_ * 1024 + h * 64 + 8 * ch8); pre[1] = *(const v4u*)(RQK + (size_t)rn_ * 1024 + 512 + h * 64 + 8 * ch8); \
            pre[2] = *(const v4u*)(U + (size_t)rw0_ * UC + U_RV + h * 128 + 8 * ch16); pre[3] = *(const v4u*)(U + (size_t)rw1_ * UC + U_RV + h * 128 + 8 * ch16); \
        } } while (0)
#pragma unroll
    for (int u = 0; u < NPF; ++u) SCAN_PREFETCH(u, preb[u], u);
    for (int st2 = 0; st2 < 68; st2 += NPF) {
#pragma unroll
    for (int u = 0; u < NPF; ++u) {
        const int st = st2 + u;
        v4u (&pre)[5] = preb[u];
        float clast;
        if (SSD) {
            clast = pcl[u];
            const float dtx = pdt[u], wx = __expf(clast - pcum[u]);
            float x[8], v[8], vw[8]; unpack8(pre[0], x);
#pragma unroll
            for (int e = 0; e < 8; ++e) { v[e] = x[e] * dtx; vw[e] = v[e] * wx; }
            *(LAS v4u*)(lds + O_V + tok8 * RSV + 16 * ch8) = pack8(v); *(LAS v4u*)(lds + O_VW + tok8 * RSV + 16 * ch8) = pack8(vw);
            *(LAS v4u*)(lds + O_K + tok16 * RSQ + 16 * ch16) = pre[1]; *(LAS v4u*)(lds + O_K + (32 + tok16) * RSQ + 16 * ch16) = pre[2];
            *(LAS v4u*)(lds + O_K2 + tok16 * RSK2 + 16 * ch16) = pre[1]; *(LAS v4u*)(lds + O_K2 + (32 + tok16) * RSK2 + 16 * ch16) = pre[2];
            *(LAS v4u*)(lds + O_Q + tok16 * RSQ + 16 * ch16) = pre[3]; *(LAS v4u*)(lds + O_Q + (32 + tok16) * RSQ + 16 * ch16) = pre[4];
            if (w == 0) *(LAS float*)(lds + O_CUM + 4 * lane) = pcw[u];
        } else {
            clast = la_const * 64.f;
            *(LAS v4u*)(lds + O_Q + tok8 * RSQ + 16 * ch8) = pre[0];
            *(LAS v4u*)(lds + O_K + tok8 * RSQ + 16 * ch8) = pre[1]; *(LAS v4u*)(lds + O_K2 + tok8 * RSK2 + 16 * ch8) = pre[1];
            const float w0 = __expf(la_const * (float)(63 - tok16)), w1 = __expf(la_const * (float)(31 - tok16));
            float v0[8], v1[8], q0[8], q1[8]; unpack8(pre[2], v0); unpack8(pre[3], v1);
#pragma unroll
            for (int e = 0; e < 8; ++e) { q0[e] = v0[e] * w0; q1[e] = v1[e] * w1; }
            *(LAS v4u*)(lds + O_V + tok16 * RSV + 16 * ch16) = pre[2]; *(LAS v4u*)(lds + O_V + (32 + tok16) * RSV + 16 * ch16) = pre[3];
            *(LAS v4u*)(lds + O_VW + tok16 * RSV + 16 * ch16) = pack8(q0); *(LAS v4u*)(lds + O_VW + (32 + tok16) * RSV + 16 * ch16) = pack8(q1);
            if (w == 0) *(LAS float*)(lds + O_CUM + 4 * lane) = la_const * (float)(lane + 1);
        }
        SCAN_BAR();
        if (st + NPF < 68) SCAN_PREFETCH(st + NPF, pre, u);
        const float dcy = __expf(clast);
        if (w < 4) {
            const int jb = w >> 1, ib = w & 1;
            f32x16 acc;
#pragma unroll
            for (int i = 0; i < 16; ++i) acc[i] = 0.f;
            if (!(jb == 1 && ib == 0)) {
                bf16x8 fa[DN / 16], fq[DN / 16];
#pragma unroll
                for (int kk = 0; kk < DN / 16; ++kk) {
                    fa[kk] = *(const LAS bf16x8*)(lds + O_K + (jb * 32 + r) * RSQ + (kk * 16 + 8 * hh) * 2);
                    fq[kk] = *(const LAS bf16x8*)(lds + O_Q + (ib * 32 + r) * RSQ + (kk * 16 + 8 * hh) * 2);
                }
                __builtin_amdgcn_sched_barrier(0);
#pragma unroll
                for (int kk = 0; kk < DN / 16; ++kk) acc = MFMA32(fa[kk], fq[kk], acc);
            }
            const int i = ib * 32 + r; const float ci = *(const LAS float*)(lds + O_CUM + 4 * i);
#pragma unroll
            for (int g4 = 0; g4 < 4; ++g4) {
                const int j0 = jb * 32 + 8 * g4 + 4 * hh; const f32x4 cj = *(const LAS f32x4*)(lds + O_CUM + 4 * j0);
                float v[4];
#pragma unroll
                for (int e = 0; e < 4; ++e) { const float cje = e == 0 ? cj.x : (e == 1 ? cj.y : (e == 2 ? cj.z : cj.w)); v[e] = (j0 + e <= i) ? acc[4 * g4 + e] * __expf(ci - cje) : 0.f; }
                v2u o; o.x = pk2(v[0], v[1]); o.y = pk2(v[2], v[3]);
                *(LAS v2u*)(lds + O_S + i * RSJ + j0 * 2) = o;
            }
        }
        SCAN_BAR();
        for (int blk = w; blk < (DP / 32) * 2; blk += 8) {
            const int pb = blk >> 1, ib = blk & 1;
            f32x16 a1, a2;
#pragma unroll
            for (int i = 0; i < 16; ++i) { a1[i] = 0.f; a2[i] = 0.f; }
            bf16x8 fv[4], fs[4], fh[DN / 16], fq[DN / 16];
#pragma unroll
            for (int kk = 0; kk < 4; ++kk) {
                fv[kk] = tr_frag(lds + O_V, RSV, pb, kk, lane);
                fs[kk] = *(const LAS bf16x8*)(lds + O_S + (ib * 32 + r) * RSJ + (kk * 16 + 8 * hh) * 2);
            }
#pragma unroll
            for (int kk = 0; kk < DN / 16; ++kk) {
                fh[kk] = *(const LAS bf16x8*)(lds + O_HST + (pb * 32 + r) * RSQ + (kk * 16 + 8 * hh) * 2);
                fq[kk] = *(const LAS bf16x8*)(lds + O_Q + (ib * 32 + r) * RSQ + (kk * 16 + 8 * hh) * 2);
            }
            __builtin_amdgcn_sched_barrier(0);
#pragma unroll
            for (int kk = 0; kk < 4; ++kk) a1 = MFMA32(fv[kk], fs[kk], a1);
#pragma unroll
            for (int kk = 0; kk < DN / 16; ++kk) a2 = MFMA32(fh[kk], fq[kk], a2);
            const int i = ib * 32 + r; const float ei = __expf(*(const LAS float*)(lds + O_CUM + 4 * i));
            const int row = row_of(st, i);
#pragma unroll
            for (int g4 = 0; g4 < 4; ++g4) {
                const int p0 = pb * 32 + 8 * g4 + 4 * hh;
                v2u o; o.x = pk2(a1[4 * g4 + 0] + ei * a2[4 * g4 + 0], a1[4 * g4 + 1] + ei * a2[4 * g4 + 1]); o.y = pk2(a1[4 * g4 + 2] + ei * a2[4 * g4 + 2], a1[4 * g4 + 3] + ei * a2[4 * g4 + 3]);
                *(v2u*)(YS + (size_t)row * 1024 + ycol + p0) = o;
            }
        }
        {
            const int nb = w / (DP / 32), pb = w % (DP / 32);
#pragma unroll
            for (int i = 0; i < 16; ++i) Hs[i] *= dcy;
            bf16x8 fk[4], fw[4];
#pragma unroll
            for (int kk = 0; kk < 4; ++kk) {
                fk[kk] = tr_frag(lds + O_K2, RSK2, nb, kk, lane);
                fw[kk] = tr_frag(lds + O_VW, RSV, pb, kk, lane);
            }
            __builtin_amdgcn_sched_barrier(0);
#pragma unroll
            for (int kk = 0; kk < 4; ++kk) Hs = MFMA32(fk[kk], fw[kk], Hs);
            SCAN_BAR();
#pragma unroll
            for (int g4 = 0; g4 < 4; ++g4) {
                const int n0 = nb * 32 + 8 * g4 + 4 * hh;
                v2u o; o.x = pk2(Hs[4 * g4 + 0], Hs[4 * g4 + 1]); o.y = pk2(Hs[4 * g4 + 2], Hs[4 * g4 + 3]);
                *(LAS v2u*)(lds + O_HST + (pb * 32 + r) * RSQ + n0 * 2) = o;
            }
        }
    }
    }
    __syncthreads();
#undef SCAN_PREFETCH
}

__device__ __forceinline__ void phase_fin(Frame& F, int l, int nrows) {
    frame_refresh(F);
    const bf16* U = (const bf16*)(F.ws + WS_U); const bf16* YS = (const bf16*)(F.ws + WS_YS); bf16* YB = (bf16*)(F.ws + WS_YB);
    const float* nw = F.in[I_SSDNW] + (size_t)l * 1024; const float* dskp = F.in[I_SSDD] + (size_t)l * 16; const bf16* XBCA = (const bf16*)(F.ws + WS_XBCA);
    const int gw = F.bid * NWAVES + F.wave, NGW = F.G * NWAVES, lane = F.lane;
    for (int row = gw; row < nrows; row += NGW) {
        {
            float g[2][8]; float ss = 0.f;
#pragma unroll
            for (int k = 0; k < 2; ++k) { const int c = k * 512 + 8 * lane; float yf[8], yb[8], z[8];
                unpack8(*(const v4u*)(YS + (size_t)row * 1024 + c), yf); unpack8(*(const v4u*)(YS + YS_STRIDE + (size_t)row * 1024 + c), yb); unpack8(*(const v4u*)(U + (size_t)row * UC + U_Z + c), z);
                float xs[8]; unpack8(*(const v4u*)(XBCA + (size_t)row * 2048 + c), xs); const float dsk = dskp[c >> 6];
#pragma unroll
                for (int e = 0; e < 8; ++e) { g[k][e] = (yf[e] + yb[e] + dsk * xs[e]) * siluf_(z[e]); ss += g[k][e] * g[k][e]; } }
            const float rs = rsqrtf(wave_sum(ss) * (1.0f / 1024.0f) + EPS);
#pragma unroll
            for (int k = 0; k < 2; ++k) { const int c = k * 512 + 8 * lane; float wv[8], o[8]; ld8f(nw + c, wv);
#pragma unroll
                for (int e = 0; e < 8; ++e) o[e] = g[k][e] * rs * wv[e];
                *(v4u*)(YB + yb_off(row, c)) = pack8(o); }
        }
        {
            const int c = 16 * lane; float v[16];
            { float a[8], b2[8]; unpack8(*(const v4u*)(YS + 2 * YS_STRIDE + (size_t)row * 1024 + c), a); unpack8(*(const v4u*)(YS + 3 * YS_STRIDE + (size_t)row * 1024 + c), b2);
#pragma unroll
              for (int e = 0; e < 8; ++e) v[e] = a[e] + b2[e];
              unpack8(*(const v4u*)(YS + 2 * YS_STRIDE + (size_t)row * 1024 + c + 8), a); unpack8(*(const v4u*)(YS + 3 * YS_STRIDE + (size_t)row * 1024 + c + 8), b2);
#pragma unroll
              for (int e = 0; e < 8; ++e) v[8 + e] = a[e] + b2[e]; }
            float s = 0.f;
#pragma unroll
            for (int e = 0; e < 16; ++e) s += v[e];
            s = red8(s);
            const float mu = s * (1.0f / 128.0f); float q = 0.f;
#pragma unroll
            for (int e = 0; e < 16; ++e) { v[e] -= mu; q += v[e] * v[e]; }
            q = red8(q);
            const float rs = rsqrtf(q * (1.0f / 128.0f) + EPS);
            float g0[8], g1[8], o0[8], o1[8]; unpack8(*(const v4u*)(U + (size_t)row * UC + U_RG + c), g0); unpack8(*(const v4u*)(U + (size_t)row * UC + U_RG + c + 8), g1);
#pragma unroll
            for (int e = 0; e < 8; ++e) { o0[e] = siluf_(g0[e]) * v[e] * rs; o1[e] = siluf_(g1[e]) * v[8 + e] * rs; }
            *(v4u*)(YB + 3 * YS_STRIDE + yb_off(row, c)) = pack8(o0); *(v4u*)(YB + 3 * YS_STRIDE + yb_off(row, c + 8)) = pack8(o1);
        }
    }
}

__device__ __forceinline__ size_t act_off(int row, int col) { return (size_t)(row >> 8) * (256 * DFF) + (size_t)(col >> 6) * (256 * 64) + (size_t)((row & 255) * 64 + (col & 63)); }
__device__ __forceinline__ v4u ldedge(const bf16* EDGE, int blk, int j, int h, int c, bool ok) { return ok ? *(const v4u*)(EDGE + ((size_t)(blk * 4 + j) * 2 + h) * DFF + c) : (v4u){0u, 0u, 0u, 0u}; }
__device__ __forceinline__ void phase_ffnfix(Frame& F, int l, int nrows) {
    frame_refresh(F);
    const bf16* EDGE = (const bf16*)(F.ws + WS_UP); bf16* ACT = (bf16*)(F.ws + WS_ACT);
    const int gw = F.bid * NWAVES + F.wave, NGW = F.G * NWAVES, lane = F.lane;
    const int ntask = (nrows / 64) * 11;
    for (int task = gw; task < ntask; task += NGW) {
        const int blk = task / 11, cb = task % 11, c = cb * 512 + lane * 8, r0 = blk * 64; int s0, s1; seq_bounds(r0, s0, s1);
        const bool hp = r0 > s0, hn = r0 + 64 < s1;
        float wa0[8], wa1[8], wa2[8], ba[8], wb0[8], wb1[8], wb2[8], bb[8];
        const float* cw = F.in[I_FFNCW] + (size_t)l * 3 * UPC; const float* cbp = F.in[I_FFNCB] + (size_t)l * UPC;
        v4u ra[6], rb[6];
        ra[0] = ldedge(EDGE, blk - 1, 3, 0, c, hp); ra[1] = ldedge(EDGE, blk, 0, 0, c, true); ra[2] = ldedge(EDGE, blk, 1, 0, c, true);
        ra[3] = ldedge(EDGE, blk, 2, 0, c, true); ra[4] = ldedge(EDGE, blk, 3, 0, c, true); ra[5] = ldedge(EDGE, blk + 1, 0, 0, c, hn);
        rb[0] = ldedge(EDGE, blk - 1, 3, 1, c, hp); rb[1] = ldedge(EDGE, blk, 0, 1, c, true); rb[2] = ldedge(EDGE, blk, 1, 1, c, true);
        rb[3] = ldedge(EDGE, blk, 2, 1, c, true); rb[4] = ldedge(EDGE, blk, 3, 1, c, true); rb[5] = ldedge(EDGE, blk + 1, 0, 1, c, hn);
        ld8f(cw + c, wa0); ld8f(cw + UPC + c, wa1); ld8f(cw + 2 * UPC + c, wa2); ld8f(cbp + c, ba);
        ld8f(cw + DFF + c, wb0); ld8f(cw + UPC + DFF + c, wb1); ld8f(cw + 2 * UPC + DFF + c, wb2); ld8f(cbp + DFF + c, bb);
#pragma unroll
        for (int j = 0; j < 2; ++j) {
            float p[8], q[8], n[8], o[8], a[8];
            unpack8(ra[3 * j], p); unpack8(ra[3 * j + 1], q); unpack8(ra[3 * j + 2], n);
#pragma unroll
            for (int e = 0; e < 8; ++e) a[e] = siluf_(wa0[e] * p[e] + wa1[e] * q[e] + wa2[e] * n[e] + ba[e]);
            unpack8(rb[3 * j], p); unpack8(rb[3 * j + 1], q); unpack8(rb[3 * j + 2], n);
#pragma unroll
            for (int e = 0; e < 8; ++e) o[e] = a[e] * (wb0[e] * p[e] + wb1[e] * q[e] + wb2[e] * n[e] + bb[e]);
            *(v4u*)(ACT + act_off(r0 + 63 * j, c)) = pack8(o);
        }
    }
}

using pg8::f32x4; using pg8::Unit; using pg8::HALF; using pg8::BM;
__device__ __forceinline__ size_t gate_off(int pm, int gt, int wave, int frag, int lane) { return ((((size_t)pm * 32 + gt) * 8 + wave) * 16 + frag) * 512 + (size_t)lane * 8; }
struct EpiInGate {
    static constexpr bool PERM = true, CHAIN = false;
    bf16* U; float* DT; unsigned char* G; const float* bg; int pn0;
    __device__ __forceinline__ void operator()(const f32x4 (&acc)[2][2][4][2], const Unit& u, int wr, int wc, int fr, int fq) const {
        const int row0 = u.pm * BM + wr * 64 + fr, pn = u.pn + pn0;
        if (pn < 40) {
            const int col0 = pn * BM + wc * 32 + 8 * fq;
#pragma unroll
            for (int ai = 0; ai < 2; ++ai)
#pragma unroll
                for (int m = 0; m < 4; ++m) { bf16* rowp = U + (size_t)(row0 + ai * HALF + m * 16) * UC + col0;
#pragma unroll
                    for (int bj = 0; bj < 2; ++bj) { const f32x4 v0 = acc[ai][bj][m][0], v1 = acc[ai][bj][m][1];
                        v4u w; w.x = pg8::cvt_pk_bf16(v0[0], v0[1]); w.y = pg8::cvt_pk_bf16(v0[2], v0[3]); w.z = pg8::cvt_pk_bf16(v1[0], v1[1]); w.w = pg8::cvt_pk_bf16(v1[2], v1[3]);
                        *(v4u*)(rowp + bj * HALF) = w; } }
        } else if (pn == 40) {
            if (wc == 0 && fq < 2) {
#pragma unroll
                for (int ai = 0; ai < 2; ++ai)
#pragma unroll
                    for (int m = 0; m < 4; ++m) { float* rp = DT + (size_t)(row0 + ai * HALF + m * 16) * 16 + 8 * fq; *(f32x4*)rp = acc[ai][0][m][0]; *(f32x4*)(rp + 4) = acc[ai][0][m][1]; }
            }
        } else {
            const int col0 = (pn - 41) * BM + wc * 32 + 8 * fq;
            f32x4 bv[2][2];
#pragma unroll
            for (int bj = 0; bj < 2; ++bj)
#pragma unroll
                for (int n = 0; n < 2; ++n) bv[bj][n] = *(const f32x4*)(bg + col0 + bj * HALF + 4 * n) * -1.44269504f;
            constexpr float QC = 1.0f / 255.99f;
#pragma unroll
            for (int ai = 0; ai < 2; ++ai)
#pragma unroll
                for (int m = 0; m < 4; ++m) { unsigned char* rowp = G + gate_off(u.pm, pn - 41, wr * 4 + wc, ai * 8 + m * 2, fq * 16 + fr);
#pragma unroll
                    for (int bj = 0; bj < 2; ++bj) {
                        unsigned q[8];
#pragma unroll
                        for (int e = 0; e < 4; ++e) {
                            const float e0 = __builtin_amdgcn_exp2f(__builtin_fmaf(acc[ai][bj][m][0][e], -1.44269504f, bv[bj][0][e])), e1 = __builtin_amdgcn_exp2f(__builtin_fmaf(acc[ai][bj][m][1][e], -1.44269504f, bv[bj][1][e]));
                            q[e] = (unsigned)__builtin_amdgcn_rcpf(__builtin_fmaf(e0, QC, QC)); q[4 + e] = (unsigned)__builtin_amdgcn_rcpf(__builtin_fmaf(e1, QC, QC)); }
                        v2u w; w.x = q[0] | (q[1] << 8) | (q[2] << 16) | (q[3] << 24); w.y = q[4] | (q[5] << 8) | (q[6] << 16) | (q[7] << 24);
                        *(v2u*)(rowp + bj * 512) = w; } }
        }
    }
};
template <bool SCALE> struct EpiBf16 {
    static constexpr bool PERM = true, CHAIN = false;
    bf16* O; int ldc; const float* scale;
    __device__ __forceinline__ int operator()(const f32x4 (&acc)[2][2][4][2], const Unit& u, int wr, int wc, int fr, int fq) const {
        const int row0 = u.pm * BM + wr * 64 + fr, col0 = u.pn * BM + wc * 32 + 8 * fq;
        f32x4 sv[2][2];
        if (SCALE) {
#pragma unroll
            for (int bj = 0; bj < 2; ++bj)
#pragma unroll
                for (int n = 0; n < 2; ++n) sv[bj][n] = *(const f32x4*)(scale + col0 + bj * HALF + 4 * n);
        }
#pragma unroll
        for (int ai = 0; ai < 2; ++ai)
#pragma unroll
            for (int m = 0; m < 4; ++m) {
#pragma unroll
                for (int bj = 0; bj < 2; ++bj) { f32x4 v0 = acc[ai][bj][m][0], v1 = acc[ai][bj][m][1];
                    if (SCALE) { v0 = v0 * sv[bj][0]; v1 = v1 * sv[bj][1]; }
                    v4u w; w.x = pg8::cvt_pk_bf16(v0[0], v0[1]); w.y = pg8::cvt_pk_bf16(v0[2], v0[3]); w.z = pg8::cvt_pk_bf16(v1[0], v1[1]); w.w = pg8::cvt_pk_bf16(v1[2], v1[3]);
                    *(v4u*)(O + yb_off(row0 + ai * HALF + m * 16, col0 + bj * HALF)) = w; } }
        return 16;
    }
};
struct EpiFfn {
    static constexpr bool PERM = true, CHAIN = false;
    bf16* ACT; bf16* EDGE; const float* cw; const float* cb;
    template <int CTRL> static __device__ __forceinline__ float dpp(float x) { return __builtin_bit_cast(float, __builtin_amdgcn_update_dpp(0, __builtin_bit_cast(int, x), CTRL, 0xf, 0xf, true)); }
    template <int M> static __device__ __forceinline__ f32x4 conv4(const f32x4 (&x)[4][2], int n, const f32x4 (&w)[4], const f32x4 we0, const f32x4 we2) {
        f32x4 r;
#pragma unroll
        for (int e = 0; e < 4; ++e) { const float c = x[M][n][e];
            float t = __builtin_fmaf(w[1][e], c, w[3][e]);
            t = __builtin_fmaf(w[0][e], dpp<0x111>(c), t);
            t = __builtin_fmaf(w[2][e], dpp<0x101>(c), t);
            if (M > 0) t = __builtin_fmaf(we0[e], dpp<0x121>(x[M > 0 ? M - 1 : 0][n][e]), t);
            if (M < 3) t = __builtin_fmaf(we2[e], dpp<0x12f>(x[M < 3 ? M + 1 : 3][n][e]), t);
            r[e] = t; }
        return r;
    }
    template <int M> __device__ __forceinline__ v2u act4(const f32x4 (&xa)[4][2], const f32x4 (&xb)[4][2], int n, const f32x4 (&wa)[4], const f32x4 (&wb)[4], const f32x4 wae0, const f32x4 wae2, const f32x4 wbe0, const f32x4 wbe2) const {
        const f32x4 va = conv4<M>(xa, n, wa, wae0, wae2), vb = conv4<M>(xb, n, wb, wbe0, wbe2);
        float o[4];
#pragma unroll
        for (int e = 0; e < 4; ++e) o[e] = va[e] * __builtin_amdgcn_rcpf(1.0f + __builtin_amdgcn_exp2f(va[e] * -1.44269504f)) * vb[e];
        v2u r; r.x = pk2(o[0], o[1]); r.y = pk2(o[2], o[3]); return r;
    }
    __device__ __forceinline__ void operator()(const f32x4 (&acc)[2][2][4][2], const Unit& u, int wr, int wc, int fr, int fq) const {
        const int row0 = u.pm * BM + wr * 64 + fr, c0 = u.pn * 128 + wc * 32 + 8 * fq;
        const float e0 = fr == 0 ? 1.f : 0.f, e15 = fr == 15 ? 1.f : 0.f;
#pragma unroll
        for (int ai = 0; ai < 2; ++ai) {
            const int blk = u.pm * 4 + ai * 2 + wr;
            if (fr < 2 || fr >= 14) {
                const int j = fr < 2 ? fr : fr - 12;
                const f32x4 a0 = fr < 2 ? acc[ai][0][0][0] : acc[ai][0][3][0], a1 = fr < 2 ? acc[ai][0][0][1] : acc[ai][0][3][1];
                const f32x4 b0 = fr < 2 ? acc[ai][1][0][0] : acc[ai][1][3][0], b1 = fr < 2 ? acc[ai][1][0][1] : acc[ai][1][3][1];
                bf16* ep = EDGE + ((size_t)(blk * 4 + j) * 2) * DFF + c0;
                v4u w; w.x = pk2(a0[0], a0[1]); w.y = pk2(a0[2], a0[3]); w.z = pk2(a1[0], a1[1]); w.w = pk2(a1[2], a1[3]); *(v4u*)ep = w;
                w.x = pk2(b0[0], b0[1]); w.y = pk2(b0[2], b0[3]); w.z = pk2(b1[0], b1[1]); w.w = pk2(b1[2], b1[3]); *(v4u*)(ep + DFF) = w;
            }
        }
        __builtin_amdgcn_sched_barrier(0);
#pragma unroll
        for (int n = 0; n < 2; ++n) {
            f32x4 wa[4], wb[4];
#pragma unroll
            for (int k = 0; k < 3; ++k) { wa[k] = *(const f32x4*)(cw + k * UPC + c0 + 4 * n); wb[k] = *(const f32x4*)(cw + k * UPC + DFF + c0 + 4 * n); }
            wa[3] = *(const f32x4*)(cb + c0 + 4 * n); wb[3] = *(const f32x4*)(cb + DFF + c0 + 4 * n);
            const f32x4 wae0 = wa[0] * e0, wae2 = wa[2] * e15, wbe0 = wb[0] * e0, wbe2 = wb[2] * e15;
#pragma unroll
            for (int ai = 0; ai < 2; ++ai) {
                v2u r[4];
                r[0] = act4<0>(acc[ai][0], acc[ai][1], n, wa, wb, wae0, wae2, wbe0, wbe2); r[1] = act4<1>(acc[ai][0], acc[ai][1], n, wa, wb, wae0, wae2, wbe0, wbe2);
                r[2] = act4<2>(acc[ai][0], acc[ai][1], n, wa, wb, wae0, wae2, wbe0, wbe2); r[3] = act4<3>(acc[ai][0], acc[ai][1], n, wa, wb, wae0, wae2, wbe0, wbe2);
#pragma unroll
                for (int m = 0; m < 4; ++m) *(v2u*)(ACT + act_off(row0 + ai * HALF + m * 16, c0 + 4 * n)) = r[m];
            }
            __builtin_amdgcn_sched_barrier(0);
        }
    }
};
struct EpiBranch {
    static constexpr bool PERM = true, CHAIN = true;
    const unsigned char* G; bf16* MERGED; int skip;
    static __device__ __forceinline__ void deq8(const v2u w, float (&g)[8]) {
        g[0] = (float)(w.x & 0xffu); g[1] = (float)((w.x >> 8) & 0xffu); g[2] = (float)((w.x >> 16) & 0xffu); g[3] = (float)(w.x >> 24);
        g[4] = (float)(w.y & 0xffu); g[5] = (float)((w.y >> 8) & 0xffu); g[6] = (float)((w.y >> 16) & 0xffu); g[7] = (float)(w.y >> 24);
#pragma unroll
        for (int e = 0; e < 8; ++e) g[e] = (g[e] + 0.5f) * (1.0f / 256.0f);
    }
    static __device__ __forceinline__ void deqs(const v2u w, float (&g)[8], float sc) {
        g[0] = (float)(w.x & 0xffu); g[1] = (float)((w.x >> 8) & 0xffu); g[2] = (float)((w.x >> 16) & 0xffu); g[3] = (float)(w.x >> 24);
        g[4] = (float)(w.y & 0xffu); g[5] = (float)((w.y >> 8) & 0xffu); g[6] = (float)((w.y >> 16) & 0xffu); g[7] = (float)(w.y >> 24);
        const float hb = 0.5f * sc;
#pragma unroll
        for (int e = 0; e < 8; ++e) g[e] = __builtin_fmaf(g[e], sc, hb);
    }
    __device__ __forceinline__ bool operator()(f32x4 (&acc)[2][2][4][2], const Unit& u, int wr, int wc, int fr, int fq) const {
        const int row0 = u.pm * BM + wr * 64 + fr, col0 = u.pn * BM + wc * 32 + 8 * fq, sub = u.sub;
        const int subn = sub < 3 ? sub + 1 : sub;
        if (skip) return sub == 3;
        const int wave = wr * 4 + wc, ln = fq * 16 + fr;
        const bool last = sub == 3;
        const float sg = last ? 127.5f / 65536.0f : 1.0f / 256.0f;
        v2u gv[2][4][2], hv[2][4][2];
#pragma unroll
        for (int ai = 0; ai < 2; ++ai)
#pragma unroll
            for (int m = 0; m < 4; ++m)
#pragma unroll
                for (int bj = 0; bj < 2; ++bj) { gv[ai][m][bj] = *(const v2u*)(G + gate_off(u.pm, sub * 8 + u.pn, wave, ai * 8 + m * 2 + bj, ln)); hv[ai][m][bj] = *(const v2u*)(G + gate_off(u.pm, subn * 8 + u.pn, wave, ai * 8 + m * 2 + bj, ln)); }
        __builtin_amdgcn_sched_barrier(0);
#pragma unroll
        for (int ai = 0; ai < 2; ++ai)
#pragma unroll
            for (int m = 0; m < 4; ++m)
#pragma unroll
                for (int bj = 0; bj < 2; ++bj) {
                    v2u hw = hv[ai][m][bj]; if (last) { hw.x = 0x7f7f7f7fu; hw.y = 0x7f7f7f7fu; }
                    float g[8], h[8]; deqs(gv[ai][m][bj], g, sg); deqs(hw, h, 1.0f / 256.0f);
#pragma unroll
                    for (int e = 0; e < 8; ++e) g[e] = g[e] * __builtin_amdgcn_rcpf(h[e]);
                    f32x4& v0 = acc[ai][bj][m][0]; f32x4& v1 = acc[ai][bj][m][1];
                    v0[0] *= g[0]; v0[1] *= g[1]; v0[2] *= g[2]; v0[3] *= g[3]; v1[0] *= g[4]; v1[1] *= g[5]; v1[2] *= g[6]; v1[3] *= g[7];
                    if (bj == 1) __builtin_amdgcn_sched_barrier(0);
                }
        if (last) {
#pragma unroll
            for (int ai = 0; ai < 2; ++ai)
#pragma unroll
                for (int m = 0; m < 4; ++m)
#pragma unroll
                    for (int bj = 0; bj < 2; ++bj) {
                        const f32x4 v0 = acc[ai][bj][m][0], v1 = acc[ai][bj][m][1];
                        v4u w; w.x = pg8::cvt_pk_bf16(v0[0], v0[1]); w.y = pg8::cvt_pk_bf16(v0[2], v0[3]); w.z = pg8::cvt_pk_bf16(v1[0], v1[1]); w.w = pg8::cvt_pk_bf16(v1[2], v1[3]);
                        *(v4u*)(MERGED + (size_t)(row0 + ai * HALF + m * 16) * 2048 + col0 + bj * HALF) = w;
                    }
        }
        return last;
    }
};
struct EpiResid {
    static constexpr bool PERM = false, CHAIN = false;
    float* X; const float* modl; int goff, skip;
    __device__ __forceinline__ void operator()(const f32x4 (&acc)[2][2][4][2], const Unit& u, int wr, int wc, int fr, int fq) const {
        if (skip) return;
        const int row0 = u.pm * BM + wr * 64 + fr, col0 = u.pn * BM + wc * 32 + 4 * fq;
        const float* gp = modl + (size_t)(u.pm < 64 ? (u.pm >> 4) : 4) * 12288 + goff + col0;
        f32x4 gv[2][2];
#pragma unroll
        for (int bj = 0; bj < 2; ++bj)
#pragma unroll
            for (int n = 0; n < 2; ++n) gv[bj][n] = *(const f32x4*)(gp + bj * HALF + n * 16);
#pragma unroll
        for (int ai = 0; ai < 2; ++ai) {
            f32x4 xv[4][2][2];
#pragma unroll
            for (int m = 0; m < 4; ++m)
#pragma unroll
                for (int bj = 0; bj < 2; ++bj)
#pragma unroll
                    for (int n = 0; n < 2; ++n) xv[m][bj][n] = *(const f32x4*)(X + (size_t)(row0 + ai * HALF + m * 16) * D + col0 + bj * HALF + n * 16);
#pragma unroll
            for (int m = 0; m < 4; ++m)
#pragma unroll
                for (int bj = 0; bj < 2; ++bj)
#pragma unroll
                    for (int n = 0; n < 2; ++n) *(f32x4*)(X + (size_t)(row0 + ai * HALF + m * 16) * D + col0 + bj * HALF + n * 16) = xv[m][bj][n] + gv[bj][n] * acc[ai][bj][m][n];
        }
    }
};

struct EpiPart {
    static constexpr bool PERM = false, CHAIN = false;
    float* PART; const float* modl; int goff;
    __device__ __forceinline__ int operator()(const f32x4 (&acc)[2][2][4][2], const Unit& u, int wr, int wc, int fr, int fq) const {
        const int row0 = (u.pm - 64) * BM + wr * 64 + fr, col0 = u.pn * BM + wc * 32 + 4 * fq;
        const float* gp = modl + (size_t)4 * 12288 + goff + col0;
        float* P = PART + (size_t)u.sub * MC * D;
        f32x4 gv[2][2];
#pragma unroll
        for (int bj = 0; bj < 2; ++bj)
#pragma unroll
            for (int n = 0; n < 2; ++n) gv[bj][n] = *(const f32x4*)(gp + bj * HALF + n * 16);
#pragma unroll
        for (int ai = 0; ai < 2; ++ai)
#pragma unroll
            for (int m = 0; m < 4; ++m)
#pragma unroll
                for (int bj = 0; bj < 2; ++bj)
#pragma unroll
                    for (int n = 0; n < 2; ++n) *(f32x4*)(P + (size_t)(row0 + ai * HALF + m * 16) * D + col0 + bj * HALF + n * 16) = gv[bj][n] * acc[ai][bj][m][n];
        return 32;
    }
};

constexpr int NPH = 11;
constexpr int N_PHASES = 1 + DEPTH * NPH + 1;

__global__ void __launch_bounds__(NWAVES * 64, 2) fwd_kernel(Args args) {
    extern __shared__ __attribute__((aligned(16))) unsigned char lds_raw[];
    Frame F;
    F.lds = (LAS unsigned char*)lds_raw;
    F.tid = threadIdx.x; F.lane = F.tid & 63; F.wave = __builtin_amdgcn_readfirstlane(F.tid >> 6);
    F.G = gridDim.x; F.bid = blockIdx.x; F.ws = args.ws; F.in = args.in;
#if defined(PROBE_K)
    F.variant = args.variant;
#else
    F.variant = 0;
#endif
    gu32* ctl = (gu32*)(args.ws + WS_CTL);
    for (int u = F.tid; u < (LDS_BYTES - LDSCTL_OFF) / 4; u += NWAVES * 64) ((LAS unsigned*)(F.lds + LDSCTL_OFF))[u] = 0u;
    __syncthreads();
    XcdBarrier bar; bar.bar = (unsigned*)(ctl + CW_BAR); bar.x = 0; bar.st = nullptr;
    if (!MK_PER_PHASE && args.ph_hi - args.ph_lo > 1) bar = xcd_barrier_post((unsigned*)(ctl + CW_BAR), (volatile LAS unsigned*)(F.lds + MISC_OFF) + 8);
    const int lo = args.ph_lo, hi = args.ph_hi;
#ifndef PH_MASK
#define PH_MASK 0xFFFF
#endif
#define EN(b) (((PH_MASK) >> (b)) & 1)
#define IN(k) (lo <= (k) && (k) < hi)
#define SEAM(k) do { if (!MK_PER_PHASE && IN((k) + 1)) xcd_barrier(bar); } while (0)

    if (EN(11) && IN(0)) { phase_mod(F); steal_convert(F, 0, 0, true); SEAM(0); }

    for (int l = 0; l < DEPTH; ++l) {
        const int p0 = 1 + l * NPH;
        const int nrows = (l == DEPTH - 1) ? ML : M;
        const int nMp = nrows / 256;
        const float* modl = (const float*)(F.ws + WS_MOD) + (size_t)l * 5 * 12288;
        const unsigned char* wb = F.ws + (size_t)(l & 1) * W_SPAN;
        const bool cv = l + 1 < DEPTH;
        if (EN(0) && IN(p0 + 0)) {
            if (l == 0) phase_norm<true>(F, l, F.in[I_NORM1] + (size_t)l * D, 0, 2048, M);
            else phase_norm<false>(F, l, F.in[I_NORM1] + (size_t)l * D, 0, 2048, M, true);
            SEAM(p0 + 0);
        }
        if (EN(1) && IN(p0 + 1)) {
            const bool two = (nrows == ML);
            {
                pg8::Gemm g{(const char*)(F.ws + WS_H), (const char*)(wb + WS_WIG), (size_t)256 * D * 2, 0, 0, (size_t)256 * D * 2, 0, D, D, D};
                pg8::TileOrder<1> S; S.init(M / 256, two ? 41 : NIG / 256, F.G, F.bid);
                EpiInGate E{(bf16*)(F.ws + WS_U), (float*)(F.ws + WS_DT), (unsigned char*)(F.ws + WS_G), F.in[I_BGATE] + (size_t)l * 4 * 2048, 0};
                pg8::gemm_phase(F.lds + RING_OFF, g, S, E);
            }
            if (two) {
                pg8::Gemm g{(const char*)(F.ws + WS_H), (const char*)(wb + WS_WIG) + (size_t)41 * 256 * D * 2, (size_t)256 * D * 2, 0, 0, (size_t)256 * D * 2, 0, D, D, D};
                pg8::TileOrder<1> S; S.init(ML / 256, 32, F.G, F.bid);
                EpiInGate E{(bf16*)(F.ws + WS_U), (float*)(F.ws + WS_DT), (unsigned char*)(F.ws + WS_G), F.in[I_BGATE] + (size_t)l * 4 * 2048, 41};
                pg8::gemm_phase(F.lds + RING_OFF, g, S, E);
            }
            if (cv) steal_convert(F, l + 1, 1 + l * 6 + 0, false);
            SEAM(p0 + 1);
        }
        if (EN(2) && IN(p0 + 2)) { phase_pre(F, l); SEAM(p0 + 2); }
        if (EN(3) && IN(p0 + 3)) {
            const int nscan = 192;
            const bool split = F.G > nscan;
            for (int id = F.bid; id < nscan; id += F.G) {
#ifndef NO_SSD
                if (id < 128) scan_unit<128, 64, true>(F, l, id >> 5, (id >> 1) & 15, id & 1);
                else
#endif
#ifndef NO_RET
                { const int j = id - 128; scan_unit<64, 128, false>(F, l, j >> 4, (j >> 1) & 7, j & 1); }
#else
                {}
#endif
            }
#ifndef NO_POOLG
            if (!split || F.bid >= nscan) {
                pg8::Gemm g{(const char*)(F.ws + WS_POOLED), (const char*)(wb + WS_WPOOL), (size_t)256 * 1024 * 2, (size_t)256 * 2, 0, (size_t)256 * 256 * 2, 0, 1024, 256, 256};
                pg8::TileOrder<1> S; S.init(M / 256, 4, split ? F.G - nscan : F.G, split ? F.bid - nscan : F.bid);
                EpiBf16<true> E{(bf16*)(F.ws + WS_YB) + YS_STRIDE, 1024, F.in[I_POOLS] + (size_t)l * 1024};
                pg8::gemm_phase(F.lds + RING_OFF, g, S, E);
                sc_phase(F, l, split ? F.bid - nscan : F.bid, split ? F.G - nscan : F.G);
            }
            if (cv) steal_convert(F, l + 1, 1 + l * 6 + 5, false);
#endif
            SEAM(p0 + 3);
        }
        if (EN(4) && IN(p0 + 4)) { phase_fin(F, l, nrows); SEAM(p0 + 4); }
        if (EN(5) && IN(p0 + 5)) {
            pg8::Gemm g{(const char*)(F.ws + WS_YB), (const char*)(wb + WS_WB), (size_t)256 * 1024 * 2, 0, YS_STRIDE * 2, (size_t)256 * 1024 * 2, (size_t)2048 * 1024 * 2, 64, 1024, 1024, (size_t)256 * 64 * 2};
            pg8::TileOrder<4> S; S.init(nMp, D / 256, F.G, F.bid, 8);
            EpiBranch E{(const unsigned char*)(F.ws + WS_G), (bf16*)(F.ws + WS_MERGED), F.variant & 128};
            pg8::gemm_phase(F.lds + RING_OFF, g, S, E);
            if (cv) steal_convert(F, l + 1, 1 + l * 6 + 1, false);
            SEAM(p0 + 5);
        }
        if (EN(6) && IN(p0 + 6)) {
            pg8::Gemm g{(const char*)(F.ws + WS_MERGED), (const char*)(wb + WS_WO), (size_t)256 * D * 2, 0, 0, (size_t)256 * D * 2, 0, D, D, D};
            pg8::TileOrder<1> S; S.init(ML / 256, D / 256, F.G, F.bid);
            EpiResid E{(float*)(F.ws + WS_X), modl, 4096, F.variant & 128};
            pg8::gemm_phase(F.lds + RING_OFF, g, S, E);
            if (nMp > ML / 256) {
                pg8::Gemm g2{(const char*)(F.ws + WS_MERGED), (const char*)(wb + WS_WO), (size_t)256 * D * 2, 0, (size_t)(D / 4) * 2, (size_t)256 * D * 2, (size_t)(D / 4) * 2, D, D, D / 4};
                pg8::SplitOrder<4> S2; S2.init(nMp - ML / 256, D / 256, ML / 256, F.G, F.bid);
                EpiPart E2{(float*)(F.ws + WS_PART), modl, 4096};
                pg8::gemm_phase(F.lds + RING_OFF, g2, S2, E2);
            }
            if (cv) steal_convert(F, l + 1, 1 + l * 6 + 2, false);
            SEAM(p0 + 6);
        }
        if (EN(7) && IN(p0 + 7)) { phase_norm<false>(F, l, F.in[I_NORM2] + (size_t)l * D, 6144, 8192, nrows, nrows > ML); SEAM(p0 + 7); }
        if (EN(8) && IN(p0 + 8)) {
            pg8::Gemm g{(const char*)(F.ws + WS_H), (const char*)(wb + WS_WUP), (size_t)256 * D * 2, 0, 0, (size_t)256 * D * 2, 0, D, D, D};
            pg8::TileOrder<1> S; S.init(nMp, UPC / 256, F.G, F.bid);
            EpiFfn E{(bf16*)(F.ws + WS_ACT), (bf16*)(F.ws + WS_UP), F.in[I_FFNCW] + (size_t)l * 3 * UPC, F.in[I_FFNCB] + (size_t)l * UPC};
            pg8::gemm_phase(F.lds + RING_OFF, g, S, E);
            if (cv) steal_convert(F, l + 1, 1 + l * 6 + 3, false);
            SEAM(p0 + 8);
        }
        if (EN(9) && IN(p0 + 9)) { phase_ffnfix(F, l, nrows); SEAM(p0 + 9); }
        if (EN(10) && IN(p0 + 10)) {
            pg8::Gemm g{(const char*)(F.ws + WS_ACT), (const char*)(wb + WS_WDN), (size_t)256 * DFF * 2, 0, 0, (size_t)256 * DFF * 2, 0, 64, DFF, DFF, (size_t)256 * 64 * 2};
            pg8::TileOrder<1> S; S.init(ML / 256, D / 256, F.G, F.bid, 2);
            EpiResid E{(float*)(F.ws + WS_X), modl, 10240, F.variant & 128};
            pg8::gemm_phase(F.lds + RING_OFF, g, S, E);
            if (nMp > ML / 256) {
                pg8::Gemm g2{(const char*)(F.ws + WS_ACT), (const char*)(wb + WS_WDN), (size_t)256 * DFF * 2, 0, (size_t)(DFF / 4 / 64) * 256 * 64 * 2, (size_t)256 * DFF * 2, (size_t)(DFF / 4) * 2, 64, DFF, DFF / 4, (size_t)256 * 64 * 2};
                pg8::SplitOrder<4> S2; S2.init(nMp - ML / 256, D / 256, ML / 256, F.G, F.bid);
                EpiPart E2{(float*)(F.ws + WS_PART), modl, 10240};
                pg8::gemm_phase(F.lds + RING_OFF, g2, S2, E2);
            }
            if (cv) steal_convert(F, l + 1, 1 + l * 6 + 4, true);
            SEAM(p0 + 10);
        }
    }
    if (EN(12) && IN(N_PHASES - 1)) {
        phase_final(F, args.out);
    }
#undef IN
#undef SEAM
}

extern "C" void kernel_launch(void* const* d_in, const int* in_sizes, int n_in, void* d_out, int out_size, void* d_ws, size_t ws_size, hipStream_t stream) {
    static int grid = 0;
    if (grid == 0) {
        if (n_in != 28 || in_sizes[0] != ML * D || out_size != ML * D || ws_size < WS_END) { fprintf(stderr, "kernel_launch: unexpected shapes (n_in %d, in0 %d, out %d, ws %zu < %zu); nothing launched\n", n_in, n_in > 0 ? in_sizes[0] : -1, out_size, ws_size, (size_t)WS_END); grid = -1; return; }
        int dev = 0, cus = 0, per_cu = 0;
        if (hipGetDevice(&dev) != hipSuccess || hipDeviceGetAttribute(&cus, hipDeviceAttributeMultiprocessorCount, dev) != hipSuccess) { fprintf(stderr, "kernel_launch: device query failed\n"); grid = -1; return; }
        if (hipFuncSetAttribute((const void*)fwd_kernel, hipFuncAttributeMaxDynamicSharedMemorySize, LDS_BYTES) != hipSuccess) { fprintf(stderr, "kernel_launch: hipFuncSetAttribute failed\n"); grid = -1; return; }
        if (hipOccupancyMaxActiveBlocksPerMultiprocessor(&per_cu, (const void*)fwd_kernel, NWAVES * 64, LDS_BYTES) != hipSuccess || per_cu < 1)
            fprintf(stderr, "kernel_launch: note: occupancy query reports %d workgroups per CU\n", per_cu);
        (void)hipGetLastError();
        grid = cus;
    }
    if (grid < 0) return;
    if (hipMemsetAsync((char*)d_ws + WS_CTL, 0, CTL_ZERO_BYTES, stream) != hipSuccess) { fprintf(stderr, "kernel_launch: memset failed\n"); return; }
    Args a{};
    for (int i = 0; i < 28; ++i) a.in[i] = (const float*)d_in[i];
    a.out = (float*)d_out; a.ws = (unsigned char*)d_ws;
#if defined(PROBE_K)
    a.ph_lo = 0; a.ph_hi = N_PHASES;
    hipLaunchKernelGGL(fwd_kernel, dim3(grid), dim3(NWAVES * 64), LDS_BYTES, stream, a);
    for (int rep = 0; rep < PROBE_REPS; ++rep) for (int l = 0; l < DEPTH; ++l) { a.ph_lo = 1 + l * NPH + PROBE_K; a.ph_hi = a.ph_lo + 1; a.variant = PROBE_VARIANT; hipLaunchKernelGGL(fwd_kernel, dim3(grid), dim3(NWAVES * 64), LDS_BYTES, stream, a); }
#elif MK_PER_PHASE
    for (int p = 0; p < N_PHASES; ++p) { a.ph_lo = p; a.ph_hi = p + 1; hipLaunchKernelGGL(fwd_kernel, dim3(grid), dim3(NWAVES * 64), LDS_BYTES, stream, a); }
#else
    a.ph_lo = 0; a.ph_hi = N_PHASES;
    hipLaunchKernelGGL(fwd_kernel, dim3(grid), dim3(NWAVES * 64), LDS_BYTES, stream, a);
#endif
    const hipError_t le = hipPeekAtLastError();
    if (le != hipSuccess) fprintf(stderr, "kernel_launch: launch failed: %s\n", hipGetErrorName(le));
}
```

```cpp
#include <hip/hip_runtime.h>
#include <cstdio>
#include <cstdint>

#ifndef MK_PER_PHASE
#define MK_PER_PHASE 0
#endif

namespace pg8 {
#define PG8_LAS __attribute__((address_space(3)))
typedef unsigned short bf16_t;
typedef short bf16x8 __attribute__((ext_vector_type(8)));
typedef float f32x4 __attribute__((ext_vector_type(4)));
typedef unsigned u32x4 __attribute__((ext_vector_type(4)));
constexpr int BM = 256, BK = 64, HALF = 128, HTB = HALF * BK * 2, STAGE_BYTES = 8 * HTB, NXCD = 8, WGM = 8;

__host__ __device__ __forceinline__ int lds_byte(int r, int c) { const int st = (r >> 4) * 2 + (c >> 5), rr = r & 15, cc = c & 31, ob = rr * 64 + cc * 2; return st * 1024 + (ob ^ (((ob >> 9) & 1) << 5)); }
__host__ __device__ __forceinline__ void stage_rc(int b, int& R, int& C) { const int st = b / 1024, sb = b % 1024, swz = sb ^ (((sb >> 9) & 1) << 5); R = (st >> 1) * 16 + swz / 64; C = (st & 1) * 32 + (swz % 64) / 2; }
__host__ __device__ __forceinline__ int perm32(int rho) { const int n = rho >> 4, i = rho & 15; return 8 * (i >> 2) + 4 * n + (i & 3); }

struct Unit { int pm, pn, sub; };
struct Gemm { const char* A; const char* B; size_t a_tile, a_pn, a_sub, b_tile, b_sub; int lda, ldb, K; size_t kstepA = (size_t)(BK * 2); };

template <int NSUB> struct TileOrder {
    int nM, nN, nwg, G, c, wgm;
    __device__ __forceinline__ void init(int nM_, int nN_, int G_, int c_, int wgm_ = 4) { nM = nM_; nN = nN_; nwg = nM * nN; G = G_; c = c_; wgm = wgm_; }
    __device__ __forceinline__ bool next(int i, Unit& u) const {
        const int sub = i % NSUB; const long L = (long)(i / NSUB) * G + c; if (L >= nwg) return false;
        int wgid = (int)L; { const int q = nwg / NXCD, r = nwg % NXCD, xcd = wgid % NXCD, off = wgid / NXCD; wgid = (xcd < r ? xcd * (q + 1) : r * (q + 1) + (xcd - r) * q) + off; }
        const int nig = wgm * nN, gid = wgid / nig, fm = gid * wgm, gsz = (nM - fm) < wgm ? (nM - fm) : wgm;
        u.pm = fm + ((wgid % nig) % gsz); u.pn = (wgid % nig) / gsz; u.sub = sub; return true;
    }
};

template <int NSUB> struct SplitOrder {
    int nM, nN, pm0, G, c;
    __device__ __forceinline__ void init(int nM_, int nN_, int pm0_, int G_, int c_) { nM = nM_; nN = nN_; pm0 = pm0_; G = G_; c = c_; }
    __device__ __forceinline__ bool next(int i, Unit& u) const {
        const int j = i * G + c; if (j >= nM * nN * NSUB) return false;
        const int tile = j / NSUB; u.sub = j % NSUB; u.pm = pm0 + tile / nN; u.pn = tile % nN; return true;
    }
};
typedef __bf16 bf16x2_t __attribute__((ext_vector_type(2)));
typedef float f32x2_t __attribute__((ext_vector_type(2)));
__device__ __forceinline__ unsigned cvt_pk_bf16(float lo, float hi) { const f32x2_t v = {lo, hi}; return __builtin_bit_cast(unsigned, __builtin_convertvector(v, bf16x2_t)); }

template <class Epi, class Sched>
__device__ __forceinline__ void gemm_phase(PG8_LAS unsigned char* lds, const Gemm g, const Sched& S, const Epi& E) {
    int tid_ = threadIdx.x; asm volatile("" : "+v"(tid_));
    const int tid = tid_, wid = __builtin_amdgcn_readfirstlane(tid >> 6), lane = tid & 63, wr = wid >> 2, wc = wid & 3, fr = lane & 15, fq = lane >> 4;
    const int K = g.K, nt = K / BK;
    unsigned voffA[2], voffB[2];
#pragma unroll
    for (int i = 0; i < 2; ++i) { int R, C; stage_rc(tid * 16 + i * 8192, R, C); const int Rb = Epi::PERM ? ((R & ~31) + perm32(R & 31)) : R;
        voffA[i] = (unsigned)(R * g.lda + C) * 2u; voffB[i] = (unsigned)(Rb * g.ldb + C) * 2u; }
    const size_t kstep = (size_t)(BK * 2), kstepA = g.kstepA;
    const size_t hstepA = (size_t)HALF * g.lda * 2, hstepB = (size_t)HALF * g.ldb * 2;
    const unsigned ldsw = (unsigned)wid * 1024u;
    const int aoff = lds_byte(wr * 64 + fr, fq * 8), boff = lds_byte(wc * 32 + fr, fq * 8);
#define PG8_SA(b, h) (((b) * 2 + (h)) * HTB)
#define PG8_SB(b, h) ((4 + (b) * 2 + (h)) * HTB)
#define PG8_STAGE(bufoff, gbase, voff) do { _Pragma("unroll") for (int _i = 0; _i < 2; ++_i) \
        __builtin_amdgcn_global_load_lds((const unsigned*)((const char*)(gbase) + (voff)[_i]), (PG8_LAS unsigned*)(lds + (bufoff) + ldsw + _i * 8192), 16, 0, 0); } while (0)
#define PG8_LDA(dst, b, h) do { _Pragma("unroll") for (int m = 0; m < 4; ++m) _Pragma("unroll") for (int k = 0; k < 2; ++k) dst[m][k] = *(const PG8_LAS bf16x8*)(lds + PG8_SA(b, h) + aoff + m * 2048 + k * 1024); } while (0)
#define PG8_LDB(dst, b, h) do { _Pragma("unroll") for (int n = 0; n < 2; ++n) _Pragma("unroll") for (int k = 0; k < 2; ++k) dst[n][k] = *(const PG8_LAS bf16x8*)(lds + PG8_SB(b, h) + boff + n * 2048 + k * 1024); } while (0)
#define PG8_MMA(ai, bj, At, Bt) do { __builtin_amdgcn_s_setprio(1); _Pragma("unroll") for (int m = 0; m < 4; ++m) _Pragma("unroll") for (int n = 0; n < 2; ++n) _Pragma("unroll") for (int k = 0; k < 2; ++k) \
        acc[ai][bj][m][n] = __builtin_amdgcn_mfma_f32_16x16x32_bf16(Bt[n][k], At[m][k], acc[ai][bj][m][n], 0, 0, 0); __builtin_amdgcn_s_setprio(0); } while (0)
#define PG8_WAIT_V(n) asm volatile("s_waitcnt vmcnt(" #n ")" ::: "memory")
#define PG8_WAIT_L(n) asm volatile("s_waitcnt lgkmcnt(" #n ")" ::: "memory")
#define PG8_BAR __builtin_amdgcn_s_barrier()
#define PG8_SCHED __builtin_amdgcn_sched_barrier(0)
    Unit cur, nxt; int ui = 0;
    if (!S.next(0, cur)) return;
    f32x4 acc[2][2][4][2];
#pragma unroll
    for (int a = 0; a < 2; ++a)
#pragma unroll
        for (int b = 0; b < 2; ++b)
#pragma unroll
            for (int m = 0; m < 4; ++m)
#pragma unroll
                for (int n = 0; n < 2; ++n) acc[a][b][m][n] = (f32x4){0.f, 0.f, 0.f, 0.f};
    bf16x8 At[4][2], B0[2][2], B1[2][2];
    const char* cA = g.A + (size_t)cur.pm * g.a_tile + (size_t)cur.pn * g.a_pn + (size_t)cur.sub * g.a_sub;
    const char* cB = g.B + (size_t)cur.pn * g.b_tile + (size_t)cur.sub * g.b_sub;
    PG8_STAGE(PG8_SB(0, 0), cB, voffB); PG8_STAGE(PG8_SB(0, 1), cB + hstepB, voffB); PG8_STAGE(PG8_SA(0, 0), cA, voffA); PG8_STAGE(PG8_SA(0, 1), cA + hstepA, voffA);
    if (wr == 1) PG8_BAR;
    PG8_WAIT_V(2); PG8_BAR;
    PG8_STAGE(PG8_SB(1, 0), cB + kstep, voffB); PG8_STAGE(PG8_SA(1, 0), cA + kstepA, voffA); PG8_STAGE(PG8_SB(1, 1), cB + hstepB + kstep, voffB);
    PG8_WAIT_V(6); PG8_BAR;
    for (;;) {
        const bool has_next = S.next(ui + 1, nxt);
        const char* nA = has_next ? g.A + (size_t)nxt.pm * g.a_tile + (size_t)nxt.pn * g.a_pn + (size_t)nxt.sub * g.a_sub : cA;
        const char* nB = has_next ? g.B + (size_t)nxt.pn * g.b_tile + (size_t)nxt.sub * g.b_sub : cB;
        for (int t = 0; t < nt; t += 2) {
            const bool last = (t == nt - 2);
            const char* a1 = cA + (size_t)(t + 1) * kstepA;
            const char* a2 = last ? nA : cA + (size_t)(t + 2) * kstepA; const char* b2 = last ? nB : cB + (size_t)(t + 2) * kstep;
            const char* a3 = a2 + kstepA; const char* b3 = b2 + kstep;
            PG8_LDB(B0, 0, 0); PG8_LDB(B1, 0, 1); PG8_SCHED; PG8_LDA(At, 0, 0); PG8_STAGE(PG8_SA(1, 1), a1 + hstepA, voffA);
            PG8_WAIT_V(8); PG8_WAIT_L(0); PG8_BAR; PG8_MMA(0, 0, At, B0); PG8_MMA(0, 1, At, B1); PG8_BAR; PG8_SCHED;
            PG8_LDA(At, 0, 1); PG8_STAGE(PG8_SB(0, 0), b2, voffB); PG8_STAGE(PG8_SB(0, 1), b2 + hstepB, voffB); PG8_STAGE(PG8_SA(0, 0), a2, voffA);
            PG8_WAIT_V(8); PG8_WAIT_L(0); PG8_BAR; PG8_MMA(1, 0, At, B0); PG8_MMA(1, 1, At, B1); PG8_BAR; PG8_SCHED;
            PG8_LDB(B0, 1, 0); PG8_LDB(B1, 1, 1); PG8_SCHED; PG8_LDA(At, 1, 0); PG8_STAGE(PG8_SA(0, 1), a2 + hstepA, voffA);
            PG8_WAIT_V(8); PG8_WAIT_L(0); PG8_BAR; PG8_MMA(0, 0, At, B0); PG8_MMA(0, 1, At, B1); PG8_BAR; PG8_SCHED;
            PG8_LDA(At, 1, 1); PG8_STAGE(PG8_SB(1, 0), b3, voffB); PG8_STAGE(PG8_SB(1, 1), b3 + hstepB, voffB); PG8_STAGE(PG8_SA(1, 0), a3, voffA);
            PG8_WAIT_V(8); PG8_WAIT_L(0); PG8_BAR; PG8_MMA(1, 0, At, B0); PG8_MMA(1, 1, At, B1); PG8_BAR; PG8_SCHED;
        }
        if (wr == 0) PG8_BAR;
        bool zero_acc = true;
        int fr2 = fr, fq2 = fq; asm volatile("" : "+v"(fr2), "+v"(fq2));
        if constexpr (Epi::CHAIN) zero_acc = E(acc, cur, wr, wc, fr2, fq2); else E(acc, cur, wr, wc, fr2, fq2);
        if (!has_next) break;
        if (zero_acc) {
#pragma unroll
        for (int a = 0; a < 2; ++a)
#pragma unroll
            for (int b = 0; b < 2; ++b)
#pragma unroll
                for (int m = 0; m < 4; ++m)
#pragma unroll
                    for (int n = 0; n < 2; ++n) acc[a][b][m][n] = (f32x4){0.f, 0.f, 0.f, 0.f};
        }
        cur = nxt; cA = nA; cB = nB; ++ui;
        if (wr == 1) PG8_BAR;
    }
    PG8_WAIT_V(0);
    PG8_BAR;
#undef PG8_SA
#undef PG8_SB
#undef PG8_STAGE
#undef PG8_LDA
#undef PG8_LDB
#undef PG8_MMA
#undef PG8_WAIT_V
#undef PG8_WAIT_L
#undef PG8_BAR
#undef PG8_SCHED
}
}

constexpr int NWAVES = 8;
constexpr int D = 2048, NB = 4, SEQ = 4096, CTX = 256, DEPTH = 4;
constexpr int ML = NB * SEQ;
constexpr int MC = NB * CTX;
constexpr int M = ML + MC;
constexpr int UC = 10240;
constexpr int NIG = 10496 + 8192;
constexpr int DFF = 5632, UPC = 2 * DFF;
constexpr int IN_COLS = 10256;
constexpr float EPS = 1e-6f;
constexpr int U_Z = 0, U_XBC = 1024, U_POOL = 3072, U_SCB = 4096, U_SCC = 5120, U_SCX = 6144, U_RQ = 7168, U_RK = 7680, U_RV = 8192, U_RG = 9216;

constexpr size_t MiB = 1u << 20;
constexpr size_t WS_CTL = 0, CTL_ZERO_BYTES = 128 * 1024;
constexpr size_t WS_MOD = 1 * MiB;
constexpr size_t WS_ROPE = WS_MOD + (size_t)DEPTH * 5 * 12288 * 4;
constexpr size_t WS_X = 2 * MiB;
constexpr size_t WS_H = WS_X + 136 * MiB;
constexpr size_t WS_WIG = WS_H + 68 * MiB;
constexpr size_t WS_WB = WS_WIG + 73 * MiB;
constexpr size_t WS_WO = WS_WB + 16 * MiB;
constexpr size_t WS_WUP = WS_WO + 8 * MiB;
constexpr size_t WS_WDN = WS_WUP + 44 * MiB;
constexpr size_t WS_WPOOL = WS_WDN + 22 * MiB;
constexpr size_t W_SPAN = WS_WPOOL + 1 * MiB - WS_WIG;
constexpr size_t WS_U = WS_WIG + 2 * W_SPAN;
constexpr size_t WS_DT = WS_U + 340 * MiB;
constexpr size_t WS_G = WS_DT + 2 * MiB;
constexpr size_t WS_UP = WS_U;
constexpr size_t WS_CUMA = WS_G + 140 * MiB;
constexpr size_t WS_DTA = WS_CUMA + 4 * MiB;
constexpr size_t WS_PART = WS_G + 152 * MiB;
constexpr size_t WS_XBCA = WS_G + 272 * MiB;
constexpr size_t WS_RQK = WS_XBCA + 68 * MiB;
constexpr size_t WS_YS = WS_RQK + 34 * MiB;
constexpr size_t WS_YB = WS_YS + 136 * MiB;
constexpr size_t WS_POOLED = WS_YB + 136 * MiB;
constexpr size_t WS_MERGED = WS_POOLED + 34 * MiB;
constexpr size_t WS_MRG32 = WS_XBCA;
constexpr size_t WS_ACT = WS_XBCA;
constexpr size_t WS_END = WS_MERGED + 68 * MiB;
static_assert(WS_UP + (size_t)M * UPC * 2 <= WS_XBCA, "UP overlay");
static_assert(WS_DTA + 4 * MiB <= WS_PART && WS_PART + 32 * MiB <= WS_XBCA, "PART");
static_assert(WS_UP + (size_t)M * UPC * 2 <= WS_CUMA && WS_DTA + 4 * MiB <= WS_XBCA && (size_t)2 * 16 * M * 4 <= 4 * MiB, "cum/dt arrays");
static_assert(WS_ACT + (size_t)M * DFF * 2 <= WS_YB, "ACT overlay");
static_assert(WS_MRG32 + (size_t)M * D * 4 <= WS_YS + 34 * MiB, "MRG32 overlay");
static_assert(WS_ROPE + 8192 <= WS_X, "mod/rope");
__host__ __device__ __forceinline__ size_t yb_off(int row, int col) { return (size_t)(row >> 8) * (256 * 1024) + (size_t)(col >> 6) * (256 * 64) + (size_t)((row & 255) * 64 + (col & 63)); }
constexpr size_t YS_STRIDE = (size_t)M * 1024;

constexpr int CW_TMO = 0, CW_CODE = 1, CW_BAR = 4096, CW_Q = 16384, CW_FIN = 20480;

constexpr int RING_OFF = 0, RING_BYTES = 131072;
constexpr int LDSCTL_OFF = RING_BYTES, MISC_OFF = LDSCTL_OFF + 320;
constexpr int LDS_BYTES = 147456;

#define GAS __attribute__((address_space(1)))
#define LAS __attribute__((address_space(3)))
typedef unsigned short bf16;
typedef unsigned v4u __attribute__((ext_vector_type(4)));
typedef unsigned v2u __attribute__((ext_vector_type(2)));
typedef float f32x4 __attribute__((ext_vector_type(4)));
typedef float f32x16 __attribute__((ext_vector_type(16)));
typedef short bf16x8 __attribute__((ext_vector_type(8)));
typedef GAS unsigned gu32;
#define RLX_AGENT __ATOMIC_RELAXED, __HIP_MEMORY_SCOPE_AGENT
#define LDS_WAIT() asm volatile("s_waitcnt lgkmcnt(0)" ::: "memory")
#define VM_WAIT() asm volatile("s_waitcnt vmcnt(0)" ::: "memory")
__device__ __forceinline__ unsigned f2bf(float f) { return (unsigned)__builtin_bit_cast(unsigned short, (__bf16)f); }
__device__ __forceinline__ unsigned pk2(float lo, float hi) { return pg8::cvt_pk_bf16(lo, hi); }
__device__ __forceinline__ float bflo(unsigned w) { return __builtin_bit_cast(float, w << 16); }
__device__ __forceinline__ float bfhi(unsigned w) { return __builtin_bit_cast(float, w & 0xffff0000u); }
__device__ __forceinline__ float bf1(unsigned short b) { return __builtin_bit_cast(float, (unsigned)b << 16); }
__device__ __forceinline__ void unpack8(const v4u w, float (&f)[8]) { f[0] = bflo(w.x); f[1] = bfhi(w.x); f[2] = bflo(w.y); f[3] = bfhi(w.y); f[4] = bflo(w.z); f[5] = bfhi(w.z); f[6] = bflo(w.w); f[7] = bfhi(w.w); }
__device__ __forceinline__ v4u pack8(const float (&f)[8]) { v4u w; w.x = pk2(f[0], f[1]); w.y = pk2(f[2], f[3]); w.z = pk2(f[4], f[5]); w.w = pk2(f[6], f[7]); return w; }
__device__ __forceinline__ float sigmoidf_(float x) { return __builtin_amdgcn_rcpf(1.0f + __expf(-x)); }
__device__ __forceinline__ float siluf_(float x) { return x * sigmoidf_(x); }
__device__ __forceinline__ float softplusf_(float x) { return fmaxf(x, 0.f) + log1pf(expf(-fabsf(x))); }
template <int CTRL> __device__ __forceinline__ float dppf(float v) { return __builtin_bit_cast(float, __builtin_amdgcn_update_dpp(0, __builtin_bit_cast(int, v), CTRL, 0xf, 0xf, true)); }
__device__ __forceinline__ float red8(float v) { v += dppf<0xB1>(v); v += dppf<0x4E>(v); v += dppf<0x141>(v); return v; }
__device__ __forceinline__ float wave_sum(float v) {
    v = red8(v); v += dppf<0x140>(v);
    v += __builtin_bit_cast(float, __builtin_amdgcn_ds_swizzle(__builtin_bit_cast(int, v), 0x401F));
    return __builtin_bit_cast(float, __builtin_amdgcn_readlane(__builtin_bit_cast(int, v), 0)) + __builtin_bit_cast(float, __builtin_amdgcn_readlane(__builtin_bit_cast(int, v), 32));
}

#define XB_TMO      128
#define XB_XCNT(j)  (256  + 64 * (j))
#define XB_XSUB(j)  (1280 + 64 * (j))
#define XB_XGEN(j)  (2304 + 64 * (j))
#define XB_TOP      3328
#define XB_TOPGEN   3392
#define XCD_BAR_WORDS 3456
#define XB_SPIN_CAP (1u << 18)
__device__ __forceinline__ unsigned xb_ld(unsigned* p)              { return __hip_atomic_load(p, __ATOMIC_RELAXED, __HIP_MEMORY_SCOPE_AGENT); }
__device__ __forceinline__ unsigned xb_add(unsigned* p, unsigned v) { return __hip_atomic_fetch_add(p, v, __ATOMIC_RELAXED, __HIP_MEMORY_SCOPE_AGENT); }
__device__ __forceinline__ unsigned xb_xcc_id() { return (unsigned)__builtin_amdgcn_s_getreg((3 << 11) | 20) & 0xFu; }
#define XB_SPIN(cond, bar) do { unsigned _sp = 0; while (cond) { __builtin_amdgcn_s_sleep(1); \
    if ((++_sp & 255u) == 0u) { if (xb_ld(&(bar)[XB_TMO])) break; if (_sp > XB_SPIN_CAP) { atomicAdd(&(bar)[XB_TMO], 1u); break; } } } } while (0)
struct XcdBarrier { unsigned* bar; unsigned x; volatile LAS unsigned* st; };
__device__ __forceinline__ XcdBarrier xcd_barrier_post(unsigned* bar, volatile LAS unsigned* st) {
    XcdBarrier b; b.bar = bar; b.x = xb_xcc_id(); b.st = st;
    if (threadIdx.x == 0) (void)xb_add(&bar[XB_XCNT(b.x)], 1u);
    return b;
}
__device__ __forceinline__ void xcd_barrier_complete(unsigned* bar, unsigned x, unsigned& nloc, unsigned& nx) {
    const unsigned G = gridDim.x * gridDim.y * gridDim.z;
    unsigned sum, cnt, mine, sp = 0u;
    for (;;) {
        sum = 0u; cnt = 0u; mine = 0u;
#pragma unroll
        for (unsigned j = 0; j < 16; ++j) { const unsigned c = xb_ld(&bar[XB_XCNT(j)]); sum += c; cnt += (c > 0u) ? 1u : 0u; mine = (j == x) ? c : mine; }
        if (sum == G) break;
        __builtin_amdgcn_s_sleep(1);
        if ((++sp & 255u) == 0u) { if (xb_ld(&bar[XB_TMO])) break; if (sp > XB_SPIN_CAP) { atomicAdd(&bar[XB_TMO], 1u); break; } }
    }
    nloc = mine > 0u ? mine : 1u; nx = cnt > 0u ? cnt : 1u;
}
__device__ __forceinline__ void xcd_barrier(const XcdBarrier& b) {
    asm volatile("s_waitcnt vmcnt(0)" ::: "memory");
    __syncthreads();
    if (threadIdx.x == 0) {
        unsigned* bar = b.bar;
        __builtin_amdgcn_s_waitcnt(0);
        unsigned nloc = b.st[0], nx = b.st[1];
        if (nloc == 0u) { xcd_barrier_complete(bar, b.x, nloc, nx); b.st[0] = nloc; b.st[1] = nx; }
        const unsigned old = xb_add(&bar[XB_XSUB(b.x)], 1u);
        const unsigned gen = old / nloc;
        if (old + 1u == (gen + 1u) * nloc) {
            __builtin_amdgcn_fence(__ATOMIC_RELEASE, "agent");
            asm volatile("s_waitcnt vmcnt(0)" ::: "memory");
            const unsigned og = xb_add(&bar[XB_TOP], 1u);
            const unsigned tg = og / nx;
            if (og + 1u == (tg + 1u) * nx) xb_add(&bar[XB_TOPGEN], 1u);
            else XB_SPIN(xb_ld(&bar[XB_TOPGEN]) == tg, bar);
            __builtin_amdgcn_fence(__ATOMIC_ACQUIRE, "agent");
            xb_add(&bar[XB_XGEN(b.x)], 1u);
            asm volatile("s_waitcnt vmcnt(0)" ::: "memory");
        } else {
            XB_SPIN(xb_ld(&bar[XB_XGEN(b.x)]) == gen, bar);
            __builtin_amdgcn_fence(__ATOMIC_ACQUIRE, "agent");
            asm volatile("s_waitcnt vmcnt(0)" ::: "memory");
        }
    }
    __syncthreads();
}

struct Args {
    const float* in[28];
    float* out; unsigned char* ws;
    int ph_lo, ph_hi, variant, pad;
};
struct Frame {
    LAS unsigned char* lds;
    int tid, lane, wave, G, bid, variant;
    unsigned char* ws;
    const float* const* in;
};
__device__ __forceinline__ void frame_refresh(Frame& F) {
    int t = threadIdx.x; asm volatile("" : "+v"(t)); F.tid = t; F.lane = t & 63; F.wave = __builtin_amdgcn_readfirstlane(t >> 6);
    int b = blockIdx.x; asm volatile("" : "+s"(b)); F.bid = b;
}
enum { I_X = 0, I_C, I_CTX, I_CCTX, I_WMOD, I_BMOD, I_NORM1, I_WIN, I_SSDCW, I_SSDCB, I_SSDALOG, I_SSDDTB, I_SSDD, I_SSDNW, I_POOLW, I_POOLS, I_SCONVW, I_RETDL,
       I_WBR, I_WGATE, I_BGATE, I_WO, I_NORM2, I_FFNUP, I_FFNCW, I_FFNCB, I_FFNDN, I_FNW };

__device__ __forceinline__ void seq_bounds(int row, int& s0, int& s1) {
    if (row < ML) { s0 = row & ~(SEQ - 1); s1 = s0 + SEQ; } else { s0 = ML + ((row - ML) & ~(CTX - 1)); s1 = s0 + CTX; }
}
__device__ __forceinline__ int mod_vec(int row) { return row < ML ? (row >> 12) : 4; }

__device__ __forceinline__ void phase_mod(Frame& F) {
    frame_refresh(F);
    LAS float* sv = (LAS float*)(F.lds);
    LAS float* red = (LAS float*)(F.lds + 5 * 2048 * 4);
    const float* c = F.in[I_C]; const float* cc = F.in[I_CCTX];
    for (int i = F.tid; i < 5 * 2048; i += 512) { const int v = i >> 11, k = i & 2047; const float x = v < 4 ? c[v * 2048 + k] : cc[k]; sv[i] = siluf_(x); }
    __syncthreads();
    float* MOD = (float*)(F.ws + WS_MOD);
    for (int it = F.bid; it < DEPTH * 48; it += F.G) {
        const int l = it / 48, jb = it % 48;
        const float* W = F.in[I_WMOD] + (size_t)l * 2048 * 12288 + jb * 256 + 4 * F.lane;
        float a[5][4];
#pragma unroll
        for (int v = 0; v < 5; ++v) { a[v][0] = a[v][1] = a[v][2] = a[v][3] = 0.f; }
        const int k0 = F.wave * 256;
#pragma unroll 4
        for (int k = 0; k < 256; ++k) {
            const f32x4 w = *(const f32x4*)(W + (size_t)(k0 + k) * 12288);
#pragma unroll
            for (int v = 0; v < 5; ++v) { const float s = sv[v * 2048 + k0 + k]; a[v][0] += s * w.x; a[v][1] += s * w.y; a[v][2] += s * w.z; a[v][3] += s * w.w; }
        }
#pragma unroll
        for (int v = 0; v < 5; ++v) *(LAS f32x4*)(red + (F.wave * 5 + v) * 256 + 4 * F.lane) = (f32x4){a[v][0], a[v][1], a[v][2], a[v][3]};
        __syncthreads();
        for (int i = F.tid; i < 5 * 256; i += 512) { const int v = i >> 8, j = i & 255; float s = 0.f;
#pragma unroll
            for (int w = 0; w < 8; ++w) s += red[(w * 5 + v) * 256 + j];
            MOD[((size_t)l * 5 + v) * 12288 + jb * 256 + j] = s + F.in[I_BMOD][l * 12288 + jb * 256 + j]; }
        __syncthreads();
    }
    if (F.bid == F.G - 1) {
        float* R = (float*)(F.ws + WS_ROPE);
        for (int i = F.tid; i < 1024; i += 512) { const int pos = i >> 4, m = i & 15; const float inv = powf(10000.0f, -(float)m / 16.0f); const float ang = (float)pos * inv; R[2 * i] = cosf(ang); R[2 * i + 1] = sinf(ang); }
    }
}

template <class RowMap>
__device__ __forceinline__ void transpose_item(const float* W, int K, int N, bf16* WT, const RowMap& rm, LAS float* scr, int item, int lane) {
    const int nblk = (N + 31) / 32, kb = item / nblk, nb = item % nblk, k0 = 64 * kb, n0 = 32 * nb;
    const int ncl = min(n0 + (lane & 31), N - 1);
    const float* src = W + (size_t)(k0 + (lane >> 5)) * N + ncl;
    float t[32];
#pragma unroll
    for (int i = 0; i < 32; ++i) t[i] = src[(size_t)(2 * i) * N];
    __builtin_amdgcn_sched_barrier(0);
#pragma unroll
    for (int i = 0; i < 32; ++i) scr[(2 * i + (lane >> 5)) * 33 + (lane & 31)] = t[i];
    LDS_WAIT(); asm volatile("" ::: "memory");
    const int c = lane & 7;
#pragma unroll
    for (int j = 0; j < 4; ++j) { const int n = (lane >> 3) + 8 * j; const LAS float* s = scr + (8 * c) * 33 + n;
        v4u o; o.x = pk2(s[0 * 33], s[1 * 33]); o.y = pk2(s[2 * 33], s[3 * 33]); o.z = pk2(s[4 * 33], s[5 * 33]); o.w = pk2(s[6 * 33], s[7 * 33]);
        if (n0 + n < N) *(GAS v4u*)(WT + (size_t)rm(n0 + n) * K + k0 + 8 * c) = o; }
    LDS_WAIT(); asm volatile("" ::: "memory");
}
struct RowId { int off; __device__ __forceinline__ int operator()(int n) const { return n + off; } };
struct RowUp { __device__ __forceinline__ int operator()(int n) const { const int h = n >= DFF ? 1 : 0, c = n - h * DFF; return (c >> 7) * 256 + h * 128 + (c & 127); } };
struct RowWin { __device__ __forceinline__ int operator()(int n) const { return n < 3072 ? n : (n < 3088 ? 10240 + (n - 3072) : n - 16); } };

constexpr int CI_IN = 32 * 321, CI_G1 = 32 * 64, CI_B1 = 16 * 64, CI_O = 32 * 64, CI_UP = 32 * 352, CI_DN = 88 * 64, CI_P1 = 4 * 8, CI_Z = 30;
constexpr int NITW = CI_IN + 4 * CI_G1 + 4 * CI_B1 + CI_O + CI_UP + CI_DN + 4 * CI_P1 + CI_Z;
__device__ __forceinline__ void convert_item(Frame& F, int l, int it, LAS float* scr, int lane) {
    unsigned char* wb = F.ws + (size_t)(l & 1) * W_SPAN;
    bf16* WIG = (bf16*)(wb + WS_WIG); bf16* WB = (bf16*)(wb + WS_WB); bf16* WO = (bf16*)(wb + WS_WO);
    bf16* WUP = (bf16*)(wb + WS_WUP); bf16* WDN = (bf16*)(wb + WS_WDN); bf16* WPOOL = (bf16*)(wb + WS_WPOOL);
    int r = it;
    if (r < CI_IN) { transpose_item(F.in[I_WIN] + (size_t)l * 2048 * IN_COLS, 2048, IN_COLS, WIG, RowWin{}, scr, r, lane); return; } r -= CI_IN;
    if (r < 4 * CI_G1) { const int i = r / CI_G1; transpose_item(F.in[I_WGATE] + ((size_t)l * 4 + i) * 2048 * 2048, 2048, 2048, WIG, RowId{10496 + i * 2048}, scr, r % CI_G1, lane); return; } r -= 4 * CI_G1;
    if (r < 4 * CI_B1) { const int i = r / CI_B1; transpose_item(F.in[I_WBR] + ((size_t)l * 4 + i) * 1024 * 2048, 1024, 2048, WB + (size_t)i * 2048 * 1024, RowId{0}, scr, r % CI_B1, lane); return; } r -= 4 * CI_B1;
    if (r < CI_O) { transpose_item(F.in[I_WO] + (size_t)l * 2048 * 2048, 2048, 2048, WO, RowId{0}, scr, r, lane); return; } r -= CI_O;
    if (r < CI_UP) { transpose_item(F.in[I_FFNUP] + (size_t)l * 2048 * UPC, 2048, UPC, WUP, RowUp{}, scr, r, lane); return; } r -= CI_UP;
    if (r < CI_DN) { transpose_item(F.in[I_FFNDN] + (size_t)l * DFF * 2048, DFF, 2048, WDN, RowId{0}, scr, r, lane); return; } r -= CI_DN;
    if (r < 4 * CI_P1) { const int g = r / CI_P1; transpose_item(F.in[I_POOLW] + ((size_t)l * 4 + g) * 256 * 256, 256, 256, WPOOL + (size_t)g * 256 * 256, RowId{0}, scr, r % CI_P1, lane); return; } r -= 4 * CI_P1;
    {
        unsigned char* base = (unsigned char*)WIG + (size_t)(10256 + 8 * r) * 2048 * 2;
#pragma unroll 4
        for (int k = 0; k < 32; ++k) *(GAS v4u*)(base + (size_t)(k * 64 + lane) * 16) = (v4u){0u, 0u, 0u, 0u};
    }
}
__device__ __forceinline__ void steal_convert(Frame& F, int l, int finidx, bool drain) {
    frame_refresh(F);
    gu32* q = (gu32*)(F.ws + WS_CTL) + CW_Q + 64 * l;
    gu32* fin = (gu32*)(F.ws + WS_CTL) + CW_FIN + 64 * finidx;
    volatile LAS unsigned* box = (volatile LAS unsigned*)(F.lds + MISC_OFF);
    LAS float* scr = (LAS float*)(F.lds + F.wave * 16384);
    unsigned finv = 0;
    if (F.tid == 0 && !drain) finv = __hip_atomic_fetch_add(fin, 1u, RLX_AGENT) + 1u;
    for (;;) {
        if (F.tid == 0) { unsigned v = 0xffffffffu;
            if (drain || finv < (unsigned)F.G) { v = __hip_atomic_fetch_add(q, 1u, RLX_AGENT); if (!drain) finv = __hip_atomic_load(fin, RLX_AGENT); }
            box[0] = v; }
        __syncthreads();
        const unsigned got = box[0];
        __syncthreads();
        if (got == 0xffffffffu) break;
        const int base = (int)got * 8;
        if (base >= NITW) break;
        { const int wi = base + F.wave; if (wi < NITW) convert_item(F, l, wi, scr, F.lane); }
    }
}

template <bool FIRST>
__device__ __forceinline__ void phase_norm(Frame& F, int l, const float* nw, int sh_off, int sc_off, int nrows, bool addpart = false) {
    frame_refresh(F);
    float* X = (float*)(F.ws + WS_X); bf16* H = (bf16*)(F.ws + WS_H); const float* MOD = (const float*)(F.ws + WS_MOD);
    const int gw = F.bid * NWAVES + F.wave, NGW = F.G * NWAVES;
    for (int row = gw; row < nrows; row += NGW) {
        const float* src = FIRST ? (row < ML ? F.in[I_X] + (size_t)row * D : F.in[I_CTX] + (size_t)(row - ML) * D) : X + (size_t)row * D;
        f32x4 v[8]; float ss = 0.f;
#pragma unroll
        for (int j = 0; j < 8; ++j) { v[j] = *(const f32x4*)(src + 256 * j + 4 * F.lane); ss += (v[j].x * v[j].x + v[j].y * v[j].y) + (v[j].z * v[j].z + v[j].w * v[j].w); }
        if (FIRST) {
#pragma unroll
            for (int j = 0; j < 8; ++j) *(f32x4*)(X + (size_t)row * D + 256 * j + 4 * F.lane) = v[j];
        }
        if (!FIRST && addpart && row >= ML) {
            const float* P = (const float*)(F.ws + WS_PART) + (size_t)(row - ML) * D;
            ss = 0.f;
#pragma unroll
            for (int j = 0; j < 8; ++j) {
#pragma unroll
                for (int sp = 0; sp < 4; ++sp) v[j] += *(const f32x4*)(P + (size_t)sp * MC * D + 256 * j + 4 * F.lane);
                *(f32x4*)(X + (size_t)row * D + 256 * j + 4 * F.lane) = v[j];
                ss += (v[j].x * v[j].x + v[j].y * v[j].y) + (v[j].z * v[j].z + v[j].w * v[j].w);
            }
        }
        const float rs = rsqrtf(wave_sum(ss) * (1.0f / D) + EPS);
        const float* mv = MOD + ((size_t)l * 5 + mod_vec(row)) * 12288;
#pragma unroll
        for (int j = 0; j < 8; ++j) { const int c = 256 * j + 4 * F.lane;
            const f32x4 w = *(const f32x4*)(nw + c), sh = *(const f32x4*)(mv + sh_off + c), sc = *(const f32x4*)(mv + sc_off + c);
            const f32x4 y = v[j] * rs * w; const f32x4 h = y * (sc + 1.0f) + sh;
            v2u o; o.x = pk2(h.x, h.y); o.y = pk2(h.z, h.w); *(v2u*)(H + (size_t)row * D + c) = o; }
    }
}
__device__ __forceinline__ void phase_final(Frame& F, float* out) {
    frame_refresh(F);
    const float* X = (const float*)(F.ws + WS_X); const float* nw = F.in[I_FNW];
    const int gw = F.bid * NWAVES + F.wave, NGW = F.G * NWAVES;
    for (int row = gw; row < ML; row += NGW) {
        f32x4 v[8]; float ss = 0.f;
#pragma unroll
        for (int j = 0; j < 8; ++j) { v[j] = *(const f32x4*)(X + (size_t)row * D + 256 * j + 4 * F.lane); ss += (v[j].x * v[j].x + v[j].y * v[j].y) + (v[j].z * v[j].z + v[j].w * v[j].w); }
        const float rs = rsqrtf(wave_sum(ss) * (1.0f / D) + EPS);
#pragma unroll
        for (int j = 0; j < 8; ++j) { const int c = 256 * j + 4 * F.lane; *(f32x4*)(out + (size_t)row * D + c) = v[j] * rs * *(const f32x4*)(nw + c); }
    }
}

__device__ __forceinline__ v4u ldrow(const bf16* base, int row, int ld, int col, bool ok) { return ok ? *(const v4u*)(base + (size_t)row * ld + col) : (v4u){0u, 0u, 0u, 0u}; }
__device__ __forceinline__ void ld8f(const float* p, float (&f)[8]) { const f32x4 a = *(const f32x4*)p, b = *(const f32x4*)(p + 4); f[0] = a.x; f[1] = a.y; f[2] = a.z; f[3] = a.w; f[4] = b.x; f[5] = b.y; f[6] = b.z; f[7] = b.w; }

__device__ __forceinline__ void sc_task(Frame& F, int l, int r, int lane) {
    const bf16* U = (const bf16*)(F.ws + WS_U); bf16* YB2 = (bf16*)(F.ws + WS_YB) + 2 * YS_STRIDE;
            const int rb = r >> 1, cb = r & 1, c = cb * 512 + lane * 8, r0 = rb * 32; int s0, s1; seq_bounds(r0, s0, s1);
            float w0[8], w1[8], w2[8];
            ld8f(F.in[I_SCONVW] + ((size_t)l * 3 + 0) * 1024 + c, w0); ld8f(F.in[I_SCONVW] + ((size_t)l * 3 + 1) * 1024 + c, w1); ld8f(F.in[I_SCONVW] + ((size_t)l * 3 + 2) * 1024 + c, w2);
            for (int r4 = r0; r4 < r0 + 32; r4 += 4) {
                v4u bc[6], bx[6], bg[4];
#pragma unroll
                for (int k = 0; k < 6; ++k) { const int s = r4 - 1 + k; const bool ok = s >= s0 && s < s1; bc[k] = ldrow(U, s, UC, U_SCC + c, ok); bx[k] = ldrow(U, s, UC, U_SCX + c, ok); }
#pragma unroll
                for (int k = 0; k < 4; ++k) bg[k] = ldrow(U, r4 + k, UC, U_SCB + c, true);
                float pr[6][8];
#pragma unroll
                for (int k = 0; k < 6; ++k) { float a[8], b[8]; unpack8(bc[k], a); unpack8(bx[k], b);
#pragma unroll
                    for (int e = 0; e < 8; ++e) pr[k][e] = a[e] * b[e]; }
#pragma unroll
                for (int j = 0; j < 4; ++j) { float g[8], o[8]; unpack8(bg[j], g);
#pragma unroll
                    for (int e = 0; e < 8; ++e) o[e] = g[e] * (w0[e] * pr[j][e] + w1[e] * pr[j + 1][e] + w2[e] * pr[j + 2][e]);
                    *(v4u*)(YB2 + yb_off(r4 + j, c)) = pack8(o); }
            }
}
__device__ __forceinline__ void sc_phase(Frame& F, int l, int c, int Gs) {
    frame_refresh(F);
    const int gw = c * NWAVES + F.wave, NGW = Gs * NWAVES;
    for (int task = gw; task < (M / 32) * 2; task += NGW) sc_task(F, l, task, F.lane);
}
template <int HMAX>
__device__ __forceinline__ void pool_task(const bf16* U, bf16* POOLED, int r0, int s0, int s1, int c, int half) {
    constexpr int NR = 8 + 2 * HMAX - 1, HA = HMAX / 2;
    const bool big = (half == HMAX);
    for (int r8 = r0; r8 < r0 + 32; r8 += 8) {
        v4u buf[NR];
#pragma unroll
        for (int k = 0; k < NR; ++k) { const int s = r8 - HMAX + k; buf[k] = ldrow(U, s, UC, U_POOL + c, s >= s0 && s < s1); }
        float sa[8], sb[8];
#pragma unroll
        for (int e = 0; e < 8; ++e) { sa[e] = 0.f; sb[e] = 0.f; }
#pragma unroll
        for (int k = 0; k < 2 * HMAX; ++k) { float t[8]; unpack8(buf[k], t);
#pragma unroll
            for (int e = 0; e < 8; ++e) { sb[e] += t[e]; if (k >= HA && k < HMAX + HA) sa[e] += t[e]; } }
#pragma unroll
        for (int j = 0; j < 8; ++j) {
            const int rr = r8 + j; int lo = rr - half, hi = rr + half; lo = lo < s0 ? s0 : lo; hi = hi > s1 ? s1 : hi;
            float x[8], o[8]; unpack8(buf[j + HMAX], x); const float inv = 1.0f / (float)(hi - lo);
#pragma unroll
            for (int e = 0; e < 8; ++e) o[e] = (big ? sb[e] : sa[e]) * inv - x[e];
            *(v4u*)(POOLED + (size_t)rr * 1024 + c) = pack8(o);
            if (j < 7) {
                float tin[8], tout[8];
                unpack8(buf[j + 2 * HMAX], tin); unpack8(buf[j], tout);
#pragma unroll
                for (int e = 0; e < 8; ++e) sb[e] += tin[e] - tout[e];
                unpack8(buf[j + HMAX + HA], tin); unpack8(buf[j + HA], tout);
#pragma unroll
                for (int e = 0; e < 8; ++e) sa[e] += tin[e] - tout[e];
            }
        }
    }
}
__device__ __forceinline__ void phase_pre(Frame& F, int l) {
    frame_refresh(F);
    const bf16* U = (const bf16*)(F.ws + WS_U);
    bf16* XBCA = (bf16*)(F.ws + WS_XBCA); bf16* RQK = (bf16*)(F.ws + WS_RQK); bf16* YB2 = (bf16*)(F.ws + WS_YB) + 2 * YS_STRIDE; bf16* POOLED = (bf16*)(F.ws + WS_POOLED);
    const float* ROPE = (const float*)(F.ws + WS_ROPE);
    const int gw = F.bid * NWAVES + F.wave, NGW = F.G * NWAVES, lane = F.lane;
    constexpr int NRB = M / 32;
    constexpr int T_CUM = (M / 64) * 2, T_XBC = NRB * 4, T_POOL = NRB * 2, T_ROPE = NRB;
    float* CUMA = (float*)(F.ws + WS_CUMA); float* DTA = (float*)(F.ws + WS_DTA); const float* DT = (const float*)(F.ws + WS_DT);
    for (int task = gw; task < T_CUM + T_XBC + T_POOL + T_ROPE; task += NGW) {
        int r = task;
        if (r < T_CUM) {
            const int blk = r >> 1, dir = r & 1, row = blk * 64 + (dir ? 63 - lane : lane);
            for (int hh = 0; hh < 16; ++hh) {
                const float dt = softplusf_(DT[(size_t)row * 16 + hh] + F.in[I_SSDDTB][(l * 2 + dir) * 16 + hh]);
                float cum = dt * -expf(F.in[I_SSDALOG][(l * 2 + dir) * 16 + hh]);
#pragma unroll
                for (int o = 1; o < 64; o <<= 1) { const float t = __shfl_up(cum, o); if (lane >= o) cum += t; }
                CUMA[(size_t)(dir * 16 + hh) * M + row] = cum; DTA[(size_t)(dir * 16 + hh) * M + row] = dt;
            }
            continue;
        }
        r -= T_CUM;
        if (r < T_XBC) {
            const int rb = r >> 2, cb = r & 3, c = cb * 512 + lane * 8, r0 = rb * 32; int s0, s1; seq_bounds(r0, s0, s1);
            float w0[8], w1[8], w2[8], bb[8];
            ld8f(F.in[I_SSDCW] + ((size_t)l * 3 + 0) * 2048 + c, w0); ld8f(F.in[I_SSDCW] + ((size_t)l * 3 + 1) * 2048 + c, w1); ld8f(F.in[I_SSDCW] + ((size_t)l * 3 + 2) * 2048 + c, w2); ld8f(F.in[I_SSDCB] + (size_t)l * 2048 + c, bb);
            v4u bufA[10], bufB[10];
#define XBC_LOAD(buf, r8_) do { _Pragma("unroll") for (int k = 0; k < 10; ++k) { const int s = (r8_) - 1 + k; buf[k] = ldrow(U, s, UC, U_XBC + c, s >= s0 && s < s1); } } while (0)
#define XBC_COMP(buf, r8_) do { _Pragma("unroll") for (int j = 0; j < 8; ++j) { \
                    float p[8], q[8], n[8], o[8]; unpack8(buf[j], p); unpack8(buf[j + 1], q); unpack8(buf[j + 2], n); \
                    _Pragma("unroll") for (int e = 0; e < 8; ++e) o[e] = siluf_(w0[e] * p[e] + w1[e] * q[e] + w2[e] * n[e] + bb[e]); \
                    *(v4u*)(XBCA + (size_t)((r8_) + j) * 2048 + c) = pack8(o); } } while (0)
            XBC_LOAD(bufA, r0);
            XBC_LOAD(bufB, r0 + 8);  XBC_COMP(bufA, r0);
            XBC_LOAD(bufA, r0 + 16); XBC_COMP(bufB, r0 + 8);
            XBC_LOAD(bufB, r0 + 24); XBC_COMP(bufA, r0 + 16);
            XBC_COMP(bufB, r0 + 24);
#undef XBC_LOAD
#undef XBC_COMP
            continue;
        }
        r -= T_XBC;
        if (r < T_POOL) {
            const int rb = r >> 1, cb = r & 1, c = cb * 512 + lane * 8, r0 = rb * 32; int s0, s1; seq_bounds(r0, s0, s1);
            const int grp = c >> 8, half = 1 << grp;
            if (cb == 0) pool_task<2>(U, POOLED, r0, s0, s1, c, half); else pool_task<8>(U, POOLED, r0, s0, s1, c, half);
            continue;
        }
        r -= T_POOL;
        {
            const int r0 = r * 32; int s0, s1; seq_bounds(r0, s0, s1);
            const int qk = lane >> 5, rem = lane & 31, head = rem >> 2, part = (rem >> 1) & 1, sub = rem & 1;
            const int c1 = head * 64 + part * 32 + sub * 8, c2 = c1 + 16; const float scl = qk == 0 ? 0.125f : 1.0f;
            const int ucol = (qk == 0 ? U_RQ : U_RK);
            for (int r8 = r0; r8 < r0 + 32; r8 += 8) {
                v4u b1[8], b2[8];
#pragma unroll
                for (int k = 0; k < 8; ++k) { b1[k] = ldrow(U, r8 + k, UC, ucol + c1, true); b2[k] = ldrow(U, r8 + k, UC, ucol + c2, true); }
#pragma unroll
                for (int k = 0; k < 8; ++k) {
                    const int rr = r8 + k; float x1[8], x2[8], o1[8], o2[8]; unpack8(b1[k], x1); unpack8(b2[k], x2);
                    if (rr < ML) {
                        const int t = rr - s0, pos = part == 0 ? (t >> 6) : (t & 63);
                        const float* rp = ROPE + (size_t)(pos * 16 + sub * 8) * 2;
#pragma unroll
                        for (int e = 0; e < 8; ++e) { const float cs = rp[2 * e], sn = rp[2 * e + 1]; o1[e] = (x1[e] * cs - x2[e] * sn) * scl; o2[e] = (x1[e] * sn + x2[e] * cs) * scl; }
                    } else {
#pragma unroll
                        for (int e = 0; e < 8; ++e) { o1[e] = x1[e] * scl; o2[e] = x2[e] * scl; }
                    }
                    *(v4u*)(RQK + (size_t)rr * 1024 + qk * 512 + c1) = pack8(o1); *(v4u*)(RQK + (size_t)rr * 1024 + qk * 512 + c2) = pack8(o2);
                }
            }
        }
    }
}

#define MFMA32(a, b, c) __builtin_amdgcn_mfma_f32_32x32x16_bf16((a), (b), (c), 0, 0, 0)
#define SCAN_BAR() do { asm volatile("s_waitcnt lgkmcnt(0)" ::: "memory"); __builtin_amdgcn_s_barrier(); asm volatile("" ::: "memory"); } while (0)
typedef short s16x4 __attribute__((ext_vector_type(4)));
__device__ __forceinline__ bf16x8 tr_frag(LAS unsigned char* tile, int rs, int c, int ks, int lane) {
    const int h = lane >> 5, blk = (lane >> 4) & 1, q = (lane & 15) >> 2, p = lane & 3;
    LAS unsigned char* a0 = tile + (16 * ks + 8 * h + q) * rs + (32 * c + 16 * blk + 4 * p) * 2;
    const s16x4 lo = __builtin_amdgcn_ds_read_tr16_b64_v4i16((LAS s16x4*)a0);
    const s16x4 hi = __builtin_amdgcn_ds_read_tr16_b64_v4i16((LAS s16x4*)(a0 + 4 * rs));
    return __builtin_shufflevector(lo, hi, 0, 1, 2, 3, 4, 5, 6, 7);
}
template <int DN, int DP, bool SSD>
__device__ __forceinline__ void scan_unit(Frame& F, int l, int b, int h, int dir) {
    frame_refresh(F);
    constexpr int RSQ = (DN + 8) * 2, RSK2 = DN * 2 + 64, RSV = DP * 2 + 64, RSJ = 72 * 2;
    constexpr int O_Q = 0, O_K = O_Q + 64 * RSQ, O_K2 = O_K + 64 * RSQ, O_V = O_K2 + 64 * RSK2, O_VW = O_V + 64 * RSV, O_S = O_VW + 64 * RSV, O_HST = O_S + 64 * RSJ, O_CUM = O_HST + DP * RSQ, O_END = O_CUM + 256;
    static_assert(O_END <= RING_BYTES, "scan LDS");
    LAS unsigned char* lds = F.lds;
    const int tid = F.tid, lane = F.lane, w = F.wave, r = lane & 31, hh = lane >> 5;
    const bf16* XBCA = (const bf16*)(F.ws + WS_XBCA); const bf16* RQK = (const bf16*)(F.ws + WS_RQK); const bf16* U = (const bf16*)(F.ws + WS_U);
    const float* CUMA = (const float*)(F.ws + WS_CUMA) + (size_t)(dir * 16 + h) * M; const float* DTA = (const float*)(F.ws + WS_DTA) + (size_t)(dir * 16 + h) * M;
    bf16* YS = (bf16*)(F.ws + WS_YS) + (size_t)((SSD ? 0 : 2) + dir) * YS_STRIDE;
    const int ycol = SSD ? h * 64 : h * 128;
    float la_const = 0.f;
    if (!SSD) la_const = -softplusf_(-F.in[I_RETDL][(l * 2 + dir) * 8 + h]);
    for (int i = tid; i < DP * RSQ / 16; i += 512) *(LAS v4u*)(lds + O_HST + i * 16) = (v4u){0u, 0u, 0u, 0u};
    f32x16 Hs;
#pragma unroll
    for (int i = 0; i < 16; ++i) Hs[i] = 0.f;
    const int tok8 = tid >> 3, ch8 = tid & 7, tok16 = tid >> 4, ch16 = tid & 15;
    constexpr int NPF = 2;
    v4u preb[NPF][5]; float pcum[NPF], pdt[NPF], pcl[NPF], pcw[NPF];
#pragma unroll
    for (int u = 0; u < NPF; ++u) { pcum[u] = 0.f; pdt[u] = 1.f; pcl[u] = 0.f; pcw[u] = 0.f;
#pragma unroll
        for (int k = 0; k < 5; ++k) preb[u][k] = (v4u){0u, 0u, 0u, 0u}; }
    auto row_of = [&](int st, int i) -> int {
        int base, sub;
        if (st < 4) { base = ML + b * CTX; sub = dir ? 3 - st : st; } else { base = b * SEQ; sub = dir ? 67 - st : st - 4; }
        return base + sub * 64 + (dir ? 63 - i : i);
    };
#define SCAN_PREFETCH(st_, pre, u_) do { \
        const int rn_ = row_of((st_), tok8), rw0_ = row_of((st_), tok16), rw1_ = row_of((st_), 32 + tok16); \
        if (SSD) { const int g = h >> 2; \
            pre[0] = *(const v4u*)(XBCA + (size_t)rn_ * 2048 + h * 64 + 8 * ch8); \
            pre[1] = *(const v4u*)(XBCA + (size_t)rw0_ * 2048 + 1024 + g * 128 + 8 * ch16); pre[2] = *(const v4u*)(XBCA + (size_t)rw1_ * 2048 + 1024 + g * 128 + 8 * ch16); \
            pre[3] = *(const v4u*)(XBCA + (size_t)rw0_ * 2048 + 1536 + g * 128 + 8 * ch16); pre[4] = *(const v4u*)(XBCA + (size_t)rw1_ * 2048 + 1536 + g * 128 + 8 * ch16); \
            pcum[u_] = CUMA[rn_]; pdt[u_] = DTA[rn_]; pcl[u_] = CUMA[row_of((st_), 63)]; pcw[u_] = CUMA[row_of((st_), lane)]; \
        } else { \
            pre[0] = *(const v4u*)(RQK + (size_t)rn_ * 1024 + h * 64 + 8 * ch8); pre[1] = *(const v4u*)(RQK + (size_t)rn_ * 1024 + 512 + h * 64 + 8 * ch8); \
            pre[2] = *(const v4u*)(U + (size_t)rw0_ * UC + U_RV + h * 128 + 8 * ch16); pre[3] = *(const v4u*)(U + (size_t)rw1_ * UC + U_RV + h * 128 + 8 * ch16); \
        } } while (0)
#pragma unroll
    for (int u = 0; u < NPF; ++u) SCAN_PREFETCH(u, preb[u], u);
    for (int st2 = 0; st2 < 68; st2 += NPF) {
#pragma unroll
    for (int u = 0; u < NPF; ++u) {
        const int st = st2 + u;
        v4u (&pre)[5] = preb[u];
        float clast;
        if (SSD) {
            clast = pcl[u];
            const float dtx = pdt[u], wx = __expf(clast - pcum[u]);
            float x[8], v[8], vw[8]; unpack8(pre[0], x);
#pragma unroll
            for (int e = 0; e < 8; ++e) { v[e] = x[e] * dtx; vw[e] = v[e] * wx; }
            *(LAS v4u*)(lds + O_V + tok8 * RSV + 16 * ch8) = pack8(v); *(LAS v4u*)(lds + O_VW + tok8 * RSV + 16 * ch8) = pack8(vw);
            *(LAS v4u*)(lds + O_K + tok16 * RSQ + 16 * ch16) = pre[1]; *(LAS v4u*)(lds + O_K + (32 + tok16) * RSQ + 16 * ch16) = pre[2];
            *(LAS v4u*)(lds + O_K2 + tok16 * RSK2 + 16 * ch16) = pre[1]; *(LAS v4u*)(lds + O_K2 + (32 + tok16) * RSK2 + 16 * ch16) = pre[2];
            *(LAS v4u*)(lds + O_Q + tok16 * RSQ + 16 * ch16) = pre[3]; *(LAS v4u*)(lds + O_Q + (32 + tok16) * RSQ + 16 * ch16) = pre[4];
            if (w == 0) *(LAS float*)(lds + O_CUM + 4 * lane) = pcw[u];
        } else {
            clast = la_const * 64.f;
            *(LAS v4u*)(lds + O_Q + tok8 * RSQ + 16 * ch8) = pre[0];
            *(LAS v4u*)(lds + O_K + tok8 * RSQ + 16 * ch8) = pre[1]; *(LAS v4u*)(lds + O_K2 + tok8 * RSK2 + 16 * ch8) = pre[1];
            const float w0 = __expf(la_const * (float)(63 - tok16)), w1 = __expf(la_const * (float)(31 - tok16));
            float v0[8], v1[8], q0[8], q1[8]; unpack8(pre[2], v0); unpack8(pre[3], v1);
#pragma unroll
            for (int e = 0; e < 8; ++e) { q0[e] = v0[e] * w0; q1[e] = v1[e] * w1; }
            *(LAS v4u*)(lds + O_V + tok16 * RSV + 16 * ch16) = pre[2]; *(LAS v4u*)(lds + O_V + (32 + tok16) * RSV + 16 * ch16) = pre[3];
            *(LAS v4u*)(lds + O_VW + tok16 * RSV + 16 * ch16) = pack8(q0); *(LAS v4u*)(lds + O_VW + (32 + tok16) * RSV + 16 * ch16) = pack8(q1);
            if (w == 0) *(LAS float*)(lds + O_CUM + 4 * lane) = la_const * (float)(lane + 1);
        }
        SCAN_BAR();
        if (st + NPF < 68) SCAN_PREFETCH(st + NPF, pre, u);
        const float dcy = __expf(clast);
        if (w < 4) {
            const int jb = w >> 1, ib = w & 1;
            f32x16 acc;
#pragma unroll
            for (int i = 0; i < 16; ++i) acc[i] = 0.f;
            if (!(jb == 1 && ib == 0)) {
                bf16x8 fa[DN / 16], fq[DN / 16];
#pragma unroll
                for (int kk = 0; kk < DN / 16; ++kk) {
                    fa[kk] = *(const LAS bf16x8*)(lds + O_K + (jb * 32 + r) * RSQ + (kk * 16 + 8 * hh) * 2);
                    fq[kk] = *(const LAS bf16x8*)(lds + O_Q + (ib * 32 + r) * RSQ + (kk * 16 + 8 * hh) * 2);
                }
                __builtin_amdgcn_sched_barrier(0);
#pragma unroll
                for (int kk = 0; kk < DN / 16; ++kk) acc = MFMA32(fa[kk], fq[kk], acc);
            }
            const int i = ib * 32 + r; const float ci = *(const LAS float*)(lds + O_CUM + 4 * i);
#pragma unroll
            for (int g4 = 0; g4 < 4; ++g4) {
                const int j0 = jb * 32 + 8 * g4 + 4 * hh; const f32x4 cj = *(const LAS f32x4*)(lds + O_CUM + 4 * j0);
                float v[4];
#pragma unroll
                for (int e = 0; e < 4; ++e) { const float cje = e == 0 ? cj.x : (e == 1 ? cj.y : (e == 2 ? cj.z : cj.w)); v[e] = (j0 + e <= i) ? acc[4 * g4 + e] * __expf(ci - cje) : 0.f; }
                v2u o; o.x = pk2(v[0], v[1]); o.y = pk2(v[2], v[3]);
                *(LAS v2u*)(lds + O_S + i * RSJ + j0 * 2) = o;
            }
        }
        SCAN_BAR();
        for (int blk = w; blk < (DP / 32) * 2; blk += 8) {
            const int pb = blk >> 1, ib = blk & 1;
            f32x16 a1, a2;
#pragma unroll
            for (int i = 0; i < 16; ++i) { a1[i] = 0.f; a2[i] = 0.f; }
            bf16x8 fv[4], fs[4], fh[DN / 16], fq[DN / 16];
#pragma unroll
            for (int kk = 0; kk < 4; ++kk) {
                fv[kk] = tr_frag(lds + O_V, RSV, pb, kk, lane);
                fs[kk] = *(const LAS bf16x8*)(lds + O_S + (ib * 32 + r) * RSJ + (kk * 16 + 8 * hh) * 2);
            }
#pragma unroll
            for (int kk = 0; kk < DN / 16; ++kk) {
                fh[kk] = *(const LAS bf16x8*)(lds + O_HST + (pb * 32 + r) * RSQ + (kk * 16 + 8 * hh) * 2);
                fq[kk] = *(const LAS bf16x8*)(lds + O_Q + (ib * 32 + r) * RSQ + (kk * 16 + 8 * hh) * 2);
            }
            __builtin_amdgcn_sched_barrier(0);
#pragma unroll
            for (int kk = 0; kk < 4; ++kk) a1 = MFMA32(fv[kk], fs[kk], a1);
#pragma unroll
            for (int kk = 0; kk < DN / 16; ++kk) a2 = MFMA32(fh[kk], fq[kk], a2);
            const int i = ib * 32 + r; const float ei = __expf(*(const LAS float*)(lds + O_CUM + 4 * i));
            const int row = row_of(st, i);
#pragma unroll
            for (int g4 = 0; g4 < 4; ++g4) {
                const int p0 = pb * 32 + 8 * g4 + 4 * hh;
                v2u o; o.x = pk2(a1[4 * g4 + 0] + ei * a2[4 * g4 + 0], a1[4 * g4 + 1] + ei * a2[4 * g4 + 1]); o.y = pk2(a1[4 * g4 + 2] + ei * a2[4 * g4 + 2], a1[4 * g4 + 3] + ei * a2[4 * g4 + 3]);
                *(v2u*)(YS + (size_t)row * 1024 + ycol + p0) = o;
            }
        }
        {
            const int nb = w / (DP / 32), pb = w % (DP / 32);
#pragma unroll
            for (int i = 0; i < 16; ++i) Hs[i] *= dcy;
            bf16x8 fk[4], fw[4];
#pragma unroll
            for (int kk = 0; kk < 4; ++kk) {
                fk[kk] = tr_frag(lds + O_K2, RSK2, nb, kk, lane);
                fw[kk] = tr_frag(lds + O_VW, RSV, pb, kk, lane);
            }
            __builtin_amdgcn_sched_barrier(0);
#pragma unroll
            for (int kk = 0; kk < 4; ++kk) Hs = MFMA32(fk[kk], fw[kk], Hs);
            SCAN_BAR();
#pragma unroll
            for (int g4 = 0; g4 < 4; ++g4) {
                const int n0 = nb * 32 + 8 * g4 + 4 * hh;
                v2u o; o.x = pk2(Hs[4 * g4 + 0], Hs[4 * g4 + 1]); o.y = pk2(Hs[4 * g4 + 2], Hs[4 * g4 + 3]);
                *(LAS v2u*)(lds + O_HST + (pb * 32 + r) * RSQ + n0 * 2) = o;
            }
        }
    }
    }
    __syncthreads();
#undef SCAN_PREFETCH
}

__device__ __forceinline__ void phase_fin(Frame& F, int l, int nrows) {
    frame_refresh(F);
    const bf16* U = (const bf16*)(F.ws + WS_U); const bf16* YS = (const bf16*)(F.ws + WS_YS); bf16* YB = (bf16*)(F.ws + WS_YB);
    const float* nw = F.in[I_SSDNW] + (size_t)l * 1024; const float* dskp = F.in[I_SSDD] + (size_t)l * 16; const bf16* XBCA = (const bf16*)(F.ws + WS_XBCA);
    const int gw = F.bid * NWAVES + F.wave, NGW = F.G * NWAVES, lane = F.lane;
    for (int row = gw; row < nrows; row += NGW) {
        {
            float g[2][8]; float ss = 0.f;
#pragma unroll
            for (int k = 0; k < 2; ++k) { const int c = k * 512 + 8 * lane; float yf[8], yb[8], z[8];
                unpack8(*(const v4u*)(YS + (size_t)row * 1024 + c), yf); unpack8(*(const v4u*)(YS + YS_STRIDE + (size_t)row * 1024 + c), yb); unpack8(*(const v4u*)(U + (size_t)row * UC + U_Z + c), z);
                float xs[8]; unpack8(*(const v4u*)(XBCA + (size_t)row * 2048 + c), xs); const float dsk = dskp[c >> 6];
#pragma unroll
                for (int e = 0; e < 8; ++e) { g[k][e] = (yf[e] + yb[e] + dsk * xs[e]) * siluf_(z[e]); ss += g[k][e] * g[k][e]; } }
            const float rs = rsqrtf(wave_sum(ss) * (1.0f / 1024.0f) + EPS);
#pragma unroll
            for (int k = 0; k < 2; ++k) { const int c = k * 512 + 8 * lane; float wv[8], o[8]; ld8f(nw + c, wv);
#pragma unroll
                for (int e = 0; e < 8; ++e) o[e] = g[k][e] * rs * wv[e];
                *(v4u*)(YB + yb_off(row, c)) = pack8(o); }
        }
        {
            const int c = 16 * lane; float v[16];
            { float a[8], b2[8]; unpack8(*(const v4u*)(YS + 2 * YS_STRIDE + (size_t)row * 1024 + c), a); unpack8(*(const v4u*)(YS + 3 * YS_STRIDE + (size_t)row * 1024 + c), b2);
#pragma unroll
              for (int e = 0; e < 8; ++e) v[e] = a[e] + b2[e];
              unpack8(*(const v4u*)(YS + 2 * YS_STRIDE + (size_t)row * 1024 + c + 8), a); unpack8(*(const v4u*)(YS + 3 * YS_STRIDE + (size_t)row * 1024 + c + 8), b2);
#pragma unroll
              for (int e = 0; e < 8; ++e) v[8 + e] = a[e] + b2[e]; }
            float s = 0.f;
#pragma unroll
            for (int e = 0; e < 16; ++e) s += v[e];
            s = red8(s);
            const float mu = s * (1.0f / 128.0f); float q = 0.f;
#pragma unroll
            for (int e = 0; e < 16; ++e) { v[e] -= mu; q += v[e] * v[e]; }
            q = red8(q);
            const float rs = rsqrtf(q * (1.0f / 128.0f) + EPS);
            float g0[8], g1[8], o0[8], o1[8]; unpack8(*(const v4u*)(U + (size_t)row * UC + U_RG + c), g0); unpack8(*(const v4u*)(U + (size_t)row * UC + U_RG + c + 8), g1);
#pragma unroll
            for (int e = 0; e < 8; ++e) { o0[e] = siluf_(g0[e]) * v[e] * rs; o1[e] = siluf_(g1[e]) * v[8 + e] * rs; }
            *(v4u*)(YB + 3 * YS_STRIDE + yb_off(row, c)) = pack8(o0); *(v4u*)(YB + 3 * YS_STRIDE + yb_off(row, c + 8)) = pack8(o1);
        }
    }
}

__device__ __forceinline__ size_t act_off(int row, int col) { return (size_t)(row >> 8) * (256 * DFF) + (size_t)(col >> 6) * (256 * 64) + (size_t)((row & 255) * 64 + (col & 63)); }
__device__ __forceinline__ v4u ldedge(const bf16* EDGE, int blk, int j, int h, int c, bool ok) { return ok ? *(const v4u*)(EDGE + ((size_t)(blk * 4 + j) * 2 + h) * DFF + c) : (v4u){0u, 0u, 0u, 0u}; }
__device__ __forceinline__ void phase_ffnfix(Frame& F, int l, int nrows) {
    frame_refresh(F);
    const bf16* EDGE = (const bf16*)(F.ws + WS_UP); bf16* ACT = (bf16*)(F.ws + WS_ACT);
    const int gw = F.bid * NWAVES + F.wave, NGW = F.G * NWAVES, lane = F.lane;
    const int ntask = (nrows / 64) * 11;
    for (int task = gw; task < ntask; task += NGW) {
        const int blk = task / 11, cb = task % 11, c = cb * 512 + lane * 8, r0 = blk * 64; int s0, s1; seq_bounds(r0, s0, s1);
        const bool hp = r0 > s0, hn = r0 + 64 < s1;
        float wa0[8], wa1[8], wa2[8], ba[8], wb0[8], wb1[8], wb2[8], bb[8];
        const float* cw = F.in[I_FFNCW] + (size_t)l * 3 * UPC; const float* cbp = F.in[I_FFNCB] + (size_t)l * UPC;
        v4u ra[6], rb[6];
        ra[0] = ldedge(EDGE, blk - 1, 3, 0, c, hp); ra[1] = ldedge(EDGE, blk, 0, 0, c, true); ra[2] = ldedge(EDGE, blk, 1, 0, c, true);
        ra[3] = ldedge(EDGE, blk, 2, 0, c, true); ra[4] = ldedge(EDGE, blk, 3, 0, c, true); ra[5] = ldedge(EDGE, blk + 1, 0, 0, c, hn);
        rb[0] = ldedge(EDGE, blk - 1, 3, 1, c, hp); rb[1] = ldedge(EDGE, blk, 0, 1, c, true); rb[2] = ldedge(EDGE, blk, 1, 1, c, true);
        rb[3] = ldedge(EDGE, blk, 2, 1, c, true); rb[4] = ldedge(EDGE, blk, 3, 1, c, true); rb[5] = ldedge(EDGE, blk + 1, 0, 1, c, hn);
        ld8f(cw + c, wa0); ld8f(cw + UPC + c, wa1); ld8f(cw + 2 * UPC + c, wa2); ld8f(cbp + c, ba);
        ld8f(cw + DFF + c, wb0); ld8f(cw + UPC + DFF + c, wb1); ld8f(cw + 2 * UPC + DFF + c, wb2); ld8f(cbp + DFF + c, bb);
#pragma unroll
        for (int j = 0; j < 2; ++j) {
            float p[8], q[8], n[8], o[8], a[8];
            unpack8(ra[3 * j], p); unpack8(ra[3 * j + 1], q); unpack8(ra[3 * j + 2], n);
#pragma unroll
            for (int e = 0; e < 8; ++e) a[e] = siluf_(wa0[e] * p[e] + wa1[e] * q[e] + wa2[e] * n[e] + ba[e]);
            unpack8(rb[3 * j], p); unpack8(rb[3 * j + 1], q); unpack8(rb[3 * j + 2], n);
#pragma unroll
            for (int e = 0; e < 8; ++e) o[e] = a[e] * (wb0[e] * p[e] + wb1[e] * q[e] + wb2[e] * n[e] + bb[e]);
            *(v4u*)(ACT + act_off(r0 + 63 * j, c)) = pack8(o);
        }
    }
}

using pg8::f32x4; using pg8::Unit; using pg8::HALF; using pg8::BM;
__device__ __forceinline__ size_t gate_off(int pm, int gt, int wave, int frag, int lane) { return ((((size_t)pm * 32 + gt) * 8 + wave) * 16 + frag) * 512 + (size_t)lane * 8; }
struct EpiInGate {
    static constexpr bool PERM = true, CHAIN = false;
    bf16* U; float* DT; unsigned char* G; const float* bg; int pn0;
    __device__ __forceinline__ void operator()(const f32x4 (&acc)[2][2][4][2], const Unit& u, int wr, int wc, int fr, int fq) const {
        const int row0 = u.pm * BM + wr * 64 + fr, pn = u.pn + pn0;
        if (pn < 40) {
            const int col0 = pn * BM + wc * 32 + 8 * fq;
#pragma unroll
            for (int ai = 0; ai < 2; ++ai)
#pragma unroll
                for (int m = 0; m < 4; ++m) { bf16* rowp = U + (size_t)(row0 + ai * HALF + m * 16) * UC + col0;
#pragma unroll
                    for (int bj = 0; bj < 2; ++bj) { const f32x4 v0 = acc[ai][bj][m][0], v1 = acc[ai][bj][m][1];
                        v4u w; w.x = pg8::cvt_pk_bf16(v0[0], v0[1]); w.y = pg8::cvt_pk_bf16(v0[2], v0[3]); w.z = pg8::cvt_pk_bf16(v1[0], v1[1]); w.w = pg8::cvt_pk_bf16(v1[2], v1[3]);
                        *(v4u*)(rowp + bj * HALF) = w; } }
        } else if (pn == 40) {
            if (wc == 0 && fq < 2) {
#pragma unroll
                for (int ai = 0; ai < 2; ++ai)
#pragma unroll
                    for (int m = 0; m < 4; ++m) { float* rp = DT + (size_t)(row0 + ai * HALF + m * 16) * 16 + 8 * fq; *(f32x4*)rp = acc[ai][0][m][0]; *(f32x4*)(rp + 4) = acc[ai][0][m][1]; }
            }
        } else {
            const int col0 = (pn - 41) * BM + wc * 32 + 8 * fq;
            f32x4 bv[2][2];
#pragma unroll
            for (int bj = 0; bj < 2; ++bj)
#pragma unroll
                for (int n = 0; n < 2; ++n) bv[bj][n] = *(const f32x4*)(bg + col0 + bj * HALF + 4 * n) * -1.44269504f;
            constexpr float QC = 1.0f / 255.99f;
#pragma unroll
            for (int ai = 0; ai < 2; ++ai)
#pragma unroll
                for (int m = 0; m < 4; ++m) { unsigned char* rowp = G + gate_off(u.pm, pn - 41, wr * 4 + wc, ai * 8 + m * 2, fq * 16 + fr);
#pragma unroll
                    for (int bj = 0; bj < 2; ++bj) {
                        unsigned q[8];
#pragma unroll
                        for (int e = 0; e < 4; ++e) {
                            const float e0 = __builtin_amdgcn_exp2f(__builtin_fmaf(acc[ai][bj][m][0][e], -1.44269504f, bv[bj][0][e])), e1 = __builtin_amdgcn_exp2f(__builtin_fmaf(acc[ai][bj][m][1][e], -1.44269504f, bv[bj][1][e]));
                            q[e] = (unsigned)__builtin_amdgcn_rcpf(__builtin_fmaf(e0, QC, QC)); q[4 + e] = (unsigned)__builtin_amdgcn_rcpf(__builtin_fmaf(e1, QC, QC)); }
                        v2u w; w.x = q[0] | (q[1] << 8) | (q[2] << 16) | (q[3] << 24); w.y = q[4] | (q[5] << 8) | (q[6] << 16) | (q[7] << 24);
                        *(v2u*)(rowp + bj * 512) = w; } }
        }
    }
};
template <bool SCALE> struct EpiBf16 {
    static constexpr bool PERM = true, CHAIN = false;
    bf16* O; int ldc; const float* scale;
    __device__ __forceinline__ int operator()(const f32x4 (&acc)[2][2][4][2], const Unit& u, int wr, int wc, int fr, int fq) const {
        const int row0 = u.pm * BM + wr * 64 + fr, col0 = u.pn * BM + wc * 32 + 8 * fq;
        f32x4 sv[2][2];
        if (SCALE) {
#pragma unroll
            for (int bj = 0; bj < 2; ++bj)
#pragma unroll
                for (int n = 0; n < 2; ++n) sv[bj][n] = *(const f32x4*)(scale + col0 + bj * HALF + 4 * n);
        }
#pragma unroll
        for (int ai = 0; ai < 2; ++ai)
#pragma unroll
            for (int m = 0; m < 4; ++m) {
#pragma unroll
                for (int bj = 0; bj < 2; ++bj) { f32x4 v0 = acc[ai][bj][m][0], v1 = acc[ai][bj][m][1];
                    if (SCALE) { v0 = v0 * sv[bj][0]; v1 = v1 * sv[bj][1]; }
                    v4u w; w.x = pg8::cvt_pk_bf16(v0[0], v0[1]); w.y = pg8::cvt_pk_bf16(v0[2], v0[3]); w.z = pg8::cvt_pk_bf16(v1[0], v1[1]); w.w = pg8::cvt_pk_bf16(v1[2], v1[3]);
                    *(v4u*)(O + yb_off(row0 + ai * HALF + m * 16, col0 + bj * HALF)) = w; } }
        return 16;
    }
};
struct EpiFfn {
    static constexpr bool PERM = true, CHAIN = false;
    bf16* ACT; bf16* EDGE; const float* cw; const float* cb;
    template <int CTRL> static __device__ __forceinline__ float dpp(float x) { return __builtin_bit_cast(float, __builtin_amdgcn_update_dpp(0, __builtin_bit_cast(int, x), CTRL, 0xf, 0xf, true)); }
    template <int M> static __device__ __forceinline__ f32x4 conv4(const f32x4 (&x)[4][2], int n, const f32x4 (&w)[4], const f32x4 we0, const f32x4 we2) {
        f32x4 r;
#pragma unroll
        for (int e = 0; e < 4; ++e) { const float c = x[M][n][e];
            float t = __builtin_fmaf(w[1][e], c, w[3][e]);
            t = __builtin_fmaf(w[0][e], dpp<0x111>(c), t);
            t = __builtin_fmaf(w[2][e], dpp<0x101>(c), t);
            if (M > 0) t = __builtin_fmaf(we0[e], dpp<0x121>(x[M > 0 ? M - 1 : 0][n][e]), t);
            if (M < 3) t = __builtin_fmaf(we2[e], dpp<0x12f>(x[M < 3 ? M + 1 : 3][n][e]), t);
            r[e] = t; }
        return r;
    }
    template <int M> __device__ __forceinline__ v2u act4(const f32x4 (&xa)[4][2], const f32x4 (&xb)[4][2], int n, const f32x4 (&wa)[4], const f32x4 (&wb)[4], const f32x4 wae0, const f32x4 wae2, const f32x4 wbe0, const f32x4 wbe2) const {
        const f32x4 va = conv4<M>(xa, n, wa, wae0, wae2), vb = conv4<M>(xb, n, wb, wbe0, wbe2);
        float o[4];
#pragma unroll
        for (int e = 0; e < 4; ++e) o[e] = va[e] * __builtin_amdgcn_rcpf(1.0f + __builtin_amdgcn_exp2f(va[e] * -1.44269504f)) * vb[e];
        v2u r; r.x = pk2(o[0], o[1]); r.y = pk2(o[2], o[3]); return r;
    }
    __device__ __forceinline__ void operator()(const f32x4 (&acc)[2][2][4][2], const Unit& u, int wr, int wc, int fr, int fq) const {
        const int row0 = u.pm * BM + wr * 64 + fr, c0 = u.pn * 128 + wc * 32 + 8 * fq;
        const float e0 = fr == 0 ? 1.f : 0.f, e15 = fr == 15 ? 1.f : 0.f;
#pragma unroll
        for (int ai = 0; ai < 2; ++ai) {
            const int blk = u.pm * 4 + ai * 2 + wr;
            if (fr < 2 || fr >= 14) {
                const int j = fr < 2 ? fr : fr - 12;
                const f32x4 a0 = fr < 2 ? acc[ai][0][0][0] : acc[ai][0][3][0], a1 = fr < 2 ? acc[ai][0][0][1] : acc[ai][0][3][1];
                const f32x4 b0 = fr < 2 ? acc[ai][1][0][0] : acc[ai][1][3][0], b1 = fr < 2 ? acc[ai][1][0][1] : acc[ai][1][3][1];
                bf16* ep = EDGE + ((size_t)(blk * 4 + j) * 2) * DFF + c0;
                v4u w; w.x = pk2(a0[0], a0[1]); w.y = pk2(a0[2], a0[3]); w.z = pk2(a1[0], a1[1]); w.w = pk2(a1[2], a1[3]); *(v4u*)ep = w;
                w.x = pk2(b0[0], b0[1]); w.y = pk2(b0[2], b0[3]); w.z = pk2(b1[0], b1[1]); w.w = pk2(b1[2], b1[3]); *(v4u*)(ep + DFF) = w;
            }
        }
        __builtin_amdgcn_sched_barrier(0);
#pragma unroll
        for (int n = 0; n < 2; ++n) {
            f32x4 wa[4], wb[4];
#pragma unroll
            for (int k = 0; k < 3; ++k) { wa[k] = *(const f32x4*)(cw + k * UPC + c0 + 4 * n); wb[k] = *(const f32x4*)(cw + k * UPC + DFF + c0 + 4 * n); }
            wa[3] = *(const f32x4*)(cb + c0 + 4 * n); wb[3] = *(const f32x4*)(cb + DFF + c0 + 4 * n);
            const f32x4 wae0 = wa[0] * e0, wae2 = wa[2] * e15, wbe0 = wb[0] * e0, wbe2 = wb[2] * e15;
#pragma unroll
            for (int ai = 0; ai < 2; ++ai) {
                v2u r[4];
                r[0] = act4<0>(acc[ai][0], acc[ai][1], n, wa, wb, wae0, wae2, wbe0, wbe2); r[1] = act4<1>(acc[ai][0], acc[ai][1], n, wa, wb, wae0, wae2, wbe0, wbe2);
                r[2] = act4<2>(acc[ai][0], acc[ai][1], n, wa, wb, wae0, wae2, wbe0, wbe2); r[3] = act4<3>(acc[ai][0], acc[ai][1], n, wa, wb, wae0, wae2, wbe0, wbe2);
#pragma unroll
                for (int m = 0; m < 4; ++m) *(v2u*)(ACT + act_off(row0 + ai * HALF + m * 16, c0 + 4 * n)) = r[m];
            }
            __builtin_amdgcn_sched_barrier(0);
        }
    }
};
struct EpiBranch {
    static constexpr bool PERM = true, CHAIN = true;
    const unsigned char* G; bf16* MERGED; int skip;
    static __device__ __forceinline__ void deq8(const v2u w, float (&g)[8]) {
        g[0] = (float)(w.x & 0xffu); g[1] = (float)((w.x >> 8) & 0xffu); g[2] = (float)((w.x >> 16) & 0xffu); g[3] = (float)(w.x >> 24);
        g[4] = (float)(w.y & 0xffu); g[5] = (float)((w.y >> 8) & 0xffu); g[6] = (float)((w.y >> 16) & 0xffu); g[7] = (float)(w.y >> 24);
#pragma unroll
        for (int e = 0; e < 8; ++e) g[e] = (g[e] + 0.5f) * (1.0f / 256.0f);
    }
    static __device__ __forceinline__ void deqs(const v2u w, float (&g)[8], float sc) {
        g[0] = (float)(w.x & 0xffu); g[1] = (float)((w.x >> 8) & 0xffu); g[2] = (float)((w.x >> 16) & 0xffu); g[3] = (float)(w.x >> 24);
        g[4] = (float)(w.y & 0xffu); g[5] = (float)((w.y >> 8) & 0xffu); g[6] = (float)((w.y >> 16) & 0xffu); g[7] = (float)(w.y >> 24);
        const float hb = 0.5f * sc;
#pragma unroll
        for (int e = 0; e < 8; ++e) g[e] = __builtin_fmaf(g[e], sc, hb);
    }
    __device__ __forceinline__ bool operator()(f32x4 (&acc)[2][2][4][2], const Unit& u, int wr, int wc, int fr, int fq) const {
        const int row0 = u.pm * BM + wr * 64 + fr, col0 = u.pn * BM + wc * 32 + 8 * fq, sub = u.sub;
        const int subn = sub < 3 ? sub + 1 : sub;
        if (skip) return sub == 3;
        const int wave = wr * 4 + wc, ln = fq * 16 + fr;
        const bool last = sub == 3;
        const float sg = last ? 127.5f / 65536.0f : 1.0f / 256.0f;
        v2u gv[2][4][2], hv[2][4][2];
#pragma unroll
        for (int ai = 0; ai < 2; ++ai)
#pragma unroll
            for (int m = 0; m < 4; ++m)
#pragma unroll
                for (int bj = 0; bj < 2; ++bj) { gv[ai][m][bj] = *(const v2u*)(G + gate_off(u.pm, sub * 8 + u.pn, wave, ai * 8 + m * 2 + bj, ln)); hv[ai][m][bj] = *(const v2u*)(G + gate_off(u.pm, subn * 8 + u.pn, wave, ai * 8 + m * 2 + bj, ln)); }
        __builtin_amdgcn_sched_barrier(0);
#pragma unroll
        for (int ai = 0; ai < 2; ++ai)
#pragma unroll
            for (int m = 0; m < 4; ++m)
#pragma unroll
                for (int bj = 0; bj < 2; ++bj) {
                    v2u hw = hv[ai][m][bj]; if (last) { hw.x = 0x7f7f7f7fu; hw.y = 0x7f7f7f7fu; }
                    float g[8], h[8]; deqs(gv[ai][m][bj], g, sg); deqs(hw, h, 1.0f / 256.0f);
#pragma unroll
                    for (int e = 0; e < 8; ++e) g[e] = g[e] * __builtin_amdgcn_rcpf(h[e]);
                    f32x4& v0 = acc[ai][bj][m][0]; f32x4& v1 = acc[ai][bj][m][1];
                    v0[0] *= g[0]; v0[1] *= g[1]; v0[2] *= g[2]; v0[3] *= g[3]; v1[0] *= g[4]; v1[1] *= g[5]; v1[2] *= g[6]; v1[3] *= g[7];
                    if (bj == 1) __builtin_amdgcn_sched_barrier(0);
                }
        if (last) {
#pragma unroll
            for (int ai = 0; ai < 2; ++ai)
#pragma unroll
                for (int m = 0; m < 4; ++m)
#pragma unroll
                    for (int bj = 0; bj < 2; ++bj) {
                        const f32x4 v0 = acc[ai][bj][m][0], v1 = acc[ai][bj][m][1];
                        v4u w; w.x = pg8::cvt_pk_bf16(v0[0], v0[1]); w.y = pg8::cvt_pk_bf16(v0[2], v0[3]); w.z = pg8::cvt_pk_bf16(v1[0], v1[1]); w.w = pg8::cvt_pk_bf16(v1[2], v1[3]);
                        *(v4u*)(MERGED + (size_t)(row0 + ai * HALF + m * 16) * 2048 + col0 + bj * HALF) = w;
                    }
        }
        return last;
    }
};
struct EpiResid {
    static constexpr bool PERM = false, CHAIN = false;
    float* X; const float* modl; int goff, skip;
    __device__ __forceinline__ void operator()(const f32x4 (&acc)[2][2][4][2], const Unit& u, int wr, int wc, int fr, int fq) const {
        if (skip) return;
        const int row0 = u.pm * BM + wr * 64 + fr, col0 = u.pn * BM + wc * 32 + 4 * fq;
        const float* gp = modl + (size_t)(u.pm < 64 ? (u.pm >> 4) : 4) * 12288 + goff + col0;
        f32x4 gv[2][2];
#pragma unroll
        for (int bj = 0; bj < 2; ++bj)
#pragma unroll
            for (int n = 0; n < 2; ++n) gv[bj][n] = *(const f32x4*)(gp + bj * HALF + n * 16);
#pragma unroll
        for (int ai = 0; ai < 2; ++ai) {
            f32x4 xv[4][2][2];
#pragma unroll
            for (int m = 0; m < 4; ++m)
#pragma unroll
                for (int bj = 0; bj < 2; ++bj)
#pragma unroll
                    for (int n = 0; n < 2; ++n) xv[m][bj][n] = *(const f32x4*)(X + (size_t)(row0 + ai * HALF + m * 16) * D + col0 + bj * HALF + n * 16);
#pragma unroll
            for (int m = 0; m < 4; ++m)
#pragma unroll
                for (int bj = 0; bj < 2; ++bj)
#pragma unroll
                    for (int n = 0; n < 2; ++n) *(f32x4*)(X + (size_t)(row0 + ai * HALF + m * 16) * D + col0 + bj * HALF + n * 16) = xv[m][bj][n] + gv[bj][n] * acc[ai][bj][m][n];
        }
    }
};

struct EpiPart {
    static constexpr bool PERM = false, CHAIN = false;
    float* PART; const float* modl; int goff;
    __device__ __forceinline__ int operator()(const f32x4 (&acc)[2][2][4][2], const Unit& u, int wr, int wc, int fr, int fq) const {
        const int row0 = (u.pm - 64) * BM + wr * 64 + fr, col0 = u.pn * BM + wc * 32 + 4 * fq;
        const float* gp = modl + (size_t)4 * 12288 + goff + col0;
        float* P = PART + (size_t)u.sub * MC * D;
        f32x4 gv[2][2];
#pragma unroll
        for (int bj = 0; bj < 2; ++bj)
#pragma unroll
            for (int n = 0; n < 2; ++n) gv[bj][n] = *(const f32x4*)(gp + bj * HALF + n * 16);
#pragma unroll
        for (int ai = 0; ai < 2; ++ai)
#pragma unroll
            for (int m = 0; m < 4; ++m)
#pragma unroll
                for (int bj = 0; bj < 2; ++bj)
#pragma unroll
                    for (int n = 0; n < 2; ++n) *(f32x4*)(P + (size_t)(row0 + ai * HALF + m * 16) * D + col0 + bj * HALF + n * 16) = gv[bj][n] * acc[ai][bj][m][n];
        return 32;
    }
};

constexpr int NPH = 11;
constexpr int N_PHASES = 1 + DEPTH * NPH + 1;

__global__ void __launch_bounds__(NWAVES * 64, 2) fwd_kernel(Args args) {
    extern __shared__ __attribute__((aligned(16))) unsigned char lds_raw[];
    Frame F;
    F.lds = (LAS unsigned char*)lds_raw;
    F.tid = threadIdx.x; F.lane = F.tid & 63; F.wave = __builtin_amdgcn_readfirstlane(F.tid >> 6);
    F.G = gridDim.x; F.bid = blockIdx.x; F.ws = args.ws; F.in = args.in;
#if defined(PROBE_K)
    F.variant = args.variant;
#else
    F.variant = 0;
#endif
    gu32* ctl = (gu32*)(args.ws + WS_CTL);
    for (int u = F.tid; u < (LDS_BYTES - LDSCTL_OFF) / 4; u += NWAVES * 64) ((LAS unsigned*)(F.lds + LDSCTL_OFF))[u] = 0u;
    __syncthreads();
    XcdBarrier bar; bar.bar = (unsigned*)(ctl + CW_BAR); bar.x = 0; bar.st = nullptr;
    if (!MK_PER_PHASE && args.ph_hi - args.ph_lo > 1) bar = xcd_barrier_post((unsigned*)(ctl + CW_BAR), (volatile LAS unsigned*)(F.lds + MISC_OFF) + 8);
    const int lo = args.ph_lo, hi = args.ph_hi;
#ifndef PH_MASK
#define PH_MASK 0xFFFF
#endif
#define EN(b) (((PH_MASK) >> (b)) & 1)
#define IN(k) (lo <= (k) && (k) < hi)
#define SEAM(k) do { if (!MK_PER_PHASE && IN((k) + 1)) xcd_barrier(bar); } while (0)

    if (EN(11) && IN(0)) { phase_mod(F); steal_convert(F, 0, 0, true); SEAM(0); }

    for (int l = 0; l < DEPTH; ++l) {
        const int p0 = 1 + l * NPH;
        const int nrows = (l == DEPTH - 1) ? ML : M;
        const int nMp = nrows / 256;
        const float* modl = (const float*)(F.ws + WS_MOD) + (size_t)l * 5 * 12288;
        const unsigned char* wb = F.ws + (size_t)(l & 1) * W_SPAN;
        const bool cv = l + 1 < DEPTH;
        if (EN(0) && IN(p0 + 0)) {
            if (l == 0) phase_norm<true>(F, l, F.in[I_NORM1] + (size_t)l * D, 0, 2048, M);
            else phase_norm<false>(F, l, F.in[I_NORM1] + (size_t)l * D, 0, 2048, M, true);
            SEAM(p0 + 0);
        }
        if (EN(1) && IN(p0 + 1)) {
            const bool two = (nrows == ML);
            {
                pg8::Gemm g{(const char*)(F.ws + WS_H), (const char*)(wb + WS_WIG), (size_t)256 * D * 2, 0, 0, (size_t)256 * D * 2, 0, D, D, D};
                pg8::TileOrder<1> S; S.init(M / 256, two ? 41 : NIG / 256, F.G, F.bid);
                EpiInGate E{(bf16*)(F.ws + WS_U), (float*)(F.ws + WS_DT), (unsigned char*)(F.ws + WS_G), F.in[I_BGATE] + (size_t)l * 4 * 2048, 0};
                pg8::gemm_phase(F.lds + RING_OFF, g, S, E);
            }
            if (two) {
                pg8::Gemm g{(const char*)(F.ws + WS_H), (const char*)(wb + WS_WIG) + (size_t)41 * 256 * D * 2, (size_t)256 * D * 2, 0, 0, (size_t)256 * D * 2, 0, D, D, D};
                pg8::TileOrder<1> S; S.init(ML / 256, 32, F.G, F.bid);
                EpiInGate E{(bf16*)(F.ws + WS_U), (float*)(F.ws + WS_DT), (unsigned char*)(F.ws + WS_G), F.in[I_BGATE] + (size_t)l * 4 * 2048, 41};
                pg8::gemm_phase(F.lds + RING_OFF, g, S, E);
            }
            if (cv) steal_convert(F, l + 1, 1 + l * 6 + 0, false);
            SEAM(p0 + 1);
        }
        if (EN(2) && IN(p0 + 2)) { phase_pre(F, l); SEAM(p0 + 2); }
        if (EN(3) && IN(p0 + 3)) {
            const int nscan = 192;
            const bool split = F.G > nscan;
            for (int id = F.bid; id < nscan; id += F.G) {
#ifndef NO_SSD
                if (id < 128) scan_unit<128, 64, true>(F, l, id >> 5, (id >> 1) & 15, id & 1);
                else
#endif
#ifndef NO_RET
                { const int j = id - 128; scan_unit<64, 128, false>(F, l, j >> 4, (j >> 1) & 7, j & 1); }
#else
                {}
#endif
            }
#ifndef NO_POOLG
            if (!split || F.bid >= nscan) {
                pg8::Gemm g{(const char*)(F.ws + WS_POOLED), (const char*)(wb + WS_WPOOL), (size_t)256 * 1024 * 2, (size_t)256 * 2, 0, (size_t)256 * 256 * 2, 0, 1024, 256, 256};
                pg8::TileOrder<1> S; S.init(M / 256, 4, split ? F.G - nscan : F.G, split ? F.bid - nscan : F.bid);
                EpiBf16<true> E{(bf16*)(F.ws + WS_YB) + YS_STRIDE, 1024, F.in[I_POOLS] + (size_t)l * 1024};
                pg8::gemm_phase(F.lds + RING_OFF, g, S, E);
                sc_phase(F, l, split ? F.bid - nscan : F.bid, split ? F.G - nscan : F.G);
            }
            if (cv) steal_convert(F, l + 1, 1 + l * 6 + 5, false);
#endif
            SEAM(p0 + 3);
        }
        if (EN(4) && IN(p0 + 4)) { phase_fin(F, l, nrows); SEAM(p0 + 4); }
        if (EN(5) && IN(p0 + 5)) {
            pg8::Gemm g{(const char*)(F.ws + WS_YB), (const char*)(wb + WS_WB), (size_t)256 * 1024 * 2, 0, YS_STRIDE * 2, (size_t)256 * 1024 * 2, (size_t)2048 * 1024 * 2, 64, 1024, 1024, (size_t)256 * 64 * 2};
            pg8::TileOrder<4> S; S.init(nMp, D / 256, F.G, F.bid, 8);
            EpiBranch E{(const unsigned char*)(F.ws + WS_G), (bf16*)(F.ws + WS_MERGED), F.variant & 128};
            pg8::gemm_phase(F.lds + RING_OFF, g, S, E);
            if (cv) steal_convert(F, l + 1, 1 + l * 6 + 1, false);
            SEAM(p0 + 5);
        }
        if (EN(6) && IN(p0 + 6)) {
            pg8::Gemm g{(const char*)(F.ws + WS_MERGED), (const char*)(wb + WS_WO), (size_t)256 * D * 2, 0, 0, (size_t)256 * D * 2, 0, D, D, D};
            pg8::TileOrder<1> S; S.init(ML / 256, D / 256, F.G, F.bid);
            EpiResid E{(float*)(F.ws + WS_X), modl, 4096, F.variant & 128};
            pg8::gemm_phase(F.lds + RING_OFF, g, S, E);
            if (nMp > ML / 256) {
                pg8::Gemm g2{(const char*)(F.ws + WS_MERGED), (const char*)(wb + WS_WO), (size_t)256 * D * 2, 0, (size_t)(D / 4) * 2, (size_t)256 * D * 2, (size_t)(D / 4) * 2, D, D, D / 4};
                pg8::SplitOrder<4> S2; S2.init(nMp - ML / 256, D / 256, ML / 256, F.G, F.bid);
                EpiPart E2{(float*)(F.ws + WS_PART), modl, 4096};
                pg8::gemm_phase(F.lds + RING_OFF, g2, S2, E2);
            }
            if (cv) steal_convert(F, l + 1, 1 + l * 6 + 2, false);
            SEAM(p0 + 6);
        }
        if (EN(7) && IN(p0 + 7)) { phase_norm<false>(F, l, F.in[I_NORM2] + (size_t)l * D, 6144, 8192, nrows, nrows > ML); SEAM(p0 + 7); }
        if (EN(8) && IN(p0 + 8)) {
            pg8::Gemm g{(const char*)(F.ws + WS_H), (const char*)(wb + WS_WUP), (size_t)256 * D * 2, 0, 0, (size_t)256 * D * 2, 0, D, D, D};
            pg8::TileOrder<1> S; S.init(nMp, UPC / 256, F.G, F.bid);
            EpiFfn E{(bf16*)(F.ws + WS_ACT), (bf16*)(F.ws + WS_UP), F.in[I_FFNCW] + (size_t)l * 3 * UPC, F.in[I_FFNCB] + (size_t)l * UPC};
            pg8::gemm_phase(F.lds + RING_OFF, g, S, E);
            if (cv) steal_convert(F, l + 1, 1 + l * 6 + 3, false);
            SEAM(p0 + 8);
        }
        if (EN(9) && IN(p0 + 9)) { phase_ffnfix(F, l, nrows); SEAM(p0 + 9); }
        if (EN(10) && IN(p0 + 10)) {
            pg8::Gemm g{(const char*)(F.ws + WS_ACT), (const char*)(wb + WS_WDN), (size_t)256 * DFF * 2, 0, 0, (size_t)256 * DFF * 2, 0, 64, DFF, DFF, (size_t)256 * 64 * 2};
            pg8::TileOrder<1> S; S.init(ML / 256, D / 256, F.G, F.bid, 2);
            EpiResid E{(float*)(F.ws + WS_X), modl, 10240, F.variant & 128};
            pg8::gemm_phase(F.lds + RING_OFF, g, S, E);
            if (nMp > ML / 256) {
                pg8::Gemm g2{(const char*)(F.ws + WS_ACT), (const char*)(wb + WS_WDN), (size_t)256 * DFF * 2, 0, (size_t)(DFF / 4 / 64) * 256 * 64 * 2, (size_t)256 * DFF * 2, (size_t)(DFF / 4) * 2, 64, DFF, DFF / 4, (size_t)256 * 64 * 2};
                pg8::SplitOrder<4> S2; S2.init(nMp - ML / 256, D / 256, ML / 256, F.G, F.bid);
                EpiPart E2{(float*)(F.ws + WS_PART), modl, 10240};
                pg8::gemm_phase(F.lds + RING_OFF, g2, S2, E2);
            }
            if (cv) steal_convert(F, l + 1, 1 + l * 6 + 4, true);
            SEAM(p0 + 10);
        }
    }
    if (EN(12) && IN(N_PHASES - 1)) {
        phase_final(F, args.out);
    }
#undef IN
#undef SEAM
}

extern "C" void kernel_launch(void* const* d_in, const int* in_sizes, int n_in, void* d_out, int out_size, void* d_ws, size_t ws_size, hipStream_t stream) {
    static int grid = 0;
    if (grid == 0) {
        if (n_in != 28 || in_sizes[0] != ML * D || out_size != ML * D || ws_size < WS_END) { fprintf(stderr, "kernel_launch: unexpected shapes (n_in %d, in0 %d, out %d, ws %zu < %zu); nothing launched\n", n_in, n_in > 0 ? in_sizes[0] : -1, out_size, ws_size, (size_t)WS_END); grid = -1; return; }
        int dev = 0, cus = 0, per_cu = 0;
        if (hipGetDevice(&dev) != hipSuccess || hipDeviceGetAttribute(&cus, hipDeviceAttributeMultiprocessorCount, dev) != hipSuccess) { fprintf(stderr, "kernel_launch: device query failed\n"); grid = -1; return; }
        if (hipFuncSetAttribute((const void*)fwd_kernel, hipFuncAttributeMaxDynamicSharedMemorySize, LDS_BYTES) != hipSuccess) { fprintf(stderr, "kernel_launch: hipFuncSetAttribute failed\n"); grid = -1; return; }
        if (hipOccupancyMaxActiveBlocksPerMultiprocessor(&per_cu, (const void*)fwd_kernel, NWAVES * 64, LDS_BYTES) != hipSuccess || per_cu < 1)
            fprintf(stderr, "kernel_launch: note: occupancy query reports %d workgroups per CU\n", per_cu);
        (void)hipGetLastError();
        grid = cus;
    }
    if (grid < 0) return;
    if (hipMemsetAsync((char*)d_ws + WS_CTL, 0, CTL_ZERO_BYTES, stream) != hipSuccess) { fprintf(stderr, "kernel_launch: memset failed\n"); return; }
    Args a{};
    for (int i = 0; i < 28; ++i) a.in[i] = (const float*)d_in[i];
    a.out = (float*)d_out; a.ws = (unsigned char*)d_ws;
#if defined(PROBE_K)
    a.ph_lo = 0; a.ph_hi = N_PHASES;
    hipLaunchKernelGGL(fwd_kernel, dim3(grid), dim3(NWAVES * 64), LDS_BYTES, stream, a);
    for (int rep = 0; rep < PROBE_REPS; ++rep) for (int l = 0; l < DEPTH; ++l) { a.ph_lo = 1 + l * NPH + PROBE_K; a.ph_hi = a.ph_lo + 1; a.variant = PROBE_VARIANT; hipLaunchKernelGGL(fwd_kernel, dim3(grid), dim3(NWAVES * 64), LDS_BYTES, stream, a); }
#elif MK_PER_PHASE
    for (int p = 0; p < N_PHASES; ++p) { a.ph_lo = p; a.ph_hi = p + 1; hipLaunchKernelGGL(fwd_kernel, dim3(grid), dim3(NWAVES * 64), LDS_BYTES, stream, a); }
#else
    a.ph_lo = 0; a.ph_hi = N_PHASES;
    hipLaunchKernelGGL(fwd_kernel, dim3(grid), dim3(NWAVES * 64), LDS_BYTES, stream, a);
#endif
    const hipError_t le = hipPeekAtLastError();
    if (le != hipSuccess) fprintf(stderr, "kernel_launch: launch failed: %s\n", hipGetErrorName(le));
}
```

```cpp
#include <hip/hip_runtime.h>
#include <cstdio>
#include <cstdint>

#ifndef MK_PER_PHASE
#define MK_PER_PHASE 0
#endif

namespace pg8 {
#define PG8_LAS __attribute__((address_space(3)))
typedef unsigned short bf16_t;
typedef short bf16x8 __attribute__((ext_vector_type(8)));
typedef float f32x4 __attribute__((ext_vector_type(4)));
typedef unsigned u32x4 __attribute__((ext_vector_type(4)));
constexpr int BM = 256, BK = 64, HALF = 128, HTB = HALF * BK * 2, STAGE_BYTES = 8 * HTB, NXCD = 8, WGM = 8;

__host__ __device__ __forceinline__ int lds_byte(int r, int c) { const int st = (r >> 4) * 2 + (c >> 5), rr = r & 15, cc = c & 31, ob = rr * 64 + cc * 2; return st * 1024 + (ob ^ (((ob >> 9) & 1) << 5)); }
__host__ __device__ __forceinline__ void stage_rc(int b, int& R, int& C) { const int st = b / 1024, sb = b % 1024, swz = sb ^ (((sb >> 9) & 1) << 5); R = (st >> 1) * 16 + swz / 64; C = (st & 1) * 32 + (swz % 64) / 2; }
__host__ __device__ __forceinline__ int perm32(int rho) { const int n = rho >> 4, i = rho & 15; return 8 * (i >> 2) + 4 * n + (i & 3); }

struct Unit { int pm, pn, sub; };
struct Gemm { const char* A; const char* B; size_t a_tile, a_pn, a_sub, b_tile, b_sub; int lda, ldb, K; size_t kstepA = (size_t)(BK * 2); };

template <int NSUB> struct TileOrder {
    int nM, nN, nwg, G, c, wgm, basex, g8, nig;
    __device__ __forceinline__ void init(int nM_, int nN_, int G_, int c_, int wgm_ = 4) { nM = nM_; nN = nN_; nwg = nM * nN; G = G_; c = c_; wgm = wgm_; nig = wgm * nN;
        const int q = nwg / NXCD, r = nwg % NXCD, xcd = c % NXCD; basex = (xcd < r ? xcd * (q + 1) : r * (q + 1) + (xcd - r) * q) + c / NXCD; g8 = (G % NXCD == 0) ? G / NXCD : 0; }
    __device__ __forceinline__ bool next(int i, Unit& u) const {
        const int sub = i % NSUB, t = i / NSUB; const long L = (long)t * G + c; if (L >= nwg) return false;
        int wgid;
        if (g8) wgid = basex + t * g8;
        else { wgid = (int)L; const int q = nwg / NXCD, r = nwg % NXCD, xcd = wgid % NXCD, off = wgid / NXCD; wgid = (xcd < r ? xcd * (q + 1) : r * (q + 1) + (xcd - r) * q) + off; }
        const int gid = wgid / nig, rem = wgid - gid * nig, fm = gid * wgm, gsz = (nM - fm) < wgm ? (nM - fm) : wgm;
        const int pn = rem / gsz;
        u.pm = fm + (rem - pn * gsz); u.pn = pn; u.sub = sub; return true;
    }
};

template <int NSUB> struct SplitOrder {
    int nM, nN, pm0, G, c;
    __device__ __forceinline__ void init(int nM_, int nN_, int pm0_, int G_, int c_) { nM = nM_; nN = nN_; pm0 = pm0_; G = G_; c = c_; }
    __device__ __forceinline__ bool next(int i, Unit& u) const {
        const int j = i * G + c; if (j >= nM * nN * NSUB) return false;
        const int tile = j / NSUB; u.sub = j % NSUB; u.pm = pm0 + tile / nN; u.pn = tile % nN; return true;
    }
};
typedef __bf16 bf16x2_t __attribute__((ext_vector_type(2)));
typedef float f32x2_t __attribute__((ext_vector_type(2)));
__device__ __forceinline__ unsigned cvt_pk_bf16(float lo, float hi) { const f32x2_t v = {lo, hi}; return __builtin_bit_cast(unsigned, __builtin_convertvector(v, bf16x2_t)); }

template <class Epi, class Sched>
__device__ __forceinline__ void gemm_phase(PG8_LAS unsigned char* lds, const Gemm g, const Sched& S, const Epi& E) {
    int tid_ = threadIdx.x; asm volatile("" : "+v"(tid_));
    const int tid = tid_, wid = __builtin_amdgcn_readfirstlane(tid >> 6), lane = tid & 63, wr = wid >> 2, wc = wid & 3, fr = lane & 15, fq = lane >> 4;
    const int K = g.K, nt = K / BK;
    unsigned voffA[2], voffB[2];
#pragma unroll
    for (int i = 0; i < 2; ++i) { int R, C; stage_rc(tid * 16 + i * 8192, R, C); const int Rb = Epi::PERM ? ((R & ~31) + perm32(R & 31)) : R;
        voffA[i] = (unsigned)(R * g.lda + C) * 2u; voffB[i] = (unsigned)(Rb * g.ldb + C) * 2u; }
    const size_t kstep = (size_t)(BK * 2), kstepA = g.kstepA;
    const size_t hstepA = (size_t)HALF * g.lda * 2, hstepB = (size_t)HALF * g.ldb * 2;
    const unsigned ldsw = (unsigned)wid * 1024u;
    const int aoff = lds_byte(wr * 64 + fr, fq * 8), boff = lds_byte(wc * 32 + fr, fq * 8);
#define PG8_SA(b, h) (((b) * 2 + (h)) * HTB)
#define PG8_SB(b, h) ((4 + (b) * 2 + (h)) * HTB)
#define PG8_STAGE(bufoff, gbase, voff) do { _Pragma("unroll") for (int _i = 0; _i < 2; ++_i) \
        __builtin_amdgcn_global_load_lds((const unsigned*)((const char*)(gbase) + (voff)[_i]), (PG8_LAS unsigned*)(lds + (bufoff) + ldsw + _i * 8192), 16, 0, 0); } while (0)
#define PG8_LDA(dst, b, h) do { _Pragma("unroll") for (int m = 0; m < 4; ++m) _Pragma("unroll") for (int k = 0; k < 2; ++k) dst[m][k] = *(const PG8_LAS bf16x8*)(lds + PG8_SA(b, h) + aoff + m * 2048 + k * 1024); } while (0)
#define PG8_LDB(dst, b, h) do { _Pragma("unroll") for (int n = 0; n < 2; ++n) _Pragma("unroll") for (int k = 0; k < 2; ++k) dst[n][k] = *(const PG8_LAS bf16x8*)(lds + PG8_SB(b, h) + boff + n * 2048 + k * 1024); } while (0)
#define PG8_MMA(ai, bj, At, Bt) do { __builtin_amdgcn_s_setprio(1); _Pragma("unroll") for (int m = 0; m < 4; ++m) _Pragma("unroll") for (int n = 0; n < 2; ++n) _Pragma("unroll") for (int k = 0; k < 2; ++k) \
        acc[ai][bj][m][n] = __builtin_amdgcn_mfma_f32_16x16x32_bf16(Bt[n][k], At[m][k], acc[ai][bj][m][n], 0, 0, 0); __builtin_amdgcn_s_setprio(0); } while (0)
#define PG8_WAIT_V(n) asm volatile("s_waitcnt vmcnt(" #n ")" ::: "memory")
#define PG8_WAIT_L(n) asm volatile("s_waitcnt lgkmcnt(" #n ")" ::: "memory")
#define PG8_BAR __builtin_amdgcn_s_barrier()
#define PG8_SCHED __builtin_amdgcn_sched_barrier(0)
    Unit cur, nxt; int ui = 0;
    if (!S.next(0, cur)) return;
    f32x4 acc[2][2][4][2];
#pragma unroll
    for (int a = 0; a < 2; ++a)
#pragma unroll
        for (int b = 0; b < 2; ++b)
#pragma unroll
            for (int m = 0; m < 4; ++m)
#pragma unroll
                for (int n = 0; n < 2; ++n) acc[a][b][m][n] = (f32x4){0.f, 0.f, 0.f, 0.f};
    bf16x8 At[4][2], B0[2][2], B1[2][2];
    const char* cA = g.A + (size_t)cur.pm * g.a_tile + (size_t)cur.pn * g.a_pn + (size_t)cur.sub * g.a_sub;
    const char* cB = g.B + (size_t)cur.pn * g.b_tile + (size_t)cur.sub * g.b_sub;
    PG8_STAGE(PG8_SB(0, 0), cB, voffB); PG8_STAGE(PG8_SB(0, 1), cB + hstepB, voffB); PG8_STAGE(PG8_SA(0, 0), cA, voffA); PG8_STAGE(PG8_SA(0, 1), cA + hstepA, voffA);
    if (wr == 1) PG8_BAR;
    PG8_WAIT_V(2); PG8_BAR;
    PG8_STAGE(PG8_SB(1, 0), cB + kstep, voffB); PG8_STAGE(PG8_SA(1, 0), cA + kstepA, voffA); PG8_STAGE(PG8_SB(1, 1), cB + hstepB + kstep, voffB);
    PG8_WAIT_V(6); PG8_BAR;
    for (;;) {
        const bool has_next = S.next(ui + 1, nxt);
        const char* nA = has_next ? g.A + (size_t)nxt.pm * g.a_tile + (size_t)nxt.pn * g.a_pn + (size_t)nxt.sub * g.a_sub : cA;
        const char* nB = has_next ? g.B + (size_t)nxt.pn * g.b_tile + (size_t)nxt.sub * g.b_sub : cB;
        for (int t = 0; t < nt; t += 2) {
            const bool last = (t == nt - 2);
            const char* a1 = cA + (size_t)(t + 1) * kstepA;
            const char* a2 = last ? nA : cA + (size_t)(t + 2) * kstepA; const char* b2 = last ? nB : cB + (size_t)(t + 2) * kstep;
            const char* a3 = a2 + kstepA; const char* b3 = b2 + kstep;
            PG8_LDB(B0, 0, 0); PG8_LDB(B1, 0, 1); PG8_SCHED; PG8_LDA(At, 0, 0); PG8_STAGE(PG8_SA(1, 1), a1 + hstepA, voffA);
            PG8_WAIT_V(8); PG8_WAIT_L(0); PG8_BAR; PG8_MMA(0, 0, At, B0); PG8_MMA(0, 1, At, B1); PG8_BAR; PG8_SCHED;
            PG8_LDA(At, 0, 1); PG8_STAGE(PG8_SB(0, 0), b2, voffB); PG8_STAGE(PG8_SB(0, 1), b2 + hstepB, voffB); PG8_STAGE(PG8_SA(0, 0), a2, voffA);
            PG8_WAIT_V(8); PG8_WAIT_L(0); PG8_BAR; PG8_MMA(1, 0, At, B0); PG8_MMA(1, 1, At, B1); PG8_BAR; PG8_SCHED;
            PG8_LDB(B0, 1, 0); PG8_LDB(B1, 1, 1); PG8_SCHED; PG8_LDA(At, 1, 0); PG8_STAGE(PG8_SA(0, 1), a2 + hstepA, voffA);
            PG8_WAIT_V(8); PG8_WAIT_L(0); PG8_BAR; PG8_MMA(0, 0, At, B0); PG8_MMA(0, 1, At, B1); PG8_BAR; PG8_SCHED;
            PG8_LDA(At, 1, 1); PG8_STAGE(PG8_SB(1, 0), b3, voffB); PG8_STAGE(PG8_SB(1, 1), b3 + hstepB, voffB); PG8_STAGE(PG8_SA(1, 0), a3, voffA);
            PG8_WAIT_V(8); PG8_WAIT_L(0); PG8_BAR; PG8_MMA(1, 0, At, B0); PG8_MMA(1, 1, At, B1); PG8_BAR; PG8_SCHED;
        }
        if (wr == 0) PG8_BAR;
        bool zero_acc = true;
        int fr2 = fr, fq2 = fq; asm volatile("" : "+v"(fr2), "+v"(fq2));
        if constexpr (Epi::CHAIN) zero_acc = E(acc, cur, wr, wc, fr2, fq2); else E(acc, cur, wr, wc, fr2, fq2);
        if (!has_next) break;
        if (zero_acc) {
#pragma unroll
        for (int a = 0; a < 2; ++a)
#pragma unroll
            for (int b = 0; b < 2; ++b)
#pragma unroll
                for (int m = 0; m < 4; ++m)
#pragma unroll
                    for (int n = 0; n < 2; ++n) acc[a][b][m][n] = (f32x4){0.f, 0.f, 0.f, 0.f};
        }
        cur = nxt; cA = nA; cB = nB; ++ui;
        if (wr == 1) PG8_BAR;
    }
    PG8_WAIT_V(0);
    PG8_BAR;
#undef PG8_SA
#undef PG8_SB
#undef PG8_STAGE
#undef PG8_LDA
#undef PG8_LDB
#undef PG8_MMA
#undef PG8_WAIT_V
#undef PG8_WAIT_L
#undef PG8_BAR
#undef PG8_SCHED
}
}

constexpr int NWAVES = 8;
constexpr int D = 2048, NB = 4, SEQ = 4096, CTX = 256, DEPTH = 4;
constexpr int ML = NB * SEQ;
constexpr int MC = NB * CTX;
constexpr int M = ML + MC;
constexpr int UC = 10240;
constexpr int NIG = 10496 + 8192;
constexpr int DFF = 5632, UPC = 2 * DFF;
constexpr int IN_COLS = 10256;
constexpr float EPS = 1e-6f;
constexpr int U_Z = 0, U_XBC = 1024, U_POOL = 3072, U_SCB = 4096, U_SCC = 5120, U_SCX = 6144, U_RQ = 7168, U_RK = 7680, U_RV = 8192, U_RG = 9216;

constexpr size_t MiB = 1u << 20;
constexpr size_t WS_CTL = 0, CTL_ZERO_BYTES = 128 * 1024;
constexpr size_t WS_MOD = 1 * MiB;
constexpr size_t WS_ROPE = WS_MOD + (size_t)DEPTH * 5 * 12288 * 4;
constexpr size_t WS_X = 2 * MiB;
constexpr size_t WS_H = WS_X + 136 * MiB;
constexpr size_t WS_WIG = WS_H + 68 * MiB;
constexpr size_t WS_WB = WS_WIG + 73 * MiB;
constexpr size_t WS_WO = WS_WB + 16 * MiB;
constexpr size_t WS_WUP = WS_WO + 8 * MiB;
constexpr size_t WS_WDN = WS_WUP + 44 * MiB;
constexpr size_t WS_WPOOL = WS_WDN + 22 * MiB;
constexpr size_t W_SPAN = WS_WPOOL + 1 * MiB - WS_WIG;
constexpr size_t WS_U = WS_WIG + 2 * W_SPAN;
constexpr size_t WS_DT = WS_U + 340 * MiB;
constexpr size_t WS_G = WS_DT + 2 * MiB;
constexpr size_t WS_UP = WS_U;
constexpr size_t WS_CUMA = WS_G + 140 * MiB;
constexpr size_t WS_DTA = WS_CUMA + 4 * MiB;
constexpr size_t WS_PART = WS_G + 152 * MiB;
constexpr size_t WS_XBCA = WS_G + 272 * MiB;
constexpr size_t WS_RQK = WS_XBCA + 68 * MiB;
constexpr size_t WS_YS = WS_RQK + 34 * MiB;
constexpr size_t WS_YB = WS_YS + 136 * MiB;
constexpr size_t WS_POOLED = WS_YB + 136 * MiB;
constexpr size_t WS_MERGED = WS_POOLED + 34 * MiB;
constexpr size_t WS_MRG32 = WS_XBCA;
constexpr size_t WS_ACT = WS_XBCA;
constexpr size_t WS_END = WS_MERGED + 68 * MiB;
static_assert(WS_UP + (size_t)M * UPC * 2 <= WS_XBCA, "UP overlay");
static_assert(WS_DTA + 4 * MiB <= WS_PART && WS_PART + 32 * MiB <= WS_XBCA, "PART");
static_assert(WS_UP + (size_t)M * UPC * 2 <= WS_CUMA && WS_DTA + 4 * MiB <= WS_XBCA && (size_t)2 * 16 * M * 4 <= 4 * MiB, "cum/dt arrays");
static_assert(WS_ACT + (size_t)M * DFF * 2 <= WS_YB, "ACT overlay");
static_assert(WS_MRG32 + (size_t)M * D * 4 <= WS_YS + 34 * MiB, "MRG32 overlay");
static_assert(WS_ROPE + 8192 <= WS_X, "mod/rope");
__host__ __device__ __forceinline__ size_t yb_off(int row, int col) { return (size_t)(row >> 8) * (256 * 1024) + (size_t)(col >> 6) * (256 * 64) + (size_t)((row & 255) * 64 + (col & 63)); }
constexpr size_t YS_STRIDE = (size_t)M * 1024;

constexpr int CW_TMO = 0, CW_CODE = 1, CW_BAR = 4096, CW_Q = 16384, CW_FIN = 20480;

constexpr int RING_OFF = 0, RING_BYTES = 131072;
constexpr int LDSCTL_OFF = RING_BYTES, MISC_OFF = LDSCTL_OFF + 320;
constexpr int LDS_BYTES = 147456;

#define GAS __attribute__((address_space(1)))
#define LAS __attribute__((address_space(3)))
typedef unsigned short bf16;
typedef unsigned v4u __attribute__((ext_vector_type(4)));
typedef unsigned v2u __attribute__((ext_vector_type(2)));
typedef float f32x4 __attribute__((ext_vector_type(4)));
typedef float f32x16 __attribute__((ext_vector_type(16)));
typedef short bf16x8 __attribute__((ext_vector_type(8)));
typedef GAS unsigned gu32;
#define RLX_AGENT __ATOMIC_RELAXED, __HIP_MEMORY_SCOPE_AGENT
#define LDS_WAIT() asm volatile("s_waitcnt lgkmcnt(0)" ::: "memory")
#define VM_WAIT() asm volatile("s_waitcnt vmcnt(0)" ::: "memory")
__device__ __forceinline__ unsigned f2bf(float f) { return (unsigned)__builtin_bit_cast(unsigned short, (__bf16)f); }
__device__ __forceinline__ unsigned pk2(float lo, float hi) { return pg8::cvt_pk_bf16(lo, hi); }
__device__ __forceinline__ float bflo(unsigned w) { return __builtin_bit_cast(float, w << 16); }
__device__ __forceinline__ float bfhi(unsigned w) { return __builtin_bit_cast(float, w & 0xffff0000u); }
__device__ __forceinline__ float bf1(unsigned short b) { return __builtin_bit_cast(float, (unsigned)b << 16); }
__device__ __forceinline__ void unpack8(const v4u w, float (&f)[8]) { f[0] = bflo(w.x); f[1] = bfhi(w.x); f[2] = bflo(w.y); f[3] = bfhi(w.y); f[4] = bflo(w.z); f[5] = bfhi(w.z); f[6] = bflo(w.w); f[7] = bfhi(w.w); }
__device__ __forceinline__ v4u pack8(const float (&f)[8]) { v4u w; w.x = pk2(f[0], f[1]); w.y = pk2(f[2], f[3]); w.z = pk2(f[4], f[5]); w.w = pk2(f[6], f[7]); return w; }
__device__ __forceinline__ f32x4 unpack4(const v2u w) { return (f32x4){bflo(w.x), bfhi(w.x), bflo(w.y), bfhi(w.y)}; }
__device__ __forceinline__ v2u pack4(const f32x4 v) { v2u o; o.x = pk2(v.x, v.y); o.y = pk2(v.z, v.w); return o; }
__device__ __forceinline__ float sigmoidf_(float x) { return __builtin_amdgcn_rcpf(1.0f + __expf(-x)); }
__device__ __forceinline__ float siluf_(float x) { return x * sigmoidf_(x); }
__device__ __forceinline__ float softplusf_(float x) { return fmaxf(x, 0.f) + log1pf(expf(-fabsf(x))); }
template <int CTRL> __device__ __forceinline__ float dppf(float v) { return __builtin_bit_cast(float, __builtin_amdgcn_update_dpp(0, __builtin_bit_cast(int, v), CTRL, 0xf, 0xf, true)); }
__device__ __forceinline__ float red8(float v) { v += dppf<0xB1>(v); v += dppf<0x4E>(v); v += dppf<0x141>(v); return v; }
__device__ __forceinline__ float wave_sum(float v) {
    v = red8(v); v += dppf<0x140>(v);
    v += __builtin_bit_cast(float, __builtin_amdgcn_ds_swizzle(__builtin_bit_cast(int, v), 0x401F));
    return __builtin_bit_cast(float, __builtin_amdgcn_readlane(__builtin_bit_cast(int, v), 0)) + __builtin_bit_cast(float, __builtin_amdgcn_readlane(__builtin_bit_cast(int, v), 32));
}

#define XB_TMO      128
#define XB_XCNT(j)  (256  + 64 * (j))
#define XB_XSUB(j)  (1280 + 64 * (j))
#define XB_XGEN(j)  (2304 + 64 * (j))
#define XB_TOP      3328
#define XB_TOPGEN   3392
#define XCD_BAR_WORDS 3456
#define XB_SPIN_CAP (1u << 18)
__device__ __forceinline__ unsigned xb_ld(unsigned* p)              { return __hip_atomic_load(p, __ATOMIC_RELAXED, __HIP_MEMORY_SCOPE_AGENT); }
__device__ __forceinline__ unsigned xb_add(unsigned* p, unsigned v) { return __hip_atomic_fetch_add(p, v, __ATOMIC_RELAXED, __HIP_MEMORY_SCOPE_AGENT); }
__device__ __forceinline__ unsigned xb_xcc_id() { return (unsigned)__builtin_amdgcn_s_getreg((3 << 11) | 20) & 0xFu; }
#define XB_SPIN(cond, bar) do { unsigned _sp = 0; while (cond) { __builtin_amdgcn_s_sleep(1); \
    if ((++_sp & 255u) == 0u) { if (xb_ld(&(bar)[XB_TMO])) break; if (_sp > XB_SPIN_CAP) { atomicAdd(&(bar)[XB_TMO], 1u); break; } } } } while (0)
struct XcdBarrier { unsigned* bar; unsigned x; volatile LAS unsigned* st; };
__device__ __forceinline__ XcdBarrier xcd_barrier_post(unsigned* bar, volatile LAS unsigned* st) {
    XcdBarrier b; b.bar = bar; b.x = xb_xcc_id(); b.st = st;
    if (threadIdx.x == 0) (void)xb_add(&bar[XB_XCNT(b.x)], 1u);
    return b;
}
__device__ __forceinline__ void xcd_barrier_complete(unsigned* bar, unsigned x, unsigned& nloc, unsigned& nx) {
    const unsigned G = gridDim.x * gridDim.y * gridDim.z;
    unsigned sum, cnt, mine, sp = 0u;
    for (;;) {
        sum = 0u; cnt = 0u; mine = 0u;
#pragma unroll
        for (unsigned j = 0; j < 16; ++j) { const unsigned c = xb_ld(&bar[XB_XCNT(j)]); sum += c; cnt += (c > 0u) ? 1u : 0u; mine = (j == x) ? c : mine; }
        if (sum == G) break;
        __builtin_amdgcn_s_sleep(1);
        if ((++sp & 255u) == 0u) { if (xb_ld(&bar[XB_TMO])) break; if (sp > XB_SPIN_CAP) { atomicAdd(&bar[XB_TMO], 1u); break; } }
    }
    nloc = mine > 0u ? mine : 1u; nx = cnt > 0u ? cnt : 1u;
}
__device__ __forceinline__ void xcd_barrier(const XcdBarrier& b) {
    asm volatile("s_waitcnt vmcnt(0)" ::: "memory");
    __syncthreads();
    if (threadIdx.x == 0) {
        unsigned* bar = b.bar;
        __builtin_amdgcn_s_waitcnt(0);
        unsigned nloc = b.st[0], nx = b.st[1];
        if (nloc == 0u) { xcd_barrier_complete(bar, b.x, nloc, nx); b.st[0] = nloc; b.st[1] = nx; }
        const unsigned old = xb_add(&bar[XB_XSUB(b.x)], 1u);
        const unsigned gen = old / nloc;
        if (old + 1u == (gen + 1u) * nloc) {
            __builtin_amdgcn_fence(__ATOMIC_RELEASE, "agent");
            asm volatile("s_waitcnt vmcnt(0)" ::: "memory");
            const unsigned og = xb_add(&bar[XB_TOP], 1u);
            const unsigned tg = og / nx;
            if (og + 1u == (tg + 1u) * nx) xb_add(&bar[XB_TOPGEN], 1u);
            else XB_SPIN(xb_ld(&bar[XB_TOPGEN]) == tg, bar);
            __builtin_amdgcn_fence(__ATOMIC_ACQUIRE, "agent");
            xb_add(&bar[XB_XGEN(b.x)], 1u);
            asm volatile("s_waitcnt vmcnt(0)" ::: "memory");
        } else {
            XB_SPIN(xb_ld(&bar[XB_XGEN(b.x)]) == gen, bar);
            __builtin_amdgcn_fence(__ATOMIC_ACQUIRE, "agent");
            asm volatile("s_waitcnt vmcnt(0)" ::: "memory");
        }
    }
    __syncthreads();
}

struct Args {
    const float* in[28];
    float* out; unsigned char* ws;
    int ph_lo, ph_hi, variant, pad;
};
struct Frame {
    LAS unsigned char* lds;
    int tid, lane, wave, G, bid, variant;
    unsigned char* ws;
    const float* const* in;
};
__device__ __forceinline__ void frame_refresh(Frame& F) {
    int t = threadIdx.x; asm volatile("" : "+v"(t)); F.tid = t; F.lane = t & 63; F.wave = __builtin_amdgcn_readfirstlane(t >> 6);
    int b = blockIdx.x; asm volatile("" : "+s"(b)); F.bid = b;
}
enum { I_X = 0, I_C, I_CTX, I_CCTX, I_WMOD, I_BMOD, I_NORM1, I_WIN, I_SSDCW, I_SSDCB, I_SSDALOG, I_SSDDTB, I_SSDD, I_SSDNW, I_POOLW, I_POOLS, I_SCONVW, I_RETDL,
       I_WBR, I_WGATE, I_BGATE, I_WO, I_NORM2, I_FFNUP, I_FFNCW, I_FFNCB, I_FFNDN, I_FNW };

__device__ __forceinline__ void seq_bounds(int row, int& s0, int& s1) {
    if (row < ML) { s0 = row & ~(SEQ - 1); s1 = s0 + SEQ; } else { s0 = ML + ((row - ML) & ~(CTX - 1)); s1 = s0 + CTX; }
}
__device__ __forceinline__ int mod_vec(int row) { return row < ML ? (row >> 12) : 4; }

__device__ __forceinline__ void phase_mod(Frame& F) {
    frame_refresh(F);
    LAS float* sv = (LAS float*)(F.lds);
    LAS float* red = (LAS float*)(F.lds + 5 * 2048 * 4);
    const float* c = F.in[I_C]; const float* cc = F.in[I_CCTX];
    for (int i = F.tid; i < 5 * 2048; i += 512) { const int v = i >> 11, k = i & 2047; const float x = v < 4 ? c[v * 2048 + k] : cc[k]; sv[i] = siluf_(x); }
    __syncthreads();
    float* MOD = (float*)(F.ws + WS_MOD);
    for (int it = F.bid; it < DEPTH * 48; it += F.G) {
        const int l = it / 48, jb = it % 48;
        const float* W = F.in[I_WMOD] + (size_t)l * 2048 * 12288 + jb * 256 + 4 * F.lane;
        float a[5][4];
#pragma unroll
        for (int v = 0; v < 5; ++v) { a[v][0] = a[v][1] = a[v][2] = a[v][3] = 0.f; }
        const int k0 = F.wave * 256;
#pragma unroll 4
        for (int k = 0; k < 256; ++k) {
            const f32x4 w = *(const f32x4*)(W + (size_t)(k0 + k) * 12288);
#pragma unroll
            for (int v = 0; v < 5; ++v) { const float s = sv[v * 2048 + k0 + k]; a[v][0] += s * w.x; a[v][1] += s * w.y; a[v][2] += s * w.z; a[v][3] += s * w.w; }
        }
#pragma unroll
        for (int v = 0; v < 5; ++v) *(LAS f32x4*)(red + (F.wave * 5 + v) * 256 + 4 * F.lane) = (f32x4){a[v][0], a[v][1], a[v][2], a[v][3]};
        __syncthreads();
        for (int i = F.tid; i < 5 * 256; i += 512) { const int v = i >> 8, j = i & 255; float s = 0.f;
#pragma unroll
            for (int w = 0; w < 8; ++w) s += red[(w * 5 + v) * 256 + j];
            MOD[((size_t)l * 5 + v) * 12288 + jb * 256 + j] = s + F.in[I_BMOD][l * 12288 + jb * 256 + j]; }
        __syncthreads();
    }
    if (F.bid == F.G - 1) {
        float* R = (float*)(F.ws + WS_ROPE);
        for (int i = F.tid; i < 1024; i += 512) { const int pos = i >> 4, m = i & 15; const float inv = powf(10000.0f, -(float)m / 16.0f); const float ang = (float)pos * inv; R[2 * i] = cosf(ang); R[2 * i + 1] = sinf(ang); }
    }
}

template <class RowMap>
__device__ __forceinline__ void transpose_item(const float* W, int K, int N, bf16* WT, const RowMap& rm, LAS float* scr, int item, int lane) {
    const int nblk = (N + 31) / 32, kb = item / nblk, nb = item % nblk, k0 = 64 * kb, n0 = 32 * nb;
    const int ncl = min(n0 + (lane & 31), N - 1);
    const float* src = W + (size_t)(k0 + (lane >> 5)) * N + ncl;
    float t[32];
#pragma unroll
    for (int i = 0; i < 32; ++i) t[i] = src[(size_t)(2 * i) * N];
    __builtin_amdgcn_sched_barrier(0);
#pragma unroll
    for (int i = 0; i < 32; ++i) scr[(2 * i + (lane >> 5)) * 33 + (lane & 31)] = t[i];
    LDS_WAIT(); asm volatile("" ::: "memory");
    const int c = lane & 7;
#pragma unroll
    for (int j = 0; j < 4; ++j) { const int n = (lane >> 3) + 8 * j; const LAS float* s = scr + (8 * c) * 33 + n;
        v4u o; o.x = pk2(s[0 * 33], s[1 * 33]); o.y = pk2(s[2 * 33], s[3 * 33]); o.z = pk2(s[4 * 33], s[5 * 33]); o.w = pk2(s[6 * 33], s[7 * 33]);
        if (n0 + n < N) *(GAS v4u*)(WT + (size_t)rm(n0 + n) * K + k0 + 8 * c) = o; }
    LDS_WAIT(); asm volatile("" ::: "memory");
}
struct RowId { int off; __device__ __forceinline__ int operator()(int n) const { return n + off; } };
struct RowUp { __device__ __forceinline__ int operator()(int n) const { const int h = n >= DFF ? 1 : 0, c = n - h * DFF; return (c >> 7) * 256 + h * 128 + (c & 127); } };
struct RowWin { __device__ __forceinline__ int operator()(int n) const { return n < 3072 ? n : (n < 3088 ? 10240 + (n - 3072) : n - 16); } };

constexpr int CI_IN = 32 * 321, CI_G1 = 32 * 64, CI_B1 = 16 * 64, CI_O = 32 * 64, CI_UP = 32 * 352, CI_DN = 88 * 64, CI_P1 = 4 * 8, CI_Z = 30;
constexpr int NITW = CI_IN + 4 * CI_G1 + 4 * CI_B1 + CI_O + CI_UP + CI_DN + 4 * CI_P1 + CI_Z;
__device__ __forceinline__ void convert_item(Frame& F, int l, int it, LAS float* scr, int lane) {
    unsigned char* wb = F.ws + (size_t)(l & 1) * W_SPAN;
    bf16* WIG = (bf16*)(wb + WS_WIG); bf16* WB = (bf16*)(wb + WS_WB); bf16* WO = (bf16*)(wb + WS_WO);
    bf16* WUP = (bf16*)(wb + WS_WUP); bf16* WDN = (bf16*)(wb + WS_WDN); bf16* WPOOL = (bf16*)(wb + WS_WPOOL);
    int r = it;
    if (r < CI_IN) { transpose_item(F.in[I_WIN] + (size_t)l * 2048 * IN_COLS, 2048, IN_COLS, WIG, RowWin{}, scr, r, lane); return; } r -= CI_IN;
    if (r < 4 * CI_G1) { const int i = r / CI_G1; transpose_item(F.in[I_WGATE] + ((size_t)l * 4 + i) * 2048 * 2048, 2048, 2048, WIG, RowId{10496 + i * 2048}, scr, r % CI_G1, lane); return; } r -= 4 * CI_G1;
    if (r < 4 * CI_B1) { const int i = r / CI_B1; transpose_item(F.in[I_WBR] + ((size_t)l * 4 + i) * 1024 * 2048, 1024, 2048, WB + (size_t)i * 2048 * 1024, RowId{0}, scr, r % CI_B1, lane); return; } r -= 4 * CI_B1;
    if (r < CI_O) { transpose_item(F.in[I_WO] + (size_t)l * 2048 * 2048, 2048, 2048, WO, RowId{0}, scr, r, lane); return; } r -= CI_O;
    if (r < CI_UP) { transpose_item(F.in[I_FFNUP] + (size_t)l * 2048 * UPC, 2048, UPC, WUP, RowUp{}, scr, r, lane); return; } r -= CI_UP;
    if (r < CI_DN) { transpose_item(F.in[I_FFNDN] + (size_t)l * DFF * 2048, DFF, 2048, WDN, RowId{0}, scr, r, lane); return; } r -= CI_DN;
    if (r < 4 * CI_P1) { const int g = r / CI_P1; transpose_item(F.in[I_POOLW] + ((size_t)l * 4 + g) * 256 * 256, 256, 256, WPOOL + (size_t)g * 256 * 256, RowId{0}, scr, r % CI_P1, lane); return; } r -= 4 * CI_P1;
    {
        unsigned char* base = (unsigned char*)WIG + (size_t)(10256 + 8 * r) * 2048 * 2;
#pragma unroll 4
        for (int k = 0; k < 32; ++k) *(GAS v4u*)(base + (size_t)(k * 64 + lane) * 16) = (v4u){0u, 0u, 0u, 0u};
    }
}
__device__ __forceinline__ void steal_convert(Frame& F, int l, int finidx, bool drain) {
    frame_refresh(F);
    gu32* q = (gu32*)(F.ws + WS_CTL) + CW_Q + 64 * l;
    gu32* fin = (gu32*)(F.ws + WS_CTL) + CW_FIN + 64 * finidx;
    volatile LAS unsigned* box = (volatile LAS unsigned*)(F.lds + MISC_OFF);
    LAS float* scr = (LAS float*)(F.lds + F.wave * 16384);
    unsigned finv = 0;
    if (F.tid == 0 && !drain) finv = __hip_atomic_fetch_add(fin, 1u, RLX_AGENT) + 1u;
    for (;;) {
        if (F.tid == 0) { unsigned v = 0xffffffffu;
            if (drain || finv < (unsigned)F.G) { v = __hip_atomic_fetch_add(q, 1u, RLX_AGENT); if (!drain) finv = __hip_atomic_load(fin, RLX_AGENT); }
            box[0] = v; }
        __syncthreads();
        const unsigned got = box[0];
        __syncthreads();
        if (got == 0xffffffffu) break;
        const int base = (int)got * 8;
        if (base >= NITW) break;
        { const int wi = base + F.wave; if (wi < NITW) convert_item(F, l, wi, scr, F.lane); }
    }
}

#define NC(j) (512 * ((j) >> 1) + 8 * F.lane + 4 * ((j) & 1))
__device__ __forceinline__ v4u join8(const v2u a, const v2u b) { v4u w; w.x = a.x; w.y = a.y; w.z = b.x; w.w = b.y; return w; }
template <bool FIRST>
__device__ __forceinline__ void phase_norm(Frame& F, int l, const float* nw, int sh_off, int sc_off, int nrows, bool addpart = false) {
    frame_refresh(F);
    bf16* X = (bf16*)(F.ws + WS_X); bf16* H = (bf16*)(F.ws + WS_H); const float* MOD = (const float*)(F.ws + WS_MOD);
    const int gw = F.bid * NWAVES + F.wave, NGW = F.G * NWAVES;
    for (int row = gw; row < nrows; row += NGW) {
        const float* src = row < ML ? F.in[I_X] + (size_t)row * D : F.in[I_CTX] + (size_t)(row - ML) * D;
        f32x4 v[8]; float ss = 0.f;
#pragma unroll
        for (int k = 0; k < 4; ++k) {
            if (FIRST) { v[2 * k] = *(const f32x4*)(src + NC(2 * k)); v[2 * k + 1] = *(const f32x4*)(src + NC(2 * k + 1)); }
            else { const v4u w = *(const v4u*)(X + (size_t)row * D + NC(2 * k)); v2u lo, hi; lo.x = w.x; lo.y = w.y; hi.x = w.z; hi.y = w.w; v[2 * k] = unpack4(lo); v[2 * k + 1] = unpack4(hi); }
        }
#pragma unroll
        for (int j = 0; j < 8; ++j) ss += (v[j].x * v[j].x + v[j].y * v[j].y) + (v[j].z * v[j].z + v[j].w * v[j].w);
        if (FIRST) {
#pragma unroll
            for (int k = 0; k < 4; ++k) *(v4u*)(X + (size_t)row * D + NC(2 * k)) = join8(pack4(v[2 * k]), pack4(v[2 * k + 1]));
        }
        if (!FIRST && addpart && row >= ML) {
            const float* P = (const float*)(F.ws + WS_PART) + (size_t)(row - ML) * D;
            ss = 0.f;
#pragma unroll
            for (int j = 0; j < 8; ++j) {
#pragma unroll
                for (int sp = 0; sp < 4; ++sp) v[j] += *(const f32x4*)(P + (size_t)sp * MC * D + NC(j));
                ss += (v[j].x * v[j].x + v[j].y * v[j].y) + (v[j].z * v[j].z + v[j].w * v[j].w);
            }
#pragma unroll
            for (int k = 0; k < 4; ++k) *(v4u*)(X + (size_t)row * D + NC(2 * k)) = join8(pack4(v[2 * k]), pack4(v[2 * k + 1]));
        }
        const float rs = rsqrtf(wave_sum(ss) * (1.0f / D) + EPS);
        const float* mv = MOD + ((size_t)l * 5 + mod_vec(row)) * 12288;
#pragma unroll
        for (int k = 0; k < 4; ++k) {
            v2u o[2];
#pragma unroll
            for (int t = 0; t < 2; ++t) { const int j = 2 * k + t, c = NC(j);
                const f32x4 w = *(const f32x4*)(nw + c), sh = *(const f32x4*)(mv + sh_off + c), sc = *(const f32x4*)(mv + sc_off + c);
                const f32x4 y = v[j] * rs * w; const f32x4 h = y * (sc + 1.0f) + sh;
                o[t].x = pk2(h.x, h.y); o[t].y = pk2(h.z, h.w); }
            *(v4u*)(H + (size_t)row * D + NC(2 * k)) = join8(o[0], o[1]);
        }
    }
}
__device__ __forceinline__ void phase_final(Frame& F, float* out) {
    frame_refresh(F);
    const bf16* X = (const bf16*)(F.ws + WS_X); const float* nw = F.in[I_FNW];
    const int gw = F.bid * NWAVES + F.wave, NGW = F.G * NWAVES;
    for (int row = gw; row < ML; row += NGW) {
        f32x4 v[8]; float ss = 0.f;
#pragma unroll
        for (int k = 0; k < 4; ++k) { const v4u w = *(const v4u*)(X + (size_t)row * D + NC(2 * k)); v2u lo, hi; lo.x = w.x; lo.y = w.y; hi.x = w.z; hi.y = w.w; v[2 * k] = unpack4(lo); v[2 * k + 1] = unpack4(hi); }
#pragma unroll
        for (int j = 0; j < 8; ++j) ss += (v[j].x * v[j].x + v[j].y * v[j].y) + (v[j].z * v[j].z + v[j].w * v[j].w);
        const float rs = rsqrtf(wave_sum(ss) * (1.0f / D) + EPS);
#pragma unroll
        for (int j = 0; j < 8; ++j) { const int c = NC(j); *(f32x4*)(out + (size_t)row * D + c) = v[j] * rs * *(const f32x4*)(nw + c); }
    }
}
#undef NC

__device__ __forceinline__ v4u ldrow(const bf16* base, int row, int ld, int col, bool ok) { return ok ? *(const v4u*)(base + (size_t)row * ld + col) : (v4u){0u, 0u, 0u, 0u}; }
__device__ __forceinline__ void ld8f(const float* p, float (&f)[8]) { const f32x4 a = *(const f32x4*)p, b = *(const f32x4*)(p + 4); f[0] = a.x; f[1] = a.y; f[2] = a.z; f[3] = a.w; f[4] = b.x; f[5] = b.y; f[6] = b.z; f[7] = b.w; }

__device__ __forceinline__ void sc_task(Frame& F, int l, int r, int lane) {
    const bf16* U = (const bf16*)(F.ws + WS_U); bf16* YB2 = (bf16*)(F.ws + WS_YB) + 2 * YS_STRIDE;
            const int rb = r >> 1, cb = r & 1, c = cb * 512 + lane * 8, r0 = rb * 32; int s0, s1; seq_bounds(r0, s0, s1);
            float w0[8], w1[8], w2[8];
            ld8f(F.in[I_SCONVW] + ((size_t)l * 3 + 0) * 1024 + c, w0); ld8f(F.in[I_SCONVW] + ((size_t)l * 3 + 1) * 1024 + c, w1); ld8f(F.in[I_SCONVW] + ((size_t)l * 3 + 2) * 1024 + c, w2);
            for (int r4 = r0; r4 < r0 + 32; r4 += 4) {
                v4u bc[6], bx[6], bg[4];
#pragma unroll
                for (int k = 0; k < 6; ++k) { const int s = r4 - 1 + k; const bool ok = s >= s0 && s < s1; bc[k] = ldrow(U, s, UC, U_SCC + c, ok); bx[k] = ldrow(U, s, UC, U_SCX + c, ok); }
#pragma unroll
                for (int k = 0; k < 4; ++k) bg[k] = ldrow(U, r4 + k, UC, U_SCB + c, true);
                float pr[6][8];
#pragma unroll
                for (int k = 0; k < 6; ++k) { float a[8], b[8]; unpack8(bc[k], a); unpack8(bx[k], b);
#pragma unroll
                    for (int e = 0; e < 8; ++e) pr[k][e] = a[e] * b[e]; }
#pragma unroll
                for (int j = 0; j < 4; ++j) { float g[8], o[8]; unpack8(bg[j], g);
#pragma unroll
                    for (int e = 0; e < 8; ++e) o[e] = g[e] * (w0[e] * pr[j][e] + w1[e] * pr[j + 1][e] + w2[e] * pr[j + 2][e]);
                    *(v4u*)(YB2 + yb_off(r4 + j, c)) = pack8(o); }
            }
}
__device__ __forceinline__ void sc_phase(Frame& F, int l, int c, int Gs) {
    frame_refresh(F);
    const int gw = c * NWAVES + F.wave, NGW = Gs * NWAVES;
    for (int task = gw; task < (M / 32) * 2; task += NGW) sc_task(F, l, task, F.lane);
}
template <int HMAX>
__device__ __forceinline__ void pool_task(const bf16* U, bf16* POOLED, int r0, int s0, int s1, int c, int half) {
    constexpr int NR = 8 + 2 * HMAX - 1, HA = HMAX / 2;
    const bool big = (half == HMAX);
    for (int r8 = r0; r8 < r0 + 32; r8 += 8) {
        v4u buf[NR];
#pragma unroll
        for (int k = 0; k < NR; ++k) { const int s = r8 - HMAX + k; buf[k] = ldrow(U, s, UC, U_POOL + c, s >= s0 && s < s1); }
        float sa[8], sb[8];
#pragma unroll
        for (int e = 0; e < 8; ++e) { sa[e] = 0.f; sb[e] = 0.f; }
#pragma unroll
        for (int k = 0; k < 2 * HMAX; ++k) { float t[8]; unpack8(buf[k], t);
#pragma unroll
            for (int e = 0; e < 8; ++e) { sb[e] += t[e]; if (k >= HA && k < HMAX + HA) sa[e] += t[e]; } }
#pragma unroll
        for (int j = 0; j < 8; ++j) {
            const int rr = r8 + j; int lo = rr - half, hi = rr + half; lo = lo < s0 ? s0 : lo; hi = hi > s1 ? s1 : hi;
            float x[8], o[8]; unpack8(buf[j + HMAX], x); const float inv = 1.0f / (float)(hi - lo);
#pragma unroll
            for (int e = 0; e < 8; ++e) o[e] = (big ? sb[e] : sa[e]) * inv - x[e];
            *(v4u*)(POOLED + (size_t)rr * 1024 + c) = pack8(o);
            if (j < 7) {
                float tin[8], tout[8];
                unpack8(buf[j + 2 * HMAX], tin); unpack8(buf[j], tout);
#pragma unroll
                for (int e = 0; e < 8; ++e) sb[e] += tin[e] - tout[e];
                unpack8(buf[j + HMAX + HA], tin); unpack8(buf[j + HA], tout);
#pragma unroll
                for (int e = 0; e < 8; ++e) sa[e] += tin[e] - tout[e];
            }
        }
    }
}
__device__ __forceinline__ void phase_pre(Frame& F, int l) {
    frame_refresh(F);
    const bf16* U = (const bf16*)(F.ws + WS_U);
    bf16* XBCA = (bf16*)(F.ws + WS_XBCA); bf16* RQK = (bf16*)(F.ws + WS_RQK); bf16* YB2 = (bf16*)(F.ws + WS_YB) + 2 * YS_STRIDE; bf16* POOLED = (bf16*)(F.ws + WS_POOLED);
    const float* ROPE = (const float*)(F.ws + WS_ROPE);
    LAS float* ropeL = (LAS float*)F.lds;
    for (int i = F.tid; i < 2048; i += NWAVES * 64) ropeL[i] = ROPE[i];
    __syncthreads();
    const int gw = F.bid * NWAVES + F.wave, NGW = F.G * NWAVES, lane = F.lane;
    constexpr int NRB = M / 32;
    constexpr int T_CUM = (M / 64) * 2, T_XBC = NRB * 4, T_POOL = NRB * 2, T_ROPE = NRB;
    float* CUMA = (float*)(F.ws + WS_CUMA); float* DTA = (float*)(F.ws + WS_DTA); const float* DT = (const float*)(F.ws + WS_DT);
    for (int task = gw; task < T_CUM + T_XBC + T_POOL + T_ROPE; task += NGW) {
        int r = task;
        if (r < T_CUM) {
            const int blk = r >> 1, dir = r & 1, row = blk * 64 + (dir ? 63 - lane : lane);
            for (int hh = 0; hh < 16; ++hh) {
                const float dt = softplusf_(DT[(size_t)row * 16 + hh] + F.in[I_SSDDTB][(l * 2 + dir) * 16 + hh]);
                float cum = dt * -expf(F.in[I_SSDALOG][(l * 2 + dir) * 16 + hh]);
#pragma unroll
                for (int o = 1; o < 64; o <<= 1) { const float t = __shfl_up(cum, o); if (lane >= o) cum += t; }
                CUMA[(size_t)(dir * 16 + hh) * M + row] = cum; DTA[(size_t)(dir * 16 + hh) * M + row] = dt;
            }
            continue;
        }
        r -= T_CUM;
        if (r < T_XBC) {
            const int rb = r >> 2, cb = r & 3, c = cb * 512 + lane * 8, r0 = rb * 32; int s0, s1; seq_bounds(r0, s0, s1);
            float w0[8], w1[8], w2[8], bb[8];
            ld8f(F.in[I_SSDCW] + ((size_t)l * 3 + 0) * 2048 + c, w0); ld8f(F.in[I_SSDCW] + ((size_t)l * 3 + 1) * 2048 + c, w1); ld8f(F.in[I_SSDCW] + ((size_t)l * 3 + 2) * 2048 + c, w2); ld8f(F.in[I_SSDCB] + (size_t)l * 2048 + c, bb);
            v4u bufA[10], bufB[10];
#define XBC_LOAD(buf, r8_) do { _Pragma("unroll") for (int k = 0; k < 10; ++k) { const int s = (r8_) - 1 + k; buf[k] = ldrow(U, s, UC, U_XBC + c, s >= s0 && s < s1); } } while (0)
#define XBC_COMP(buf, r8_) do { _Pragma("unroll") for (int j = 0; j < 8; ++j) { \
                    float p[8], q[8], n[8], o[8]; unpack8(buf[j], p); unpack8(buf[j + 1], q); unpack8(buf[j + 2], n); \
                    _Pragma("unroll") for (int e = 0; e < 8; ++e) o[e] = siluf_(w0[e] * p[e] + w1[e] * q[e] + w2[e] * n[e] + bb[e]); \
                    *(v4u*)(XBCA + (size_t)((r8_) + j) * 2048 + c) = pack8(o); } } while (0)
            XBC_LOAD(bufA, r0);
            XBC_LOAD(bufB, r0 + 8);  XBC_COMP(bufA, r0);
            XBC_LOAD(bufA, r0 + 16); XBC_COMP(bufB, r0 + 8);
            XBC_LOAD(bufB, r0 + 24); XBC_COMP(bufA, r0 + 16);
            XBC_COMP(bufB, r0 + 24);
#undef XBC_LOAD
#undef XBC_COMP
            continue;
        }
        r -= T_XBC;
        if (r < T_POOL) {
            const int rb = r >> 1, cb = r & 1, c = cb * 512 + lane * 8, r0 = rb * 32; int s0, s1; seq_bounds(r0, s0, s1);
            const int grp = c >> 8, half = 1 << grp;
            if (cb == 0) pool_task<2>(U, POOLED, r0, s0, s1, c, half); else pool_task<8>(U, POOLED, r0, s0, s1, c, half);
            continue;
        }
        r -= T_POOL;
        {
            const int r0 = r * 32; int s0, s1; seq_bounds(r0, s0, s1);
            const int qk = lane >> 5, rem = lane & 31, head = rem >> 2, part = (rem >> 1) & 1, sub = rem & 1;
            const int c1 = head * 64 + part * 32 + sub * 8, c2 = c1 + 16; const float scl = qk == 0 ? 0.125f : 1.0f;
            const int ucol = (qk == 0 ? U_RQ : U_RK);
            for (int r8 = r0; r8 < r0 + 32; r8 += 8) {
                v4u b1[8], b2[8];
#pragma unroll
                for (int k = 0; k < 8; ++k) { b1[k] = ldrow(U, r8 + k, UC, ucol + c1, true); b2[k] = ldrow(U, r8 + k, UC, ucol + c2, true); }
#pragma unroll
                for (int k = 0; k < 8; ++k) {
                    const int rr = r8 + k; float x1[8], x2[8], o1[8], o2[8]; unpack8(b1[k], x1); unpack8(b2[k], x2);
                    if (rr < ML) {
                        const int t = rr - s0, pos = part == 0 ? (t >> 6) : (t & 63);
                        const LAS float* rp = ropeL + (pos * 16 + sub * 8) * 2;
#pragma unroll
                        for (int e = 0; e < 8; ++e) { const float cs = rp[2 * e], sn = rp[2 * e + 1]; o1[e] = (x1[e] * cs - x2[e] * sn) * scl; o2[e] = (x1[e] * sn + x2[e] * cs) * scl; }
                    } else {
#pragma unroll
                        for (int e = 0; e < 8; ++e) { o1[e] = x1[e] * scl; o2[e] = x2[e] * scl; }
                    }
                    *(v4u*)(RQK + (size_t)rr * 1024 + qk * 512 + c1) = pack8(o1); *(v4u*)(RQK + (size_t)rr * 1024 + qk * 512 + c2) = pack8(o2);
                }
            }
        }
    }
}

#define MFMA32(a, b, c) __builtin_amdgcn_mfma_f32_32x32x16_bf16((a), (b), (c), 0, 0, 0)
#define SCAN_BAR() do { asm volatile("s_waitcnt lgkmcnt(0)" ::: "memory"); __builtin_amdgcn_s_barrier(); asm volatile("" ::: "memory"); } while (0)
typedef short s16x4 __attribute__((ext_vector_type(4)));
__device__ __forceinline__ bf16x8 tr_frag(LAS unsigned char* tile, int rs, int c, int ks, int lane) {
    const int h = lane >> 5, blk = (lane >> 4) & 1, q = (lane & 15) >> 2, p = lane & 3;
    LAS unsigned char* a0 = tile + (16 * ks + 8 * h + q) * rs + (32 * c + 16 * blk + 4 * p) * 2;
    const s16x4 lo = __builtin_amdgcn_ds_read_tr16_b64_v4i16((LAS s16x4*)a0);
    const s16x4 hi = __builtin_amdgcn_ds_read_tr16_b64_v4i16((LAS s16x4*)(a0 + 4 * rs));
    return __builtin_shufflevector(lo, hi, 0, 1, 2, 3, 4, 5, 6, 7);
}
template <int DN, int DP, bool SSD>
__device__ __forceinline__ void scan_unit(Frame& F, int l, int b, int h, int dir) {
    frame_refresh(F);
    constexpr int RSQ = (DN + 8) * 2, RSK2 = DN * 2 + 64, RSV = DP * 2 + 64, RSJ = 72 * 2;
    constexpr int O_Q = 0, O_K = O_Q + 64 * RSQ, O_K2 = O_K + 64 * RSQ, O_V = O_K2 + 64 * RSK2, O_VW = O_V + 64 * RSV, O_S = O_VW + 64 * RSV, O_HST = O_S + 64 * RSJ, O_CUM = O_HST + DP * RSQ, O_END = O_CUM + 256;
    static_assert(O_END <= RING_BYTES, "scan LDS");
    LAS unsigned char* lds = F.lds;
    const int tid = F.tid, lane = F.lane, w = F.wave, r = lane & 31, hh = lane >> 5;
    const bf16* XBCA = (const bf16*)(F.ws + WS_XBCA); const bf16* RQK = (const bf16*)(F.ws + WS_RQK); const bf16* U = (const bf16*)(F.ws + WS_U);
    const float* CUMA = (const float*)(F.ws + WS_CUMA) + (size_t)(dir * 16 + h) * M; const float* DTA = (const float*)(F.ws + WS_DTA) + (size_t)(dir * 16 + h) * M;
    bf16* YS = (bf16*)(F.ws + WS_YS) + (size_t)((SSD ? 0 : 2) + dir) * YS_STRIDE;
    const int ycol = SSD ? h * 64 : h * 128;
    float la_const = 0.f;
    if (!SSD) la_const = -softplusf_(-F.in[I_RETDL][(l * 2 + dir) * 8 + h]);
    for (int i = tid; i < DP * RSQ / 16; i += 512) *(LAS v4u*)(lds + O_HST + i * 16) = (v4u){0u, 0u, 0u, 0u};
    f32x16 Hs;
#pragma unroll
    for (int i = 0; i < 16; ++i) Hs[i] = 0.f;
    const int tok8 = tid >> 3, ch8 = tid & 7, tok16 = tid >> 4, ch16 = tid & 15;
    constexpr int NPF = 2;
    v4u preb[NPF][5]; float pcum[NPF], pdt[NPF], pcl[NPF], pcw[NPF];
#pragma unroll
    for (int u = 0; u < NPF; ++u) { pcum[u] = 0.f; pdt[u] = 1.f; pcl[u] = 0.f; pcw[u] = 0.f;
#pragma unroll
        for (int k = 0; k < 5; ++k) preb[u][k] = (v4u){0u, 0u, 0u, 0u}; }
    auto row_of = [&](int st, int i) -> int {
        int base, sub;
        if (st < 4) { base = ML + b * CTX; sub = dir ? 3 - st : st; } else { base = b * SEQ; sub = dir ? 67 - st : st - 4; }
        return base + sub * 64 + (dir ? 63 - i : i);
    };
#define SCAN_PREFETCH(st_, pre, u_) do { \
        const int rn_ = row_of((st_), tok8), rw0_ = row_of((st_), tok16), rw1_ = row_of((st_), 32 + tok16); \
        if (SSD) { const int g = h >> 2; \
            pre[0] = *(const v4u*)(XBCA + (size_t)rn_ * 2048 + h * 64 + 8 * ch8); \
            pre[1] = *(const v4u*)(XBCA + (size_t)rw0_ * 2048 + 1024 + g * 128 + 8 * ch16); pre[2] = *(const v4u*)(XBCA + (size_t)rw1_ * 2048 + 1024 + g * 128 + 8 * ch16); \
            pre[3] = *(const v4u*)(XBCA + (size_t)rw0_ * 2048 + 1536 + g * 128 + 8 * ch16); pre[4] = *(const v4u*)(XBCA + (size_t)rw1_ * 2048 + 1536 + g * 128 + 8 * ch16); \
            pcum[u_] = CUMA[rn_]; pdt[u_] = DTA[rn_]; pcl[u_] = CUMA[row_of((st_), 63)]; pcw[u_] = CUMA[row_of((st_), lane)]; \
        } else { \
            pre[0] = *(const v4u*)(RQK + (size_t)rn_ * 1024 + h * 64 + 8 * ch8); pre[1] = *(const v4u*)(RQK + (size_t)rn_ * 1024 + 512 + h * 64 + 8 * ch8); \
            pre[2] = *(const v4u*)(U + (size_t)rw0_ * UC + U_RV + h * 128 + 8 * ch16); pre[3] = *(const v4u*)(U + (size_t)rw1_ * UC + U_RV + h * 128 + 8 * ch16); \
        } } while (0)
#pragma unroll
    for (int u = 0; u < NPF; ++u) SCAN_PREFETCH(u, preb[u], u);
    for (int st2 = 0; st2 < 68; st2 += NPF) {
#pragma unroll
    for (int u = 0; u < NPF; ++u) {
        const int st = st2 + u;
        v4u (&pre)[5] = preb[u];
        float clast;
        if (SSD) {
            clast = pcl[u];
            const float dtx = pdt[u], wx = __expf(clast - pcum[u]);
            float x[8], v[8], vw[8]; unpack8(pre[0], x);
#pragma unroll
            for (int e = 0; e < 8; ++e) { v[e] = x[e] * dtx; vw[e] = v[e] * wx; }
            *(LAS v4u*)(lds + O_V + tok8 * RSV + 16 * ch8) = pack8(v); *(LAS v4u*)(lds + O_VW + tok8 * RSV + 16 * ch8) = pack8(vw);
            *(LAS v4u*)(lds + O_K + tok16 * RSQ + 16 * ch16) = pre[1]; *(LAS v4u*)(lds + O_K + (32 + tok16) * RSQ + 16 * ch16) = pre[2];
            *(LAS v4u*)(lds + O_K2 + tok16 * RSK2 + 16 * ch16) = pre[1]; *(LAS v4u*)(lds + O_K2 + (32 + tok16) * RSK2 + 16 * ch16) = pre[2];
            *(LAS v4u*)(lds + O_Q + tok16 * RSQ + 16 * ch16) = pre[3]; *(LAS v4u*)(lds + O_Q + (32 + tok16) * RSQ + 16 * ch16) = pre[4];
            if (w == 0) *(LAS float*)(lds + O_CUM + 4 * lane) = pcw[u];
        } else {
            clast = la_const * 64.f;
            *(LAS v4u*)(lds + O_Q + tok8 * RSQ + 16 * ch8) = pre[0];
            *(LAS v4u*)(lds + O_K + tok8 * RSQ + 16 * ch8) = pre[1]; *(LAS v4u*)(lds + O_K2 + tok8 * RSK2 + 16 * ch8) = pre[1];
            const float w0 = __expf(la_const * (float)(63 - tok16)), w1 = __expf(la_const * (float)(31 - tok16));
            float v0[8], v1[8], q0[8], q1[8]; unpack8(pre[2], v0); unpack8(pre[3], v1);
#pragma unroll
            for (int e = 0; e < 8; ++e) { q0[e] = v0[e] * w0; q1[e] = v1[e] * w1; }
            *(LAS v4u*)(lds + O_V + tok16 * RSV + 16 * ch16) = pre[2]; *(LAS v4u*)(lds + O_V + (32 + tok16) * RSV + 16 * ch16) = pre[3];
            *(LAS v4u*)(lds + O_VW + tok16 * RSV + 16 * ch16) = pack8(q0); *(LAS v4u*)(lds + O_VW + (32 + tok16) * RSV + 16 * ch16) = pack8(q1);
            if (w == 0) *(LAS float*)(lds + O_CUM + 4 * lane) = la_const * (float)(lane + 1);
        }
        SCAN_BAR();
        if (st + NPF < 68) SCAN_PREFETCH(st + NPF, pre, u);
        const float dcy = __expf(clast);
        if (w < 4) {
            const int jb = w >> 1, ib = w & 1;
            f32x16 acc;
#pragma unroll
            for (int i = 0; i < 16; ++i) acc[i] = 0.f;
            if (!(jb == 1 && ib == 0)) {
                bf16x8 fa[DN / 16], fq[DN / 16];
#pragma unroll
                for (int kk = 0; kk < DN / 16; ++kk) {
                    fa[kk] = *(const LAS bf16x8*)(lds + O_K + (jb * 32 + r) * RSQ + (kk * 16 + 8 * hh) * 2);
                    fq[kk] = *(const LAS bf16x8*)(lds + O_Q + (ib * 32 + r) * RSQ + (kk * 16 + 8 * hh) * 2);
                }
                __builtin_amdgcn_sched_barrier(0);
#pragma unroll
                for (int kk = 0; kk < DN / 16; ++kk) acc = MFMA32(fa[kk], fq[kk], acc);
            }
            const int i = ib * 32 + r; const float ci = *(const LAS float*)(lds + O_CUM + 4 * i);
#pragma unroll
            for (int g4 = 0; g4 < 4; ++g4) {
                const int j0 = jb * 32 + 8 * g4 + 4 * hh; const f32x4 cj = *(const LAS f32x4*)(lds + O_CUM + 4 * j0);
                float v[4];
#pragma unroll
                for (int e = 0; e < 4; ++e) { const float cje = e == 0 ? cj.x : (e == 1 ? cj.y : (e == 2 ? cj.z : cj.w)); v[e] = (j0 + e <= i) ? acc[4 * g4 + e] * __expf(ci - cje) : 0.f; }
                v2u o; o.x = pk2(v[0], v[1]); o.y = pk2(v[2], v[3]);
                *(LAS v2u*)(lds + O_S + i * RSJ + j0 * 2) = o;
            }
        }
        SCAN_BAR();
        for (int blk = w; blk < (DP / 32) * 2; blk += 8) {
            const int pb = blk >> 1, ib = blk & 1;
            f32x16 a1, a2;
#pragma unroll
            for (int i = 0; i < 16; ++i) { a1[i] = 0.f; a2[i] = 0.f; }
            bf16x8 fv[4], fs[4], fh[DN / 16], fq[DN / 16];
#pragma unroll
            for (int kk = 0; kk < 4; ++kk) {
                fv[kk] = tr_frag(lds + O_V, RSV, pb, kk, lane);
                fs[kk] = *(const LAS bf16x8*)(lds + O_S + (ib * 32 + r) * RSJ + (kk * 16 + 8 * hh) * 2);
            }
#pragma unroll
            for (int kk = 0; kk < DN / 16; ++kk) {
                fh[kk] = *(const LAS bf16x8*)(lds + O_HST + (pb * 32 + r) * RSQ + (kk * 16 + 8 * hh) * 2);
                fq[kk] = *(const LAS bf16x8*)(lds + O_Q + (ib * 32 + r) * RSQ + (kk * 16 + 8 * hh) * 2);
            }
            __builtin_amdgcn_sched_barrier(0);
#pragma unroll
            for (int kk = 0; kk < 4; ++kk) a1 = MFMA32(fv[kk], fs[kk], a1);
#pragma unroll
            for (int kk = 0; kk < DN / 16; ++kk) a2 = MFMA32(fh[kk], fq[kk], a2);
            const int i = ib * 32 + r; const float ei = __expf(*(const LAS float*)(lds + O_CUM + 4 * i));
            const int row = row_of(st, i);
#pragma unroll
            for (int g4 = 0; g4 < 4; ++g4) {
                const int p0 = pb * 32 + 8 * g4 + 4 * hh;
                v2u o; o.x = pk2(a1[4 * g4 + 0] + ei * a2[4 * g4 + 0], a1[4 * g4 + 1] + ei * a2[4 * g4 + 1]); o.y = pk2(a1[4 * g4 + 2] + ei * a2[4 * g4 + 2], a1[4 * g4 + 3] + ei * a2[4 * g4 + 3]);
                *(v2u*)(YS + (size_t)row * 1024 + ycol + p0) = o;
            }
        }
        {
            const int nb = w / (DP / 32), pb = w % (DP / 32);
#pragma unroll
            for (int i = 0; i < 16; ++i) Hs[i] *= dcy;
            bf16x8 fk[4], fw[4];
#pragma unroll
            for (int kk = 0; kk < 4; ++kk) {
                fk[kk] = tr_frag(lds + O_K2, RSK2, nb, kk, lane);
                fw[kk] = tr_frag(lds + O_VW, RSV, pb, kk, lane);
            }
            __builtin_amdgcn_sched_barrier(0);
#pragma unroll
            for (int kk = 0; kk < 4; ++kk) Hs = MFMA32(fk[kk], fw[kk], Hs);
            SCAN_BAR();
#pragma unroll
            for (int g4 = 0; g4 < 4; ++g4) {
                const int n0 = nb * 32 + 8 * g4 + 4 * hh;
                v2u o; o.x = pk2(Hs[4 * g4 + 0], Hs[4 * g4 + 1]); o.y = pk2(Hs[4 * g4 + 2], Hs[4 * g4 + 3]);
                *(LAS v2u*)(lds + O_HST + (pb * 32 + r) * RSQ + n0 * 2) = o;
            }
        }
    }
    }
    __syncthreads();
#undef SCAN_PREFETCH
}

__device__ __forceinline__ void phase_fin(Frame& F, int l, int nrows) {
    frame_refresh(F);
    const bf16* U = (const bf16*)(F.ws + WS_U); const bf16* YS = (const bf16*)(F.ws + WS_YS); bf16* YB = (bf16*)(F.ws + WS_YB);
    const float* nw = F.in[I_SSDNW] + (size_t)l * 1024; const float* dskp = F.in[I_SSDD] + (size_t)l * 16; const bf16* XBCA = (const bf16*)(F.ws + WS_XBCA);
    const int gw = F.bid * NWAVES + F.wave, NGW = F.G * NWAVES, lane = F.lane;
    for (int row = gw; row < nrows; row += NGW) {
        {
            float g[2][8]; float ss = 0.f;
#pragma unroll
            for (int k = 0; k < 2; ++k) { const int c = k * 512 + 8 * lane; float yf[8], yb[8], z[8];
                unpack8(*(const v4u*)(YS + (size_t)row * 1024 + c), yf); unpack8(*(const v4u*)(YS + YS_STRIDE + (size_t)row * 1024 + c), yb); unpack8(*(const v4u*)(U + (size_t)row * UC + U_Z + c), z);
                float xs[8]; unpack8(*(const v4u*)(XBCA + (size_t)row * 2048 + c), xs); const float dsk = dskp[c >> 6];
#pragma unroll
                for (int e = 0; e < 8; ++e) { g[k][e] = (yf[e] + yb[e] + dsk * xs[e]) * siluf_(z[e]); ss += g[k][e] * g[k][e]; } }
            const float rs = rsqrtf(wave_sum(ss) * (1.0f / 1024.0f) + EPS);
#pragma unroll
            for (int k = 0; k < 2; ++k) { const int c = k * 512 + 8 * lane; float wv[8], o[8]; ld8f(nw + c, wv);
#pragma unroll
                for (int e = 0; e < 8; ++e) o[e] = g[k][e] * rs * wv[e];
                *(v4u*)(YB + yb_off(row, c)) = pack8(o); }
        }
        {
            const int c = 16 * lane; float v[16];
            { float a[8], b2[8]; unpack8(*(const v4u*)(YS + 2 * YS_STRIDE + (size_t)row * 1024 + c), a); unpack8(*(const v4u*)(YS + 3 * YS_STRIDE + (size_t)row * 1024 + c), b2);
#pragma unroll
              for (int e = 0; e < 8; ++e) v[e] = a[e] + b2[e];
              unpack8(*(const v4u*)(YS + 2 * YS_STRIDE + (size_t)row * 1024 + c + 8), a); unpack8(*(const v4u*)(YS + 3 * YS_STRIDE + (size_t)row * 1024 + c + 8), b2);
#pragma unroll
              for (int e = 0; e < 8; ++e) v[8 + e] = a[e] + b2[e]; }
            float s = 0.f;
#pragma unroll
            for (int e = 0; e < 16; ++e) s += v[e];
            s = red8(s);
            const float mu = s * (1.0f / 128.0f); float q = 0.f;
#pragma unroll
            for (int e = 0; e < 16; ++e) { v[e] -= mu; q += v[e] * v[e]; }
            q = red8(q);
            const float rs = rsqrtf(q * (1.0f / 128.0f) + EPS);
            float g0[8], g1[8], o0[8], o1[8]; unpack8(*(const v4u*)(U + (size_t)row * UC + U_RG + c), g0); unpack8(*(const v4u*)(U + (size_t)row * UC + U_RG + c + 8), g1);
#pragma unroll
            for (int e = 0; e < 8; ++e) { o0[e] = siluf_(g0[e]) * v[e] * rs; o1[e] = siluf_(g1[e]) * v[8 + e] * rs; }
            *(v4u*)(YB + 3 * YS_STRIDE + yb_off(row, c)) = pack8(o0); *(v4u*)(YB + 3 * YS_STRIDE + yb_off(row, c + 8)) = pack8(o1);
        }
    }
}

__device__ __forceinline__ size_t act_off(int row, int col) { return (size_t)(row >> 8) * (256 * DFF) + (size_t)(col >> 6) * (256 * 64) + (size_t)((row & 255) * 64 + (col & 63)); }
__device__ __forceinline__ v4u ldedge(const bf16* EDGE, int blk, int j, int h, int c, bool ok) { return ok ? *(const v4u*)(EDGE + ((size_t)(blk * 4 + j) * 2 + h) * DFF + c) : (v4u){0u, 0u, 0u, 0u}; }
__device__ __forceinline__ void phase_ffnfix(Frame& F, int l, int nrows) {
    frame_refresh(F);
    const bf16* EDGE = (const bf16*)(F.ws + WS_UP); bf16* ACT = (bf16*)(F.ws + WS_ACT);
    const int gw = F.bid * NWAVES + F.wave, NGW = F.G * NWAVES, lane = F.lane;
    const int ntask = (nrows / 64) * 11;
    for (int task = gw; task < ntask; task += NGW) {
        const int blk = task / 11, cb = task % 11, c = cb * 512 + lane * 8, r0 = blk * 64; int s0, s1; seq_bounds(r0, s0, s1);
        const bool hp = r0 > s0, hn = r0 + 64 < s1;
        float wa0[8], wa1[8], wa2[8], ba[8], wb0[8], wb1[8], wb2[8], bb[8];
        const float* cw = F.in[I_FFNCW] + (size_t)l * 3 * UPC; const float* cbp = F.in[I_FFNCB] + (size_t)l * UPC;
        v4u ra[6], rb[6];
        ra[0] = ldedge(EDGE, blk - 1, 3, 0, c, hp); ra[1] = ldedge(EDGE, blk, 0, 0, c, true); ra[2] = ldedge(EDGE, blk, 1, 0, c, true);
        ra[3] = ldedge(EDGE, blk, 2, 0, c, true); ra[4] = ldedge(EDGE, blk, 3, 0, c, true); ra[5] = ldedge(EDGE, blk + 1, 0, 0, c, hn);
        rb[0] = ldedge(EDGE, blk - 1, 3, 1, c, hp); rb[1] = ldedge(EDGE, blk, 0, 1, c, true); rb[2] = ldedge(EDGE, blk, 1, 1, c, true);
        rb[3] = ldedge(EDGE, blk, 2, 1, c, true); rb[4] = ldedge(EDGE, blk, 3, 1, c, true); rb[5] = ldedge(EDGE, blk + 1, 0, 1, c, hn);
        ld8f(cw + c, wa0); ld8f(cw + UPC + c, wa1); ld8f(cw + 2 * UPC + c, wa2); ld8f(cbp + c, ba);
        ld8f(cw + DFF + c, wb0); ld8f(cw + UPC + DFF + c, wb1); ld8f(cw + 2 * UPC + DFF + c, wb2); ld8f(cbp + DFF + c, bb);
#pragma unroll
        for (int j = 0; j < 2; ++j) {
            float p[8], q[8], n[8], o[8], a[8];
            unpack8(ra[3 * j], p); unpack8(ra[3 * j + 1], q); unpack8(ra[3 * j + 2], n);
#pragma unroll
            for (int e = 0; e < 8; ++e) a[e] = siluf_(wa0[e] * p[e] + wa1[e] * q[e] + wa2[e] * n[e] + ba[e]);
            unpack8(rb[3 * j], p); unpack8(rb[3 * j + 1], q); unpack8(rb[3 * j + 2], n);
#pragma unroll
            for (int e = 0; e < 8; ++e) o[e] = a[e] * (wb0[e] * p[e] + wb1[e] * q[e] + wb2[e] * n[e] + bb[e]);
            *(v4u*)(ACT + act_off(r0 + 63 * j, c)) = pack8(o);
        }
    }
}

using pg8::f32x4; using pg8::Unit; using pg8::HALF; using pg8::BM;
__device__ __forceinline__ size_t gate_off(int pm, int gt, int wave, int frag, int lane) { return ((((size_t)pm * 32 + gt) * 8 + wave) * 8 + frag) * 1024 + (size_t)lane * 16; }
struct EpiInGate {
    static constexpr bool PERM = true, CHAIN = false;
    bf16* U; float* DT; unsigned char* G; const float* bg; int pn0;
    __device__ __forceinline__ void operator()(const f32x4 (&acc)[2][2][4][2], const Unit& u, int wr, int wc, int fr, int fq) const {
        const int row0 = u.pm * BM + wr * 64 + fr, pn = u.pn + pn0;
        if (pn < 40) {
            const int col0 = pn * BM + wc * 32 + 8 * fq;
#pragma unroll
            for (int ai = 0; ai < 2; ++ai)
#pragma unroll
                for (int m = 0; m < 4; ++m) { bf16* rowp = U + (size_t)(row0 + ai * HALF + m * 16) * UC + col0;
#pragma unroll
                    for (int bj = 0; bj < 2; ++bj) { const f32x4 v0 = acc[ai][bj][m][0], v1 = acc[ai][bj][m][1];
                        v4u w; w.x = pg8::cvt_pk_bf16(v0[0], v0[1]); w.y = pg8::cvt_pk_bf16(v0[2], v0[3]); w.z = pg8::cvt_pk_bf16(v1[0], v1[1]); w.w = pg8::cvt_pk_bf16(v1[2], v1[3]);
                        *(v4u*)(rowp + bj * HALF) = w; } }
        } else if (pn == 40) {
            if (wc == 0 && fq < 2) {
#pragma unroll
                for (int ai = 0; ai < 2; ++ai)
#pragma unroll
                    for (int m = 0; m < 4; ++m) { float* rp = DT + (size_t)(row0 + ai * HALF + m * 16) * 16 + 8 * fq; *(f32x4*)rp = acc[ai][0][m][0]; *(f32x4*)(rp + 4) = acc[ai][0][m][1]; }
            }
        } else {
            const int col0 = (pn - 41) * BM + wc * 32 + 8 * fq;
            f32x4 bv[2][2];
#pragma unroll
            for (int bj = 0; bj < 2; ++bj)
#pragma unroll
                for (int n = 0; n < 2; ++n) bv[bj][n] = *(const f32x4*)(bg + col0 + bj * HALF + 4 * n) * -1.44269504f;
            constexpr float QC = 1.0f / 255.99f;
#pragma unroll
            for (int ai = 0; ai < 2; ++ai)
#pragma unroll
                for (int m = 0; m < 4; ++m) { unsigned char* rowp = G + gate_off(u.pm, pn - 41, wr * 4 + wc, ai * 4 + m, fq * 16 + fr); v4u w4;
#pragma unroll
                    for (int bj = 0; bj < 2; ++bj) {
                        unsigned q[8];
#pragma unroll
                        for (int e = 0; e < 4; ++e) {
                            const float e0 = __builtin_amdgcn_exp2f(__builtin_fmaf(acc[ai][bj][m][0][e], -1.44269504f, bv[bj][0][e])), e1 = __builtin_amdgcn_exp2f(__builtin_fmaf(acc[ai][bj][m][1][e], -1.44269504f, bv[bj][1][e]));
                            q[e] = (unsigned)__builtin_amdgcn_rcpf(__builtin_fmaf(e0, QC, QC)); q[4 + e] = (unsigned)__builtin_amdgcn_rcpf(__builtin_fmaf(e1, QC, QC)); }
                        v2u w; w.x = q[0] | (q[1] << 8) | (q[2] << 16) | (q[3] << 24); w.y = q[4] | (q[5] << 8) | (q[6] << 16) | (q[7] << 24);
                        if (bj == 0) { w4.x = w.x; w4.y = w.y; } else { w4.z = w.x; w4.w = w.y; } }
                    *(v4u*)rowp = w4; }
        }
    }
};
template <bool SCALE> struct EpiBf16 {
    static constexpr bool PERM = true, CHAIN = false;
    bf16* O; int ldc; const float* scale;
    __device__ __forceinline__ int operator()(const f32x4 (&acc)[2][2][4][2], const Unit& u, int wr, int wc, int fr, int fq) const {
        const int row0 = u.pm * BM + wr * 64 + fr, col0 = u.pn * BM + wc * 32 + 8 * fq;
        f32x4 sv[2][2];
        if (SCALE) {
#pragma unroll
            for (int bj = 0; bj < 2; ++bj)
#pragma unroll
                for (int n = 0; n < 2; ++n) sv[bj][n] = *(const f32x4*)(scale + col0 + bj * HALF + 4 * n);
        }
#pragma unroll
        for (int ai = 0; ai < 2; ++ai)
#pragma unroll
            for (int m = 0; m < 4; ++m) {
#pragma unroll
                for (int bj = 0; bj < 2; ++bj) { f32x4 v0 = acc[ai][bj][m][0], v1 = acc[ai][bj][m][1];
                    if (SCALE) { v0 = v0 * sv[bj][0]; v1 = v1 * sv[bj][1]; }
                    v4u w; w.x = pg8::cvt_pk_bf16(v0[0], v0[1]); w.y = pg8::cvt_pk_bf16(v0[2], v0[3]); w.z = pg8::cvt_pk_bf16(v1[0], v1[1]); w.w = pg8::cvt_pk_bf16(v1[2], v1[3]);
                    *(v4u*)(O + yb_off(row0 + ai * HALF + m * 16, col0 + bj * HALF)) = w; } }
        return 16;
    }
};
struct EpiFfn {
    static constexpr bool PERM = true, CHAIN = false;
    bf16* ACT; bf16* EDGE; const float* cw; const float* cb;
    template <int CTRL> static __device__ __forceinline__ float dpp(float x) { return __builtin_bit_cast(float, __builtin_amdgcn_update_dpp(0, __builtin_bit_cast(int, x), CTRL, 0xf, 0xf, true)); }
    template <int M> static __device__ __forceinline__ f32x4 conv4(const f32x4 (&x)[4][2], int n, const f32x4 (&w)[4], const f32x4 we0, const f32x4 we2) {
        f32x4 r;
#pragma unroll
        for (int e = 0; e < 4; ++e) { const float c = x[M][n][e];
            float t = __builtin_fmaf(w[1][e], c, w[3][e]);
            t = __builtin_fmaf(w[0][e], dpp<0x111>(c), t);
            t = __builtin_fmaf(w[2][e], dpp<0x101>(c), t);
            if (M > 0) t = __builtin_fmaf(we0[e], dpp<0x121>(x[M > 0 ? M - 1 : 0][n][e]), t);
            if (M < 3) t = __builtin_fmaf(we2[e], dpp<0x12f>(x[M < 3 ? M + 1 : 3][n][e]), t);
            r[e] = t; }
        return r;
    }
    template <int M> __device__ __forceinline__ v2u act4(const f32x4 (&xa)[4][2], const f32x4 (&xb)[4][2], int n, const f32x4 (&wa)[4], const f32x4 (&wb)[4], const f32x4 wae0, const f32x4 wae2, const f32x4 wbe0, const f32x4 wbe2) const {
        const f32x4 va = conv4<M>(xa, n, wa, wae0, wae2), vb = conv4<M>(xb, n, wb, wbe0, wbe2);
        float o[4];
#pragma unroll
        for (int e = 0; e < 4; ++e) o[e] = va[e] * __builtin_amdgcn_rcpf(1.0f + __builtin_amdgcn_exp2f(va[e] * -1.44269504f)) * vb[e];
        v2u r; r.x = pk2(o[0], o[1]); r.y = pk2(o[2], o[3]); return r;
    }
    __device__ __forceinline__ void operator()(const f32x4 (&acc)[2][2][4][2], const Unit& u, int wr, int wc, int fr, int fq) const {
        const int row0 = u.pm * BM + wr * 64 + fr, c0 = u.pn * 128 + wc * 32 + 8 * fq;
        const float e0 = fr == 0 ? 1.f : 0.f, e15 = fr == 15 ? 1.f : 0.f;
#pragma unroll
        for (int ai = 0; ai < 2; ++ai) {
            const int blk = u.pm * 4 + ai * 2 + wr;
            if (fr < 2 || fr >= 14) {
                const int j = fr < 2 ? fr : fr - 12;
                const f32x4 a0 = fr < 2 ? acc[ai][0][0][0] : acc[ai][0][3][0], a1 = fr < 2 ? acc[ai][0][0][1] : acc[ai][0][3][1];
                const f32x4 b0 = fr < 2 ? acc[ai][1][0][0] : acc[ai][1][3][0], b1 = fr < 2 ? acc[ai][1][0][1] : acc[ai][1][3][1];
                bf16* ep = EDGE + ((size_t)(blk * 4 + j) * 2) * DFF + c0;
                v4u w; w.x = pk2(a0[0], a0[1]); w.y = pk2(a0[2], a0[3]); w.z = pk2(a1[0], a1[1]); w.w = pk2(a1[2], a1[3]); *(v4u*)ep = w;
                w.x = pk2(b0[0], b0[1]); w.y = pk2(b0[2], b0[3]); w.z = pk2(b1[0], b1[1]); w.w = pk2(b1[2], b1[3]); *(v4u*)(ep + DFF) = w;
            }
        }
        __builtin_amdgcn_sched_barrier(0);
        v2u op[2][4];
#pragma unroll
        for (int n = 0; n < 2; ++n) {
            f32x4 wa[4], wb[4];
#pragma unroll
            for (int k = 0; k < 3; ++k) { wa[k] = *(const f32x4*)(cw + k * UPC + c0 + 4 * n); wb[k] = *(const f32x4*)(cw + k * UPC + DFF + c0 + 4 * n); }
            wa[3] = *(const f32x4*)(cb + c0 + 4 * n); wb[3] = *(const f32x4*)(cb + DFF + c0 + 4 * n);
            const f32x4 wae0 = wa[0] * e0, wae2 = wa[2] * e15, wbe0 = wb[0] * e0, wbe2 = wb[2] * e15;
#pragma unroll
            for (int ai = 0; ai < 2; ++ai) {
                v2u r[4];
                r[0] = act4<0>(acc[ai][0], acc[ai][1], n, wa, wb, wae0, wae2, wbe0, wbe2); r[1] = act4<1>(acc[ai][0], acc[ai][1], n, wa, wb, wae0, wae2, wbe0, wbe2);
                r[2] = act4<2>(acc[ai][0], acc[ai][1], n, wa, wb, wae0, wae2, wbe0, wbe2); r[3] = act4<3>(acc[ai][0], acc[ai][1], n, wa, wb, wae0, wae2, wbe0, wbe2);
#pragma unroll
                for (int m = 0; m < 4; ++m) {
                    if (n == 0) op[ai][m] = r[m];
                    else { v4u w; w.x = op[ai][m].x; w.y = op[ai][m].y; w.z = r[m].x; w.w = r[m].y; *(v4u*)(ACT + act_off(row0 + ai * HALF + m * 16, c0)) = w; }
                }
            }
            __builtin_amdgcn_sched_barrier(0);
        }
    }
};
struct EpiBranch {
    static constexpr bool PERM = true, CHAIN = true;
    const unsigned char* G; bf16* MERGED; int skip;
    static __device__ __forceinline__ void deq8(const v2u w, float (&g)[8]) {
        g[0] = (float)(w.x & 0xffu); g[1] = (float)((w.x >> 8) & 0xffu); g[2] = (float)((w.x >> 16) & 0xffu); g[3] = (float)(w.x >> 24);
        g[4] = (float)(w.y & 0xffu); g[5] = (float)((w.y >> 8) & 0xffu); g[6] = (float)((w.y >> 16) & 0xffu); g[7] = (float)(w.y >> 24);
#pragma unroll
        for (int e = 0; e < 8; ++e) g[e] = (g[e] + 0.5f) * (1.0f / 256.0f);
    }
    static __device__ __forceinline__ void deqs(const v2u w, float (&g)[8], float sc) {
        g[0] = (float)(w.x & 0xffu); g[1] = (float)((w.x >> 8) & 0xffu); g[2] = (float)((w.x >> 16) & 0xffu); g[3] = (float)(w.x >> 24);
        g[4] = (float)(w.y & 0xffu); g[5] = (float)((w.y >> 8) & 0xffu); g[6] = (float)((w.y >> 16) & 0xffu); g[7] = (float)(w.y >> 24);
        const float hb = 0.5f * sc;
#pragma unroll
        for (int e = 0; e < 8; ++e) g[e] = __builtin_fmaf(g[e], sc, hb);
    }
    __device__ __forceinline__ bool operator()(f32x4 (&acc)[2][2][4][2], const Unit& u, int wr, int wc, int fr, int fq) const {
        const int row0 = u.pm * BM + wr * 64 + fr, col0 = u.pn * BM + wc * 32 + 8 * fq, sub = u.sub;
        const int subn = sub < 3 ? sub + 1 : sub;
        if (skip) return sub == 3;
        const int wave = wr * 4 + wc, ln = fq * 16 + fr;
        const bool last = sub == 3;
        const float sg = last ? 127.5f / 65536.0f : 1.0f / 256.0f;
        v4u gv4[2][4], hv4[2][4];
#pragma unroll
        for (int ai = 0; ai < 2; ++ai)
#pragma unroll
            for (int m = 0; m < 4; ++m)
                { gv4[ai][m] = *(const v4u*)(G + gate_off(u.pm, sub * 8 + u.pn, wave, ai * 4 + m, ln)); hv4[ai][m] = *(const v4u*)(G + gate_off(u.pm, subn * 8 + u.pn, wave, ai * 4 + m, ln)); }
        __builtin_amdgcn_sched_barrier(0);
#pragma unroll
        for (int ai = 0; ai < 2; ++ai)
#pragma unroll
            for (int m = 0; m < 4; ++m)
#pragma unroll
                for (int bj = 0; bj < 2; ++bj) {
                    v2u gw, hw; gw.x = bj ? gv4[ai][m].z : gv4[ai][m].x; gw.y = bj ? gv4[ai][m].w : gv4[ai][m].y; hw.x = bj ? hv4[ai][m].z : hv4[ai][m].x; hw.y = bj ? hv4[ai][m].w : hv4[ai][m].y;
                    if (last) { hw.x = 0x7f7f7f7fu; hw.y = 0x7f7f7f7fu; }
                    float g[8], h[8]; deqs(gw, g, sg); deqs(hw, h, 1.0f / 256.0f);
#pragma unroll
                    for (int e = 0; e < 8; ++e) g[e] = g[e] * __builtin_amdgcn_rcpf(h[e]);
                    f32x4& v0 = acc[ai][bj][m][0]; f32x4& v1 = acc[ai][bj][m][1];
                    v0[0] *= g[0]; v0[1] *= g[1]; v0[2] *= g[2]; v0[3] *= g[3]; v1[0] *= g[4]; v1[1] *= g[5]; v1[2] *= g[6]; v1[3] *= g[7];
                    if (bj == 1) __builtin_amdgcn_sched_barrier(0);
                }
        if (last) {
#pragma unroll
            for (int ai = 0; ai < 2; ++ai)
#pragma unroll
                for (int m = 0; m < 4; ++m)
#pragma unroll
                    for (int bj = 0; bj < 2; ++bj) {
                        const f32x4 v0 = acc[ai][bj][m][0], v1 = acc[ai][bj][m][1];
                        v4u w; w.x = pg8::cvt_pk_bf16(v0[0], v0[1]); w.y = pg8::cvt_pk_bf16(v0[2], v0[3]); w.z = pg8::cvt_pk_bf16(v1[0], v1[1]); w.w = pg8::cvt_pk_bf16(v1[2], v1[3]);
                        *(v4u*)(MERGED + (size_t)(row0 + ai * HALF + m * 16) * 2048 + col0 + bj * HALF) = w;
                    }
        }
        return last;
    }
};
struct EpiResid {
    static constexpr bool PERM = true, CHAIN = false;
    bf16* X; const float* modl; int goff, skip;
    __device__ __forceinline__ void operator()(const f32x4 (&acc)[2][2][4][2], const Unit& u, int wr, int wc, int fr, int fq) const {
        if (skip) return;
        const int row0 = u.pm * BM + wr * 64 + fr, col0 = u.pn * BM + wc * 32 + 8 * fq;
        const float* gp = modl + (size_t)(u.pm < 64 ? (u.pm >> 4) : 4) * 12288 + goff + col0;
        f32x4 gv[2][2];
#pragma unroll
        for (int bj = 0; bj < 2; ++bj)
#pragma unroll
            for (int n = 0; n < 2; ++n) gv[bj][n] = *(const f32x4*)(gp + bj * HALF + 4 * n);
#pragma unroll
        for (int ai = 0; ai < 2; ++ai) {
            v4u xv[4][2];
#pragma unroll
            for (int m = 0; m < 4; ++m)
#pragma unroll
                for (int bj = 0; bj < 2; ++bj) xv[m][bj] = *(const v4u*)(X + (size_t)(row0 + ai * HALF + m * 16) * D + col0 + bj * HALF);
#pragma unroll
            for (int m = 0; m < 4; ++m)
#pragma unroll
                for (int bj = 0; bj < 2; ++bj) {
                    v2u lo; lo.x = xv[m][bj].x; lo.y = xv[m][bj].y; v2u hi; hi.x = xv[m][bj].z; hi.y = xv[m][bj].w;
                    const v2u a = pack4(unpack4(lo) + gv[bj][0] * acc[ai][bj][m][0]), b = pack4(unpack4(hi) + gv[bj][1] * acc[ai][bj][m][1]);
                    v4u w; w.x = a.x; w.y = a.y; w.z = b.x; w.w = b.y;
                    *(v4u*)(X + (size_t)(row0 + ai * HALF + m * 16) * D + col0 + bj * HALF) = w;
                }
        }
    }
};

struct EpiPart {
    static constexpr bool PERM = false, CHAIN = false;
    float* PART; const float* modl; int goff;
    __device__ __forceinline__ int operator()(const f32x4 (&acc)[2][2][4][2], const Unit& u, int wr, int wc, int fr, int fq) const {
        const int row0 = (u.pm - 64) * BM + wr * 64 + fr, col0 = u.pn * BM + wc * 32 + 4 * fq;
        const float* gp = modl + (size_t)4 * 12288 + goff + col0;
        float* P = PART + (size_t)u.sub * MC * D;
        f32x4 gv[2][2];
#pragma unroll
        for (int bj = 0; bj < 2; ++bj)
#pragma unroll
            for (int n = 0; n < 2; ++n) gv[bj][n] = *(const f32x4*)(gp + bj * HALF + n * 16);
#pragma unroll
        for (int ai = 0; ai < 2; ++ai)
#pragma unroll
            for (int m = 0; m < 4; ++m)
#pragma unroll
                for (int bj = 0; bj < 2; ++bj)
#pragma unroll
                    for (int n = 0; n < 2; ++n) *(f32x4*)(P + (size_t)(row0 + ai * HALF + m * 16) * D + col0 + bj * HALF + n * 16) = gv[bj][n] * acc[ai][bj][m][n];
        return 32;
    }
};

constexpr int NPH = 11;
constexpr int N_PHASES = 1 + DEPTH * NPH + 1;

__global__ void __launch_bounds__(NWAVES * 64, 2) fwd_kernel(Args args) {
    extern __shared__ __attribute__((aligned(16))) unsigned char lds_raw[];
    Frame F;
    F.lds = (LAS unsigned char*)lds_raw;
    F.tid = threadIdx.x; F.lane = F.tid & 63; F.wave = __builtin_amdgcn_readfirstlane(F.tid >> 6);
    F.G = gridDim.x; F.bid = blockIdx.x; F.ws = args.ws; F.in = args.in;
#if defined(PROBE_K)
    F.variant = args.variant;
#else
    F.variant = 0;
#endif
    gu32* ctl = (gu32*)(args.ws + WS_CTL);
    for (int u = F.tid; u < (LDS_BYTES - LDSCTL_OFF) / 4; u += NWAVES * 64) ((LAS unsigned*)(F.lds + LDSCTL_OFF))[u] = 0u;
    __syncthreads();
    XcdBarrier bar; bar.bar = (unsigned*)(ctl + CW_BAR); bar.x = 0; bar.st = nullptr;
    if (!MK_PER_PHASE && args.ph_hi - args.ph_lo > 1) bar = xcd_barrier_post((unsigned*)(ctl + CW_BAR), (volatile LAS unsigned*)(F.lds + MISC_OFF) + 8);
    const int lo = args.ph_lo, hi = args.ph_hi;
#ifndef PH_MASK
#define PH_MASK 0xFFFF
#endif
#define EN(b) (((PH_MASK) >> (b)) & 1)
#define IN(k) (lo <= (k) && (k) < hi)
#define SEAM(k) do { if (!MK_PER_PHASE && IN((k) + 1)) xcd_barrier(bar); } while (0)

    if (EN(11) && IN(0)) { phase_mod(F); steal_convert(F, 0, 0, true); SEAM(0); }

    for (int l = 0; l < DEPTH; ++l) {
        const int p0 = 1 + l * NPH;
        const int nrows = (l == DEPTH - 1) ? ML : M;
        const int nMp = nrows / 256;
        const float* modl = (const float*)(F.ws + WS_MOD) + (size_t)l * 5 * 12288;
        const unsigned char* wb = F.ws + (size_t)(l & 1) * W_SPAN;
        const bool cv = l + 1 < DEPTH;
        if (EN(0) && IN(p0 + 0)) {
            if (l == 0) phase_norm<true>(F, l, F.in[I_NORM1] + (size_t)l * D, 0, 2048, M);
            else phase_norm<false>(F, l, F.in[I_NORM1] + (size_t)l * D, 0, 2048, M, true);
            SEAM(p0 + 0);
        }
        if (EN(1) && IN(p0 + 1)) {
            const bool two = (nrows == ML);
            {
                pg8::Gemm g{(const char*)(F.ws + WS_H), (const char*)(wb + WS_WIG), (size_t)256 * D * 2, 0, 0, (size_t)256 * D * 2, 0, D, D, D};
                pg8::TileOrder<1> S; S.init(M / 256, two ? 41 : NIG / 256, F.G, F.bid);
                EpiInGate E{(bf16*)(F.ws + WS_U), (float*)(F.ws + WS_DT), (unsigned char*)(F.ws + WS_G), F.in[I_BGATE] + (size_t)l * 4 * 2048, 0};
                pg8::gemm_phase(F.lds + RING_OFF, g, S, E);
            }
            if (two) {
                pg8::Gemm g{(const char*)(F.ws + WS_H), (const char*)(wb + WS_WIG) + (size_t)41 * 256 * D * 2, (size_t)256 * D * 2, 0, 0, (size_t)256 * D * 2, 0, D, D, D};
                pg8::TileOrder<1> S; S.init(ML / 256, 32, F.G, F.bid);
                EpiInGate E{(bf16*)(F.ws + WS_U), (float*)(F.ws + WS_DT), (unsigned char*)(F.ws + WS_G), F.in[I_BGATE] + (size_t)l * 4 * 2048, 41};
                pg8::gemm_phase(F.lds + RING_OFF, g, S, E);
            }
            if (cv) steal_convert(F, l + 1, 1 + l * 6 + 0, false);
            SEAM(p0 + 1);
        }
        if (EN(2) && IN(p0 + 2)) { phase_pre(F, l); SEAM(p0 + 2); }
        if (EN(3) && IN(p0 + 3)) {
            const int nscan = 192;
            const bool split = F.G > nscan;
            for (int id = F.bid; id < nscan; id += F.G) {
#ifndef NO_SSD
                if (id < 128) scan_unit<128, 64, true>(F, l, id >> 5, (id >> 1) & 15, id & 1);
                else
#endif
#ifndef NO_RET
                { const int j = id - 128; scan_unit<64, 128, false>(F, l, j >> 4, (j >> 1) & 7, j & 1); }
#else
                {}
#endif
            }
#ifndef NO_POOLG
            if (!split || F.bid >= nscan) {
                pg8::Gemm g{(const char*)(F.ws + WS_POOLED), (const char*)(wb + WS_WPOOL), (size_t)256 * 1024 * 2, (size_t)256 * 2, 0, (size_t)256 * 256 * 2, 0, 1024, 256, 256};
                pg8::TileOrder<1> S; S.init(M / 256, 4, split ? F.G - nscan : F.G, split ? F.bid - nscan : F.bid);
                EpiBf16<true> E{(bf16*)(F.ws + WS_YB) + YS_STRIDE, 1024, F.in[I_POOLS] + (size_t)l * 1024};
                pg8::gemm_phase(F.lds + RING_OFF, g, S, E);
                sc_phase(F, l, split ? F.bid - nscan : F.bid, split ? F.G - nscan : F.G);
            }
            if (cv) steal_convert(F, l + 1, 1 + l * 6 + 5, false);
#endif
            SEAM(p0 + 3);
        }
        if (EN(4) && IN(p0 + 4)) { phase_fin(F, l, nrows); SEAM(p0 + 4); }
        if (EN(5) && IN(p0 + 5)) {
            pg8::Gemm g{(const char*)(F.ws + WS_YB), (const char*)(wb + WS_WB), (size_t)256 * 1024 * 2, 0, YS_STRIDE * 2, (size_t)256 * 1024 * 2, (size_t)2048 * 1024 * 2, 64, 1024, 1024, (size_t)256 * 64 * 2};
            pg8::TileOrder<4> S; S.init(nMp, D / 256, F.G, F.bid, 8);
            EpiBranch E{(const unsigned char*)(F.ws + WS_G), (bf16*)(F.ws + WS_MERGED), F.variant & 128};
            pg8::gemm_phase(F.lds + RING_OFF, g, S, E);
            if (cv) steal_convert(F, l + 1, 1 + l * 6 + 1, false);
            SEAM(p0 + 5);
        }
        if (EN(6) && IN(p0 + 6)) {
            pg8::Gemm g{(const char*)(F.ws + WS_MERGED), (const char*)(wb + WS_WO), (size_t)256 * D * 2, 0, 0, (size_t)256 * D * 2, 0, D, D, D};
            pg8::TileOrder<1> S; S.init(ML / 256, D / 256, F.G, F.bid);
            EpiResid E{(bf16*)(F.ws + WS_X), modl, 4096, F.variant & 128};
            pg8::gemm_phase(F.lds + RING_OFF, g, S, E);
            if (nMp > ML / 256) {
                pg8::Gemm g2{(const char*)(F.ws + WS_MERGED), (const char*)(wb + WS_WO), (size_t)256 * D * 2, 0, (size_t)(D / 4) * 2, (size_t)256 * D * 2, (size_t)(D / 4) * 2, D, D, D / 4};
                pg8::SplitOrder<4> S2; S2.init(nMp - ML / 256, D / 256, ML / 256, F.G, F.bid);
                EpiPart E2{(float*)(F.ws + WS_PART), modl, 4096};
                pg8::gemm_phase(F.lds + RING_OFF, g2, S2, E2);
            }
            if (cv) steal_convert(F, l + 1, 1 + l * 6 + 2, false);
            SEAM(p0 + 6);
        }
        if (EN(7) && IN(p0 + 7)) { phase_norm<false>(F, l, F.in[I_NORM2] + (size_t)l * D, 6144, 8192, nrows, nrows > ML); SEAM(p0 + 7); }
        if (EN(8) && IN(p0 + 8)) {
            pg8::Gemm g{(const char*)(F.ws + WS_H), (const char*)(wb + WS_WUP), (size_t)256 * D * 2, 0, 0, (size_t)256 * D * 2, 0, D, D, D};
            pg8::TileOrder<1> S; S.init(nMp, UPC / 256, F.G, F.bid);
            EpiFfn E{(bf16*)(F.ws + WS_ACT), (bf16*)(F.ws + WS_UP), F.in[I_FFNCW] + (size_t)l * 3 * UPC, F.in[I_FFNCB] + (size_t)l * UPC};
            pg8::gemm_phase(F.lds + RING_OFF, g, S, E);
            if (cv) steal_convert(F, l + 1, 1 + l * 6 + 3, false);
            SEAM(p0 + 8);
        }
        if (EN(9) && IN(p0 + 9)) { phase_ffnfix(F, l, nrows); SEAM(p0 + 9); }
        if (EN(10) && IN(p0 + 10)) {
            pg8::Gemm g{(const char*)(F.ws + WS_ACT), (const char*)(wb + WS_WDN), (size_t)256 * DFF * 2, 0, 0, (size_t)256 * DFF * 2, 0, 64, DFF, DFF, (size_t)256 * 64 * 2};
            pg8::TileOrder<1> S; S.init(ML / 256, D / 256, F.G, F.bid, 2);
            EpiResid E{(bf16*)(F.ws + WS_X), modl, 10240, F.variant & 128};
            pg8::gemm_phase(F.lds + RING_OFF, g, S, E);
            if (nMp > ML / 256) {
                pg8::Gemm g2{(const char*)(F.ws + WS_ACT), (const char*)(wb + WS_WDN), (size_t)256 * DFF * 2, 0, (size_t)(DFF / 4 / 64) * 256 * 64 * 2, (size_t)256 * DFF * 2, (size_t)(DFF / 4) * 2, 64, DFF, DFF / 4, (size_t)256 * 64 * 2};
                pg8::SplitOrder<4> S2; S2.init(nMp - ML / 256, D / 256, ML / 256, F.G, F.bid);
                EpiPart E2{(float*)(F.ws + WS_PART), modl, 10240};
                pg8::gemm_phase(F.lds + RING_OFF, g2, S2, E2);
            }
            if (cv) steal_convert(F, l + 1, 1 + l * 6 + 4, true);
            SEAM(p0 + 10);
        }
    }
    if (EN(12) && IN(N_PHASES - 1)) {
        phase_final(F, args.out);
    }
#undef IN
#undef SEAM
}

extern "C" void kernel_launch(void* const* d_in, const int* in_sizes, int n_in, void* d_out, int out_size, void* d_ws, size_t ws_size, hipStream_t stream) {
    static int grid = 0;
    if (grid == 0) {
        if (n_in != 28 || in_sizes[0] != ML * D || out_size != ML * D || ws_size < WS_END) { fprintf(stderr, "kernel_launch: unexpected shapes (n_in %d, in0 %d, out %d, ws %zu < %zu); nothing launched\n", n_in, n_in > 0 ? in_sizes[0] : -1, out_size, ws_size, (size_t)WS_END); grid = -1; return; }
        int dev = 0, cus = 0, per_cu = 0;
        if (hipGetDevice(&dev) != hipSuccess || hipDeviceGetAttribute(&cus, hipDeviceAttributeMultiprocessorCount, dev) != hipSuccess) { fprintf(stderr, "kernel_launch: device query failed\n"); grid = -1; return; }
        if (hipFuncSetAttribute((const void*)fwd_kernel, hipFuncAttributeMaxDynamicSharedMemorySize, LDS_BYTES) != hipSuccess) { fprintf(stderr, "kernel_launch: hipFuncSetAttribute failed\n"); grid = -1; return; }
        if (hipOccupancyMaxActiveBlocksPerMultiprocessor(&per_cu, (const void*)fwd_kernel, NWAVES * 64, LDS_BYTES) != hipSuccess || per_cu < 1)
            fprintf(stderr, "kernel_launch: note: occupancy query reports %d workgroups per CU\n", per_cu);
        (void)hipGetLastError();
        grid = cus;
    }
    if (grid < 0) return;
    if (hipMemsetAsync((char*)d_ws + WS_CTL, 0, CTL_ZERO_BYTES, stream) != hipSuccess) { fprintf(stderr, "kernel_launch: memset failed\n"); return; }
    Args a{};
    for (int i = 0; i < 28; ++i) a.in[i] = (const float*)d_in[i];
    a.out = (float*)d_out; a.ws = (unsigned char*)d_ws;
#if defined(PROBE_K)
    a.ph_lo = 0; a.ph_hi = N_PHASES;
    hipLaunchKernelGGL(fwd_kernel, dim3(grid), dim3(NWAVES * 64), LDS_BYTES, stream, a);
    for (int rep = 0; rep < PROBE_REPS; ++rep) for (int l = 0; l < DEPTH; ++l) { a.ph_lo = 1 + l * NPH + PROBE_K; a.ph_hi = a.ph_lo + 1; a.variant = PROBE_VARIANT; hipLaunchKernelGGL(fwd_kernel, dim3(grid), dim3(NWAVES * 64), LDS_BYTES, stream, a); }
#elif MK_PER_PHASE
    for (int p = 0; p < N_PHASES; ++p) { a.ph_lo = p; a.ph_hi = p + 1; hipLaunchKernelGGL(fwd_kernel, dim3(grid), dim3(NWAVES * 64), LDS_BYTES, stream, a); }
#else
    a.ph_lo = 0; a.ph_hi = N_PHASES;
    hipLaunchKernelGGL(fwd_kernel, dim3(grid), dim3(NWAVES * 64), LDS_BYTES, stream, a);
#endif
    const hipError_t le = hipPeekAtLastError();
    if (le != hipSuccess) fprintf(stderr, "kernel_launch: launch failed: %s\n", hipGetErrorName(le));
}
```
